# Optimizing an MI355X kernel written in HIP

```python
import jax, jax.numpy as jnp
from jax import lax
import numpy as np

D_MODEL = 2048
BATCH = 32
SEQ = 256
DEPTH = 4
DEC_BATCH = 2
DEC_SEQ = 1024
PAST_LEN = 512

GRID_W = 64
A_GROUPS = 8
A_GROUP_DIM = 128
A_WIDTH = A_GROUPS * A_GROUP_DIM
A_CHUNK = 128
B_HEADS = 8
B_HEAD_DIM = 128
B_WIDTH = B_HEADS * B_HEAD_DIM
NB_ROWS_MAX = 8
NB_COLS = 16
ROPE_THETA = 10000.0
CTX_Q_BLOCK = 128
C_HEADS = 8
C_KEY_DIM = 128
C_VAL_DIM = 128
C_FWIDTH = C_HEADS * C_KEY_DIM
C_VWIDTH = C_HEADS * C_VAL_DIM
C_CHUNK = 32
D_FF = -(-8 * D_MODEL // (3 * 256)) * 256
NORM_EPS = 1e-6
NEG_INF = -1e30
IN_SIZES = (A_WIDTH, A_WIDTH, B_WIDTH, B_WIDTH, B_WIDTH, C_FWIDTH, C_FWIDTH, C_FWIDTH,
            C_VWIDTH, C_VWIDTH, D_MODEL, D_MODEL, D_MODEL)
IN_WIDTH = sum(IN_SIZES)

kernel_name = 'hybrid_flow_prefix_trunk'


def rmsnorm(x, g=None):
    xf = x.astype(jnp.float32)
    y = xf * lax.rsqrt(jnp.mean(xf * xf, -1, keepdims=True) + NORM_EPS)
    if g is not None:
        y = y * g.astype(jnp.float32)
    return y.astype(x.dtype)


def layernorm_plain(x):
    xf = x.astype(jnp.float32)
    mu = jnp.mean(xf, -1, keepdims=True)
    var = jnp.mean(jnp.square(xf - mu), -1, keepdims=True)
    return ((xf - mu) * lax.rsqrt(var + NORM_EPS)).astype(x.dtype)


def split_cols(z):
    out, start = [], 0
    for size in IN_SIZES:
        out.append(z[..., start:start + size])
        start += size
    return out


def ada_mod(cond, w_ada_l, b_ada_l):
    m = jax.nn.silu(cond) @ w_ada_l + b_ada_l
    return jnp.split(m[:, None, :], 6, axis=-1)


def axial_rope(x):
    n, hd = x.shape[1], x.shape[-1]
    ax = hd // 2
    pos = jnp.arange(n)
    inv = ROPE_THETA ** (-jnp.arange(0, ax, 2, dtype=jnp.float32) / ax)

    def rot(xa, p):
        ang = p.astype(jnp.float32)[:, None] * inv[None, :]
        ang = jnp.concatenate([ang, ang], -1)[None, :, None, :]
        x1, x2 = jnp.split(xa, 2, axis=-1)
        return xa * jnp.cos(ang) + jnp.concatenate([-x2, x1], -1) * jnp.sin(ang)

    xf = x.astype(jnp.float32)
    out = jnp.concatenate([rot(xf[..., :ax], pos // GRID_W), rot(xf[..., ax:], pos % GRID_W)], -1)
    return out.astype(x.dtype)


def chunk_mlp(u, v, w_s, b_s):
    bsz, n, _ = u.shape
    u = jax.nn.gelu(u)
    v = layernorm_plain(jax.nn.gelu(v))
    vr = v.reshape(bsz, n // A_CHUNK, A_CHUNK, A_GROUPS, A_GROUP_DIM)
    z = jnp.einsum('gts,bnsgc->bntgc', w_s, vr) + b_s.T[:, :, None]
    return u * z.reshape(bsz, n, A_WIDTH)


def ctx_attention(q, k, v):
    bsz, n, h, hd = q.shape
    scale = hd ** -0.5
    qb = q.reshape(bsz, n // CTX_Q_BLOCK, CTX_Q_BLOCK, h, hd).swapaxes(0, 1)

    def block(q_blk):
        s = jnp.einsum('bqhd,blhd->bhql', q_blk, k).astype(jnp.float32) * scale
        p = jax.nn.softmax(s, axis=-1).astype(v.dtype)
        return jnp.einsum('bhql,blhd->bqhd', p, v)

    return lax.map(block, qb).swapaxes(0, 1).reshape(bsz, n, h, hd)


def nbhd_attention(q, k, v, k_ctx, v_ctx, rpb):
    bsz, n, h, hd = q.shape
    rows = n // GRID_W
    wr = min(NB_ROWS_MAX, rows)
    scale = hd ** -0.5
    grid = lambda t: t.reshape(bsz, rows, GRID_W, h, hd)
    qg, kg, vg = grid(q), grid(k), grid(v)
    cols = jnp.arange(GRID_W)
    c_start = jnp.clip(cols - NB_COLS // 2, 0, GRID_W - NB_COLS)
    col_ok = (cols[None, :] >= c_start[:, None]) & (cols[None, :] < c_start[:, None] + NB_COLS)
    dc_idx = jnp.clip(cols[None, :] - cols[:, None] + NB_COLS - 1, 0, 2 * NB_COLS - 2)
    rpb_cols = rpb[:, :, dc_idx]
    n_loc = wr * GRID_W

    def row_block(r):
        r_start = jnp.clip(r - wr // 2, 0, rows - wr)
        q_r = lax.dynamic_index_in_dim(qg, r, axis=1, keepdims=False)
        k_r = lax.dynamic_slice_in_dim(kg, r_start, wr, axis=1)
        v_r = lax.dynamic_slice_in_dim(vg, r_start, wr, axis=1)
        dr_idx = r_start + jnp.arange(wr) - r + NB_ROWS_MAX - 1
        bias = jnp.take(rpb_cols, dr_idx, axis=1).transpose(0, 2, 1, 3).astype(jnp.float32)
        s_loc = jnp.einsum('bqhd,bjkhd->bhqjk', q_r, k_r).astype(jnp.float32) * scale + bias[None]
        s_loc = jnp.where(col_ok[:, None, :], s_loc, NEG_INF)
        s_ctx = jnp.einsum('bqhd,blhd->bhql', q_r, k_ctx).astype(jnp.float32) * scale
        s = jnp.concatenate([s_loc.reshape(bsz, h, GRID_W, n_loc), s_ctx], -1)
        p = jax.nn.softmax(s, axis=-1).astype(v.dtype)
        p_loc = p[..., :n_loc].reshape(bsz, h, GRID_W, wr, GRID_W)
        return (jnp.einsum('bhqjk,bjkhd->bqhd', p_loc, v_r)
                + jnp.einsum('bhql,blhd->bqhd', p[..., n_loc:], v_ctx))

    o = lax.map(row_block, jnp.arange(rows))
    return o.swapaxes(0, 1).reshape(bsz, n, h, hd)


def hgrn_lower_bounds(lb_logits):
    p = jax.nn.softmax(lb_logits.astype(jnp.float32), axis=1)
    cs = jnp.cumsum(p, axis=1)
    return cs - cs[:, :1]


def hgrn_gates(z, lb):
    zf = z.astype(jnp.float32)
    log_f = jnp.logaddexp(jnp.log(lb), jnp.log1p(-lb) + jax.nn.log_sigmoid(zf))
    k = (1.0 - lb) * jax.nn.sigmoid(-zf)
    return log_f, k


def hgrn_scan(q, k, v, log_f, s0):
    bsz, n, h, _ = q.shape
    dv = v.shape[-1]
    nch = n // C_CHUNK

    def chunks(t):
        return t.astype(jnp.float32).reshape(bsz, nch, C_CHUNK, h, t.shape[-1]).swapaxes(0, 1)

    causal = jnp.tril(jnp.ones((C_CHUNK, C_CHUNK), dtype=bool))[None, :, :, None, None]

    def step(state, xs):
        qc, kc, vc, lf = xs
        b = jnp.cumsum(lf, axis=1)
        o_inter = jnp.einsum('bthd,bhde->bthe', qc * jnp.exp(b), state)
        decay = jnp.exp(jnp.where(causal, b[:, :, None] - b[:, None, :], -jnp.inf))
        attn = jnp.einsum('bthd,bshd,btshd->bhts', qc, kc, decay)
        o_intra = jnp.einsum('bhts,bshe->bthe', attn, vc)
        b_last = b[:, -1]
        state = (jnp.exp(b_last)[..., None] * state
                 + jnp.einsum('bshd,bshe->bhde', kc * jnp.exp(b_last[:, None] - b), vc))
        return state, o_inter + o_intra

    s_fin, o = lax.scan(step, s0.astype(jnp.float32), (chunks(q), chunks(k), chunks(v), chunks(log_f)))
    return o.swapaxes(0, 1).reshape(bsz, n, h, dv), s_fin


def hgrn_bidir(q, k_f, k_b, log_f_f, log_f_b, v, s0_f, s0_b):
    o_f, s_f = hgrn_scan(q, k_f, v, log_f_f, s0_f)
    rev = lambda t: jnp.flip(t, axis=1)
    o_b, s_b = hgrn_scan(rev(q), rev(k_b), rev(v), rev(log_f_b), s0_b)
    return o_f + rev(o_b), s_f, s_b


def swiglu(h, w_i, w_o):
    up, gate = jnp.split(h @ w_i, 2, axis=-1)
    return (jax.nn.silu(gate) * up) @ w_o


def trunk_layer(x, cond, p, lb, l, ctx):
    bsz, n, _ = x.shape
    sh1, sc1, g1, sh2, sc2, g2 = ada_mod(cond, p['w_ada'][l], p['b_ada'][l])
    gains = p['norm_g'][l]
    h = rmsnorm(x, gains[0]) * (1.0 + sc1) + sh1
    (a_u, a_v, b_q, b_k, b_v, c_q, c_ff, c_fb, c_i, c_g,
     gt_a, gt_b, gt_c) = split_cols(h @ p['w_in'][l])
    y_a = chunk_mlp(a_u, a_v, p['a_w'][l], p['a_b'][l])
    heads = lambda t: t.reshape(bsz, n, B_HEADS, B_HEAD_DIM)
    q, k, v = heads(b_q), heads(b_k), heads(b_v)
    if ctx is None:
        o_b = ctx_attention(q, k, v)
        s0_f = jnp.zeros((bsz, C_HEADS, C_KEY_DIM, C_VAL_DIM), jnp.float32)
        s0_b = s0_f
    else:
        k_ctx, v_ctx, s0_f, s0_b = ctx
        o_b = nbhd_attention(axial_rope(q), axial_rope(k), v, k_ctx, v_ctx, p['rpb'][l])
    y_b = o_b.reshape(bsz, n, B_WIDTH)
    chead = lambda t, d: t.reshape(bsz, n, C_HEADS, d)
    log_f_f, k_f = hgrn_gates(c_ff, lb[0, l])
    log_f_b, k_b = hgrn_gates(c_fb, lb[1, l])
    o_c, s_f, s_b = hgrn_bidir(chead(jax.nn.silu(c_q), C_KEY_DIM), chead(k_f, C_KEY_DIM), chead(k_b, C_KEY_DIM),
                               chead(log_f_f, C_KEY_DIM), chead(log_f_b, C_KEY_DIM), chead(c_i, C_VAL_DIM),
                               s0_f, s0_b)
    y_c = rmsnorm(o_c).reshape(bsz, n, C_VWIDTH).astype(x.dtype) * jax.nn.silu(c_g)
    merged = (jax.nn.sigmoid(gt_a) * (y_a @ p['w_up_a'][l])
              + jax.nn.sigmoid(gt_b) * (y_b @ p['w_up_b'][l])
              + jax.nn.sigmoid(gt_c) * (y_c @ p['w_up_c'][l]))
    x = x + g1 * rmsnorm(merged @ p['w_out'][l], gains[1])
    h2 = rmsnorm(x, gains[2]) * (1.0 + sc2) + sh2
    x = x + g2 * rmsnorm(swiglu(h2, p['w_ffn_in'][l], p['w_ffn_out'][l]), gains[3])
    if ctx is None:
        return x, (k, v, jnp.stack([s_f, s_b], axis=1))
    return x, None


def setup_inputs(seed: int = 0) -> dict:
    key = jax.random.key(seed)
    ks = jax.random.split(key, 22)
    nrm = lambda kk, shape, s: jax.random.normal(kk, shape, jnp.float32) * s
    return {
        'x_prompt': nrm(ks[0], (BATCH, SEQ, D_MODEL), 1.0),
        'x_sample': nrm(ks[1], (DEC_BATCH, DEC_SEQ, D_MODEL), 1.0),
        'cache_attn_k': nrm(ks[2], (DEC_BATCH, DEPTH, PAST_LEN, B_HEADS, B_HEAD_DIM), 1.0),
        'cache_attn_v': nrm(ks[3], (DEC_BATCH, DEPTH, PAST_LEN, B_HEADS, B_HEAD_DIM), 1.0),
        'state_hgrn': nrm(ks[4], (DEC_BATCH, DEPTH, 2, C_HEADS, C_KEY_DIM, C_VAL_DIM), 0.3),
        'c': nrm(ks[5], (DEC_BATCH, D_MODEL), 1.0),
        'c_ctx': nrm(ks[6], (D_MODEL,), 1.0),
        'w_ada': nrm(ks[7], (DEPTH, D_MODEL, 6 * D_MODEL), 0.5 * D_MODEL ** -0.5),
        'b_ada': nrm(ks[8], (DEPTH, 6 * D_MODEL), 0.02),
        'norm_g': 1.0 + nrm(ks[9], (DEPTH, 4, D_MODEL), 0.02),
        'w_in': nrm(ks[10], (DEPTH, D_MODEL, IN_WIDTH), D_MODEL ** -0.5),
        'a_spatial_w': nrm(ks[11], (DEPTH, A_GROUPS, A_CHUNK, A_CHUNK), A_CHUNK ** -0.5),
        'a_spatial_b': 1.0 + nrm(ks[12], (DEPTH, A_GROUPS, A_CHUNK), 0.1),
        'nb_rpb': nrm(ks[13], (DEPTH, B_HEADS, 2 * NB_ROWS_MAX - 1, 2 * NB_COLS - 1), 0.5),
        'hgrn_lb_logits': nrm(ks[14], (2, DEPTH, C_FWIDTH), 0.5),
        'w_up_a': nrm(ks[15], (DEPTH, A_WIDTH, D_MODEL), A_WIDTH ** -0.5),
        'w_up_b': nrm(ks[16], (DEPTH, B_WIDTH, D_MODEL), B_WIDTH ** -0.5),
        'w_up_c': nrm(ks[17], (DEPTH, C_VWIDTH, D_MODEL), C_VWIDTH ** -0.5),
        'w_out': nrm(ks[18], (DEPTH, D_MODEL, D_MODEL), D_MODEL ** -0.5),
        'w_ffn_in': nrm(ks[19], (DEPTH, D_MODEL, 2 * D_FF), D_MODEL ** -0.5),
        'w_ffn_out': nrm(ks[20], (DEPTH, D_FF, D_MODEL), D_FF ** -0.5),
    }


def reference(x_prompt, x_sample, cache_attn_k, cache_attn_v, state_hgrn, c, c_ctx,
              w_ada, b_ada, norm_g, w_in, a_spatial_w, a_spatial_b, nb_rpb, hgrn_lb_logits,
              w_up_a, w_up_b, w_up_c, w_out, w_ffn_in, w_ffn_out):
    p = {'w_ada': w_ada, 'b_ada': b_ada, 'norm_g': norm_g, 'w_in': w_in,
         'a_w': a_spatial_w, 'a_b': a_spatial_b, 'rpb': nb_rpb,
         'w_up_a': w_up_a, 'w_up_b': w_up_b, 'w_up_c': w_up_c, 'w_out': w_out,
         'w_ffn_in': w_ffn_in, 'w_ffn_out': w_ffn_out}
    lb = hgrn_lower_bounds(hgrn_lb_logits)

    y_prompt = x_prompt
    ks_, vs_, ss_ = [], [], []
    for l in range(DEPTH):
        y_prompt, (k_l, v_l, s_l) = trunk_layer(y_prompt, c_ctx[None, :], p, lb, l, None)
        ks_.append(k_l)
        vs_.append(v_l)
        ss_.append(s_l)
    new_attn_k = jnp.stack(ks_, axis=1)
    new_attn_v = jnp.stack(vs_, axis=1)
    new_state_hgrn = jnp.stack(ss_, axis=1)

    y_sample = x_sample
    for l in range(DEPTH):
        ctx = (cache_attn_k[:, l], cache_attn_v[:, l], state_hgrn[:, l, 0], state_hgrn[:, l, 1])
        y_sample, _ = trunk_layer(y_sample, c, p, lb, l, ctx)

    return (y_prompt, y_sample, new_attn_k, new_attn_v, new_state_hgrn)
```

```cpp
#include <hip/hip_runtime.h>
#include <cstdio>
#include <cstdint>
namespace pg8 {
#define PG8_LAS __attribute__((address_space(3)))
typedef unsigned short bf16_t;
typedef short bf16x8 __attribute__((ext_vector_type(8)));
typedef float f32x4 __attribute__((ext_vector_type(4)));
typedef unsigned u32x4 __attribute__((ext_vector_type(4)));
constexpr int BM = 256, BK = 64, HALF = 128, HTB = HALF * BK * 2  , STAGE_BYTES = 8 * HTB, NXCD = 8, WGM = 8;

__host__ __device__ __forceinline__ int lds_byte(int r, int c) { const int st = (r >> 4) * 2 + (c >> 5), rr = r & 15, cc = c & 31, ob = rr * 64 + cc * 2; return st * 1024 + (ob ^ (((ob >> 9) & 1) << 5)); }
__host__ __device__ __forceinline__ void stage_rc(int b, int& R, int& C) { const int st = b / 1024, sb = b % 1024, swz = sb ^ (((sb >> 9) & 1) << 5); R = (st >> 1) * 16 + swz / 64; C = (st & 1) * 32 + (swz % 64) / 2; }
__host__ __device__ __forceinline__ int perm32(int rho) { const int n = rho >> 4, i = rho & 15; return 8 * (i >> 2) + 4 * n + (i & 3); }

struct Unit { int pm, pn; };
struct Gemm { const bf16_t* A; const bf16_t* Bt; int M, N, K, lda, ldb; };

struct StaticOrder {
    int nM, nN, nwg, G, c;
    __host__ __device__ void init(int M, int N, int G_, int c_) { nM = M / BM; nN = N / BM; nwg = nM * nN; G = G_; c = c_; }
    __host__ __device__ bool next(int i, Unit& u) const {
        const long L = (long)i * G + c; if (L >= nwg) return false;
        int wgid = (int)L; { const int q = nwg / NXCD, r = nwg % NXCD, xcd = wgid % NXCD, off = wgid / NXCD; wgid = (xcd < r ? xcd * (q + 1) : r * (q + 1) + (xcd - r) * q) + off; }
        const int nig = WGM * nN, gid = wgid / nig, fm = gid * WGM, gsz = (nM - fm) < WGM ? (nM - fm) : WGM;
        u.pm = fm + ((wgid % nig) % gsz); u.pn = (wgid % nig) / gsz; return true;
    }
    __device__ __forceinline__ void a_ready(const Unit&) const {}
    __device__ __forceinline__ void done(const Unit&) const {}
};
template <class Epi, class Sched, bool ALIGN_EPI = false, bool SP2 = false>
__device__ __forceinline__ void gemm_phase(PG8_LAS unsigned char* lds, const Gemm g, const Sched& S, const Epi& E) {
    int tid_ = threadIdx.x; asm volatile("" : "+v"(tid_));
    const int tid = tid_, wid = __builtin_amdgcn_readfirstlane(tid >> 6), lane = tid & 63, wr = wid >> 2, wc = wid & 3, fr = lane & 15, fq = lane >> 4;
    const int K = g.K, nt = K / BK;
    unsigned voffA[2], voffB[2];
#pragma unroll
    for (int i = 0; i < 2; ++i) { int R, C; stage_rc(tid * 16 + i * 8192, R, C); const int Rb = Epi::PERM ? ((R & ~31) + perm32(R & 31)) : R;
        voffA[i] = (unsigned)(R * g.lda + C) * 2u; voffB[i] = (unsigned)(Rb * g.ldb + C) * 2u; }
    const size_t kstep = (size_t)(BK * 2);
    const size_t hstepA = (size_t)HALF * g.lda * 2, hstepB = (size_t)HALF * g.ldb * 2;
    const size_t tstepA = 2 * hstepA, tstepB = 2 * hstepB;
    const unsigned ldsw = (unsigned)wid * 1024u;
    const int aoff = lds_byte(wr * 64 + fr, fq * 8), boff = lds_byte(wc * 32 + fr, fq * 8);
#define PG8_SA(b, h) (((b) * 2 + (h)) * HTB)
#define PG8_SB(b, h) ((4 + (b) * 2 + (h)) * HTB)
#define PG8_STAGE(bufoff, gbase, voff) do { _Pragma("unroll") for (int _i = 0; _i < 2; ++_i) \
        __builtin_amdgcn_global_load_lds((const unsigned*)((const char*)(gbase) + (voff)[_i]), (PG8_LAS unsigned*)(lds + (bufoff) + ldsw + _i * 8192), 16, 0, 0); } while (0)
#define PG8_LDA(dst, b, h) do { _Pragma("unroll") for (int m = 0; m < 4; ++m) _Pragma("unroll") for (int k = 0; k < 2; ++k) dst[m][k] = *(const PG8_LAS bf16x8*)(lds + PG8_SA(b, h) + aoff + m * 2048 + k * 1024); } while (0)
#define PG8_LDB(dst, b, h) do { _Pragma("unroll") for (int n = 0; n < 2; ++n) _Pragma("unroll") for (int k = 0; k < 2; ++k) dst[n][k] = *(const PG8_LAS bf16x8*)(lds + PG8_SB(b, h) + boff + n * 2048 + k * 1024); } while (0)
#define PG8_MMA(ai, bj, At, Bt) do { __builtin_amdgcn_s_setprio(1); _Pragma("unroll") for (int m = 0; m < 4; ++m) _Pragma("unroll") for (int n = 0; n < 2; ++n) _Pragma("unroll") for (int k = 0; k < 2; ++k) \
        acc[ai][bj][m][n] = __builtin_amdgcn_mfma_f32_16x16x32_bf16(Bt[n][k], At[m][k], acc[ai][bj][m][n], 0, 0, 0); __builtin_amdgcn_s_setprio(0); } while (0)
#define PG8_WAIT_V(n) asm volatile("s_waitcnt vmcnt(" #n ")" ::: "memory")
#define PG8_WAIT_L(n) asm volatile("s_waitcnt lgkmcnt(" #n ")" ::: "memory")
#define PG8_BAR __builtin_amdgcn_s_barrier()
#define PG8_SCHED __builtin_amdgcn_sched_barrier(0)
    Unit cur, nxt; int ui = 0;
    if (!S.next(0, cur)) return;
    f32x4 acc[2][2][4][2];
#pragma unroll
    for (int a = 0; a < 2; ++a)
#pragma unroll
        for (int b = 0; b < 2; ++b)
#pragma unroll
            for (int m = 0; m < 4; ++m)
#pragma unroll
                for (int n = 0; n < 2; ++n) acc[a][b][m][n] = (f32x4){0.f, 0.f, 0.f, 0.f};
    bf16x8 At[4][2], B0[2][2], B1[2][2];
    const char* cA = (const char*)g.A + (size_t)cur.pm * tstepA; const char* cB = (const char*)g.Bt + (size_t)cur.pn * tstepB;
    S.a_ready(cur);
    if constexpr (SP2) {
        PG8_STAGE(PG8_SB(0, 0), cB, voffB); PG8_STAGE(PG8_SB(0, 1), cB + hstepB, voffB); PG8_STAGE(PG8_SA(0, 0), cA, voffA); PG8_STAGE(PG8_SA(0, 1), cA + hstepA, voffA);
        if (wr == 1) PG8_BAR;
        PG8_WAIT_V(2); PG8_BAR;
        PG8_STAGE(PG8_SB(1, 0), cB + kstep, voffB); PG8_STAGE(PG8_SA(1, 0), cA + kstep, voffA); PG8_STAGE(PG8_SB(1, 1), cB + hstepB + kstep, voffB);
        PG8_WAIT_V(6); PG8_BAR;
    } else {
        PG8_STAGE(PG8_SB(0, 0), cB, voffB); PG8_STAGE(PG8_SA(0, 0), cA, voffA); PG8_STAGE(PG8_SB(0, 1), cB + hstepB, voffB); PG8_STAGE(PG8_SA(0, 1), cA + hstepA, voffA);
        if (wr == 1) PG8_BAR;
        PG8_WAIT_V(4); PG8_BAR;
        PG8_STAGE(PG8_SB(1, 0), cB + kstep, voffB); PG8_STAGE(PG8_SA(1, 0), cA + kstep, voffA); PG8_STAGE(PG8_SB(1, 1), cB + hstepB + kstep, voffB);
        PG8_WAIT_V(6); PG8_BAR;
    }
    for (;;) {
        const bool has_next = S.next(ui + 1, nxt);
        const char* nA = has_next ? (const char*)g.A + (size_t)nxt.pm * tstepA : cA; const char* nB = has_next ? (const char*)g.Bt + (size_t)nxt.pn * tstepB : cB;
        for (int t = 0; t < nt; t += 2) {
            const bool last = (t == nt - 2);
            const char* a1 = cA + (size_t)(t + 1) * kstep;
            const char* a2 = last ? nA : cA + (size_t)(t + 2) * kstep; const char* b2 = last ? nB : cB + (size_t)(t + 2) * kstep;
            const char* a3 = a2 + kstep; const char* b3 = b2 + kstep;
            if (last && has_next) S.a_ready(nxt);
            if constexpr (SP2) {
            PG8_LDB(B0, 0, 0); PG8_LDB(B1, 0, 1); PG8_SCHED; PG8_LDA(At, 0, 0); PG8_STAGE(PG8_SA(1, 1), a1 + hstepA, voffA);
            PG8_WAIT_V(8); PG8_WAIT_L(0); PG8_BAR; PG8_MMA(0, 0, At, B0); PG8_MMA(0, 1, At, B1); PG8_BAR; PG8_SCHED;
            PG8_LDA(At, 0, 1); PG8_STAGE(PG8_SB(0, 0), b2, voffB); PG8_STAGE(PG8_SB(0, 1), b2 + hstepB, voffB); PG8_STAGE(PG8_SA(0, 0), a2, voffA);
            PG8_WAIT_V(8); PG8_WAIT_L(0); PG8_BAR; PG8_MMA(1, 0, At, B0); PG8_MMA(1, 1, At, B1); PG8_BAR; PG8_SCHED;
            PG8_LDB(B0, 1, 0); PG8_LDB(B1, 1, 1); PG8_SCHED; PG8_LDA(At, 1, 0); PG8_STAGE(PG8_SA(0, 1), a2 + hstepA, voffA);
            PG8_WAIT_V(8); PG8_WAIT_L(0); PG8_BAR; PG8_MMA(0, 0, At, B0); PG8_MMA(0, 1, At, B1); PG8_BAR; PG8_SCHED;
            PG8_LDA(At, 1, 1); PG8_STAGE(PG8_SB(1, 0), b3, voffB); PG8_STAGE(PG8_SB(1, 1), b3 + hstepB, voffB); PG8_STAGE(PG8_SA(1, 0), a3, voffA);
            PG8_WAIT_V(8); PG8_WAIT_L(0); PG8_BAR; PG8_MMA(1, 0, At, B0); PG8_MMA(1, 1, At, B1); PG8_BAR; PG8_SCHED;
            } else {
            PG8_LDB(B0, 0, 0); PG8_SCHED; PG8_LDA(At, 0, 0); PG8_STAGE(PG8_SA(1, 1), a1 + hstepA, voffA);
            PG8_WAIT_L(8); PG8_BAR; PG8_WAIT_L(0); PG8_MMA(0, 0, At, B0); PG8_BAR; PG8_SCHED;
            PG8_LDB(B1, 0, 1); PG8_STAGE(PG8_SB(0, 0), b2, voffB);
            PG8_BAR; PG8_WAIT_L(0); PG8_MMA(0, 1, At, B1); PG8_BAR;
            PG8_LDA(At, 0, 1); PG8_STAGE(PG8_SA(0, 0), a2, voffA);
            PG8_BAR; PG8_WAIT_L(0); PG8_MMA(1, 0, At, B0); PG8_BAR; PG8_SCHED;
            PG8_STAGE(PG8_SB(0, 1), b2 + hstepB, voffB);
            PG8_WAIT_V(6); PG8_BAR; PG8_MMA(1, 1, At, B1); PG8_BAR;
            PG8_LDB(B0, 1, 0); PG8_SCHED; PG8_LDA(At, 1, 0); PG8_STAGE(PG8_SA(0, 1), a2 + hstepA, voffA);
            PG8_WAIT_L(8); PG8_BAR; PG8_WAIT_L(0); PG8_MMA(0, 0, At, B0); PG8_BAR; PG8_SCHED;
            PG8_LDB(B1, 1, 1); PG8_STAGE(PG8_SB(1, 0), b3, voffB);
            PG8_BAR; PG8_WAIT_L(0); PG8_MMA(0, 1, At, B1); PG8_BAR;
            PG8_LDA(At, 1, 1); PG8_STAGE(PG8_SA(1, 0), a3, voffA);
            PG8_BAR; PG8_WAIT_L(0); PG8_MMA(1, 0, At, B0); PG8_BAR; PG8_SCHED;
            PG8_STAGE(PG8_SB(1, 1), b3 + hstepB, voffB);
            PG8_WAIT_V(6); PG8_BAR; PG8_MMA(1, 1, At, B1); PG8_BAR;
            }
        }
        if constexpr (ALIGN_EPI) { if (wr == 0) PG8_BAR; }
        if constexpr (!Epi::AFTER_DRAIN) { E(acc, cur, wr, wc, fr, fq); S.done(cur); }
        if (!has_next) break;
#pragma unroll
        for (int a = 0; a < 2; ++a)
#pragma unroll
            for (int b = 0; b < 2; ++b)
#pragma unroll
                for (int m = 0; m < 4; ++m)
#pragma unroll
                    for (int n = 0; n < 2; ++n) acc[a][b][m][n] = (f32x4){0.f, 0.f, 0.f, 0.f};
        cur = nxt; cA = nA; cB = nB; ++ui;
        if constexpr (ALIGN_EPI) { if (wr == 1) PG8_BAR; }
    }
    PG8_WAIT_V(0);
    if constexpr (!ALIGN_EPI) { if (wr == 0) PG8_BAR; }
    PG8_BAR;
    if constexpr (Epi::AFTER_DRAIN) { E.fused(acc, cur, wr, wc, fr, fq, lds, wid, lane); S.done(cur); }
#undef PG8_SA
#undef PG8_SB
#undef PG8_STAGE
#undef PG8_LDA
#undef PG8_LDB
#undef PG8_MMA
#undef PG8_WAIT_V
#undef PG8_WAIT_L
#undef PG8_BAR
#undef PG8_SCHED
}
}

#define GAS __attribute__((address_space(1)))
#define LAS __attribute__((address_space(3)))
typedef unsigned short bf16;
typedef unsigned v4u __attribute__((ext_vector_type(4)));
typedef unsigned v2u __attribute__((ext_vector_type(2)));
typedef float f32x4 __attribute__((ext_vector_type(4)));

constexpr int DM = 2048, NCTX = 8192, NLAT = 2048, MTOK = 10240, DEPTH = 4;
constexpr int INW = 16384, DFF = 5632, NFI = 11264, YW = 3072;
constexpr float EPS = 1e-6f;
constexpr int NWAVES = 8, NTHR = 512;

constexpr size_t MiB = 1u << 20;
constexpr size_t WS_CTL = 0, CTL_ZERO_BYTES = 1 * MiB;
constexpr size_t WS_MOD = 1 * MiB;
constexpr size_t WS_LB = 2 * MiB;
constexpr size_t WS_ROPE = 2 * MiB + 65536;
constexpr size_t WS_WT = 4 * MiB;
constexpr size_t WL_ELEMS = 78643200;
constexpr size_t OFF_IN = 0, OFF_UP = 33554432, OFF_OUT = 39845888, OFF_FI = 44040192, OFF_FO = 67108864;
constexpr size_t WS_Z = 604 * MiB;
constexpr size_t WS_LOGF = 924 * MiB;
constexpr size_t WS_H = 1004 * MiB;
constexpr size_t WS_Y = 1044 * MiB;
constexpr size_t WS_OF = 1104 * MiB;
constexpr size_t WS_OB = 1144 * MiB;
constexpr size_t WS_MGF = 1184 * MiB;
constexpr size_t WS_MG = 1264 * MiB;
constexpr size_t WS_T = 1304 * MiB;
constexpr size_t WS_ACT = 1384 * MiB;
constexpr size_t WS_END = 1494 * MiB;
constexpr int CW_BAR = 4096;
constexpr int CW_Q = 16384;
constexpr size_t OUT_Y = 0, OUT_K = 20971520, OUT_V = OUT_K + 33554432, OUT_S = OUT_V + 33554432, OUT_END = OUT_S + 33554432;

constexpr int LDS_BYTES = 155648;
constexpr int LDSCTL_OFF = 154624;

constexpr int PH_PRO = 0, PH_T1 = 1, PH_L0 = 2, PH_PER_LAYER = 9, PH_END = PH_L0 + DEPTH * PH_PER_LAYER;

struct Args {
    const float *x_prompt, *x_sample, *cache_k, *cache_v, *state, *c, *c_ctx, *w_ada, *b_ada, *norm_g, *w_in, *a_w, *a_b, *rpb, *lb_logits, *w_up_a, *w_up_b, *w_up_c, *w_out, *w_fi, *w_fo;
    float* out; unsigned char* ws; int ph_lo, ph_hi;
};

__device__ __forceinline__ float bf2f_lo(unsigned w) { return __uint_as_float(w << 16); }
__device__ __forceinline__ float bf2f_hi(unsigned w) { return __uint_as_float(w & 0xffff0000u); }
__device__ __forceinline__ unsigned f2bf(float f) { unsigned u = __float_as_uint(f); return (u + 0x7fffu + ((u >> 16) & 1u)) >> 16; }
__device__ __forceinline__ unsigned pk2(float lo, float hi) { return f2bf(lo) | (f2bf(hi) << 16); }
__device__ __forceinline__ void unpack8(const v4u w, float (&f)[8]) {
    f[0] = bf2f_lo(w.x); f[1] = bf2f_hi(w.x); f[2] = bf2f_lo(w.y); f[3] = bf2f_hi(w.y); f[4] = bf2f_lo(w.z); f[5] = bf2f_hi(w.z); f[6] = bf2f_lo(w.w); f[7] = bf2f_hi(w.w); }
__device__ __forceinline__ v4u pack8(const float (&f)[8]) { v4u w; w.x = pk2(f[0], f[1]); w.y = pk2(f[2], f[3]); w.z = pk2(f[4], f[5]); w.w = pk2(f[6], f[7]); return w; }
__device__ __forceinline__ float wave_sum(float v) {
#pragma unroll
    for (int o = 1; o < 64; o <<= 1) v += __shfl_xor(v, o);
    return v;
}
__device__ __forceinline__ float sigmoidf_(float x) { return 1.0f / (1.0f + __expf(-x)); }
__device__ __forceinline__ float siluf_(float x) { return x / (1.0f + __expf(-x)); }
__device__ __forceinline__ float gelu_tanh_(float x) { const float y = 1.5957691216057308f * (x + 0.044715f * x * x * x); return x / (1.0f + __expf(-y)); }

#define XB_TMO      128
#define XB_XCNT(j)  (256  + 64 * (j))
#define XB_XSUB(j)  (1280 + 64 * (j))
#define XB_XGEN(j)  (2304 + 64 * (j))
#define XB_TOP      3328
#define XB_TOPGEN   3392
#define XCD_BAR_WORDS 3456
#define XB_SPIN_CAP (1u << 18)
__device__ __forceinline__ unsigned xb_ld(unsigned* p)              { return __hip_atomic_load(p, __ATOMIC_RELAXED, __HIP_MEMORY_SCOPE_AGENT); }
__device__ __forceinline__ unsigned xb_add(unsigned* p, unsigned v) { return __hip_atomic_fetch_add(p, v, __ATOMIC_RELAXED, __HIP_MEMORY_SCOPE_AGENT); }
__device__ __forceinline__ unsigned xb_xcc_id() { return (unsigned)__builtin_amdgcn_s_getreg((3 << 11) | 20) & 0xFu; }
#define XB_SPIN(cond, bar) do { unsigned _sp = 0; while (cond) { __builtin_amdgcn_s_sleep(1); \
    if ((++_sp & 255u) == 0u) { if (xb_ld(&(bar)[XB_TMO])) break; if (_sp > XB_SPIN_CAP) { atomicAdd(&(bar)[XB_TMO], 1u); break; } } } } while (0)
struct XcdBarrier { unsigned* bar; unsigned x; volatile LAS unsigned* st; };
__device__ __forceinline__ XcdBarrier xcd_barrier_post(unsigned* bar, volatile LAS unsigned* st) {
    XcdBarrier b; b.bar = bar; b.x = xb_xcc_id(); b.st = st;
    if (threadIdx.x == 0) (void)xb_add(&bar[XB_XCNT(b.x)], 1u);
    return b;
}
__device__ __forceinline__ void xcd_barrier_complete(unsigned* bar, unsigned x, unsigned& nloc, unsigned& nx) {
    const unsigned G = gridDim.x * gridDim.y * gridDim.z;
    unsigned sum, cnt, mine, sp = 0u;
    for (;;) {
        sum = 0u; cnt = 0u; mine = 0u;
#pragma unroll
        for (unsigned j = 0; j < 16; ++j) { const unsigned c = xb_ld(&bar[XB_XCNT(j)]); sum += c; cnt += (c > 0u) ? 1u : 0u; mine = (j == x) ? c : mine; }
        if (sum == G) break;
        __builtin_amdgcn_s_sleep(1);
        if ((++sp & 255u) == 0u) { if (xb_ld(&bar[XB_TMO])) break; if (sp > XB_SPIN_CAP) { atomicAdd(&bar[XB_TMO], 1u); break; } }
    }
    nloc = mine > 0u ? mine : 1u; nx = cnt > 0u ? cnt : 1u;
}
__device__ __forceinline__ void xcd_barrier(const XcdBarrier& b) {
    asm volatile("s_waitcnt vmcnt(0)" ::: "memory");
    __syncthreads();
    if (threadIdx.x == 0) {
        unsigned* bar = b.bar;
        __builtin_amdgcn_s_waitcnt(0);
        unsigned nloc = b.st[0], nx = b.st[1];
        if (nloc == 0u) { xcd_barrier_complete(bar, b.x, nloc, nx); b.st[0] = nloc; b.st[1] = nx; }
        const unsigned old = xb_add(&bar[XB_XSUB(b.x)], 1u);
        const unsigned gen = old / nloc;
        if (old + 1u == (gen + 1u) * nloc) {
            __builtin_amdgcn_fence(__ATOMIC_RELEASE, "agent");
            asm volatile("s_waitcnt vmcnt(0)" ::: "memory");
            const unsigned og = xb_add(&bar[XB_TOP], 1u);
            const unsigned tg = og / nx;
            if (og + 1u == (tg + 1u) * nx) xb_add(&bar[XB_TOPGEN], 1u);
            else XB_SPIN(xb_ld(&bar[XB_TOPGEN]) == tg, bar);
            __builtin_amdgcn_fence(__ATOMIC_ACQUIRE, "agent");
            xb_add(&bar[XB_XGEN(b.x)], 1u);
            asm volatile("s_waitcnt vmcnt(0)" ::: "memory");
        } else {
            XB_SPIN(xb_ld(&bar[XB_XGEN(b.x)]) == gen, bar);
            __builtin_amdgcn_fence(__ATOMIC_ACQUIRE, "agent");
            asm volatile("s_waitcnt vmcnt(0)" ::: "memory");
        }
    }
    __syncthreads();
}

struct EpiIn {
    static constexpr bool PERM = true, AFTER_DRAIN = false;
    bf16* Z; float* LOGF; const float* lbp  ; float* outK; float* outV;
    __device__ __forceinline__ void operator()(const f32x4 (&acc)[2][2][4][2], const pg8::Unit& u, int wr, int wc, int fr, int fq) const {
        const int seg = u.pn >> 2;
        const int row0 = u.pm * 256 + wr * 64 + fr, colt = u.pn * 256 + wc * 32 + 8 * fq;
#pragma unroll
        for (int ai = 0; ai < 2; ++ai)
#pragma unroll
            for (int m = 0; m < 4; ++m) {
                const int row = row0 + ai * 128 + m * 16;
#pragma unroll
                for (int bj = 0; bj < 2; ++bj) {
                    const int col = colt + bj * 128;
                    float v[8];
#pragma unroll
                    for (int j = 0; j < 4; ++j) { v[j] = acc[ai][bj][m][0][j]; v[4 + j] = acc[ai][bj][m][1][j]; }
                    if (seg == 6 || seg == 7) {
                        const float* lb = lbp + (seg - 6) * 4096 + (col - (seg == 6 ? 6144 : 7168));
                        float o[8];
#pragma unroll
                        for (int j = 0; j < 8; ++j) { const float b = lb[j]; o[j] = logf(b + (1.0f - b) * sigmoidf_(v[j])); }
                        float* dst = LOGF + (size_t)row * 2048 + (col - 6144);
                        *(f32x4*)dst = (f32x4){o[0], o[1], o[2], o[3]}; *(f32x4*)(dst + 4) = (f32x4){o[4], o[5], o[6], o[7]};
                    } else {
                        if (seg == 3 || seg == 4) {
                            if (row < NCTX) { float* dst = (seg == 3 ? outK : outV) + ((size_t)(row >> 8) * 1024 + (row & 255)) * 1024 + (col - (seg == 3 ? 3072 : 4096));
                                *(f32x4*)dst = (f32x4){v[0], v[1], v[2], v[3]}; *(f32x4*)(dst + 4) = (f32x4){v[4], v[5], v[6], v[7]}; }
                        } else if (seg == 0 || seg == 1) {
#pragma unroll
                            for (int j = 0; j < 8; ++j) v[j] = gelu_tanh_(v[j]);
                        } else if (seg == 5 || seg == 9) {
#pragma unroll
                            for (int j = 0; j < 8; ++j) v[j] = siluf_(v[j]);
                        } else if (seg >= 10) {
#pragma unroll
                            for (int j = 0; j < 8; ++j) v[j] = sigmoidf_(v[j]);
                        }
                        *(v4u*)(Z + (size_t)row * INW + col) = pack8(v);
                    }
                }
                asm volatile("" ::: "memory");
            }
    }
};
template <int BR> struct EpiUp {
    static constexpr bool PERM = true, AFTER_DRAIN = false;
    const bf16* Zg  ; float* MGF; bf16* MG;
    __device__ __forceinline__ void operator()(const f32x4 (&acc)[2][2][4][2], const pg8::Unit& u, int wr, int wc, int fr, int fq) const {
        const int row0 = u.pm * 256 + wr * 64 + fr, colt = u.pn * 256 + wc * 32 + 8 * fq;
#pragma unroll
        for (int ai = 0; ai < 2; ++ai)
#pragma unroll
            for (int m = 0; m < 4; ++m) {
                const int row = row0 + ai * 128 + m * 16;
#pragma unroll
                for (int bj = 0; bj < 2; ++bj) {
                    const int col = colt + bj * 128;
                    float g[8]; unpack8(*(const v4u*)(Zg + (size_t)row * INW + col), g);
                    float v[8];
#pragma unroll
                    for (int j = 0; j < 4; ++j) { v[j] = acc[ai][bj][m][0][j] * g[j]; v[4 + j] = acc[ai][bj][m][1][j] * g[4 + j]; }
                    float* mp = MGF + (size_t)row * DM + col;
                    if (BR > 0) { const f32x4 p0 = *(const f32x4*)mp, p1 = *(const f32x4*)(mp + 4);
#pragma unroll
                        for (int j = 0; j < 4; ++j) { v[j] += p0[j]; v[4 + j] += p1[j]; } }
                    if (BR < 2) { *(f32x4*)mp = (f32x4){v[0], v[1], v[2], v[3]}; *(f32x4*)(mp + 4) = (f32x4){v[4], v[5], v[6], v[7]}; }
                    else *(v4u*)(MG + (size_t)row * DM + col) = pack8(v);
                }
                asm volatile("" ::: "memory");
            }
    }
};
struct EpiF32P {
    static constexpr bool PERM = true, AFTER_DRAIN = false;
    float* C; int ldc;
    __device__ __forceinline__ void operator()(const f32x4 (&acc)[2][2][4][2], const pg8::Unit& u, int wr, int wc, int fr, int fq) const {
        const int row0 = u.pm * 256 + wr * 64 + fr, colt = u.pn * 256 + wc * 32 + 8 * fq;
#pragma unroll
        for (int ai = 0; ai < 2; ++ai)
#pragma unroll
            for (int m = 0; m < 4; ++m) {
                float* rp = C + (size_t)(row0 + ai * 128 + m * 16) * ldc + colt;
#pragma unroll
                for (int bj = 0; bj < 2; ++bj) { *(f32x4*)(rp + bj * 128) = acc[ai][bj][m][0]; *(f32x4*)(rp + bj * 128 + 4) = acc[ai][bj][m][1]; }
            }
    }
};
struct EpiSwi {
    static constexpr bool PERM = true, AFTER_DRAIN = false;
    bf16* ACT;
    __device__ __forceinline__ void operator()(const f32x4 (&acc)[2][2][4][2], const pg8::Unit& u, int wr, int wc, int fr, int fq) const {
        const int row0 = u.pm * 256 + wr * 64 + fr, colt = u.pn * 128 + wc * 32 + 8 * fq;
#pragma unroll
        for (int ai = 0; ai < 2; ++ai)
#pragma unroll
            for (int m = 0; m < 4; ++m) {
                float v[8];
#pragma unroll
                for (int j = 0; j < 4; ++j) { v[j] = siluf_(acc[ai][1][m][0][j]) * acc[ai][0][m][0][j]; v[4 + j] = siluf_(acc[ai][1][m][1][j]) * acc[ai][0][m][1][j]; }
                *(v4u*)(ACT + (size_t)(row0 + ai * 128 + m * 16) * DFF + colt) = pack8(v);
            }
    }
};

struct Ctx {
    LAS unsigned char* lds; int tid, lane, wave, vcu, G;
};

__device__ __forceinline__ void cvt_item(const float* W, int N, int k0, int n0, bf16* dst, int dld, int drow0, int dcol0, LAS float* scr, int lane) {
    const float* src = W + (size_t)(k0 + (lane >> 4)) * N + n0 + 4 * (lane & 15);
    f32x4 v[16];
#pragma unroll
    for (int i = 0; i < 16; ++i) v[i] = *(const f32x4*)(src + (size_t)(4 * i) * N);
#pragma unroll
    for (int i = 0; i < 16; ++i) { LAS float* s = scr + (4 * i + (lane >> 4)) * 65 + 4 * (lane & 15); s[0] = v[i].x; s[1] = v[i].y; s[2] = v[i].z; s[3] = v[i].w; }
    asm volatile("s_waitcnt lgkmcnt(0)" ::: "memory");
    const int c = lane & 7;
#pragma unroll
    for (int j = 0; j < 8; ++j) { const int n = (lane >> 3) + 8 * j; const LAS float* s = scr + (8 * c) * 65 + n;
        v4u o; o.x = pk2(s[0 * 65], s[1 * 65]); o.y = pk2(s[2 * 65], s[3 * 65]); o.z = pk2(s[4 * 65], s[5 * 65]); o.w = pk2(s[6 * 65], s[7 * 65]);
        *(v4u*)(dst + (size_t)(drow0 + n) * dld + dcol0 + 8 * c) = o; }
    asm volatile("s_waitcnt lgkmcnt(0)" ::: "memory");
}
__device__ __forceinline__ void phase_prologue(const Args& a, const Ctx& F) {
    unsigned char* ws = a.ws;
    bf16* WT = (bf16*)(ws + WS_WT);
    {
        LAS float* scr = (LAS float*)(F.lds + F.wave * 16640);
        const int gw = F.vcu * NWAVES + F.wave, NGW = F.G * NWAVES;
        constexpr int IT_IN = 32 * 256, IT_UP = 16 * 32, IT_OUT = 32 * 32, IT_FI = 32 * 176, IT_FO = 88 * 32, IT_LAYER = IT_IN + 3 * IT_UP + IT_OUT + IT_FI + IT_FO;
        for (int it = gw; it < DEPTH * IT_LAYER; it += NGW) {
            const int l = it / IT_LAYER; int r = it % IT_LAYER;
            bf16* wl = WT + (size_t)l * WL_ELEMS;
            if (r < IT_IN) { const int kb = r / 256, nb = r % 256; cvt_item(a.w_in + (size_t)l * DM * INW, INW, 64 * kb, 64 * nb, wl + OFF_IN, DM, 64 * nb, 64 * kb, scr, F.lane); continue; }
            r -= IT_IN;
            if (r < 3 * IT_UP) { const int br = r / IT_UP, q = r % IT_UP, kb = q / 32, nb = q % 32;
                const float* w = (br == 0 ? a.w_up_a : (br == 1 ? a.w_up_b : a.w_up_c)) + (size_t)l * 1024 * DM;
                cvt_item(w, DM, 64 * kb, 64 * nb, wl + OFF_UP, YW, 64 * nb, 1024 * br + 64 * kb, scr, F.lane); continue; }
            r -= 3 * IT_UP;
            if (r < IT_OUT) { const int kb = r / 32, nb = r % 32; cvt_item(a.w_out + (size_t)l * DM * DM, DM, 64 * kb, 64 * nb, wl + OFF_OUT, DM, 64 * nb, 64 * kb, scr, F.lane); continue; }
            r -= IT_OUT;
            if (r < IT_FI) { const int kb = r / 176, nb = r % 176; const int n0 = 64 * nb;
                const int drow = (n0 < DFF) ? (256 * (n0 / 128) + (n0 % 128)) : (256 * ((n0 - DFF) / 128) + 128 + ((n0 - DFF) % 128));
                cvt_item(a.w_fi + (size_t)l * DM * NFI, NFI, 64 * kb, n0, wl + OFF_FI, DM, drow, 64 * kb, scr, F.lane); continue; }
            r -= IT_FI;
            { const int kb = r / 32, nb = r % 32; cvt_item(a.w_fo + (size_t)l * DFF * DM, DM, 64 * kb, 64 * nb, wl + OFF_FO, DFF, 64 * nb, 64 * kb, scr, F.lane); }
        }
    }
    __syncthreads();
    {
        LAS float* sc = (LAS float*)F.lds;
        LAS float* red = (LAS float*)(F.lds + 24576);
        float* MOD = (float*)(ws + WS_MOD);
        for (int i = F.tid; i < 3 * DM; i += NTHR) { const int ci = i / DM, k = i % DM; const float x = (ci == 0) ? a.c_ctx[k] : a.c[(ci - 1) * DM + k]; sc[i] = x / (1.0f + expf(-x)); }
        __syncthreads();
        const int cx = F.tid & 31, kg = F.tid >> 5;
        for (int u = F.vcu; u < 4 * 96; u += F.G) {
            const int l = u / 96, cb = u % 96;
            const float* wp = a.w_ada + ((size_t)l * DM + 128 * kg) * 12288 + 128 * cb + 4 * cx;
            f32x4 a0 = {0.f, 0.f, 0.f, 0.f}, a1 = a0, a2 = a0;
#pragma unroll 8
            for (int k = 0; k < 128; ++k) { const f32x4 w = *(const f32x4*)(wp + (size_t)k * 12288);
                const float s0 = sc[128 * kg + k], s1 = sc[DM + 128 * kg + k], s2 = sc[2 * DM + 128 * kg + k];
                a0 += w * s0; a1 += w * s1; a2 += w * s2; }
#pragma unroll
            for (int j = 0; j < 4; ++j) { red[(kg * 3 + 0) * 128 + 4 * cx + j] = a0[j]; red[(kg * 3 + 1) * 128 + 4 * cx + j] = a1[j]; red[(kg * 3 + 2) * 128 + 4 * cx + j] = a2[j]; }
            __syncthreads();
            if (F.tid < 384) { const int ci = F.tid / 128, col = F.tid % 128; float s = 0.f;
#pragma unroll
                for (int g = 0; g < 16; ++g) s += red[(g * 3 + ci) * 128 + col];
                MOD[(size_t)(l * 3 + ci) * 12288 + 128 * cb + col] = s + a.b_ada[l * 12288 + 128 * cb + col]; }
            __syncthreads();
        }
    }
    {
        float* LB = (float*)(ws + WS_LB); float* ROPE = (float*)(ws + WS_ROPE);
        for (int i = F.vcu * NTHR + F.tid; i < 2048; i += F.G * NTHR) {
            const int dir = i / 1024, f = i % 1024;
            float x[4], mx = -3.0e38f;
#pragma unroll
            for (int l = 0; l < 4; ++l) { x[l] = a.lb_logits[(dir * 4 + l) * 1024 + f]; mx = fmaxf(mx, x[l]); }
            float e[4], s = 0.f;
#pragma unroll
            for (int l = 0; l < 4; ++l) { e[l] = expf(x[l] - mx); s += e[l]; }
            float cs = 0.f;
#pragma unroll
            for (int l = 0; l < 4; ++l) { if (l > 0) cs += e[l] / s; LB[(dir * 4 + l) * 1024 + f] = cs; }
            const int p = i / 32, fi = i % 32;
            const float inv = powf(10000.0f, -(float)(2 * fi) / 64.0f), ang = (float)p * inv;
            ROPE[2 * i] = cosf(ang); ROPE[2 * i + 1] = sinf(ang);
        }
    }
}

__device__ __forceinline__ void rownorm_phase(const Args& a, const Ctx& F, bool first, const float* T, const float* gate  , const float* gpost,
                                              bool write_h, const float* gn, const float* scv, const float* shv  ) {
    float* X = a.out + OUT_Y; bf16* H = (bf16*)(a.ws + WS_H);
    const int gw = F.vcu * NWAVES + F.wave, NGW = F.G * NWAVES;
    for (int m = gw; m < MTOK; m += NGW) {
        const int ci = (m < NCTX) ? 0 : 1 + ((m - NCTX) >> 10);
        const float* xr = first ? ((m < NCTX) ? a.x_prompt + (size_t)m * DM : a.x_sample + (size_t)(m - NCTX) * DM) : X + (size_t)m * DM;
        f32x4 x[8];
#pragma unroll
        for (int j = 0; j < 8; ++j) x[j] = *((const f32x4*)xr + F.lane + 64 * j);
        if (T) {
            f32x4 t[8]; float ss = 0.f;
#pragma unroll
            for (int j = 0; j < 8; ++j) { t[j] = *((const f32x4*)(T + (size_t)m * DM) + F.lane + 64 * j); ss += (t[j].x * t[j].x + t[j].y * t[j].y) + (t[j].z * t[j].z + t[j].w * t[j].w); }
            const float r = 1.0f / sqrtf(wave_sum(ss) * (1.0f / DM) + EPS);
#pragma unroll
            for (int j = 0; j < 8; ++j) { const f32x4 gp = *((const f32x4*)gpost + F.lane + 64 * j), gt = *((const f32x4*)(gate + (size_t)ci * 12288) + F.lane + 64 * j);
                x[j] += gt * (t[j] * r * gp); }
        }
        if (T || first) {
#pragma unroll
            for (int j = 0; j < 8; ++j) *((f32x4*)(X + (size_t)m * DM) + F.lane + 64 * j) = x[j];
        }
        if (write_h) {
            float ss = 0.f;
#pragma unroll
            for (int j = 0; j < 8; ++j) ss += (x[j].x * x[j].x + x[j].y * x[j].y) + (x[j].z * x[j].z + x[j].w * x[j].w);
            const float r = 1.0f / sqrtf(wave_sum(ss) * (1.0f / DM) + EPS);
#pragma unroll
            for (int j = 0; j < 8; ++j) { const f32x4 g = *((const f32x4*)gn + F.lane + 64 * j), s = *((const f32x4*)(scv + (size_t)ci * 12288) + F.lane + 64 * j), b = *((const f32x4*)(shv + (size_t)ci * 12288) + F.lane + 64 * j);
                const f32x4 h = x[j] * r * g * (s + 1.0f) + b;
                v2u w; w.x = pk2(h.x, h.y); w.y = pk2(h.z, h.w);
                *((v2u*)(H + (size_t)m * DM) + F.lane + 64 * j) = w; }
        }
    }
}

__device__ __forceinline__ void phase_ycnorm(const Args& a, const Ctx& F) {
    const float* OFp = (const float*)(a.ws + WS_OF); const float* OBp = (const float*)(a.ws + WS_OB);
    const bf16* Z = (const bf16*)(a.ws + WS_Z); bf16* Y = (bf16*)(a.ws + WS_Y);
    const int gw = F.vcu * NWAVES + F.wave, NGW = F.G * NWAVES;
    for (int m = gw; m < MTOK; m += NGW) {
        float o[16]; float ss = 0.f;
#pragma unroll
        for (int j = 0; j < 4; ++j) { const f32x4 p = *((const f32x4*)(OFp + (size_t)m * 1024 + 16 * F.lane) + j), q = *((const f32x4*)(OBp + (size_t)m * 1024 + 16 * F.lane) + j);
            const f32x4 s = p + q; o[4 * j] = s.x; o[4 * j + 1] = s.y; o[4 * j + 2] = s.z; o[4 * j + 3] = s.w; ss += (s.x * s.x + s.y * s.y) + (s.z * s.z + s.w * s.w); }
        ss += __shfl_xor(ss, 1); ss += __shfl_xor(ss, 2); ss += __shfl_xor(ss, 4);
        const float r = 1.0f / sqrtf(ss * (1.0f / 128.0f) + EPS);
        float g0[8], g1[8];
        unpack8(*(const v4u*)(Z + (size_t)m * INW + 9216 + 16 * F.lane), g0); unpack8(*(const v4u*)(Z + (size_t)m * INW + 9216 + 16 * F.lane + 8), g1);
        float y0[8], y1[8];
#pragma unroll
        for (int j = 0; j < 8; ++j) { y0[j] = o[j] * r * g0[j]; y1[j] = o[8 + j] * r * g1[j]; }
        *(v4u*)(Y + (size_t)m * YW + 2048 + 16 * F.lane) = pack8(y0); *(v4u*)(Y + (size_t)m * YW + 2048 + 16 * F.lane + 8) = pack8(y1);
    }
}

__device__ __forceinline__ void unitA(const Args& a, const Ctx& F, int l, int unit) {
    const int ch = unit >> 3, g = unit & 7, m0 = ch * 128;
    const bf16* Z = (const bf16*)(a.ws + WS_Z); bf16* Y = (bf16*)(a.ws + WS_Y);
    LAS float* Wt = (LAS float*)F.lds;
    LAS float* V = (LAS float*)(F.lds + 65536);
    LAS float* st = (LAS float*)(F.lds + 131072);
    for (int i = 0; i < 16; ++i) {
        const int s = 16 * F.wave + i;
        const bf16* rp = Z + (size_t)(m0 + s) * INW + 1024 + 16 * F.lane;
        float x0[8], x1[8]; unpack8(*(const v4u*)rp, x0); unpack8(*(const v4u*)(rp + 8), x1);
        float sm = 0.f, sq = 0.f;
#pragma unroll
        for (int j = 0; j < 8; ++j) { sm += x0[j] + x1[j]; sq += x0[j] * x0[j] + x1[j] * x1[j]; }
        sm = wave_sum(sm); sq = wave_sum(sq);
        const float mean = sm * (1.0f / 1024.0f), var = fmaxf(sq * (1.0f / 1024.0f) - mean * mean, 0.f);
        if (F.lane == 0) { st[s] = mean; st[128 + s] = 1.0f / sqrtf(var + EPS); }
    }
    __syncthreads();
    {
        const int s = F.tid >> 2, c0 = 32 * (F.tid & 3);
        const float mean = st[s], rstd = st[128 + s];
        const bf16* rp = Z + (size_t)(m0 + s) * INW + 1024 + 128 * g + c0;
#pragma unroll
        for (int q = 0; q < 4; ++q) { float x[8]; unpack8(*(const v4u*)(rp + 8 * q), x);
#pragma unroll
            for (int j = 0; j < 8; ++j) V[s * 128 + c0 + 8 * q + j] = (x[j] - mean) * rstd; }
        const int t = F.tid >> 2, s0 = 32 * (F.tid & 3);
        const float* wp = a.a_w + ((size_t)(l * 8 + g) * 128 + t) * 128 + s0;
#pragma unroll
        for (int q = 0; q < 8; ++q) { const f32x4 w = *(const f32x4*)(wp + 4 * q);
            Wt[(s0 + 4 * q + 0) * 128 + t] = w.x; Wt[(s0 + 4 * q + 1) * 128 + t] = w.y; Wt[(s0 + 4 * q + 2) * 128 + t] = w.z; Wt[(s0 + 4 * q + 3) * 128 + t] = w.w; }
    }
    __syncthreads();
    const int tg = F.tid >> 5, cx = F.tid & 31;
    float acc[8][4];
#pragma unroll
    for (int i = 0; i < 8; ++i)
#pragma unroll
        for (int j = 0; j < 4; ++j) acc[i][j] = 0.f;
    for (int s = 0; s < 128; ++s) {
        const f32x4 w0 = *(const LAS f32x4*)(Wt + s * 128 + 8 * tg), w1 = *(const LAS f32x4*)(Wt + s * 128 + 8 * tg + 4), v = *(const LAS f32x4*)(V + s * 128 + 4 * cx);
        const float w[8] = {w0.x, w0.y, w0.z, w0.w, w1.x, w1.y, w1.z, w1.w};
#pragma unroll
        for (int i = 0; i < 8; ++i) { acc[i][0] += w[i] * v.x; acc[i][1] += w[i] * v.y; acc[i][2] += w[i] * v.z; acc[i][3] += w[i] * v.w; }
    }
#pragma unroll
    for (int i = 0; i < 8; ++i) {
        const int t = 8 * tg + i; const float b = a.a_b[(l * 8 + g) * 128 + t];
        const v2u uw = *(const v2u*)(Z + (size_t)(m0 + t) * INW + 128 * g + 4 * cx);
        const float u0 = bf2f_lo(uw.x), u1 = bf2f_hi(uw.x), u2 = bf2f_lo(uw.y), u3 = bf2f_hi(uw.y);
        v2u o; o.x = pk2(u0 * (acc[i][0] + b), u1 * (acc[i][1] + b)); o.y = pk2(u2 * (acc[i][2] + b), u3 * (acc[i][3] + b));
        *(v2u*)(Y + (size_t)(m0 + t) * YW + 128 * g + 4 * cx) = o;
    }
    __syncthreads();
}

struct AttnState { float q[16], o[16], mrun, lrun; };
__device__ __forceinline__ void attn_key(AttnState& S, const LAS bf16* Ks, const LAS bf16* Vs, int key, int sub, float bias) {
    const LAS v4u* kp = (const LAS v4u*)(Ks + key * 128 + 16 * sub);
    float k0[8], k1[8]; unpack8(kp[0], k0); unpack8(kp[1], k1);
    float s = 0.f;
#pragma unroll
    for (int i = 0; i < 8; ++i) s += S.q[i] * k0[i] + S.q[8 + i] * k1[i];
    s += __shfl_xor(s, 1); s += __shfl_xor(s, 2); s += __shfl_xor(s, 4);
    s += bias;
    if (s > S.mrun) { const float corr = __expf(S.mrun - s); S.lrun *= corr;
#pragma unroll
        for (int i = 0; i < 16; ++i) S.o[i] *= corr;
        S.mrun = s; }
    const float p = __expf(s - S.mrun);
    S.lrun += p;
    const LAS v4u* vp = (const LAS v4u*)(Vs + key * 128 + 16 * sub);
    float v0[8], v1[8]; unpack8(vp[0], v0); unpack8(vp[1], v1);
#pragma unroll
    for (int i = 0; i < 8; ++i) { S.o[i] += p * v0[i]; S.o[8 + i] += p * v1[i]; }
}
__device__ __forceinline__ void attn_store(const AttnState& S, bf16* dst) {
    const float inv = 1.0f / S.lrun; float y0[8], y1[8];
#pragma unroll
    for (int i = 0; i < 8; ++i) { y0[i] = S.o[i] * inv; y1[i] = S.o[8 + i] * inv; }
    *(v4u*)dst = pack8(y0); *(v4u*)(dst + 8) = pack8(y1);
}
constexpr float ATT_SCALE = 0.08838834764831845f;

__device__ __forceinline__ void unitAttnCtx(const Args& a, const Ctx& F, int unit) {
    const int qb = unit & 3, h = (unit >> 2) & 7, b = unit >> 5;
    const bf16* Z = (const bf16*)(a.ws + WS_Z); bf16* Y = (bf16*)(a.ws + WS_Y);
    LAS bf16* Ks = (LAS bf16*)F.lds; LAS bf16* Vs = (LAS bf16*)(F.lds + 65536);
    const int qi = F.tid >> 3, sub = F.tid & 7;
    const int mq = b * 256 + 64 * qb + qi;
    AttnState S; S.mrun = -1.0e30f; S.lrun = 0.f;
    { float q0[8], q1[8]; const bf16* qp = Z + (size_t)mq * INW + 2048 + h * 128 + 16 * sub; unpack8(*(const v4u*)qp, q0); unpack8(*(const v4u*)(qp + 8), q1);
#pragma unroll
      for (int i = 0; i < 8; ++i) { S.q[i] = q0[i] * ATT_SCALE; S.q[8 + i] = q1[i] * ATT_SCALE; S.o[i] = 0.f; S.o[8 + i] = 0.f; } }
    for (int p = F.tid; p < 4096; p += NTHR) { const int key = p >> 4, c16 = p & 15; const bf16* src = Z + (size_t)(b * 256 + key) * INW + h * 128 + 8 * c16;
        *(LAS v4u*)(Ks + key * 128 + 8 * c16) = *(const v4u*)(src + 3072); *(LAS v4u*)(Vs + key * 128 + 8 * c16) = *(const v4u*)(src + 4096); }
    __syncthreads();
    for (int key = 0; key < 256; ++key) attn_key(S, Ks, Vs, key, sub, 0.f);
    attn_store(S, Y + (size_t)mq * YW + 1024 + h * 128 + 16 * sub);
    __syncthreads();
}
__device__ __forceinline__ void unitAttnLat(const Args& a, const Ctx& F, int l, int unit) {
    const int r = unit & 15, h = (unit >> 4) & 7, b = unit >> 7;
    const bf16* Z = (const bf16*)(a.ws + WS_Z); bf16* Y = (bf16*)(a.ws + WS_Y);
    const float* ROPE = (const float*)(a.ws + WS_ROPE);
    LAS bf16* Ks = (LAS bf16*)F.lds; LAS bf16* Vs = (LAS bf16*)(F.lds + 65536); LAS float* rp = (LAS float*)(F.lds + 131072);
    const int qc = F.tid >> 3, sub = F.tid & 7;
    const int r_start = min(max(r - 4, 0), 8), c_start = min(max(qc - 8, 0), 48);
    const int mq = NCTX + b * 1024 + r * 64 + qc;
    for (int i = F.tid; i < 15 * 31; i += NTHR) rp[i] = a.rpb[(size_t)(l * 8 + h) * 465 + i];
    AttnState S; S.mrun = -1.0e30f; S.lrun = 0.f;
    {
        const bool lo = (sub & 3) < 2; const int half = sub >> 2, pos = half ? qc : r, fi0 = 16 * (sub & 1);
        const bf16* qp = Z + (size_t)mq * INW + 2048 + h * 128 + 16 * sub; const bf16* pp = lo ? qp + 32 : qp - 32;
        float x0[8], x1[8], y0[8], y1[8]; unpack8(*(const v4u*)qp, x0); unpack8(*(const v4u*)(qp + 8), x1); unpack8(*(const v4u*)pp, y0); unpack8(*(const v4u*)(pp + 8), y1);
#pragma unroll
        for (int i = 0; i < 16; ++i) { const float x = i < 8 ? x0[i & 7] : x1[i & 7], y = i < 8 ? y0[i & 7] : y1[i & 7];
            const float cs = ROPE[2 * (pos * 32 + fi0 + i)], sn = ROPE[2 * (pos * 32 + fi0 + i) + 1];
            S.q[i] = (lo ? (x * cs - y * sn) : (x * cs + y * sn)) * ATT_SCALE; S.o[i] = 0.f; }
    }
    for (int chn = 0; chn < 2; ++chn) {
        __syncthreads();
        for (int job = F.tid; job < 1024; job += NTHR) {
            const int key = job >> 2, half = (job >> 1) & 1, sp = job & 1;
            const int kr = r_start + 4 * chn + (key >> 6), kc = key & 63, pos = half ? kc : kr;
            const bf16* src = Z + (size_t)(NCTX + b * 1024 + kr * 64 + kc) * INW + 3072 + h * 128 + 64 * half + 16 * sp;
            float lo0[8], lo1[8], hi0[8], hi1[8]; unpack8(*(const v4u*)src, lo0); unpack8(*(const v4u*)(src + 8), lo1); unpack8(*(const v4u*)(src + 32), hi0); unpack8(*(const v4u*)(src + 40), hi1);
            float a0[8], a1[8], b0[8], b1[8];
#pragma unroll
            for (int i = 0; i < 8; ++i) {
                const float c0 = ROPE[2 * (pos * 32 + 16 * sp + i)], s0 = ROPE[2 * (pos * 32 + 16 * sp + i) + 1], c1 = ROPE[2 * (pos * 32 + 16 * sp + 8 + i)], s1 = ROPE[2 * (pos * 32 + 16 * sp + 8 + i) + 1];
                a0[i] = lo0[i] * c0 - hi0[i] * s0; b0[i] = hi0[i] * c0 + lo0[i] * s0;
                a1[i] = lo1[i] * c1 - hi1[i] * s1; b1[i] = hi1[i] * c1 + lo1[i] * s1; }
            LAS bf16* d = Ks + key * 128 + 64 * half + 16 * sp;
            *(LAS v4u*)d = pack8(a0); *(LAS v4u*)(d + 8) = pack8(a1); *(LAS v4u*)(d + 32) = pack8(b0); *(LAS v4u*)(d + 40) = pack8(b1);
        }
        for (int p = F.tid; p < 4096; p += NTHR) { const int key = p >> 4, c16 = p & 15; const int kr = r_start + 4 * chn + (key >> 6), kc = key & 63;
            *(LAS v4u*)(Vs + key * 128 + 8 * c16) = *(const v4u*)(Z + (size_t)(NCTX + b * 1024 + kr * 64 + kc) * INW + 4096 + h * 128 + 8 * c16); }
        __syncthreads();
        for (int jj = 0; jj < 4; ++jj) {
            const int kr = r_start + 4 * chn + jj, dr = kr - r + 7;
            for (int kk = 0; kk < 16; ++kk) { const int kc = c_start + kk, dc = min(max(kc - qc + 15, 0), 30);
                attn_key(S, Ks, Vs, jj * 64 + kc, sub, rp[dr * 31 + dc]); }
        }
    }
    for (int chn = 0; chn < 2; ++chn) {
        __syncthreads();
        for (int p = F.tid; p < 4096; p += NTHR) { const int key = p >> 4, c16 = p & 15;
            const size_t off = ((size_t)(b * 4 + l) * 512 + 256 * chn + key) * 1024 + h * 128 + 8 * c16;
            const f32x4 k0 = *(const f32x4*)(a.cache_k + off), k1 = *(const f32x4*)(a.cache_k + off + 4), v0 = *(const f32x4*)(a.cache_v + off), v1 = *(const f32x4*)(a.cache_v + off + 4);
            v4u kw, vw; kw.x = pk2(k0.x, k0.y); kw.y = pk2(k0.z, k0.w); kw.z = pk2(k1.x, k1.y); kw.w = pk2(k1.z, k1.w);
            vw.x = pk2(v0.x, v0.y); vw.y = pk2(v0.z, v0.w); vw.z = pk2(v1.x, v1.y); vw.w = pk2(v1.z, v1.w);
            *(LAS v4u*)(Ks + key * 128 + 8 * c16) = kw; *(LAS v4u*)(Vs + key * 128 + 8 * c16) = vw; }
        __syncthreads();
        for (int key = 0; key < 256; ++key) attn_key(S, Ks, Vs, key, sub, 0.f);
    }
    attn_store(S, Y + (size_t)mq * YW + 1024 + h * 128 + 16 * sub);
    __syncthreads();
}

__device__ __forceinline__ void unitHgrn(const Args& a, const Ctx& F, int l, bool lat, int b, int h, int dir) {
    const bf16* Z = (const bf16*)(a.ws + WS_Z); const float* LOGF = (const float*)(a.ws + WS_LOGF);
    float* O = (float*)(a.ws + (dir ? WS_OB : WS_OF));
    LAS float* qs = (LAS float*)F.lds; LAS float* fs = (LAS float*)(F.lds + 16384); LAS float* vs = (LAS float*)(F.lds + 32768); LAS float* op = (LAS float*)(F.lds + 49152);
    const int n = lat ? 1024 : 256, mbase = lat ? NCTX + b * 1024 : b * 256;
    const int e = F.tid & 127, dq = F.tid >> 7;
    float S[32];
    if (lat) {
#pragma unroll
        for (int i = 0; i < 32; ++i) S[i] = a.state[((((size_t)b * 4 + l) * 2 + dir) * 8 + h) * 16384 + (size_t)(32 * dq + i) * 128 + e];
    } else {
#pragma unroll
        for (int i = 0; i < 32; ++i) S[i] = 0.f;
    }
    for (int blk = 0; blk < n / 32; ++blk) {
        __syncthreads();
        {
            const int tt = F.tid >> 4, d8 = 8 * (F.tid & 15);
            const int t = dir ? (n - 1 - (32 * blk + tt)) : (32 * blk + tt);
            const size_t m = (size_t)(mbase + t);
            float q[8], v[8]; unpack8(*(const v4u*)(Z + m * INW + 5120 + h * 128 + d8), q); unpack8(*(const v4u*)(Z + m * INW + 8192 + h * 128 + d8), v);
            const f32x4 f0 = *(const f32x4*)(LOGF + m * 2048 + dir * 1024 + h * 128 + d8), f1 = *(const f32x4*)(LOGF + m * 2048 + dir * 1024 + h * 128 + d8 + 4);
            const float lf[8] = {f0.x, f0.y, f0.z, f0.w, f1.x, f1.y, f1.z, f1.w};
#pragma unroll
            for (int j = 0; j < 8; ++j) { qs[tt * 128 + d8 + j] = q[j]; vs[tt * 128 + d8 + j] = v[j]; fs[tt * 128 + d8 + j] = __expf(lf[j]); }
        }
        __syncthreads();
        for (int tt = 0; tt < 32; ++tt) {
            const float v = vs[tt * 128 + e]; float po = 0.f;
#pragma unroll
            for (int i4 = 0; i4 < 8; ++i4) {
                const f32x4 f = *(const LAS f32x4*)(fs + tt * 128 + 32 * dq + 4 * i4), q = *(const LAS f32x4*)(qs + tt * 128 + 32 * dq + 4 * i4);
#pragma unroll
                for (int j = 0; j < 4; ++j) { const float ff = f[j]; float s = S[4 * i4 + j]; s = ff * s + (1.0f - ff) * v; S[4 * i4 + j] = s; po += q[j] * s; }
            }
            op[(dq * 32 + tt) * 128 + e] = po;
        }
        __syncthreads();
        {
            const int tt = F.tid >> 4, e8 = 8 * (F.tid & 15);
            const int t = dir ? (n - 1 - (32 * blk + tt)) : (32 * blk + tt);
            f32x4 s0 = {0.f, 0.f, 0.f, 0.f}, s1 = s0;
#pragma unroll
            for (int d = 0; d < 4; ++d) { s0 += *(const LAS f32x4*)(op + (d * 32 + tt) * 128 + e8); s1 += *(const LAS f32x4*)(op + (d * 32 + tt) * 128 + e8 + 4); }
            float* dst = O + (size_t)(mbase + t) * 1024 + h * 128 + e8;
            *(f32x4*)dst = s0; *(f32x4*)(dst + 4) = s1;
        }
    }
    if (!lat) {
        float* so = a.out + OUT_S + ((((size_t)b * 4 + l) * 2 + dir) * 8 + h) * 16384;
#pragma unroll
        for (int i = 0; i < 32; ++i) so[(size_t)(32 * dq + i) * 128 + e] = S[i];
    }
    __syncthreads();
}

constexpr int NU_HL = 32, NU_AL = 256, NU_HC = 512, NU_AC = 1024, NU_A = 640, NU_M1 = NU_HL + NU_AL + NU_HC + NU_AC + NU_A;
__device__ __forceinline__ void phase_mixers(const Args& a, const Ctx& F, int l) {
    unsigned* head = (unsigned*)(a.ws + WS_CTL) + CW_Q + 64 * l;
    volatile LAS unsigned* bc = (volatile LAS unsigned*)(F.lds + LDSCTL_OFF) + 4;
    for (;;) {
        __syncthreads();
        if (F.tid == 0) bc[0] = __hip_atomic_fetch_add(head, 1u, __ATOMIC_RELAXED, __HIP_MEMORY_SCOPE_AGENT);
        __syncthreads();
        int u = (int)bc[0];
        if (u >= NU_M1) break;
        if (u < NU_HL) { unitHgrn(a, F, l, true, u >> 4, (u >> 1) & 7, u & 1); continue; }
        u -= NU_HL;
        if (u < NU_AL) { unitAttnLat(a, F, l, u); continue; }
        u -= NU_AL;
        if (u < NU_HC) { unitHgrn(a, F, l, false, u >> 4, (u >> 1) & 7, u & 1); continue; }
        u -= NU_HC;
        if (u < NU_AC) { unitAttnCtx(a, F, u); continue; }
        u -= NU_AC;
        unitA(a, F, l, u);
    }
}

__device__ __forceinline__ const Args* args_ptr() { unsigned long long p = (unsigned long long)__builtin_amdgcn_kernarg_segment_ptr(); asm volatile("" : "+s"(p)); return (const Args*)(const void __attribute__((address_space(4)))*)p; }
__device__ __forceinline__ Ctx make_ctx() {
    Ctx F; int t = threadIdx.x; asm volatile("" : "+v"(t));
    unsigned z = 0; asm volatile("" : "+s"(z));
    F.lds = (LAS unsigned char*)(uintptr_t)z;
    F.tid = t; F.lane = t & 63; F.wave = __builtin_amdgcn_readfirstlane(t >> 6);
    F.G = gridDim.x; { const int bx = blockIdx.x; F.vcu = (F.G % 8 == 0) ? (bx % 8) * (F.G / 8) + bx / 8 : bx; }
    return F;
}
__global__ void __launch_bounds__(NTHR, 2) fwd(Args a_in) {
    extern __shared__ __attribute__((aligned(16))) unsigned char lds_raw[];
    volatile LAS unsigned* MISC = (volatile LAS unsigned*)((LAS unsigned char*)lds_raw + LDSCTL_OFF);
    for (int u = threadIdx.x; u < 256; u += NTHR) MISC[u] = 0u;
    __syncthreads();
    const int lo = a_in.ph_lo, hi = a_in.ph_hi;
    const bool multi = (hi - lo) > 1;
    XcdBarrier bar; bar.bar = (unsigned*)(a_in.ws + WS_CTL) + CW_BAR; bar.x = 0; bar.st = MISC;
    if (multi) bar = xcd_barrier_post((unsigned*)(a_in.ws + WS_CTL) + CW_BAR, MISC);
#ifndef PMASK
#define PMASK 0xFFFFFFFFu
#endif
#define PM(b) ((PMASK >> (b)) & 1u)
#define IN(k) (lo <= (k) && (k) < hi)
#define SEAM(k) do { if (IN(k) && IN((k) + 1)) xcd_barrier(bar); } while (0)

    if (PM(0) && IN(PH_PRO)) { const Args& a = *args_ptr(); const Ctx F = make_ctx(); phase_prologue(a, F); SEAM(PH_PRO); }
    if (PM(1) && IN(PH_T1)) { const Args& a = *args_ptr(); const Ctx F = make_ctx(); const float* MOD = (const float*)(a.ws + WS_MOD);
        rownorm_phase(a, F, true, nullptr, nullptr, nullptr, true, a.norm_g + 0, MOD + 1 * 2048, MOD + 0 * 2048); SEAM(PH_T1); }

    for (int l = 0; l < DEPTH; ++l) {
        const int pb = PH_L0 + l * PH_PER_LAYER;
        if (PM(2) && IN(pb + 0)) {
            const Args& a = *args_ptr(); const Ctx F = make_ctx(); unsigned char* ws = a.ws; const bf16* wl = (const bf16*)(ws + WS_WT) + (size_t)l * WL_ELEMS;
            pg8::Gemm g{(const bf16*)(ws + WS_H), wl + OFF_IN, MTOK, INW, DM, DM, DM}; pg8::StaticOrder S; S.init(MTOK, INW, F.G, (int)blockIdx.x);
            EpiIn E{(bf16*)(ws + WS_Z), (float*)(ws + WS_LOGF), (const float*)(ws + WS_LB) + l * 1024, a.out + OUT_K + (size_t)l * 262144, a.out + OUT_V + (size_t)l * 262144};
            pg8::gemm_phase<EpiIn, pg8::StaticOrder, true, true>(F.lds, g, S, E);
            SEAM(pb + 0);
        }
        if (PM(3) && IN(pb + 1)) { const Args& a = *args_ptr(); const Ctx F = make_ctx(); phase_mixers(a, F, l); SEAM(pb + 1); }
        if (PM(4) && IN(pb + 2)) { const Args& a = *args_ptr(); const Ctx F = make_ctx(); phase_ycnorm(a, F); SEAM(pb + 2); }
        if (PM(5) && IN(pb + 3)) {
            {   const Args& a = *args_ptr(); const Ctx F = make_ctx(); unsigned char* ws = a.ws; const bf16* wl = (const bf16*)(ws + WS_WT) + (size_t)l * WL_ELEMS;
                pg8::StaticOrder S; S.init(MTOK, DM, F.G, (int)blockIdx.x);
                pg8::Gemm g{(const bf16*)(ws + WS_Y), wl + OFF_UP, MTOK, DM, 1024, YW, YW}; EpiUp<0> E{(const bf16*)(ws + WS_Z) + 10240, (float*)(ws + WS_MGF), (bf16*)(ws + WS_MG)};
                pg8::gemm_phase<EpiUp<0>, pg8::StaticOrder, true, true>(F.lds, g, S, E); }
            {   const Args& a = *args_ptr(); const Ctx F = make_ctx(); unsigned char* ws = a.ws; const bf16* wl = (const bf16*)(ws + WS_WT) + (size_t)l * WL_ELEMS;
                pg8::StaticOrder S; S.init(MTOK, DM, F.G, (int)blockIdx.x);
                pg8::Gemm g{(const bf16*)(ws + WS_Y) + 1024, wl + OFF_UP + 1024, MTOK, DM, 1024, YW, YW}; EpiUp<1> E{(const bf16*)(ws + WS_Z) + 10240 + 2048, (float*)(ws + WS_MGF), (bf16*)(ws + WS_MG)};
                pg8::gemm_phase<EpiUp<1>, pg8::StaticOrder, true, true>(F.lds, g, S, E); }
            {   const Args& a = *args_ptr(); const Ctx F = make_ctx(); unsigned char* ws = a.ws; const bf16* wl = (const bf16*)(ws + WS_WT) + (size_t)l * WL_ELEMS;
                pg8::StaticOrder S; S.init(MTOK, DM, F.G, (int)blockIdx.x);
                pg8::Gemm g{(const bf16*)(ws + WS_Y) + 2048, wl + OFF_UP + 2048, MTOK, DM, 1024, YW, YW}; EpiUp<2> E{(const bf16*)(ws + WS_Z) + 10240 + 4096, (float*)(ws + WS_MGF), (bf16*)(ws + WS_MG)};
                pg8::gemm_phase<EpiUp<2>, pg8::StaticOrder, true, true>(F.lds, g, S, E); }
            SEAM(pb + 3);
        }
        if (PM(6) && IN(pb + 4)) {
            const Args& a = *args_ptr(); const Ctx F = make_ctx(); unsigned char* ws = a.ws; const bf16* wl = (const bf16*)(ws + WS_WT) + (size_t)l * WL_ELEMS;
            pg8::Gemm g{(const bf16*)(ws + WS_MG), wl + OFF_OUT, MTOK, DM, DM, DM, DM}; pg8::StaticOrder S; S.init(MTOK, DM, F.G, (int)blockIdx.x);
            EpiF32P E{(float*)(ws + WS_T), DM}; pg8::gemm_phase<EpiF32P, pg8::StaticOrder, true, true>(F.lds, g, S, E);
            SEAM(pb + 4);
        }
        if (PM(7) && IN(pb + 5)) { const Args& a = *args_ptr(); const Ctx F = make_ctx(); const float* modl = (const float*)(a.ws + WS_MOD) + (size_t)l * 3 * 12288; const float* gl = a.norm_g + (size_t)l * 4 * DM;
            rownorm_phase(a, F, false, (const float*)(a.ws + WS_T), modl + 2 * 2048, gl + 1 * DM, true, gl + 2 * DM, modl + 4 * 2048, modl + 3 * 2048); SEAM(pb + 5); }
        if (PM(8) && IN(pb + 6)) {
            const Args& a = *args_ptr(); const Ctx F = make_ctx(); unsigned char* ws = a.ws; const bf16* wl = (const bf16*)(ws + WS_WT) + (size_t)l * WL_ELEMS;
            pg8::Gemm g{(const bf16*)(ws + WS_H), wl + OFF_FI, MTOK, NFI, DM, DM, DM}; pg8::StaticOrder S; S.init(MTOK, NFI, F.G, (int)blockIdx.x);
            EpiSwi E{(bf16*)(ws + WS_ACT)}; pg8::gemm_phase<EpiSwi, pg8::StaticOrder, true, true>(F.lds, g, S, E);
            SEAM(pb + 6);
        }
        if (PM(9) && IN(pb + 7)) {
            const Args& a = *args_ptr(); const Ctx F = make_ctx(); unsigned char* ws = a.ws; const bf16* wl = (const bf16*)(ws + WS_WT) + (size_t)l * WL_ELEMS;
            pg8::Gemm g{(const bf16*)(ws + WS_ACT), wl + OFF_FO, MTOK, DM, DFF, DFF, DFF}; pg8::StaticOrder S; S.init(MTOK, DM, F.G, (int)blockIdx.x);
            EpiF32P E{(float*)(ws + WS_T), DM}; pg8::gemm_phase<EpiF32P, pg8::StaticOrder, true, true>(F.lds, g, S, E);
            SEAM(pb + 7);
        }
        if (PM(10) && IN(pb + 8)) {
            const Args& a = *args_ptr(); const Ctx F = make_ctx(); const float* MOD = (const float*)(a.ws + WS_MOD);
            const bool last = (l == DEPTH - 1); const int ln = last ? l : l + 1;
            const float* modl = MOD + (size_t)l * 3 * 12288; const float* gl = a.norm_g + (size_t)l * 4 * DM;
            const float* modn = MOD + (size_t)ln * 3 * 12288; const float* gnn = a.norm_g + (size_t)ln * 4 * DM;
            rownorm_phase(a, F, false, (const float*)(a.ws + WS_T), modl + 5 * 2048, gl + 3 * DM, !last, gnn + 0, modn + 1 * 2048, modn + 0 * 2048);
            SEAM(pb + 8);
        }
    }
#undef IN
#undef SEAM
}

#ifndef MK_ONE_LAUNCH
#define MK_ONE_LAUNCH 0
#endif
extern "C" void kernel_launch(void* const* d_in, const int* in_sizes, int n_in, void* d_out, int out_size, void* d_ws, size_t ws_size, hipStream_t stream) {
    static int grid = 0;
    if (grid == 0) {
        if (n_in != 21 || (size_t)out_size != OUT_END || ws_size < WS_END) { fprintf(stderr, "kernel_launch: unexpected shapes: n_in %d out %d ws %zu\n", n_in, out_size, ws_size); grid = -1; return; }
        int dev = 0, cus = 0, per_cu = 0;
        if (hipGetDevice(&dev) != hipSuccess || hipDeviceGetAttribute(&cus, hipDeviceAttributeMultiprocessorCount, dev) != hipSuccess) { grid = -1; return; }
        if (hipFuncSetAttribute((const void*)fwd, hipFuncAttributeMaxDynamicSharedMemorySize, LDS_BYTES) != hipSuccess) { fprintf(stderr, "kernel_launch: hipFuncSetAttribute failed\n"); grid = -1; return; }
        if (hipOccupancyMaxActiveBlocksPerMultiprocessor(&per_cu, (const void*)fwd, NTHR, LDS_BYTES) != hipSuccess || per_cu < 1) fprintf(stderr, "kernel_launch: occupancy query says %d\n", per_cu);
        (void)hipGetLastError();
        grid = cus;
    }
    if (grid < 0) return;
    (void)hipMemsetAsync((char*)d_ws + WS_CTL, 0, CTL_ZERO_BYTES, stream);
    Args a{};
    const float** ap = (const float**)&a;
    for (int i = 0; i < 21; ++i) ap[i] = (const float*)d_in[i];
    a.out = (float*)d_out; a.ws = (unsigned char*)d_ws;
#if MK_ONE_LAUNCH
    a.ph_lo = 0; a.ph_hi = PH_END;
    hipLaunchKernelGGL(fwd, dim3(grid), dim3(NTHR), LDS_BYTES, stream, a);
#else
    for (int p = 0; p < PH_END; ++p) { a.ph_lo = p; a.ph_hi = p + 1; hipLaunchKernelGGL(fwd, dim3(grid), dim3(NTHR), LDS_BYTES, stream, a); }
#endif
}
```

```cpp
#include <hip/hip_runtime.h>
#include <cstdio>
#include <cstdint>
namespace pg8 {
#define PG8_LAS __attribute__((address_space(3)))
typedef unsigned short bf16_t;
typedef short bf16x8 __attribute__((ext_vector_type(8)));
typedef float f32x4 __attribute__((ext_vector_type(4)));
typedef unsigned u32x4 __attribute__((ext_vector_type(4)));
constexpr int BM = 256, BK = 64, HALF = 128, HTB = HALF * BK * 2  , STAGE_BYTES = 8 * HTB, NXCD = 8, WGM = 8;

__host__ __device__ __forceinline__ int lds_byte(int r, int c) { const int st = (r >> 4) * 2 + (c >> 5), rr = r & 15, cc = c & 31, ob = rr * 64 + cc * 2; return st * 1024 + (ob ^ (((ob >> 9) & 1) << 5)); }
__host__ __device__ __forceinline__ void stage_rc(int b, int& R, int& C) { const int st = b / 1024, sb = b % 1024, swz = sb ^ (((sb >> 9) & 1) << 5); R = (st >> 1) * 16 + swz / 64; C = (st & 1) * 32 + (swz % 64) / 2; }
__host__ __device__ __forceinline__ int perm32(int rho) { const int n = rho >> 4, i = rho & 15; return 8 * (i >> 2) + 4 * n + (i & 3); }

struct Unit { int pm, pn; };
struct Gemm { const bf16_t* A; const bf16_t* Bt; int M, N, K, lda, ldb; };

struct StaticOrder {
    int nM, nN, nwg, G, c;
    __host__ __device__ void init(int M, int N, int G_, int c_) { nM = M / BM; nN = N / BM; nwg = nM * nN; G = G_; c = c_; }
    __host__ __device__ bool next(int i, Unit& u) const {
        const long L = (long)i * G + c; if (L >= nwg) return false;
        int wgid = (int)L; { const int q = nwg / NXCD, r = nwg % NXCD, xcd = wgid % NXCD, off = wgid / NXCD; wgid = (xcd < r ? xcd * (q + 1) : r * (q + 1) + (xcd - r) * q) + off; }
        const int nig = WGM * nN, gid = wgid / nig, fm = gid * WGM, gsz = (nM - fm) < WGM ? (nM - fm) : WGM;
        u.pm = fm + ((wgid % nig) % gsz); u.pn = (wgid % nig) / gsz; return true;
    }
    __device__ __forceinline__ void a_ready(const Unit&) const {}
    __device__ __forceinline__ void done(const Unit&) const {}
};
template <class Epi, class Sched, bool ALIGN_EPI = false, bool SP2 = false>
__device__ __forceinline__ void gemm_phase(PG8_LAS unsigned char* lds, const Gemm g, const Sched& S, const Epi& E) {
    int tid_ = threadIdx.x; asm volatile("" : "+v"(tid_));
    const int tid = tid_, wid = __builtin_amdgcn_readfirstlane(tid >> 6), lane = tid & 63, wr = wid >> 2, wc = wid & 3, fr = lane & 15, fq = lane >> 4;
    const int K = g.K, nt = K / BK;
    unsigned voffA[2], voffB[2];
#pragma unroll
    for (int i = 0; i < 2; ++i) { int R, C; stage_rc(tid * 16 + i * 8192, R, C); const int Rb = Epi::PERM ? ((R & ~31) + perm32(R & 31)) : R;
        voffA[i] = (unsigned)(R * g.lda + C) * 2u; voffB[i] = (unsigned)(Rb * g.ldb + C) * 2u; }
    const size_t kstep = (size_t)(BK * 2);
    const size_t hstepA = (size_t)HALF * g.lda * 2, hstepB = (size_t)HALF * g.ldb * 2;
    const size_t tstepA = 2 * hstepA, tstepB = 2 * hstepB;
    const unsigned ldsw = (unsigned)wid * 1024u;
    const int aoff = lds_byte(wr * 64 + fr, fq * 8), boff = lds_byte(wc * 32 + fr, fq * 8);
#define PG8_SA(b, h) (((b) * 2 + (h)) * HTB)
#define PG8_SB(b, h) ((4 + (b) * 2 + (h)) * HTB)
#define PG8_STAGE(bufoff, gbase, voff) do { _Pragma("unroll") for (int _i = 0; _i < 2; ++_i) \
        __builtin_amdgcn_global_load_lds((const unsigned*)((const char*)(gbase) + (voff)[_i]), (PG8_LAS unsigned*)(lds + (bufoff) + ldsw + _i * 8192), 16, 0, 0); } while (0)
#define PG8_LDA(dst, b, h) do { _Pragma("unroll") for (int m = 0; m < 4; ++m) _Pragma("unroll") for (int k = 0; k < 2; ++k) dst[m][k] = *(const PG8_LAS bf16x8*)(lds + PG8_SA(b, h) + aoff + m * 2048 + k * 1024); } while (0)
#define PG8_LDB(dst, b, h) do { _Pragma("unroll") for (int n = 0; n < 2; ++n) _Pragma("unroll") for (int k = 0; k < 2; ++k) dst[n][k] = *(const PG8_LAS bf16x8*)(lds + PG8_SB(b, h) + boff + n * 2048 + k * 1024); } while (0)
#define PG8_MMA(ai, bj, At, Bt) do { __builtin_amdgcn_s_setprio(1); _Pragma("unroll") for (int m = 0; m < 4; ++m) _Pragma("unroll") for (int n = 0; n < 2; ++n) _Pragma("unroll") for (int k = 0; k < 2; ++k) \
        acc[ai][bj][m][n] = __builtin_amdgcn_mfma_f32_16x16x32_bf16(Bt[n][k], At[m][k], acc[ai][bj][m][n], 0, 0, 0); __builtin_amdgcn_s_setprio(0); } while (0)
#define PG8_WAIT_V(n) asm volatile("s_waitcnt vmcnt(" #n ")" ::: "memory")
#define PG8_WAIT_L(n) asm volatile("s_waitcnt lgkmcnt(" #n ")" ::: "memory")
#define PG8_BAR __builtin_amdgcn_s_barrier()
#define PG8_SCHED __builtin_amdgcn_sched_barrier(0)
    Unit cur, nxt; int ui = 0;
    if (!S.next(0, cur)) return;
    f32x4 acc[2][2][4][2];
#pragma unroll
    for (int a = 0; a < 2; ++a)
#pragma unroll
        for (int b = 0; b < 2; ++b)
#pragma unroll
            for (int m = 0; m < 4; ++m)
#pragma unroll
                for (int n = 0; n < 2; ++n) acc[a][b][m][n] = (f32x4){0.f, 0.f, 0.f, 0.f};
    bf16x8 At[4][2], B0[2][2], B1[2][2];
    const char* cA = (const char*)g.A + (size_t)cur.pm * tstepA; const char* cB = (const char*)g.Bt + (size_t)cur.pn * tstepB;
    S.a_ready(cur);
    if constexpr (SP2) {
        PG8_STAGE(PG8_SB(0, 0), cB, voffB); PG8_STAGE(PG8_SB(0, 1), cB + hstepB, voffB); PG8_STAGE(PG8_SA(0, 0), cA, voffA); PG8_STAGE(PG8_SA(0, 1), cA + hstepA, voffA);
        if (wr == 1) PG8_BAR;
        PG8_WAIT_V(2); PG8_BAR;
        PG8_STAGE(PG8_SB(1, 0), cB + kstep, voffB); PG8_STAGE(PG8_SA(1, 0), cA + kstep, voffA); PG8_STAGE(PG8_SB(1, 1), cB + hstepB + kstep, voffB);
        PG8_WAIT_V(6); PG8_BAR;
    } else {
        PG8_STAGE(PG8_SB(0, 0), cB, voffB); PG8_STAGE(PG8_SA(0, 0), cA, voffA); PG8_STAGE(PG8_SB(0, 1), cB + hstepB, voffB); PG8_STAGE(PG8_SA(0, 1), cA + hstepA, voffA);
        if (wr == 1) PG8_BAR;
        PG8_WAIT_V(4); PG8_BAR;
        PG8_STAGE(PG8_SB(1, 0), cB + kstep, voffB); PG8_STAGE(PG8_SA(1, 0), cA + kstep, voffA); PG8_STAGE(PG8_SB(1, 1), cB + hstepB + kstep, voffB);
        PG8_WAIT_V(6); PG8_BAR;
    }
    for (;;) {
        const bool has_next = S.next(ui + 1, nxt);
        const char* nA = has_next ? (const char*)g.A + (size_t)nxt.pm * tstepA : cA; const char* nB = has_next ? (const char*)g.Bt + (size_t)nxt.pn * tstepB : cB;
        for (int t = 0; t < nt; t += 2) {
            const bool last = (t == nt - 2);
            const char* a1 = cA + (size_t)(t + 1) * kstep;
            const char* a2 = last ? nA : cA + (size_t)(t + 2) * kstep; const char* b2 = last ? nB : cB + (size_t)(t + 2) * kstep;
            const char* a3 = a2 + kstep; const char* b3 = b2 + kstep;
            if (last && has_next) S.a_ready(nxt);
            if constexpr (SP2) {
            PG8_LDB(B0, 0, 0); PG8_LDB(B1, 0, 1); PG8_SCHED; PG8_LDA(At, 0, 0); PG8_STAGE(PG8_SA(1, 1), a1 + hstepA, voffA);
            PG8_WAIT_V(8); PG8_WAIT_L(0); PG8_BAR; PG8_MMA(0, 0, At, B0); PG8_MMA(0, 1, At, B1); PG8_BAR; PG8_SCHED;
            PG8_LDA(At, 0, 1); PG8_STAGE(PG8_SB(0, 0), b2, voffB); PG8_STAGE(PG8_SB(0, 1), b2 + hstepB, voffB); PG8_STAGE(PG8_SA(0, 0), a2, voffA);
            PG8_WAIT_V(8); PG8_WAIT_L(0); PG8_BAR; PG8_MMA(1, 0, At, B0); PG8_MMA(1, 1, At, B1); PG8_BAR; PG8_SCHED;
            PG8_LDB(B0, 1, 0); PG8_LDB(B1, 1, 1); PG8_SCHED; PG8_LDA(At, 1, 0); PG8_STAGE(PG8_SA(0, 1), a2 + hstepA, voffA);
            PG8_WAIT_V(8); PG8_WAIT_L(0); PG8_BAR; PG8_MMA(0, 0, At, B0); PG8_MMA(0, 1, At, B1); PG8_BAR; PG8_SCHED;
            PG8_LDA(At, 1, 1); PG8_STAGE(PG8_SB(1, 0), b3, voffB); PG8_STAGE(PG8_SB(1, 1), b3 + hstepB, voffB); PG8_STAGE(PG8_SA(1, 0), a3, voffA);
            PG8_WAIT_V(8); PG8_WAIT_L(0); PG8_BAR; PG8_MMA(1, 0, At, B0); PG8_MMA(1, 1, At, B1); PG8_BAR; PG8_SCHED;
            } else {
            PG8_LDB(B0, 0, 0); PG8_SCHED; PG8_LDA(At, 0, 0); PG8_STAGE(PG8_SA(1, 1), a1 + hstepA, voffA);
            PG8_WAIT_L(8); PG8_BAR; PG8_WAIT_L(0); PG8_MMA(0, 0, At, B0); PG8_BAR; PG8_SCHED;
            PG8_LDB(B1, 0, 1); PG8_STAGE(PG8_SB(0, 0), b2, voffB);
            PG8_BAR; PG8_WAIT_L(0); PG8_MMA(0, 1, At, B1); PG8_BAR;
            PG8_LDA(At, 0, 1); PG8_STAGE(PG8_SA(0, 0), a2, voffA);
            PG8_BAR; PG8_WAIT_L(0); PG8_MMA(1, 0, At, B0); PG8_BAR; PG8_SCHED;
            PG8_STAGE(PG8_SB(0, 1), b2 + hstepB, voffB);
            PG8_WAIT_V(6); PG8_BAR; PG8_MMA(1, 1, At, B1); PG8_BAR;
            PG8_LDB(B0, 1, 0); PG8_SCHED; PG8_LDA(At, 1, 0); PG8_STAGE(PG8_SA(0, 1), a2 + hstepA, voffA);
            PG8_WAIT_L(8); PG8_BAR; PG8_WAIT_L(0); PG8_MMA(0, 0, At, B0); PG8_BAR; PG8_SCHED;
            PG8_LDB(B1, 1, 1); PG8_STAGE(PG8_SB(1, 0), b3, voffB);
            PG8_BAR; PG8_WAIT_L(0); PG8_MMA(0, 1, At, B1); PG8_BAR;
            PG8_LDA(At, 1, 1); PG8_STAGE(PG8_SA(1, 0), a3, voffA);
            PG8_BAR; PG8_WAIT_L(0); PG8_MMA(1, 0, At, B0); PG8_BAR; PG8_SCHED;
            PG8_STAGE(PG8_SB(1, 1), b3 + hstepB, voffB);
            PG8_WAIT_V(6); PG8_BAR; PG8_MMA(1, 1, At, B1); PG8_BAR;
            }
        }
        if constexpr (ALIGN_EPI) { if (wr == 0) PG8_BAR; }
        if constexpr (!Epi::AFTER_DRAIN) { E(acc, cur, wr, wc, fr, fq); S.done(cur); }
        if (!has_next) break;
#pragma unroll
        for (int a = 0; a < 2; ++a)
#pragma unroll
            for (int b = 0; b < 2; ++b)
#pragma unroll
                for (int m = 0; m < 4; ++m)
#pragma unroll
                    for (int n = 0; n < 2; ++n) acc[a][b][m][n] = (f32x4){0.f, 0.f, 0.f, 0.f};
        cur = nxt; cA = nA; cB = nB; ++ui;
        if constexpr (ALIGN_EPI) { if (wr == 1) PG8_BAR; }
    }
    PG8_WAIT_V(0);
    if constexpr (!ALIGN_EPI) { if (wr == 0) PG8_BAR; }
    PG8_BAR;
    if constexpr (Epi::AFTER_DRAIN) { E.fused(acc, cur, wr, wc, fr, fq, lds, wid, lane); S.done(cur); }
#undef PG8_SA
#undef PG8_SB
#undef PG8_STAGE
#undef PG8_LDA
#undef PG8_LDB
#undef PG8_MMA
#undef PG8_WAIT_V
#undef PG8_WAIT_L
#undef PG8_BAR
#undef PG8_SCHED
}
}

#define GAS __attribute__((address_space(1)))
#define LAS __attribute__((address_space(3)))
typedef unsigned short bf16;
typedef unsigned v4u __attribute__((ext_vector_type(4)));
typedef unsigned v2u __attribute__((ext_vector_type(2)));
typedef float f32x4 __attribute__((ext_vector_type(4)));

constexpr int DM = 2048, NCTX = 8192, NLAT = 2048, MTOK = 10240, DEPTH = 4;
constexpr int INW = 16384, DFF = 5632, NFI = 11264, YW = 3072;
constexpr float EPS = 1e-6f;
constexpr int NWAVES = 8, NTHR = 512;

constexpr size_t MiB = 1u << 20;
constexpr size_t WS_CTL = 0, CTL_ZERO_BYTES = 1 * MiB;
constexpr size_t WS_MOD = 1 * MiB;
constexpr size_t WS_LB = 2 * MiB;
constexpr size_t WS_ROPE = 2 * MiB + 65536;
constexpr size_t WS_WT = 4 * MiB;
constexpr size_t WL_ELEMS = 78643200;
constexpr size_t OFF_IN = 0, OFF_UP = 33554432, OFF_OUT = 39845888, OFF_FI = 44040192, OFF_FO = 67108864;
constexpr size_t WS_Z = 604 * MiB;
constexpr size_t WS_LOGF = 924 * MiB;
constexpr size_t WS_H = 1004 * MiB;
constexpr size_t WS_Y = 1044 * MiB;
constexpr size_t WS_OF = 1104 * MiB;
constexpr size_t WS_OB = 1144 * MiB;
constexpr size_t WS_MGF = 1184 * MiB;
constexpr size_t WS_MG = 1264 * MiB;
constexpr size_t WS_T = 1304 * MiB;
constexpr size_t WS_ACT = 1384 * MiB;
constexpr size_t WS_END = 1494 * MiB;
constexpr int CW_BAR = 4096;
constexpr int CW_Q = 16384;
constexpr size_t OUT_Y = 0, OUT_K = 20971520, OUT_V = OUT_K + 33554432, OUT_S = OUT_V + 33554432, OUT_END = OUT_S + 33554432;

constexpr int LDS_BYTES = 155648;
constexpr int LDSCTL_OFF = 154624;

constexpr int PH_PRO = 0, PH_T1 = 1, PH_L0 = 2, PH_PER_LAYER = 9, PH_END = PH_L0 + DEPTH * PH_PER_LAYER;

struct Args {
    const float *x_prompt, *x_sample, *cache_k, *cache_v, *state, *c, *c_ctx, *w_ada, *b_ada, *norm_g, *w_in, *a_w, *a_b, *rpb, *lb_logits, *w_up_a, *w_up_b, *w_up_c, *w_out, *w_fi, *w_fo;
    float* out; unsigned char* ws; int ph_lo, ph_hi;
};

__device__ __forceinline__ float bf2f_lo(unsigned w) { return __uint_as_float(w << 16); }
__device__ __forceinline__ float bf2f_hi(unsigned w) { return __uint_as_float(w & 0xffff0000u); }
__device__ __forceinline__ unsigned f2bf(float f) { unsigned u = __float_as_uint(f); return (u + 0x7fffu + ((u >> 16) & 1u)) >> 16; }
__device__ __forceinline__ unsigned pk2(float lo, float hi) { return f2bf(lo) | (f2bf(hi) << 16); }
__device__ __forceinline__ void unpack8(const v4u w, float (&f)[8]) {
    f[0] = bf2f_lo(w.x); f[1] = bf2f_hi(w.x); f[2] = bf2f_lo(w.y); f[3] = bf2f_hi(w.y); f[4] = bf2f_lo(w.z); f[5] = bf2f_hi(w.z); f[6] = bf2f_lo(w.w); f[7] = bf2f_hi(w.w); }
__device__ __forceinline__ v4u pack8(const float (&f)[8]) { v4u w; w.x = pk2(f[0], f[1]); w.y = pk2(f[2], f[3]); w.z = pk2(f[4], f[5]); w.w = pk2(f[6], f[7]); return w; }
__device__ __forceinline__ float wave_sum(float v) {
#pragma unroll
    for (int o = 1; o < 64; o <<= 1) v += __shfl_xor(v, o);
    return v;
}
__device__ __forceinline__ float sigmoidf_(float x) { return 1.0f / (1.0f + __expf(-x)); }
__device__ __forceinline__ float siluf_(float x) { return x / (1.0f + __expf(-x)); }
__device__ __forceinline__ float gelu_tanh_(float x) { const float y = 1.5957691216057308f * (x + 0.044715f * x * x * x); return x / (1.0f + __expf(-y)); }

#define XB_TMO      128
#define XB_XCNT(j)  (256  + 64 * (j))
#define XB_XSUB(j)  (1280 + 64 * (j))
#define XB_XGEN(j)  (2304 + 64 * (j))
#define XB_TOP      3328
#define XB_TOPGEN   3392
#define XCD_BAR_WORDS 3456
#define XB_SPIN_CAP (1u << 18)
__device__ __forceinline__ unsigned xb_ld(unsigned* p)              { return __hip_atomic_load(p, __ATOMIC_RELAXED, __HIP_MEMORY_SCOPE_AGENT); }
__device__ __forceinline__ unsigned xb_add(unsigned* p, unsigned v) { return __hip_atomic_fetch_add(p, v, __ATOMIC_RELAXED, __HIP_MEMORY_SCOPE_AGENT); }
__device__ __forceinline__ unsigned xb_xcc_id() { return (unsigned)__builtin_amdgcn_s_getreg((3 << 11) | 20) & 0xFu; }
#define XB_SPIN(cond, bar) do { unsigned _sp = 0; while (cond) { __builtin_amdgcn_s_sleep(1); \
    if ((++_sp & 255u) == 0u) { if (xb_ld(&(bar)[XB_TMO])) break; if (_sp > XB_SPIN_CAP) { atomicAdd(&(bar)[XB_TMO], 1u); break; } } } } while (0)
struct XcdBarrier { unsigned* bar; unsigned x; volatile LAS unsigned* st; };
__device__ __forceinline__ XcdBarrier xcd_barrier_post(unsigned* bar, volatile LAS unsigned* st) {
    XcdBarrier b; b.bar = bar; b.x = xb_xcc_id(); b.st = st;
    if (threadIdx.x == 0) (void)xb_add(&bar[XB_XCNT(b.x)], 1u);
    return b;
}
__device__ __forceinline__ void xcd_barrier_complete(unsigned* bar, unsigned x, unsigned& nloc, unsigned& nx) {
    const unsigned G = gridDim.x * gridDim.y * gridDim.z;
    unsigned sum, cnt, mine, sp = 0u;
    for (;;) {
        sum = 0u; cnt = 0u; mine = 0u;
#pragma unroll
        for (unsigned j = 0; j < 16; ++j) { const unsigned c = xb_ld(&bar[XB_XCNT(j)]); sum += c; cnt += (c > 0u) ? 1u : 0u; mine = (j == x) ? c : mine; }
        if (sum == G) break;
        __builtin_amdgcn_s_sleep(1);
        if ((++sp & 255u) == 0u) { if (xb_ld(&bar[XB_TMO])) break; if (sp > XB_SPIN_CAP) { atomicAdd(&bar[XB_TMO], 1u); break; } }
    }
    nloc = mine > 0u ? mine : 1u; nx = cnt > 0u ? cnt : 1u;
}
__device__ __forceinline__ void xcd_barrier(const XcdBarrier& b) {
    asm volatile("s_waitcnt vmcnt(0)" ::: "memory");
    __syncthreads();
    if (threadIdx.x == 0) {
        unsigned* bar = b.bar;
        __builtin_amdgcn_s_waitcnt(0);
        unsigned nloc = b.st[0], nx = b.st[1];
        if (nloc == 0u) { xcd_barrier_complete(bar, b.x, nloc, nx); b.st[0] = nloc; b.st[1] = nx; }
        const unsigned old = xb_add(&bar[XB_XSUB(b.x)], 1u);
        const unsigned gen = old / nloc;
        if (old + 1u == (gen + 1u) * nloc) {
            __builtin_amdgcn_fence(__ATOMIC_RELEASE, "agent");
            asm volatile("s_waitcnt vmcnt(0)" ::: "memory");
            const unsigned og = xb_add(&bar[XB_TOP], 1u);
            const unsigned tg = og / nx;
            if (og + 1u == (tg + 1u) * nx) xb_add(&bar[XB_TOPGEN], 1u);
            else XB_SPIN(xb_ld(&bar[XB_TOPGEN]) == tg, bar);
            __builtin_amdgcn_fence(__ATOMIC_ACQUIRE, "agent");
            xb_add(&bar[XB_XGEN(b.x)], 1u);
            asm volatile("s_waitcnt vmcnt(0)" ::: "memory");
        } else {
            XB_SPIN(xb_ld(&bar[XB_XGEN(b.x)]) == gen, bar);
            __builtin_amdgcn_fence(__ATOMIC_ACQUIRE, "agent");
            asm volatile("s_waitcnt vmcnt(0)" ::: "memory");
        }
    }
    __syncthreads();
}

struct EpiIn {
    static constexpr bool PERM = true, AFTER_DRAIN = false;
    bf16* Z; float* LOGF; const float* lbp  ; float* outK; float* outV;
    __device__ __forceinline__ void operator()(const f32x4 (&acc)[2][2][4][2], const pg8::Unit& u, int wr, int wc, int fr, int fq) const {
        const int seg = u.pn >> 2;
        const int row0 = u.pm * 256 + wr * 64 + fr, colt = u.pn * 256 + wc * 32 + 8 * fq;
#pragma unroll
        for (int ai = 0; ai < 2; ++ai)
#pragma unroll
            for (int m = 0; m < 4; ++m) {
                const int row = row0 + ai * 128 + m * 16;
#pragma unroll
                for (int bj = 0; bj < 2; ++bj) {
                    const int col = colt + bj * 128;
                    float v[8];
#pragma unroll
                    for (int j = 0; j < 4; ++j) { v[j] = acc[ai][bj][m][0][j]; v[4 + j] = acc[ai][bj][m][1][j]; }
                    if (seg == 6 || seg == 7) {
                        const float* lb = lbp + (seg - 6) * 4096 + (col - (seg == 6 ? 6144 : 7168));
                        float o[8];
#pragma unroll
                        for (int j = 0; j < 8; ++j) { const float b = lb[j]; o[j] = logf(b + (1.0f - b) * sigmoidf_(v[j])); }
                        float* dst = LOGF + (size_t)row * 2048 + (col - 6144);
                        *(f32x4*)dst = (f32x4){o[0], o[1], o[2], o[3]}; *(f32x4*)(dst + 4) = (f32x4){o[4], o[5], o[6], o[7]};
                    } else {
                        if (seg == 3 || seg == 4) {
                            if (row < NCTX) { float* dst = (seg == 3 ? outK : outV) + ((size_t)(row >> 8) * 1024 + (row & 255)) * 1024 + (col - (seg == 3 ? 3072 : 4096));
                                *(f32x4*)dst = (f32x4){v[0], v[1], v[2], v[3]}; *(f32x4*)(dst + 4) = (f32x4){v[4], v[5], v[6], v[7]}; }
                        } else if (seg == 0 || seg == 1) {
#pragma unroll
                            for (int j = 0; j < 8; ++j) v[j] = gelu_tanh_(v[j]);
                        } else if (seg == 5 || seg == 9) {
#pragma unroll
                            for (int j = 0; j < 8; ++j) v[j] = siluf_(v[j]);
                        } else if (seg >= 10) {
#pragma unroll
                            for (int j = 0; j < 8; ++j) v[j] = sigmoidf_(v[j]);
                        }
                        *(v4u*)(Z + (size_t)row * INW + col) = pack8(v);
                    }
                }
                asm volatile("" ::: "memory");
            }
    }
};
template <int BR> struct EpiUp {
    static constexpr bool PERM = true, AFTER_DRAIN = false;
    const bf16* Zg  ; float* MGF; bf16* MG;
    __device__ __forceinline__ void operator()(const f32x4 (&acc)[2][2][4][2], const pg8::Unit& u, int wr, int wc, int fr, int fq) const {
        const int row0 = u.pm * 256 + wr * 64 + fr, colt = u.pn * 256 + wc * 32 + 8 * fq;
#pragma unroll
        for (int ai = 0; ai < 2; ++ai)
#pragma unroll
            for (int m = 0; m < 4; ++m) {
                const int row = row0 + ai * 128 + m * 16;
#pragma unroll
                for (int bj = 0; bj < 2; ++bj) {
                    const int col = colt + bj * 128;
                    float g[8]; unpack8(*(const v4u*)(Zg + (size_t)row * INW + col), g);
                    float v[8];
#pragma unroll
                    for (int j = 0; j < 4; ++j) { v[j] = acc[ai][bj][m][0][j] * g[j]; v[4 + j] = acc[ai][bj][m][1][j] * g[4 + j]; }
                    float* mp = MGF + (size_t)row * DM + col;
                    if (BR > 0) { const f32x4 p0 = *(const f32x4*)mp, p1 = *(const f32x4*)(mp + 4);
#pragma unroll
                        for (int j = 0; j < 4; ++j) { v[j] += p0[j]; v[4 + j] += p1[j]; } }
                    if (BR < 2) { *(f32x4*)mp = (f32x4){v[0], v[1], v[2], v[3]}; *(f32x4*)(mp + 4) = (f32x4){v[4], v[5], v[6], v[7]}; }
                    else *(v4u*)(MG + (size_t)row * DM + col) = pack8(v);
                }
                asm volatile("" ::: "memory");
            }
    }
};
struct EpiF32P {
    static constexpr bool PERM = true, AFTER_DRAIN = false;
    float* C; int ldc;
    __device__ __forceinline__ void operator()(const f32x4 (&acc)[2][2][4][2], const pg8::Unit& u, int wr, int wc, int fr, int fq) const {
        const int row0 = u.pm * 256 + wr * 64 + fr, colt = u.pn * 256 + wc * 32 + 8 * fq;
#pragma unroll
        for (int ai = 0; ai < 2; ++ai)
#pragma unroll
            for (int m = 0; m < 4; ++m) {
                float* rp = C + (size_t)(row0 + ai * 128 + m * 16) * ldc + colt;
#pragma unroll
                for (int bj = 0; bj < 2; ++bj) { *(f32x4*)(rp + bj * 128) = acc[ai][bj][m][0]; *(f32x4*)(rp + bj * 128 + 4) = acc[ai][bj][m][1]; }
            }
    }
};
struct EpiSwi {
    static constexpr bool PERM = true, AFTER_DRAIN = false;
    bf16* ACT;
    __device__ __forceinline__ void operator()(const f32x4 (&acc)[2][2][4][2], const pg8::Unit& u, int wr, int wc, int fr, int fq) const {
        const int row0 = u.pm * 256 + wr * 64 + fr, colt = u.pn * 128 + wc * 32 + 8 * fq;
#pragma unroll
        for (int ai = 0; ai < 2; ++ai)
#pragma unroll
            for (int m = 0; m < 4; ++m) {
                float v[8];
#pragma unroll
                for (int j = 0; j < 4; ++j) { v[j] = siluf_(acc[ai][1][m][0][j]) * acc[ai][0][m][0][j]; v[4 + j] = siluf_(acc[ai][1][m][1][j]) * acc[ai][0][m][1][j]; }
                *(v4u*)(ACT + (size_t)(row0 + ai * 128 + m * 16) * DFF + colt) = pack8(v);
            }
    }
};

struct Ctx {
    LAS unsigned char* lds; int tid, lane, wave, vcu, G;
};

__device__ __forceinline__ void cvt_item(const float* W, int N, int k0, int n0, bf16* dst, int dld, int drow0, int dcol0, LAS float* scr, int lane) {
    const float* src = W + (size_t)(k0 + (lane >> 4)) * N + n0 + 4 * (lane & 15);
    f32x4 v[16];
#pragma unroll
    for (int i = 0; i < 16; ++i) v[i] = *(const f32x4*)(src + (size_t)(4 * i) * N);
#pragma unroll
    for (int i = 0; i < 16; ++i) { LAS float* s = scr + (4 * i + (lane >> 4)) * 65 + 4 * (lane & 15); s[0] = v[i].x; s[1] = v[i].y; s[2] = v[i].z; s[3] = v[i].w; }
    asm volatile("s_waitcnt lgkmcnt(0)" ::: "memory");
    const int c = lane & 7;
#pragma unroll
    for (int j = 0; j < 8; ++j) { const int n = (lane >> 3) + 8 * j; const LAS float* s = scr + (8 * c) * 65 + n;
        v4u o; o.x = pk2(s[0 * 65], s[1 * 65]); o.y = pk2(s[2 * 65], s[3 * 65]); o.z = pk2(s[4 * 65], s[5 * 65]); o.w = pk2(s[6 * 65], s[7 * 65]);
        *(v4u*)(dst + (size_t)(drow0 + n) * dld + dcol0 + 8 * c) = o; }
    asm volatile("s_waitcnt lgkmcnt(0)" ::: "memory");
}
__device__ __forceinline__ void phase_prologue(const Args& a, const Ctx& F) {
    unsigned char* ws = a.ws;
    bf16* WT = (bf16*)(ws + WS_WT);
    {
        LAS float* scr = (LAS float*)(F.lds + F.wave * 16640);
        const int gw = F.vcu * NWAVES + F.wave, NGW = F.G * NWAVES;
        constexpr int IT_IN = 32 * 256, IT_UP = 16 * 32, IT_OUT = 32 * 32, IT_FI = 32 * 176, IT_FO = 88 * 32, IT_LAYER = IT_IN + 3 * IT_UP + IT_OUT + IT_FI + IT_FO;
        for (int it = gw; it < DEPTH * IT_LAYER; it += NGW) {
            const int l = it / IT_LAYER; int r = it % IT_LAYER;
            bf16* wl = WT + (size_t)l * WL_ELEMS;
            if (r < IT_IN) { const int kb = r / 256, nb = r % 256; cvt_item(a.w_in + (size_t)l * DM * INW, INW, 64 * kb, 64 * nb, wl + OFF_IN, DM, 64 * nb, 64 * kb, scr, F.lane); continue; }
            r -= IT_IN;
            if (r < 3 * IT_UP) { const int br = r / IT_UP, q = r % IT_UP, kb = q / 32, nb = q % 32;
                const float* w = (br == 0 ? a.w_up_a : (br == 1 ? a.w_up_b : a.w_up_c)) + (size_t)l * 1024 * DM;
                cvt_item(w, DM, 64 * kb, 64 * nb, wl + OFF_UP, YW, 64 * nb, 1024 * br + 64 * kb, scr, F.lane); continue; }
            r -= 3 * IT_UP;
            if (r < IT_OUT) { const int kb = r / 32, nb = r % 32; cvt_item(a.w_out + (size_t)l * DM * DM, DM, 64 * kb, 64 * nb, wl + OFF_OUT, DM, 64 * nb, 64 * kb, scr, F.lane); continue; }
            r -= IT_OUT;
            if (r < IT_FI) { const int kb = r / 176, nb = r % 176; const int n0 = 64 * nb;
                const int drow = (n0 < DFF) ? (256 * (n0 / 128) + (n0 % 128)) : (256 * ((n0 - DFF) / 128) + 128 + ((n0 - DFF) % 128));
                cvt_item(a.w_fi + (size_t)l * DM * NFI, NFI, 64 * kb, n0, wl + OFF_FI, DM, drow, 64 * kb, scr, F.lane); continue; }
            r -= IT_FI;
            { const int kb = r / 32, nb = r % 32; cvt_item(a.w_fo + (size_t)l * DFF * DM, DM, 64 * kb, 64 * nb, wl + OFF_FO, DFF, 64 * nb, 64 * kb, scr, F.lane); }
        }
    }
    __syncthreads();
    {
        LAS float* sc = (LAS float*)F.lds;
        LAS float* red = (LAS float*)(F.lds + 24576);
        float* MOD = (float*)(ws + WS_MOD);
        for (int i = F.tid; i < 3 * DM; i += NTHR) { const int ci = i / DM, k = i % DM; const float x = (ci == 0) ? a.c_ctx[k] : a.c[(ci - 1) * DM + k]; sc[i] = x / (1.0f + expf(-x)); }
        __syncthreads();
        const int cx = F.tid & 31, kg = F.tid >> 5;
        for (int u = F.vcu; u < 4 * 96; u += F.G) {
            const int l = u / 96, cb = u % 96;
            const float* wp = a.w_ada + ((size_t)l * DM + 128 * kg) * 12288 + 128 * cb + 4 * cx;
            f32x4 a0 = {0.f, 0.f, 0.f, 0.f}, a1 = a0, a2 = a0;
#pragma unroll 8
            for (int k = 0; k < 128; ++k) { const f32x4 w = *(const f32x4*)(wp + (size_t)k * 12288);
                const float s0 = sc[128 * kg + k], s1 = sc[DM + 128 * kg + k], s2 = sc[2 * DM + 128 * kg + k];
                a0 += w * s0; a1 += w * s1; a2 += w * s2; }
#pragma unroll
            for (int j = 0; j < 4; ++j) { red[(kg * 3 + 0) * 128 + 4 * cx + j] = a0[j]; red[(kg * 3 + 1) * 128 + 4 * cx + j] = a1[j]; red[(kg * 3 + 2) * 128 + 4 * cx + j] = a2[j]; }
            __syncthreads();
            if (F.tid < 384) { const int ci = F.tid / 128, col = F.tid % 128; float s = 0.f;
#pragma unroll
                for (int g = 0; g < 16; ++g) s += red[(g * 3 + ci) * 128 + col];
                MOD[(size_t)(l * 3 + ci) * 12288 + 128 * cb + col] = s + a.b_ada[l * 12288 + 128 * cb + col]; }
            __syncthreads();
        }
    }
    {
        float* LB = (float*)(ws + WS_LB); float* ROPE = (float*)(ws + WS_ROPE);
        for (int i = F.vcu * NTHR + F.tid; i < 2048; i += F.G * NTHR) {
            const int dir = i / 1024, f = i % 1024;
            float x[4], mx = -3.0e38f;
#pragma unroll
            for (int l = 0; l < 4; ++l) { x[l] = a.lb_logits[(dir * 4 + l) * 1024 + f]; mx = fmaxf(mx, x[l]); }
            float e[4], s = 0.f;
#pragma unroll
            for (int l = 0; l < 4; ++l) { e[l] = expf(x[l] - mx); s += e[l]; }
            float cs = 0.f;
#pragma unroll
            for (int l = 0; l < 4; ++l) { if (l > 0) cs += e[l] / s; LB[(dir * 4 + l) * 1024 + f] = cs; }
            const int p = i / 32, fi = i % 32;
            const float inv = powf(10000.0f, -(float)(2 * fi) / 64.0f), ang = (float)p * inv;
            ROPE[2 * i] = cosf(ang); ROPE[2 * i + 1] = sinf(ang);
        }
    }
}

__device__ __forceinline__ void rownorm_phase(const Args& a, const Ctx& F, bool first, const float* T, const float* gate  , const float* gpost,
                                              bool write_h, const float* gn, const float* scv, const float* shv  ) {
    float* X = a.out + OUT_Y; bf16* H = (bf16*)(a.ws + WS_H);
    const int gw = F.vcu * NWAVES + F.wave, NGW = F.G * NWAVES;
    for (int m = gw; m < MTOK; m += NGW) {
        const int ci = (m < NCTX) ? 0 : 1 + ((m - NCTX) >> 10);
        const float* xr = first ? ((m < NCTX) ? a.x_prompt + (size_t)m * DM : a.x_sample + (size_t)(m - NCTX) * DM) : X + (size_t)m * DM;
        f32x4 x[8];
#pragma unroll
        for (int j = 0; j < 8; ++j) x[j] = *((const f32x4*)xr + F.lane + 64 * j);
        if (T) {
            f32x4 t[8]; float ss = 0.f;
#pragma unroll
            for (int j = 0; j < 8; ++j) { t[j] = *((const f32x4*)(T + (size_t)m * DM) + F.lane + 64 * j); ss += (t[j].x * t[j].x + t[j].y * t[j].y) + (t[j].z * t[j].z + t[j].w * t[j].w); }
            const float r = 1.0f / sqrtf(wave_sum(ss) * (1.0f / DM) + EPS);
#pragma unroll
            for (int j = 0; j < 8; ++j) { const f32x4 gp = *((const f32x4*)gpost + F.lane + 64 * j), gt = *((const f32x4*)(gate + (size_t)ci * 12288) + F.lane + 64 * j);
                x[j] += gt * (t[j] * r * gp); }
        }
        if (T || first) {
#pragma unroll
            for (int j = 0; j < 8; ++j) *((f32x4*)(X + (size_t)m * DM) + F.lane + 64 * j) = x[j];
        }
        if (write_h) {
            float ss = 0.f;
#pragma unroll
            for (int j = 0; j < 8; ++j) ss += (x[j].x * x[j].x + x[j].y * x[j].y) + (x[j].z * x[j].z + x[j].w * x[j].w);
            const float r = 1.0f / sqrtf(wave_sum(ss) * (1.0f / DM) + EPS);
#pragma unroll
            for (int j = 0; j < 8; ++j) { const f32x4 g = *((const f32x4*)gn + F.lane + 64 * j), s = *((const f32x4*)(scv + (size_t)ci * 12288) + F.lane + 64 * j), b = *((const f32x4*)(shv + (size_t)ci * 12288) + F.lane + 64 * j);
                const f32x4 h = x[j] * r * g * (s + 1.0f) + b;
                v2u w; w.x = pk2(h.x, h.y); w.y = pk2(h.z, h.w);
                *((v2u*)(H + (size_t)m * DM) + F.lane + 64 * j) = w; }
        }
    }
}

__device__ __forceinline__ void phase_ycnorm(const Args& a, const Ctx& F) {
    const float* OFp = (const float*)(a.ws + WS_OF); const float* OBp = (const float*)(a.ws + WS_OB);
    const bf16* Z = (const bf16*)(a.ws + WS_Z); bf16* Y = (bf16*)(a.ws + WS_Y);
    const int gw = F.vcu * NWAVES + F.wave, NGW = F.G * NWAVES;
    for (int m = gw; m < MTOK; m += NGW) {
        float o[16]; float ss = 0.f;
#pragma unroll
        for (int j = 0; j < 4; ++j) { const f32x4 p = *((const f32x4*)(OFp + (size_t)m * 1024 + 16 * F.lane) + j), q = *((const f32x4*)(OBp + (size_t)m * 1024 + 16 * F.lane) + j);
            const f32x4 s = p + q; o[4 * j] = s.x; o[4 * j + 1] = s.y; o[4 * j + 2] = s.z; o[4 * j + 3] = s.w; ss += (s.x * s.x + s.y * s.y) + (s.z * s.z + s.w * s.w); }
        ss += __shfl_xor(ss, 1); ss += __shfl_xor(ss, 2); ss += __shfl_xor(ss, 4);
        const float r = 1.0f / sqrtf(ss * (1.0f / 128.0f) + EPS);
        float g0[8], g1[8];
        unpack8(*(const v4u*)(Z + (size_t)m * INW + 9216 + 16 * F.lane), g0); unpack8(*(const v4u*)(Z + (size_t)m * INW + 9216 + 16 * F.lane + 8), g1);
        float y0[8], y1[8];
#pragma unroll
        for (int j = 0; j < 8; ++j) { y0[j] = o[j] * r * g0[j]; y1[j] = o[8 + j] * r * g1[j]; }
        *(v4u*)(Y + (size_t)m * YW + 2048 + 16 * F.lane) = pack8(y0); *(v4u*)(Y + (size_t)m * YW + 2048 + 16 * F.lane + 8) = pack8(y1);
    }
}

__device__ __forceinline__ void unitA(const Args& a, const Ctx& F, int l, int unit) {
    const int ch = unit >> 3, g = unit & 7, m0 = ch * 128;
    const bf16* Z = (const bf16*)(a.ws + WS_Z); bf16* Y = (bf16*)(a.ws + WS_Y);
    LAS float* Wt = (LAS float*)F.lds;
    LAS float* V = (LAS float*)(F.lds + 65536);
    LAS float* st = (LAS float*)(F.lds + 131072);
    for (int i = 0; i < 16; ++i) {
        const int s = 16 * F.wave + i;
        const bf16* rp = Z + (size_t)(m0 + s) * INW + 1024 + 16 * F.lane;
        float x0[8], x1[8]; unpack8(*(const v4u*)rp, x0); unpack8(*(const v4u*)(rp + 8), x1);
        float sm = 0.f, sq = 0.f;
#pragma unroll
        for (int j = 0; j < 8; ++j) { sm += x0[j] + x1[j]; sq += x0[j] * x0[j] + x1[j] * x1[j]; }
        sm = wave_sum(sm); sq = wave_sum(sq);
        const float mean = sm * (1.0f / 1024.0f), var = fmaxf(sq * (1.0f / 1024.0f) - mean * mean, 0.f);
        if (F.lane == 0) { st[s] = mean; st[128 + s] = 1.0f / sqrtf(var + EPS); }
    }
    __syncthreads();
    {
        const int s = F.tid >> 2, c0 = 32 * (F.tid & 3);
        const float mean = st[s], rstd = st[128 + s];
        const bf16* rp = Z + (size_t)(m0 + s) * INW + 1024 + 128 * g + c0;
#pragma unroll
        for (int q = 0; q < 4; ++q) { float x[8]; unpack8(*(const v4u*)(rp + 8 * q), x);
#pragma unroll
            for (int j = 0; j < 8; ++j) V[s * 128 + c0 + 8 * q + j] = (x[j] - mean) * rstd; }
        const int t = F.tid >> 2, s0 = 32 * (F.tid & 3);
        const float* wp = a.a_w + ((size_t)(l * 8 + g) * 128 + t) * 128 + s0;
#pragma unroll
        for (int q = 0; q < 8; ++q) { const f32x4 w = *(const f32x4*)(wp + 4 * q);
            Wt[(s0 + 4 * q + 0) * 128 + t] = w.x; Wt[(s0 + 4 * q + 1) * 128 + t] = w.y; Wt[(s0 + 4 * q + 2) * 128 + t] = w.z; Wt[(s0 + 4 * q + 3) * 128 + t] = w.w; }
    }
    __syncthreads();
    const int tg = F.tid >> 5, cx = F.tid & 31;
    float acc[8][4];
#pragma unroll
    for (int i = 0; i < 8; ++i)
#pragma unroll
        for (int j = 0; j < 4; ++j) acc[i][j] = 0.f;
    for (int s = 0; s < 128; ++s) {
        const f32x4 w0 = *(const LAS f32x4*)(Wt + s * 128 + 8 * tg), w1 = *(const LAS f32x4*)(Wt + s * 128 + 8 * tg + 4), v = *(const LAS f32x4*)(V + s * 128 + 4 * cx);
        const float w[8] = {w0.x, w0.y, w0.z, w0.w, w1.x, w1.y, w1.z, w1.w};
#pragma unroll
        for (int i = 0; i < 8; ++i) { acc[i][0] += w[i] * v.x; acc[i][1] += w[i] * v.y; acc[i][2] += w[i] * v.z; acc[i][3] += w[i] * v.w; }
    }
#pragma unroll
    for (int i = 0; i < 8; ++i) {
        const int t = 8 * tg + i; const float b = a.a_b[(l * 8 + g) * 128 + t];
        const v2u uw = *(const v2u*)(Z + (size_t)(m0 + t) * INW + 128 * g + 4 * cx);
        const float u0 = bf2f_lo(uw.x), u1 = bf2f_hi(uw.x), u2 = bf2f_lo(uw.y), u3 = bf2f_hi(uw.y);
        v2u o; o.x = pk2(u0 * (acc[i][0] + b), u1 * (acc[i][1] + b)); o.y = pk2(u2 * (acc[i][2] + b), u3 * (acc[i][3] + b));
        *(v2u*)(Y + (size_t)(m0 + t) * YW + 128 * g + 4 * cx) = o;
    }
    __syncthreads();
}

struct AttnState { float q[16], o[16], mrun, lrun; };
__device__ __forceinline__ void attn_key(AttnState& S, const LAS bf16* Ks, const LAS bf16* Vs, int key, int sub, float bias) {
    const LAS v4u* kp = (const LAS v4u*)(Ks + key * 128 + 16 * sub);
    float k0[8], k1[8]; unpack8(kp[0], k0); unpack8(kp[1], k1);
    float s = 0.f;
#pragma unroll
    for (int i = 0; i < 8; ++i) s += S.q[i] * k0[i] + S.q[8 + i] * k1[i];
    s += __shfl_xor(s, 1); s += __shfl_xor(s, 2); s += __shfl_xor(s, 4);
    s += bias;
    if (s > S.mrun) { const float corr = __expf(S.mrun - s); S.lrun *= corr;
#pragma unroll
        for (int i = 0; i < 16; ++i) S.o[i] *= corr;
        S.mrun = s; }
    const float p = __expf(s - S.mrun);
    S.lrun += p;
    const LAS v4u* vp = (const LAS v4u*)(Vs + key * 128 + 16 * sub);
    float v0[8], v1[8]; unpack8(vp[0], v0); unpack8(vp[1], v1);
#pragma unroll
    for (int i = 0; i < 8; ++i) { S.o[i] += p * v0[i]; S.o[8 + i] += p * v1[i]; }
}
__device__ __forceinline__ void attn_store(const AttnState& S, bf16* dst) {
    const float inv = 1.0f / S.lrun; float y0[8], y1[8];
#pragma unroll
    for (int i = 0; i < 8; ++i) { y0[i] = S.o[i] * inv; y1[i] = S.o[8 + i] * inv; }
    *(v4u*)dst = pack8(y0); *(v4u*)(dst + 8) = pack8(y1);
}
constexpr float ATT_SCALE = 0.08838834764831845f;

__device__ __forceinline__ void unitAttnCtx(const Args& a, const Ctx& F, int unit) {
    const int qb = unit & 3, h = (unit >> 2) & 7, b = unit >> 5;
    const bf16* Z = (const bf16*)(a.ws + WS_Z); bf16* Y = (bf16*)(a.ws + WS_Y);
    LAS bf16* Ks = (LAS bf16*)F.lds; LAS bf16* Vs = (LAS bf16*)(F.lds + 65536);
    const int qi = F.tid >> 3, sub = F.tid & 7;
    const int mq = b * 256 + 64 * qb + qi;
    AttnState S; S.mrun = -1.0e30f; S.lrun = 0.f;
    { float q0[8], q1[8]; const bf16* qp = Z + (size_t)mq * INW + 2048 + h * 128 + 16 * sub; unpack8(*(const v4u*)qp, q0); unpack8(*(const v4u*)(qp + 8), q1);
#pragma unroll
      for (int i = 0; i < 8; ++i) { S.q[i] = q0[i] * ATT_SCALE; S.q[8 + i] = q1[i] * ATT_SCALE; S.o[i] = 0.f; S.o[8 + i] = 0.f; } }
    for (int p = F.tid; p < 4096; p += NTHR) { const int key = p >> 4, c16 = p & 15; const bf16* src = Z + (size_t)(b * 256 + key) * INW + h * 128 + 8 * c16;
        *(LAS v4u*)(Ks + key * 128 + 8 * c16) = *(const v4u*)(src + 3072); *(LAS v4u*)(Vs + key * 128 + 8 * c16) = *(const v4u*)(src + 4096); }
    __syncthreads();
    for (int key = 0; key < 256; ++key) attn_key(S, Ks, Vs, key, sub, 0.f);
    attn_store(S, Y + (size_t)mq * YW + 1024 + h * 128 + 16 * sub);
    __syncthreads();
}
__device__ __forceinline__ void unitAttnLat(const Args& a, const Ctx& F, int l, int unit) {
    const int r = unit & 15, h = (unit >> 4) & 7, b = unit >> 7;
    const bf16* Z = (const bf16*)(a.ws + WS_Z); bf16* Y = (bf16*)(a.ws + WS_Y);
    const float* ROPE = (const float*)(a.ws + WS_ROPE);
    LAS bf16* Ks = (LAS bf16*)F.lds; LAS bf16* Vs = (LAS bf16*)(F.lds + 65536); LAS float* rp = (LAS float*)(F.lds + 131072);
    const int qc = F.tid >> 3, sub = F.tid & 7;
    const int r_start = min(max(r - 4, 0), 8), c_start = min(max(qc - 8, 0), 48);
    const int mq = NCTX + b * 1024 + r * 64 + qc;
    for (int i = F.tid; i < 15 * 31; i += NTHR) rp[i] = a.rpb[(size_t)(l * 8 + h) * 465 + i];
    AttnState S; S.mrun = -1.0e30f; S.lrun = 0.f;
    {
        const bool lo = (sub & 3) < 2; const int half = sub >> 2, pos = half ? qc : r, fi0 = 16 * (sub & 1);
        const bf16* qp = Z + (size_t)mq * INW + 2048 + h * 128 + 16 * sub; const bf16* pp = lo ? qp + 32 : qp - 32;
        float x0[8], x1[8], y0[8], y1[8]; unpack8(*(const v4u*)qp, x0); unpack8(*(const v4u*)(qp + 8), x1); unpack8(*(const v4u*)pp, y0); unpack8(*(const v4u*)(pp + 8), y1);
#pragma unroll
        for (int i = 0; i < 16; ++i) { const float x = i < 8 ? x0[i & 7] : x1[i & 7], y = i < 8 ? y0[i & 7] : y1[i & 7];
            const float cs = ROPE[2 * (pos * 32 + fi0 + i)], sn = ROPE[2 * (pos * 32 + fi0 + i) + 1];
            S.q[i] = (lo ? (x * cs - y * sn) : (x * cs + y * sn)) * ATT_SCALE; S.o[i] = 0.f; }
    }
    for (int chn = 0; chn < 2; ++chn) {
        __syncthreads();
        for (int job = F.tid; job < 1024; job += NTHR) {
            const int key = job >> 2, half = (job >> 1) & 1, sp = job & 1;
            const int kr = r_start + 4 * chn + (key >> 6), kc = key & 63, pos = half ? kc : kr;
            const bf16* src = Z + (size_t)(NCTX + b * 1024 + kr * 64 + kc) * INW + 3072 + h * 128 + 64 * half + 16 * sp;
            float lo0[8], lo1[8], hi0[8], hi1[8]; unpack8(*(const v4u*)src, lo0); unpack8(*(const v4u*)(src + 8), lo1); unpack8(*(const v4u*)(src + 32), hi0); unpack8(*(const v4u*)(src + 40), hi1);
            float a0[8], a1[8], b0[8], b1[8];
#pragma unroll
            for (int i = 0; i < 8; ++i) {
                const float c0 = ROPE[2 * (pos * 32 + 16 * sp + i)], s0 = ROPE[2 * (pos * 32 + 16 * sp + i) + 1], c1 = ROPE[2 * (pos * 32 + 16 * sp + 8 + i)], s1 = ROPE[2 * (pos * 32 + 16 * sp + 8 + i) + 1];
                a0[i] = lo0[i] * c0 - hi0[i] * s0; b0[i] = hi0[i] * c0 + lo0[i] * s0;
                a1[i] = lo1[i] * c1 - hi1[i] * s1; b1[i] = hi1[i] * c1 + lo1[i] * s1; }
            LAS bf16* d = Ks + key * 128 + 64 * half + 16 * sp;
            *(LAS v4u*)d = pack8(a0); *(LAS v4u*)(d + 8) = pack8(a1); *(LAS v4u*)(d + 32) = pack8(b0); *(LAS v4u*)(d + 40) = pack8(b1);
        }
        for (int p = F.tid; p < 4096; p += NTHR) { const int key = p >> 4, c16 = p & 15; const int kr = r_start + 4 * chn + (key >> 6), kc = key & 63;
            *(LAS v4u*)(Vs + key * 128 + 8 * c16) = *(const v4u*)(Z + (size_t)(NCTX + b * 1024 + kr * 64 + kc) * INW + 4096 + h * 128 + 8 * c16); }
        __syncthreads();
        for (int jj = 0; jj < 4; ++jj) {
            const int kr = r_start + 4 * chn + jj, dr = kr - r + 7;
            for (int kk = 0; kk < 16; ++kk) { const int kc = c_start + kk, dc = min(max(kc - qc + 15, 0), 30);
                attn_key(S, Ks, Vs, jj * 64 + kc, sub, rp[dr * 31 + dc]); }
        }
    }
    for (int chn = 0; chn < 2; ++chn) {
        __syncthreads();
        for (int p = F.tid; p < 4096; p += NTHR) { const int key = p >> 4, c16 = p & 15;
            const size_t off = ((size_t)(b * 4 + l) * 512 + 256 * chn + key) * 1024 + h * 128 + 8 * c16;
            const f32x4 k0 = *(const f32x4*)(a.cache_k + off), k1 = *(const f32x4*)(a.cache_k + off + 4), v0 = *(const f32x4*)(a.cache_v + off), v1 = *(const f32x4*)(a.cache_v + off + 4);
            v4u kw, vw; kw.x = pk2(k0.x, k0.y); kw.y = pk2(k0.z, k0.w); kw.z = pk2(k1.x, k1.y); kw.w = pk2(k1.z, k1.w);
            vw.x = pk2(v0.x, v0.y); vw.y = pk2(v0.z, v0.w); vw.z = pk2(v1.x, v1.y); vw.w = pk2(v1.z, v1.w);
            *(LAS v4u*)(Ks + key * 128 + 8 * c16) = kw; *(LAS v4u*)(Vs + key * 128 + 8 * c16) = vw; }
        __syncthreads();
        for (int key = 0; key < 256; ++key) attn_key(S, Ks, Vs, key, sub, 0.f);
    }
    attn_store(S, Y + (size_t)mq * YW + 1024 + h * 128 + 16 * sub);
    __syncthreads();
}

__device__ __forceinline__ void unitHgrn(const Args& a, const Ctx& F, int l, bool lat, int b, int h, int dir) {
    const bf16* Z = (const bf16*)(a.ws + WS_Z); const float* LOGF = (const float*)(a.ws + WS_LOGF);
    float* O = (float*)(a.ws + (dir ? WS_OB : WS_OF));
    LAS float* qs = (LAS float*)F.lds; LAS float* fs = (LAS float*)(F.lds + 16384); LAS float* vs = (LAS float*)(F.lds + 32768); LAS float* op = (LAS float*)(F.lds + 49152);
    const int n = lat ? 1024 : 256, mbase = lat ? NCTX + b * 1024 : b * 256;
    const int e = F.tid & 127, dq = F.tid >> 7;
    float S[32];
    if (lat) {
#pragma unroll
        for (int i = 0; i < 32; ++i) S[i] = a.state[((((size_t)b * 4 + l) * 2 + dir) * 8 + h) * 16384 + (size_t)(32 * dq + i) * 128 + e];
    } else {
#pragma unroll
        for (int i = 0; i < 32; ++i) S[i] = 0.f;
    }
    for (int blk = 0; blk < n / 32; ++blk) {
        __syncthreads();
        {
            const int tt = F.tid >> 4, d8 = 8 * (F.tid & 15);
            const int t = dir ? (n - 1 - (32 * blk + tt)) : (32 * blk + tt);
            const size_t m = (size_t)(mbase + t);
            float q[8], v[8]; unpack8(*(const v4u*)(Z + m * INW + 5120 + h * 128 + d8), q); unpack8(*(const v4u*)(Z + m * INW + 8192 + h * 128 + d8), v);
            const f32x4 f0 = *(const f32x4*)(LOGF + m * 2048 + dir * 1024 + h * 128 + d8), f1 = *(const f32x4*)(LOGF + m * 2048 + dir * 1024 + h * 128 + d8 + 4);
            const float lf[8] = {f0.x, f0.y, f0.z, f0.w, f1.x, f1.y, f1.z, f1.w};
#pragma unroll
            for (int j = 0; j < 8; ++j) { qs[tt * 128 + d8 + j] = q[j]; vs[tt * 128 + d8 + j] = v[j]; fs[tt * 128 + d8 + j] = __expf(lf[j]); }
        }
        __syncthreads();
        for (int tt = 0; tt < 32; ++tt) {
            const float v = vs[tt * 128 + e]; float po = 0.f;
#pragma unroll
            for (int i4 = 0; i4 < 8; ++i4) {
                const f32x4 f = *(const LAS f32x4*)(fs + tt * 128 + 32 * dq + 4 * i4), q = *(const LAS f32x4*)(qs + tt * 128 + 32 * dq + 4 * i4);
#pragma unroll
                for (int j = 0; j < 4; ++j) { const float ff = f[j]; float s = S[4 * i4 + j]; s = ff * s + (1.0f - ff) * v; S[4 * i4 + j] = s; po += q[j] * s; }
            }
            op[(dq * 32 + tt) * 128 + e] = po;
        }
        __syncthreads();
        {
            const int tt = F.tid >> 4, e8 = 8 * (F.tid & 15);
            const int t = dir ? (n - 1 - (32 * blk + tt)) : (32 * blk + tt);
            f32x4 s0 = {0.f, 0.f, 0.f, 0.f}, s1 = s0;
#pragma unroll
            for (int d = 0; d < 4; ++d) { s0 += *(const LAS f32x4*)(op + (d * 32 + tt) * 128 + e8); s1 += *(const LAS f32x4*)(op + (d * 32 + tt) * 128 + e8 + 4); }
            float* dst = O + (size_t)(mbase + t) * 1024 + h * 128 + e8;
            *(f32x4*)dst = s0; *(f32x4*)(dst + 4) = s1;
        }
    }
    if (!lat) {
        float* so = a.out + OUT_S + ((((size_t)b * 4 + l) * 2 + dir) * 8 + h) * 16384;
#pragma unroll
        for (int i = 0; i < 32; ++i) so[(size_t)(32 * dq + i) * 128 + e] = S[i];
    }
    __syncthreads();
}

constexpr int NU_HL = 32, NU_AL = 256, NU_HC = 512, NU_AC = 1024, NU_A = 640, NU_M1 = NU_HL + NU_AL + NU_HC + NU_AC + NU_A;
__device__ __forceinline__ void phase_mixers(const Args& a, const Ctx& F, int l) {
    unsigned* head = (unsigned*)(a.ws + WS_CTL) + CW_Q + 64 * l;
    volatile LAS unsigned* bc = (volatile LAS unsigned*)(F.lds + LDSCTL_OFF) + 4;
    for (;;) {
        __syncthreads();
        if (F.tid == 0) bc[0] = __hip_atomic_fetch_add(head, 1u, __ATOMIC_RELAXED, __HIP_MEMORY_SCOPE_AGENT);
        __syncthreads();
        int u = (int)bc[0];
        if (u >= NU_M1) break;
        if (u < NU_HL) { unitHgrn(a, F, l, true, u >> 4, (u >> 1) & 7, u & 1); continue; }
        u -= NU_HL;
        if (u < NU_AL) { unitAttnLat(a, F, l, u); continue; }
        u -= NU_AL;
        if (u < NU_HC) { unitHgrn(a, F, l, false, u >> 4, (u >> 1) & 7, u & 1); continue; }
        u -= NU_HC;
        if (u < NU_AC) { unitAttnCtx(a, F, u); continue; }
        u -= NU_AC;
        unitA(a, F, l, u);
    }
}

__device__ __forceinline__ const Args* args_ptr() { unsigned long long p = (unsigned long long)__builtin_amdgcn_kernarg_segment_ptr(); asm volatile("" : "+s"(p)); return (const Args*)(const void __attribute__((address_space(4)))*)p; }
__device__ __forceinline__ Ctx make_ctx() {
    Ctx F; int t = threadIdx.x; asm volatile("" : "+v"(t));
    unsigned z = 0; asm volatile("" : "+s"(z));
    F.lds = (LAS unsigned char*)(uintptr_t)z;
    F.tid = t; F.lane = t & 63; F.wave = __builtin_amdgcn_readfirstlane(t >> 6);
    F.G = gridDim.x; { const int bx = blockIdx.x; F.vcu = (F.G % 8 == 0) ? (bx % 8) * (F.G / 8) + bx / 8 : bx; }
    return F;
}
__global__ void __launch_bounds__(NTHR, 2) fwd(Args a_in) {
    extern __shared__ __attribute__((aligned(16))) unsigned char lds_raw[];
    volatile LAS unsigned* MISC = (volatile LAS unsigned*)((LAS unsigned char*)lds_raw + LDSCTL_OFF);
    for (int u = threadIdx.x; u < 256; u += NTHR) MISC[u] = 0u;
    __syncthreads();
    const int lo = a_in.ph_lo, hi = a_in.ph_hi;
    const bool multi = (hi - lo) > 1;
    XcdBarrier bar; bar.bar = (unsigned*)(a_in.ws + WS_CTL) + CW_BAR; bar.x = 0; bar.st = MISC;
    if (multi) bar = xcd_barrier_post((unsigned*)(a_in.ws + WS_CTL) + CW_BAR, MISC);
#ifndef PMASK
#define PMASK 0xFFFFFFFFu
#endif
#define PM(b) ((PMASK >> (b)) & 1u)
#define IN(k) (lo <= (k) && (k) < hi)
#define SEAM(k) do { if (IN(k) && IN((k) + 1)) xcd_barrier(bar); } while (0)

    if (PM(0) && IN(PH_PRO)) { const Args& a = *args_ptr(); const Ctx F = make_ctx(); phase_prologue(a, F); SEAM(PH_PRO); }
    if (PM(1) && IN(PH_T1)) { const Args& a = *args_ptr(); const Ctx F = make_ctx(); const float* MOD = (const float*)(a.ws + WS_MOD);
        rownorm_phase(a, F, true, nullptr, nullptr, nullptr, true, a.norm_g + 0, MOD + 1 * 2048, MOD + 0 * 2048); SEAM(PH_T1); }

    for (int l = 0; l < DEPTH; ++l) {
        const int pb = PH_L0 + l * PH_PER_LAYER;
        if (PM(2) && IN(pb + 0)) {
            const Args& a = *args_ptr(); const Ctx F = make_ctx(); unsigned char* ws = a.ws; const bf16* wl = (const bf16*)(ws + WS_WT) + (size_t)l * WL_ELEMS;
            pg8::Gemm g{(const bf16*)(ws + WS_H), wl + OFF_IN, MTOK, INW, DM, DM, DM}; pg8::StaticOrder S; S.init(MTOK, INW, F.G, (int)blockIdx.x);
            EpiIn E{(bf16*)(ws + WS_Z), (float*)(ws + WS_LOGF), (const float*)(ws + WS_LB) + l * 1024, a.out + OUT_K + (size_t)l * 262144, a.out + OUT_V + (size_t)l * 262144};
            pg8::gemm_phase<EpiIn, pg8::StaticOrder, true, true>(F.lds, g, S, E);
            SEAM(pb + 0);
        }
        if (PM(3) && IN(pb + 1)) { const Args& a = *args_ptr(); const Ctx F = make_ctx(); phase_mixers(a, F, l); SEAM(pb + 1); }
        if (PM(4) && IN(pb + 2)) { const Args& a = *args_ptr(); const Ctx F = make_ctx(); phase_ycnorm(a, F); SEAM(pb + 2); }
        if (PM(5) && IN(pb + 3)) {
            {   const Args& a = *args_ptr(); const Ctx F = make_ctx(); unsigned char* ws = a.ws; const bf16* wl = (const bf16*)(ws + WS_WT) + (size_t)l * WL_ELEMS;
                pg8::StaticOrder S; S.init(MTOK, DM, F.G, (int)blockIdx.x);
                pg8::Gemm g{(const bf16*)(ws + WS_Y), wl + OFF_UP, MTOK, DM, 1024, YW, YW}; EpiUp<0> E{(const bf16*)(ws + WS_Z) + 10240, (float*)(ws + WS_MGF), (bf16*)(ws + WS_MG)};
                pg8::gemm_phase<EpiUp<0>, pg8::StaticOrder, true, true>(F.lds, g, S, E); }
            {   const Args& a = *args_ptr(); const Ctx F = make_ctx(); unsigned char* ws = a.ws; const bf16* wl = (const bf16*)(ws + WS_WT) + (size_t)l * WL_ELEMS;
                pg8::StaticOrder S; S.init(MTOK, DM, F.G, (int)blockIdx.x);
                pg8::Gemm g{(const bf16*)(ws + WS_Y) + 1024, wl + OFF_UP + 1024, MTOK, DM, 1024, YW, YW}; EpiUp<1> E{(const bf16*)(ws + WS_Z) + 10240 + 2048, (float*)(ws + WS_MGF), (bf16*)(ws + WS_MG)};
                pg8::gemm_phase<EpiUp<1>, pg8::StaticOrder, true, true>(F.lds, g, S, E); }
            {   const Args& a = *args_ptr(); const Ctx F = make_ctx(); unsigned char* ws = a.ws; const bf16* wl = (const bf16*)(ws + WS_WT) + (size_t)l * WL_ELEMS;
                pg8::StaticOrder S; S.init(MTOK, DM, F.G, (int)blockIdx.x);
                pg8::Gemm g{(const bf16*)(ws + WS_Y) + 2048, wl + OFF_UP + 2048, MTOK, DM, 1024, YW, YW}; EpiUp<2> E{(const bf16*)(ws + WS_Z) + 10240 + 4096, (float*)(ws + WS_MGF), (bf16*)(ws + WS_MG)};
                pg8::gemm_phase<EpiUp<2>, pg8::StaticOrder, true, true>(F.lds, g, S, E); }
            SEAM(pb + 3);
        }
        if (PM(6) && IN(pb + 4)) {
            const Args& a = *args_ptr(); const Ctx F = make_ctx(); unsigned char* ws = a.ws; const bf16* wl = (const bf16*)(ws + WS_WT) + (size_t)l * WL_ELEMS;
            pg8::Gemm g{(const bf16*)(ws + WS_MG), wl + OFF_OUT, MTOK, DM, DM, DM, DM}; pg8::StaticOrder S; S.init(MTOK, DM, F.G, (int)blockIdx.x);
            EpiF32P E{(float*)(ws + WS_T), DM}; pg8::gemm_phase<EpiF32P, pg8::StaticOrder, true, true>(F.lds, g, S, E);
            SEAM(pb + 4);
        }
        if (PM(7) && IN(pb + 5)) { const Args& a = *args_ptr(); const Ctx F = make_ctx(); const float* modl = (const float*)(a.ws + WS_MOD) + (size_t)l * 3 * 12288; const float* gl = a.norm_g + (size_t)l * 4 * DM;
            rownorm_phase(a, F, false, (const float*)(a.ws + WS_T), modl + 2 * 2048, gl + 1 * DM, true, gl + 2 * DM, modl + 4 * 2048, modl + 3 * 2048); SEAM(pb + 5); }
        if (PM(8) && IN(pb + 6)) {
            const Args& a = *args_ptr(); const Ctx F = make_ctx(); unsigned char* ws = a.ws; const bf16* wl = (const bf16*)(ws + WS_WT) + (size_t)l * WL_ELEMS;
            pg8::Gemm g{(const bf16*)(ws + WS_H), wl + OFF_FI, MTOK, NFI, DM, DM, DM}; pg8::StaticOrder S; S.init(MTOK, NFI, F.G, (int)blockIdx.x);
            EpiSwi E{(bf16*)(ws + WS_ACT)}; pg8::gemm_phase<EpiSwi, pg8::StaticOrder, true, true>(F.lds, g, S, E);
            SEAM(pb + 6);
        }
        if (PM(9) && IN(pb + 7)) {
            const Args& a = *args_ptr(); const Ctx F = make_ctx(); unsigned char* ws = a.ws; const bf16* wl = (const bf16*)(ws + WS_WT) + (size_t)l * WL_ELEMS;
            pg8::Gemm g{(const bf16*)(ws + WS_ACT), wl + OFF_FO, MTOK, DM, DFF, DFF, DFF}; pg8::StaticOrder S; S.init(MTOK, DM, F.G, (int)blockIdx.x);
            EpiF32P E{(float*)(ws + WS_T), DM}; pg8::gemm_phase<EpiF32P, pg8::StaticOrder, true, true>(F.lds, g, S, E);
            SEAM(pb + 7);
        }
        if (PM(10) && IN(pb + 8)) {
            const Args& a = *args_ptr(); const Ctx F = make_ctx(); const float* MOD = (const float*)(a.ws + WS_MOD);
            const bool last = (l == DEPTH - 1); const int ln = last ? l : l + 1;
            const float* modl = MOD + (size_t)l * 3 * 12288; const float* gl = a.norm_g + (size_t)l * 4 * DM;
            const float* modn = MOD + (size_t)ln * 3 * 12288; const float* gnn = a.norm_g + (size_t)ln * 4 * DM;
            rownorm_phase(a, F, false, (const float*)(a.ws + WS_T), modl + 5 * 2048, gl + 3 * DM, !last, gnn + 0, modn + 1 * 2048, modn + 0 * 2048);
            SEAM(pb + 8);
        }
    }
#undef IN
#undef SEAM
}

#ifndef MK_ONE_LAUNCH
#define MK_ONE_LAUNCH 1
#endif
extern "C" void kernel_launch(void* const* d_in, const int* in_sizes, int n_in, void* d_out, int out_size, void* d_ws, size_t ws_size, hipStream_t stream) {
    static int grid = 0;
    if (grid == 0) {
        if (n_in != 21 || (size_t)out_size != OUT_END || ws_size < WS_END) { fprintf(stderr, "kernel_launch: unexpected shapes: n_in %d out %d ws %zu\n", n_in, out_size, ws_size); grid = -1; return; }
        int dev = 0, cus = 0, per_cu = 0;
        if (hipGetDevice(&dev) != hipSuccess || hipDeviceGetAttribute(&cus, hipDeviceAttributeMultiprocessorCount, dev) != hipSuccess) { grid = -1; return; }
        if (hipFuncSetAttribute((const void*)fwd, hipFuncAttributeMaxDynamicSharedMemorySize, LDS_BYTES) != hipSuccess) { fprintf(stderr, "kernel_launch: hipFuncSetAttribute failed\n"); grid = -1; return; }
        if (hipOccupancyMaxActiveBlocksPerMultiprocessor(&per_cu, (const void*)fwd, NTHR, LDS_BYTES) != hipSuccess || per_cu < 1) fprintf(stderr, "kernel_launch: occupancy query says %d\n", per_cu);
        (void)hipGetLastError();
        grid = cus;
    }
    if (grid < 0) return;
    (void)hipMemsetAsync((char*)d_ws + WS_CTL, 0, CTL_ZERO_BYTES, stream);
    Args a{};
    const float** ap = (const float**)&a;
    for (int i = 0; i < 21; ++i) ap[i] = (const float*)d_in[i];
    a.out = (float*)d_out; a.ws = (unsigned char*)d_ws;
#if MK_ONE_LAUNCH
    a.ph_lo = 0; a.ph_hi = PH_END;
    hipLaunchKernelGGL(fwd, dim3(grid), dim3(NTHR), LDS_BYTES, stream, a);
#else
    for (int p = 0; p < PH_END; ++p) { a.ph_lo = p; a.ph_hi = p + 1; hipLaunchKernelGGL(fwd, dim3(grid), dim3(NTHR), LDS_BYTES, stream, a); }
#endif
}
```

```cpp
#include <hip/hip_runtime.h>
#include <cstdio>
#include <cstdint>
namespace pg8 {
#define PG8_LAS __attribute__((address_space(3)))
typedef unsigned short bf16_t;
typedef short bf16x8 __attribute__((ext_vector_type(8)));
typedef float f32x4 __attribute__((ext_vector_type(4)));
typedef unsigned u32x4 __attribute__((ext_vector_type(4)));
constexpr int BM = 256, BK = 64, HALF = 128, HTB = HALF * BK * 2  , STAGE_BYTES = 8 * HTB, NXCD = 8, WGM = 8;

__host__ __device__ __forceinline__ int lds_byte(int r, int c) { const int st = (r >> 4) * 2 + (c >> 5), rr = r & 15, cc = c & 31, ob = rr * 64 + cc * 2; return st * 1024 + (ob ^ (((ob >> 9) & 1) << 5)); }
__host__ __device__ __forceinline__ void stage_rc(int b, int& R, int& C) { const int st = b / 1024, sb = b % 1024, swz = sb ^ (((sb >> 9) & 1) << 5); R = (st >> 1) * 16 + swz / 64; C = (st & 1) * 32 + (swz % 64) / 2; }
__host__ __device__ __forceinline__ int perm32(int rho) { const int n = rho >> 4, i = rho & 15; return 8 * (i >> 2) + 4 * n + (i & 3); }

struct Unit { int pm, pn, kq; };
struct SplitOrder {
    int G, c;
    __host__ __device__ void init(int G_, int c_) { G = G_; c = c_; }
    __host__ __device__ bool next(int i, Unit& u) const { const long L = (long)i * G + c; if (L >= 256) return false; const int t = (int)L >> 2; u.kq = (int)L & 3; u.pm = t & 7; u.pn = t >> 3; return true; }
    __device__ __forceinline__ void a_ready(const Unit&) const {}
    __device__ __forceinline__ void done(const Unit&) const {}
};
struct Gemm { const bf16_t* A; const bf16_t* Bt; int M, N, K, lda, ldb, koff; };

struct StaticOrder {
    int nM, nN, nwg, G, c;
    __host__ __device__ void init(int M, int N, int G_, int c_) { nM = M / BM; nN = N / BM; nwg = nM * nN; G = G_; c = c_; }
    __host__ __device__ bool next(int i, Unit& u) const {
        const long L = (long)i * G + c; if (L >= nwg) return false;
        int wgid = (int)L; { const int q = nwg / NXCD, r = nwg % NXCD, xcd = wgid % NXCD, off = wgid / NXCD; wgid = (xcd < r ? xcd * (q + 1) : r * (q + 1) + (xcd - r) * q) + off; }
        const int nig = WGM * nN, gid = wgid / nig, fm = gid * WGM, gsz = (nM - fm) < WGM ? (nM - fm) : WGM;
        u.pm = fm + ((wgid % nig) % gsz); u.pn = (wgid % nig) / gsz; u.kq = 0; return true;
    }
    __device__ __forceinline__ void a_ready(const Unit&) const {}
    __device__ __forceinline__ void done(const Unit&) const {}
};
template <class Epi, class Sched, bool ALIGN_EPI = false, bool SP2 = false>
__device__ __forceinline__ void gemm_phase(PG8_LAS unsigned char* lds, const Gemm g, const Sched& S, const Epi& E) {
    int tid_ = threadIdx.x; asm volatile("" : "+v"(tid_));
    const int tid = tid_, wid = __builtin_amdgcn_readfirstlane(tid >> 6), lane = tid & 63, wr = wid >> 2, wc = wid & 3, fr = lane & 15, fq = lane >> 4;
    const int K = g.K, nt = K / BK;
    unsigned voffA[2], voffB[2];
#pragma unroll
    for (int i = 0; i < 2; ++i) { int R, C; stage_rc(tid * 16 + i * 8192, R, C); const int Rb = Epi::PERM ? ((R & ~31) + perm32(R & 31)) : R;
        voffA[i] = (unsigned)(R * g.lda + C) * 2u; voffB[i] = (unsigned)(Rb * g.ldb + C) * 2u; }
    const size_t kstep = (size_t)(BK * 2);
    const size_t hstepA = (size_t)HALF * g.lda * 2, hstepB = (size_t)HALF * g.ldb * 2;
    const size_t tstepA = 2 * hstepA, tstepB = 2 * hstepB;
    const unsigned ldsw = (unsigned)wid * 1024u;
    const int aoff = lds_byte(wr * 64 + fr, fq * 8), boff = lds_byte(wc * 32 + fr, fq * 8);
#define PG8_SA(b, h) (((b) * 2 + (h)) * HTB)
#define PG8_SB(b, h) ((4 + (b) * 2 + (h)) * HTB)
#define PG8_STAGE(bufoff, gbase, voff) do { _Pragma("unroll") for (int _i = 0; _i < 2; ++_i) \
        __builtin_amdgcn_global_load_lds((const unsigned*)((const char*)(gbase) + (voff)[_i]), (PG8_LAS unsigned*)(lds + (bufoff) + ldsw + _i * 8192), 16, 0, 0); } while (0)
#define PG8_LDA(dst, b, h) do { _Pragma("unroll") for (int m = 0; m < 4; ++m) _Pragma("unroll") for (int k = 0; k < 2; ++k) dst[m][k] = *(const PG8_LAS bf16x8*)(lds + PG8_SA(b, h) + aoff + m * 2048 + k * 1024); } while (0)
#define PG8_LDB(dst, b, h) do { _Pragma("unroll") for (int n = 0; n < 2; ++n) _Pragma("unroll") for (int k = 0; k < 2; ++k) dst[n][k] = *(const PG8_LAS bf16x8*)(lds + PG8_SB(b, h) + boff + n * 2048 + k * 1024); } while (0)
#define PG8_MMA(ai, bj, At, Bt) do { __builtin_amdgcn_s_setprio(1); _Pragma("unroll") for (int m = 0; m < 4; ++m) _Pragma("unroll") for (int n = 0; n < 2; ++n) _Pragma("unroll") for (int k = 0; k < 2; ++k) \
        acc[ai][bj][m][n] = __builtin_amdgcn_mfma_f32_16x16x32_bf16(Bt[n][k], At[m][k], acc[ai][bj][m][n], 0, 0, 0); __builtin_amdgcn_s_setprio(0); } while (0)
#define PG8_WAIT_V(n) asm volatile("s_waitcnt vmcnt(" #n ")" ::: "memory")
#define PG8_WAIT_L(n) asm volatile("s_waitcnt lgkmcnt(" #n ")" ::: "memory")
#define PG8_BAR __builtin_amdgcn_s_barrier()
#define PG8_SCHED __builtin_amdgcn_sched_barrier(0)
    Unit cur, nxt; int ui = 0;
    if (!S.next(0, cur)) return;
    f32x4 acc[2][2][4][2];
#pragma unroll
    for (int a = 0; a < 2; ++a)
#pragma unroll
        for (int b = 0; b < 2; ++b)
#pragma unroll
            for (int m = 0; m < 4; ++m)
#pragma unroll
                for (int n = 0; n < 2; ++n) acc[a][b][m][n] = (f32x4){0.f, 0.f, 0.f, 0.f};
    bf16x8 At[4][2], B0[2][2], B1[2][2];
    const char* cA = (const char*)g.A + (size_t)cur.pm * tstepA + (size_t)cur.kq * g.koff; const char* cB = (const char*)g.Bt + (size_t)cur.pn * tstepB + (size_t)cur.kq * g.koff;
    S.a_ready(cur);
    if constexpr (SP2) {
        PG8_STAGE(PG8_SB(0, 0), cB, voffB); PG8_STAGE(PG8_SB(0, 1), cB + hstepB, voffB); PG8_STAGE(PG8_SA(0, 0), cA, voffA); PG8_STAGE(PG8_SA(0, 1), cA + hstepA, voffA);
        if (wr == 1) PG8_BAR;
        PG8_WAIT_V(2); PG8_BAR;
        PG8_STAGE(PG8_SB(1, 0), cB + kstep, voffB); PG8_STAGE(PG8_SA(1, 0), cA + kstep, voffA); PG8_STAGE(PG8_SB(1, 1), cB + hstepB + kstep, voffB);
        PG8_WAIT_V(6); PG8_BAR;
    } else {
        PG8_STAGE(PG8_SB(0, 0), cB, voffB); PG8_STAGE(PG8_SA(0, 0), cA, voffA); PG8_STAGE(PG8_SB(0, 1), cB + hstepB, voffB); PG8_STAGE(PG8_SA(0, 1), cA + hstepA, voffA);
        if (wr == 1) PG8_BAR;
        PG8_WAIT_V(4); PG8_BAR;
        PG8_STAGE(PG8_SB(1, 0), cB + kstep, voffB); PG8_STAGE(PG8_SA(1, 0), cA + kstep, voffA); PG8_STAGE(PG8_SB(1, 1), cB + hstepB + kstep, voffB);
        PG8_WAIT_V(6); PG8_BAR;
    }
    for (;;) {
        const bool has_next = S.next(ui + 1, nxt);
        const char* nA = has_next ? (const char*)g.A + (size_t)nxt.pm * tstepA + (size_t)nxt.kq * g.koff : cA; const char* nB = has_next ? (const char*)g.Bt + (size_t)nxt.pn * tstepB + (size_t)nxt.kq * g.koff : cB;
        for (int t = 0; t < nt; t += 2) {
            const bool last = (t == nt - 2);
            const char* a1 = cA + (size_t)(t + 1) * kstep;
            const char* a2 = last ? nA : cA + (size_t)(t + 2) * kstep; const char* b2 = last ? nB : cB + (size_t)(t + 2) * kstep;
            const char* a3 = a2 + kstep; const char* b3 = b2 + kstep;
            if (last && has_next) S.a_ready(nxt);
            if constexpr (Epi::HOOK) { if (t == Epi::H1 || t == Epi::H2) E.hook(acc, cur, t, wr, wc, fr, fq); }
            if constexpr (SP2) {
            PG8_LDB(B0, 0, 0); PG8_LDB(B1, 0, 1); PG8_SCHED; PG8_LDA(At, 0, 0); PG8_STAGE(PG8_SA(1, 1), a1 + hstepA, voffA);
            PG8_WAIT_V(8); PG8_WAIT_L(0); PG8_BAR; PG8_MMA(0, 0, At, B0); PG8_MMA(0, 1, At, B1); PG8_BAR; PG8_SCHED;
            PG8_LDA(At, 0, 1); PG8_STAGE(PG8_SB(0, 0), b2, voffB); PG8_STAGE(PG8_SB(0, 1), b2 + hstepB, voffB); PG8_STAGE(PG8_SA(0, 0), a2, voffA);
            PG8_WAIT_V(8); PG8_WAIT_L(0); PG8_BAR; PG8_MMA(1, 0, At, B0); PG8_MMA(1, 1, At, B1); PG8_BAR; PG8_SCHED;
            PG8_LDB(B0, 1, 0); PG8_LDB(B1, 1, 1); PG8_SCHED; PG8_LDA(At, 1, 0); PG8_STAGE(PG8_SA(0, 1), a2 + hstepA, voffA);
            PG8_WAIT_V(8); PG8_WAIT_L(0); PG8_BAR; PG8_MMA(0, 0, At, B0); PG8_MMA(0, 1, At, B1); PG8_BAR; PG8_SCHED;
            PG8_LDA(At, 1, 1); PG8_STAGE(PG8_SB(1, 0), b3, voffB); PG8_STAGE(PG8_SB(1, 1), b3 + hstepB, voffB); PG8_STAGE(PG8_SA(1, 0), a3, voffA);
            PG8_WAIT_V(8); PG8_WAIT_L(0); PG8_BAR; PG8_MMA(1, 0, At, B0); PG8_MMA(1, 1, At, B1); PG8_BAR; PG8_SCHED;
            } else {
            PG8_LDB(B0, 0, 0); PG8_SCHED; PG8_LDA(At, 0, 0); PG8_STAGE(PG8_SA(1, 1), a1 + hstepA, voffA);
            PG8_WAIT_L(8); PG8_BAR; PG8_WAIT_L(0); PG8_MMA(0, 0, At, B0); PG8_BAR; PG8_SCHED;
            PG8_LDB(B1, 0, 1); PG8_STAGE(PG8_SB(0, 0), b2, voffB);
            PG8_BAR; PG8_WAIT_L(0); PG8_MMA(0, 1, At, B1); PG8_BAR;
            PG8_LDA(At, 0, 1); PG8_STAGE(PG8_SA(0, 0), a2, voffA);
            PG8_BAR; PG8_WAIT_L(0); PG8_MMA(1, 0, At, B0); PG8_BAR; PG8_SCHED;
            PG8_STAGE(PG8_SB(0, 1), b2 + hstepB, voffB);
            PG8_WAIT_V(6); PG8_BAR; PG8_MMA(1, 1, At, B1); PG8_BAR;
            PG8_LDB(B0, 1, 0); PG8_SCHED; PG8_LDA(At, 1, 0); PG8_STAGE(PG8_SA(0, 1), a2 + hstepA, voffA);
            PG8_WAIT_L(8); PG8_BAR; PG8_WAIT_L(0); PG8_MMA(0, 0, At, B0); PG8_BAR; PG8_SCHED;
            PG8_LDB(B1, 1, 1); PG8_STAGE(PG8_SB(1, 0), b3, voffB);
            PG8_BAR; PG8_WAIT_L(0); PG8_MMA(0, 1, At, B1); PG8_BAR;
            PG8_LDA(At, 1, 1); PG8_STAGE(PG8_SA(1, 0), a3, voffA);
            PG8_BAR; PG8_WAIT_L(0); PG8_MMA(1, 0, At, B0); PG8_BAR; PG8_SCHED;
            PG8_STAGE(PG8_SB(1, 1), b3 + hstepB, voffB);
            PG8_WAIT_V(6); PG8_BAR; PG8_MMA(1, 1, At, B1); PG8_BAR;
            }
        }
        if constexpr (ALIGN_EPI) { if (wr == 0) PG8_BAR; }
        if constexpr (!Epi::AFTER_DRAIN) { E(acc, cur, wr, wc, fr, fq); S.done(cur); }
        if (!has_next) break;
#pragma unroll
        for (int a = 0; a < 2; ++a)
#pragma unroll
            for (int b = 0; b < 2; ++b)
#pragma unroll
                for (int m = 0; m < 4; ++m)
#pragma unroll
                    for (int n = 0; n < 2; ++n) acc[a][b][m][n] = (f32x4){0.f, 0.f, 0.f, 0.f};
        cur = nxt; cA = nA; cB = nB; ++ui;
        if constexpr (ALIGN_EPI) { if (wr == 1) PG8_BAR; }
    }
    PG8_WAIT_V(0);
    if constexpr (!ALIGN_EPI) { if (wr == 0) PG8_BAR; }
    PG8_BAR;
    if constexpr (Epi::AFTER_DRAIN) { E.fused(acc, cur, wr, wc, fr, fq, lds, wid, lane); S.done(cur); }
#undef PG8_SA
#undef PG8_SB
#undef PG8_STAGE
#undef PG8_LDA
#undef PG8_LDB
#undef PG8_MMA
#undef PG8_WAIT_V
#undef PG8_WAIT_L
#undef PG8_BAR
#undef PG8_SCHED
}
}

#define GAS __attribute__((address_space(1)))
#define LAS __attribute__((address_space(3)))
typedef unsigned short bf16;
typedef unsigned v4u __attribute__((ext_vector_type(4)));
typedef unsigned v2u __attribute__((ext_vector_type(2)));
typedef float f32x4 __attribute__((ext_vector_type(4)));

constexpr int DM = 2048, NCTX = 8192, NLAT = 2048, MTOK = 10240, DEPTH = 4;
constexpr int INW = 16384, DFF = 5632, NFI = 11264, YW = 3072;
constexpr float EPS = 1e-6f;
constexpr int NWAVES = 8, NTHR = 512;

constexpr size_t MiB = 1u << 20;
constexpr size_t WS_CTL = 0, CTL_ZERO_BYTES = 1 * MiB;
constexpr size_t WS_MOD = 1 * MiB;
constexpr size_t WS_LB = 2 * MiB;
constexpr size_t WS_ROPE = 2 * MiB + 65536;
constexpr size_t WS_WT = 4 * MiB;
constexpr size_t WL_ELEMS = 78643200;
constexpr size_t OFF_IN = 0, OFF_UP = 33554432, OFF_OUT = 39845888, OFF_FI = 44040192, OFF_FO = 67108864;
constexpr size_t WS_Z = 604 * MiB;
constexpr size_t WS_LOGF = 924 * MiB;
constexpr size_t WS_H = 1004 * MiB;
constexpr size_t WS_Y = 1044 * MiB;
constexpr size_t WS_OF = 1104 * MiB;
constexpr size_t WS_OB = 1144 * MiB;
constexpr size_t WS_TP = 1184 * MiB;
constexpr size_t TPQ = 2048 * 2048;
constexpr size_t WS_MG = 1264 * MiB;
constexpr size_t WS_T = 1304 * MiB;
constexpr size_t WS_ACT = 1384 * MiB;
constexpr size_t WS_END = 1494 * MiB;
constexpr int CW_BAR = 4096;
constexpr int CW_Q = 16384;
constexpr size_t OUT_Y = 0, OUT_K = 20971520, OUT_V = OUT_K + 33554432, OUT_S = OUT_V + 33554432, OUT_END = OUT_S + 33554432;

constexpr int LDS_BYTES = 155648;
constexpr int LDSCTL_OFF = 154624;

constexpr int PH_PRO = 0, PH_T1 = 1, PH_L0 = 2, PH_PER_LAYER = 9, PH_END = PH_L0 + DEPTH * PH_PER_LAYER;

struct Args {
    const float *x_prompt, *x_sample, *cache_k, *cache_v, *state, *c, *c_ctx, *w_ada, *b_ada, *norm_g, *w_in, *a_w, *a_b, *rpb, *lb_logits, *w_up_a, *w_up_b, *w_up_c, *w_out, *w_fi, *w_fo;
    float* out; unsigned char* ws; int ph_lo, ph_hi;
};

__device__ __forceinline__ float bf2f_lo(unsigned w) { return __uint_as_float(w << 16); }
__device__ __forceinline__ float bf2f_hi(unsigned w) { return __uint_as_float(w & 0xffff0000u); }
__device__ __forceinline__ unsigned f2bf(float f) { unsigned u = __float_as_uint(f); return (u + 0x7fffu + ((u >> 16) & 1u)) >> 16; }
__device__ __forceinline__ unsigned pk2(float lo, float hi) { return f2bf(lo) | (f2bf(hi) << 16); }
__device__ __forceinline__ void unpack8(const v4u w, float (&f)[8]) {
    f[0] = bf2f_lo(w.x); f[1] = bf2f_hi(w.x); f[2] = bf2f_lo(w.y); f[3] = bf2f_hi(w.y); f[4] = bf2f_lo(w.z); f[5] = bf2f_hi(w.z); f[6] = bf2f_lo(w.w); f[7] = bf2f_hi(w.w); }
__device__ __forceinline__ v4u pack8(const float (&f)[8]) { v4u w; w.x = pk2(f[0], f[1]); w.y = pk2(f[2], f[3]); w.z = pk2(f[4], f[5]); w.w = pk2(f[6], f[7]); return w; }
__device__ __forceinline__ float wave_sum(float v) {
#pragma unroll
    for (int o = 1; o < 64; o <<= 1) v += __shfl_xor(v, o);
    return v;
}
__device__ __forceinline__ float sigmoidf_(float x) { return 1.0f / (1.0f + __expf(-x)); }
__device__ __forceinline__ float siluf_(float x) { return x / (1.0f + __expf(-x)); }
__device__ __forceinline__ float gelu_tanh_(float x) { const float y = 1.5957691216057308f * (x + 0.044715f * x * x * x); return x / (1.0f + __expf(-y)); }

#define XB_TMO      128
#define XB_XCNT(j)  (256  + 64 * (j))
#define XB_XSUB(j)  (1280 + 64 * (j))
#define XB_XGEN(j)  (2304 + 64 * (j))
#define XB_TOP      3328
#define XB_TOPGEN   3392
#define XCD_BAR_WORDS 3456
#define XB_SPIN_CAP (1u << 18)
__device__ __forceinline__ unsigned xb_ld(unsigned* p)              { return __hip_atomic_load(p, __ATOMIC_RELAXED, __HIP_MEMORY_SCOPE_AGENT); }
__device__ __forceinline__ unsigned xb_add(unsigned* p, unsigned v) { return __hip_atomic_fetch_add(p, v, __ATOMIC_RELAXED, __HIP_MEMORY_SCOPE_AGENT); }
__device__ __forceinline__ unsigned xb_xcc_id() { return (unsigned)__builtin_amdgcn_s_getreg((3 << 11) | 20) & 0xFu; }
#define XB_SPIN(cond, bar) do { unsigned _sp = 0; while (cond) { __builtin_amdgcn_s_sleep(1); \
    if ((++_sp & 255u) == 0u) { if (xb_ld(&(bar)[XB_TMO])) break; if (_sp > XB_SPIN_CAP) { atomicAdd(&(bar)[XB_TMO], 1u); break; } } } } while (0)
struct XcdBarrier { unsigned* bar; unsigned x; volatile LAS unsigned* st; };
__device__ __forceinline__ XcdBarrier xcd_barrier_post(unsigned* bar, volatile LAS unsigned* st) {
    XcdBarrier b; b.bar = bar; b.x = xb_xcc_id(); b.st = st;
    if (threadIdx.x == 0) (void)xb_add(&bar[XB_XCNT(b.x)], 1u);
    return b;
}
__device__ __forceinline__ void xcd_barrier_complete(unsigned* bar, unsigned x, unsigned& nloc, unsigned& nx) {
    const unsigned G = gridDim.x * gridDim.y * gridDim.z;
    unsigned sum, cnt, mine, sp = 0u;
    for (;;) {
        sum = 0u; cnt = 0u; mine = 0u;
#pragma unroll
        for (unsigned j = 0; j < 16; ++j) { const unsigned c = xb_ld(&bar[XB_XCNT(j)]); sum += c; cnt += (c > 0u) ? 1u : 0u; mine = (j == x) ? c : mine; }
        if (sum == G) break;
        __builtin_amdgcn_s_sleep(1);
        if ((++sp & 255u) == 0u) { if (xb_ld(&bar[XB_TMO])) break; if (sp > XB_SPIN_CAP) { atomicAdd(&bar[XB_TMO], 1u); break; } }
    }
    nloc = mine > 0u ? mine : 1u; nx = cnt > 0u ? cnt : 1u;
}
__device__ __forceinline__ void xcd_barrier(const XcdBarrier& b) {
    asm volatile("s_waitcnt vmcnt(0)" ::: "memory");
    __syncthreads();
    if (threadIdx.x == 0) {
        unsigned* bar = b.bar;
        __builtin_amdgcn_s_waitcnt(0);
        unsigned nloc = b.st[0], nx = b.st[1];
        if (nloc == 0u) { xcd_barrier_complete(bar, b.x, nloc, nx); b.st[0] = nloc; b.st[1] = nx; }
        const unsigned old = xb_add(&bar[XB_XSUB(b.x)], 1u);
        const unsigned gen = old / nloc;
        if (old + 1u == (gen + 1u) * nloc) {
            __builtin_amdgcn_fence(__ATOMIC_RELEASE, "agent");
            asm volatile("s_waitcnt vmcnt(0)" ::: "memory");
            const unsigned og = xb_add(&bar[XB_TOP], 1u);
            const unsigned tg = og / nx;
            if (og + 1u == (tg + 1u) * nx) xb_add(&bar[XB_TOPGEN], 1u);
            else XB_SPIN(xb_ld(&bar[XB_TOPGEN]) == tg, bar);
            __builtin_amdgcn_fence(__ATOMIC_ACQUIRE, "agent");
            xb_add(&bar[XB_XGEN(b.x)], 1u);
            asm volatile("s_waitcnt vmcnt(0)" ::: "memory");
        } else {
            XB_SPIN(xb_ld(&bar[XB_XGEN(b.x)]) == gen, bar);
            __builtin_amdgcn_fence(__ATOMIC_ACQUIRE, "agent");
            asm volatile("s_waitcnt vmcnt(0)" ::: "memory");
        }
    }
    __syncthreads();
}

struct EpiIn {
    static constexpr bool PERM = true, AFTER_DRAIN = false, HOOK = false; static constexpr int H1 = -1, H2 = -1;
    bf16* Z; float* LOGF; const float* lbp  ; float* outK; float* outV;
    __device__ __forceinline__ void operator()(const f32x4 (&acc)[2][2][4][2], const pg8::Unit& u, int wr, int wc, int fr, int fq) const {
        const int seg = u.pn >> 2;
        const int row0 = u.pm * 256 + wr * 64 + fr, colt = u.pn * 256 + wc * 32 + 8 * fq;
#pragma unroll
        for (int ai = 0; ai < 2; ++ai)
#pragma unroll
            for (int m = 0; m < 4; ++m) {
                const int row = row0 + ai * 128 + m * 16;
#pragma unroll
                for (int bj = 0; bj < 2; ++bj) {
                    const int col = colt + bj * 128;
                    float v[8];
#pragma unroll
                    for (int j = 0; j < 4; ++j) { v[j] = acc[ai][bj][m][0][j]; v[4 + j] = acc[ai][bj][m][1][j]; }
                    if (seg == 6 || seg == 7) {
                        const float* lb = lbp + (seg - 6) * 4096 + (col - (seg == 6 ? 6144 : 7168));
                        float o[8];
#pragma unroll
                        for (int j = 0; j < 8; ++j) { const float b = lb[j]; o[j] = logf(b + (1.0f - b) * sigmoidf_(v[j])); }
                        float* dst = LOGF + (size_t)row * 2048 + (col - 6144);
                        *(f32x4*)dst = (f32x4){o[0], o[1], o[2], o[3]}; *(f32x4*)(dst + 4) = (f32x4){o[4], o[5], o[6], o[7]};
                    } else {
                        if (seg == 3 || seg == 4) {
                            if (row < NCTX) { float* dst = (seg == 3 ? outK : outV) + ((size_t)(row >> 8) * 1024 + (row & 255)) * 1024 + (col - (seg == 3 ? 3072 : 4096));
                                *(f32x4*)dst = (f32x4){v[0], v[1], v[2], v[3]}; *(f32x4*)(dst + 4) = (f32x4){v[4], v[5], v[6], v[7]}; }
                        } else if (seg == 0 || seg == 1) {
#pragma unroll
                            for (int j = 0; j < 8; ++j) v[j] = gelu_tanh_(v[j]);
                        } else if (seg == 5 || seg == 9) {
#pragma unroll
                            for (int j = 0; j < 8; ++j) v[j] = siluf_(v[j]);
                        } else if (seg >= 10) {
#pragma unroll
                            for (int j = 0; j < 8; ++j) v[j] = sigmoidf_(v[j]);
                        }
                        *(v4u*)(Z + (size_t)row * INW + col) = pack8(v);
                    }
                }
                asm volatile("" ::: "memory");
            }
    }
};
struct EpiUpK {
    static constexpr bool PERM = true, AFTER_DRAIN = false, HOOK = true; static constexpr int H1 = 16, H2 = 32;
    const bf16* Zg  ; bf16* MG;
    __device__ __forceinline__ void hook(f32x4 (&acc)[2][2][4][2], const pg8::Unit& u, int t, int wr, int wc, int fr, int fq) const {
        int frl = fr, fql = fq; asm volatile("" : "+v"(frl), "+v"(fql));
        const int row0 = u.pm * 256 + wr * 64 + frl, colt = u.pn * 256 + wc * 32 + 8 * fql;
        const bf16* zn = Zg + (t == 16 ? 0 : 2048);
#pragma unroll
        for (int ai = 0; ai < 2; ++ai)
#pragma unroll
            for (int m = 0; m < 4; ++m) {
                const size_t ro = (size_t)(row0 + ai * 128 + m * 16) * INW + colt;
#pragma unroll
                for (int bj = 0; bj < 2; ++bj) {
                    const v4u nw = *(const v4u*)(zn + ro + bj * 128), dw = *(const v4u*)(zn + 2048 + ro + bj * 128);
                    float gn[8], gd[8]; unpack8(nw, gn); unpack8(dw, gd);
#pragma unroll
                    for (int j = 0; j < 4; ++j) { acc[ai][bj][m][0][j] *= gn[j] * __builtin_amdgcn_rcpf(gd[j]); acc[ai][bj][m][1][j] *= gn[4 + j] * __builtin_amdgcn_rcpf(gd[4 + j]); }
                    asm volatile("" ::: "memory");
                }
            }
    }
    __device__ __forceinline__ void operator()(const f32x4 (&acc)[2][2][4][2], const pg8::Unit& u, int wr, int wc, int fr, int fq) const {
        const int row0 = u.pm * 256 + wr * 64 + fr, colt = u.pn * 256 + wc * 32 + 8 * fq;
#pragma unroll
        for (int ai = 0; ai < 2; ++ai)
#pragma unroll
            for (int m = 0; m < 4; ++m) {
                const int row = row0 + ai * 128 + m * 16;
#pragma unroll
                for (int bj = 0; bj < 2; ++bj) {
                    const int col = colt + bj * 128;
                    float g[8]; unpack8(*(const v4u*)(Zg + 4096 + (size_t)row * INW + col), g);
                    float v[8];
#pragma unroll
                    for (int j = 0; j < 4; ++j) { v[j] = acc[ai][bj][m][0][j] * g[j]; v[4 + j] = acc[ai][bj][m][1][j] * g[4 + j]; }
                    *(v4u*)(MG + (size_t)row * DM + col) = pack8(v);
                }
                asm volatile("" ::: "memory");
            }
    }
};
struct EpiF32P {
    static constexpr bool PERM = true, AFTER_DRAIN = false, HOOK = false; static constexpr int H1 = -1, H2 = -1;
    float* C; int ldc; size_t kq_stride;
    __device__ __forceinline__ void operator()(const f32x4 (&acc)[2][2][4][2], const pg8::Unit& u, int wr, int wc, int fr, int fq) const {
        const int row0 = u.pm * 256 + wr * 64 + fr, colt = u.pn * 256 + wc * 32 + 8 * fq;
#pragma unroll
        for (int ai = 0; ai < 2; ++ai)
#pragma unroll
            for (int m = 0; m < 4; ++m) {
                float* rp = C + (size_t)u.kq * kq_stride + (size_t)(row0 + ai * 128 + m * 16) * ldc + colt;
#pragma unroll
                for (int bj = 0; bj < 2; ++bj) { *(f32x4*)(rp + bj * 128) = acc[ai][bj][m][0]; *(f32x4*)(rp + bj * 128 + 4) = acc[ai][bj][m][1]; }
            }
    }
};
struct EpiSwi {
    static constexpr bool PERM = true, AFTER_DRAIN = false, HOOK = false; static constexpr int H1 = -1, H2 = -1;
    bf16* ACT;
    __device__ __forceinline__ void operator()(const f32x4 (&acc)[2][2][4][2], const pg8::Unit& u, int wr, int wc, int fr, int fq) const {
        const int row0 = u.pm * 256 + wr * 64 + fr, colt = u.pn * 128 + wc * 32 + 8 * fq;
#pragma unroll
        for (int ai = 0; ai < 2; ++ai)
#pragma unroll
            for (int m = 0; m < 4; ++m) {
                float v[8];
#pragma unroll
                for (int j = 0; j < 4; ++j) { v[j] = siluf_(acc[ai][1][m][0][j]) * acc[ai][0][m][0][j]; v[4 + j] = siluf_(acc[ai][1][m][1][j]) * acc[ai][0][m][1][j]; }
                *(v4u*)(ACT + (size_t)(row0 + ai * 128 + m * 16) * DFF + colt) = pack8(v);
            }
    }
};

struct Ctx {
    LAS unsigned char* lds; int tid, lane, wave, vcu, G;
};

__device__ __forceinline__ void cvt_item(const float* W, int N, int k0, int n0, bf16* dst, int dld, int drow0, int dcol0, LAS float* scr, int lane) {
    const float* src = W + (size_t)(k0 + (lane >> 4)) * N + n0 + 4 * (lane & 15);
    f32x4 v[16];
#pragma unroll
    for (int i = 0; i < 16; ++i) v[i] = *(const f32x4*)(src + (size_t)(4 * i) * N);
#pragma unroll
    for (int i = 0; i < 16; ++i) { LAS float* s = scr + (4 * i + (lane >> 4)) * 65 + 4 * (lane & 15); s[0] = v[i].x; s[1] = v[i].y; s[2] = v[i].z; s[3] = v[i].w; }
    asm volatile("s_waitcnt lgkmcnt(0)" ::: "memory");
    const int c = lane & 7;
#pragma unroll
    for (int j = 0; j < 8; ++j) { const int n = (lane >> 3) + 8 * j; const LAS float* s = scr + (8 * c) * 65 + n;
        v4u o; o.x = pk2(s[0 * 65], s[1 * 65]); o.y = pk2(s[2 * 65], s[3 * 65]); o.z = pk2(s[4 * 65], s[5 * 65]); o.w = pk2(s[6 * 65], s[7 * 65]);
        *(v4u*)(dst + (size_t)(drow0 + n) * dld + dcol0 + 8 * c) = o; }
    asm volatile("s_waitcnt lgkmcnt(0)" ::: "memory");
}
__device__ __forceinline__ void phase_prologue(const Args& a, const Ctx& F) {
    unsigned char* ws = a.ws;
    bf16* WT = (bf16*)(ws + WS_WT);
    {
        LAS float* scr = (LAS float*)(F.lds + F.wave * 16640);
        const int gw = F.vcu * NWAVES + F.wave, NGW = F.G * NWAVES;
        constexpr int IT_IN = 32 * 256, IT_UP = 16 * 32, IT_OUT = 32 * 32, IT_FI = 32 * 176, IT_FO = 88 * 32, IT_LAYER = IT_IN + 3 * IT_UP + IT_OUT + IT_FI + IT_FO;
        for (int it = gw; it < DEPTH * IT_LAYER; it += NGW) {
            const int l = it / IT_LAYER; int r = it % IT_LAYER;
            bf16* wl = WT + (size_t)l * WL_ELEMS;
            if (r < IT_IN) { const int kb = r / 256, nb = r % 256; cvt_item(a.w_in + (size_t)l * DM * INW, INW, 64 * kb, 64 * nb, wl + OFF_IN, DM, 64 * nb, 64 * kb, scr, F.lane); continue; }
            r -= IT_IN;
            if (r < 3 * IT_UP) { const int br = r / IT_UP, q = r % IT_UP, kb = q / 32, nb = q % 32;
                const float* w = (br == 0 ? a.w_up_a : (br == 1 ? a.w_up_b : a.w_up_c)) + (size_t)l * 1024 * DM;
                cvt_item(w, DM, 64 * kb, 64 * nb, wl + OFF_UP, YW, 64 * nb, 1024 * br + 64 * kb, scr, F.lane); continue; }
            r -= 3 * IT_UP;
            if (r < IT_OUT) { const int kb = r / 32, nb = r % 32; cvt_item(a.w_out + (size_t)l * DM * DM, DM, 64 * kb, 64 * nb, wl + OFF_OUT, DM, 64 * nb, 64 * kb, scr, F.lane); continue; }
            r -= IT_OUT;
            if (r < IT_FI) { const int kb = r / 176, nb = r % 176; const int n0 = 64 * nb;
                const int drow = (n0 < DFF) ? (256 * (n0 / 128) + (n0 % 128)) : (256 * ((n0 - DFF) / 128) + 128 + ((n0 - DFF) % 128));
                cvt_item(a.w_fi + (size_t)l * DM * NFI, NFI, 64 * kb, n0, wl + OFF_FI, DM, drow, 64 * kb, scr, F.lane); continue; }
            r -= IT_FI;
            { const int kb = r / 32, nb = r % 32; cvt_item(a.w_fo + (size_t)l * DFF * DM, DM, 64 * kb, 64 * nb, wl + OFF_FO, DFF, 64 * nb, 64 * kb, scr, F.lane); }
        }
    }
    __syncthreads();
    {
        LAS float* sc = (LAS float*)F.lds;
        LAS float* red = (LAS float*)(F.lds + 24576);
        float* MOD = (float*)(ws + WS_MOD);
        for (int i = F.tid; i < 3 * DM; i += NTHR) { const int ci = i / DM, k = i % DM; const float x = (ci == 0) ? a.c_ctx[k] : a.c[(ci - 1) * DM + k]; sc[i] = x / (1.0f + expf(-x)); }
        __syncthreads();
        const int cx = F.tid & 31, kg = F.tid >> 5;
        for (int u = F.vcu; u < 4 * 96; u += F.G) {
            const int l = u / 96, cb = u % 96;
            const float* wp = a.w_ada + ((size_t)l * DM + 128 * kg) * 12288 + 128 * cb + 4 * cx;
            f32x4 a0 = {0.f, 0.f, 0.f, 0.f}, a1 = a0, a2 = a0;
#pragma unroll 8
            for (int k = 0; k < 128; ++k) { const f32x4 w = *(const f32x4*)(wp + (size_t)k * 12288);
                const float s0 = sc[128 * kg + k], s1 = sc[DM + 128 * kg + k], s2 = sc[2 * DM + 128 * kg + k];
                a0 += w * s0; a1 += w * s1; a2 += w * s2; }
#pragma unroll
            for (int j = 0; j < 4; ++j) { red[(kg * 3 + 0) * 128 + 4 * cx + j] = a0[j]; red[(kg * 3 + 1) * 128 + 4 * cx + j] = a1[j]; red[(kg * 3 + 2) * 128 + 4 * cx + j] = a2[j]; }
            __syncthreads();
            if (F.tid < 384) { const int ci = F.tid / 128, col = F.tid % 128; float s = 0.f;
#pragma unroll
                for (int g = 0; g < 16; ++g) s += red[(g * 3 + ci) * 128 + col];
                MOD[(size_t)(l * 3 + ci) * 12288 + 128 * cb + col] = s + a.b_ada[l * 12288 + 128 * cb + col]; }
            __syncthreads();
        }
    }
    {
        float* LB = (float*)(ws + WS_LB); float* ROPE = (float*)(ws + WS_ROPE);
        for (int i = F.vcu * NTHR + F.tid; i < 2048; i += F.G * NTHR) {
            const int dir = i / 1024, f = i % 1024;
            float x[4], mx = -3.0e38f;
#pragma unroll
            for (int l = 0; l < 4; ++l) { x[l] = a.lb_logits[(dir * 4 + l) * 1024 + f]; mx = fmaxf(mx, x[l]); }
            float e[4], s = 0.f;
#pragma unroll
            for (int l = 0; l < 4; ++l) { e[l] = expf(x[l] - mx); s += e[l]; }
            float cs = 0.f;
#pragma unroll
            for (int l = 0; l < 4; ++l) { if (l > 0) cs += e[l] / s; LB[(dir * 4 + l) * 1024 + f] = cs; }
            const int p = i / 32, fi = i % 32;
            const float inv = powf(10000.0f, -(float)(2 * fi) / 64.0f), ang = (float)p * inv;
            ROPE[2 * i] = cosf(ang); ROPE[2 * i + 1] = sinf(ang);
        }
    }
}

__device__ __forceinline__ void rownorm_phase(const Args& a, const Ctx& F, bool first, const float* T, const float* gate  , const float* gpost,
                                              bool write_h, const float* gn, const float* scv, const float* shv  ) {
    float* X = a.out + OUT_Y; bf16* H = (bf16*)(a.ws + WS_H); const float* TP = (const float*)(a.ws + WS_TP);
    const int gw = F.vcu * NWAVES + F.wave, NGW = F.G * NWAVES;
    for (int m = gw; m < MTOK; m += NGW) {
        const int ci = (m < NCTX) ? 0 : 1 + ((m - NCTX) >> 10);
        const float* xr = first ? ((m < NCTX) ? a.x_prompt + (size_t)m * DM : a.x_sample + (size_t)(m - NCTX) * DM) : X + (size_t)m * DM;
        f32x4 x[8];
#pragma unroll
        for (int j = 0; j < 8; ++j) x[j] = *((const f32x4*)xr + F.lane + 64 * j);
        if (T) {
            f32x4 t[8]; float ss = 0.f;
#pragma unroll
            for (int j = 0; j < 8; ++j) {
                if (m < NCTX) t[j] = *((const f32x4*)(T + (size_t)m * DM) + F.lane + 64 * j);
                else { const f32x4* tp = (const f32x4*)(TP + (size_t)(m - NCTX) * DM) + F.lane + 64 * j; t[j] = (tp[0] + tp[TPQ / 4]) + (tp[2 * (TPQ / 4)] + tp[3 * (TPQ / 4)]); }
                ss += (t[j].x * t[j].x + t[j].y * t[j].y) + (t[j].z * t[j].z + t[j].w * t[j].w); }
            const float r = 1.0f / sqrtf(wave_sum(ss) * (1.0f / DM) + EPS);
#pragma unroll
            for (int j = 0; j < 8; ++j) { const f32x4 gp = *((const f32x4*)gpost + F.lane + 64 * j), gt = *((const f32x4*)(gate + (size_t)ci * 12288) + F.lane + 64 * j);
                x[j] += gt * (t[j] * r * gp); }
        }
        if (T || first) {
#pragma unroll
            for (int j = 0; j < 8; ++j) *((f32x4*)(X + (size_t)m * DM) + F.lane + 64 * j) = x[j];
        }
        if (write_h) {
            float ss = 0.f;
#pragma unroll
            for (int j = 0; j < 8; ++j) ss += (x[j].x * x[j].x + x[j].y * x[j].y) + (x[j].z * x[j].z + x[j].w * x[j].w);
            const float r = 1.0f / sqrtf(wave_sum(ss) * (1.0f / DM) + EPS);
#pragma unroll
            for (int j = 0; j < 8; ++j) { const f32x4 g = *((const f32x4*)gn + F.lane + 64 * j), s = *((const f32x4*)(scv + (size_t)ci * 12288) + F.lane + 64 * j), b = *((const f32x4*)(shv + (size_t)ci * 12288) + F.lane + 64 * j);
                const f32x4 h = x[j] * r * g * (s + 1.0f) + b;
                v2u w; w.x = pk2(h.x, h.y); w.y = pk2(h.z, h.w);
                *((v2u*)(H + (size_t)m * DM) + F.lane + 64 * j) = w; }
        }
    }
}

__device__ __forceinline__ void phase_ycnorm(const Args& a, const Ctx& F) {
    const float* OFp = (const float*)(a.ws + WS_OF); const float* OBp = (const float*)(a.ws + WS_OB);
    const bf16* Z = (const bf16*)(a.ws + WS_Z); bf16* Y = (bf16*)(a.ws + WS_Y);
    const int gw = F.vcu * NWAVES + F.wave, NGW = F.G * NWAVES;
    for (int m = gw; m < MTOK; m += NGW) {
        float o[16]; float ss = 0.f;
#pragma unroll
        for (int j = 0; j < 4; ++j) { const f32x4 p = *((const f32x4*)(OFp + (size_t)m * 1024 + 16 * F.lane) + j), q = *((const f32x4*)(OBp + (size_t)m * 1024 + 16 * F.lane) + j);
            const f32x4 s = p + q; o[4 * j] = s.x; o[4 * j + 1] = s.y; o[4 * j + 2] = s.z; o[4 * j + 3] = s.w; ss += (s.x * s.x + s.y * s.y) + (s.z * s.z + s.w * s.w); }
        ss += __shfl_xor(ss, 1); ss += __shfl_xor(ss, 2); ss += __shfl_xor(ss, 4);
        const float r = 1.0f / sqrtf(ss * (1.0f / 128.0f) + EPS);
        float g0[8], g1[8];
        unpack8(*(const v4u*)(Z + (size_t)m * INW + 9216 + 16 * F.lane), g0); unpack8(*(const v4u*)(Z + (size_t)m * INW + 9216 + 16 * F.lane + 8), g1);
        float y0[8], y1[8];
#pragma unroll
        for (int j = 0; j < 8; ++j) { y0[j] = o[j] * r * g0[j]; y1[j] = o[8 + j] * r * g1[j]; }
        *(v4u*)(Y + (size_t)m * YW + 2048 + 16 * F.lane) = pack8(y0); *(v4u*)(Y + (size_t)m * YW + 2048 + 16 * F.lane + 8) = pack8(y1);
    }
}

typedef short bf16x8 __attribute__((ext_vector_type(8)));
typedef short s16x4 __attribute__((ext_vector_type(4)));
typedef float f32x16 __attribute__((ext_vector_type(16)));
typedef __bf16 bf16x2_t __attribute__((ext_vector_type(2)));
typedef __bf16 bf16x4_t __attribute__((ext_vector_type(4)));
typedef float f32x2_t __attribute__((ext_vector_type(2)));
#define MFMA32(a, b, c) __builtin_amdgcn_mfma_f32_32x32x16_bf16((a), (b), (c), 0, 0, 0)
__device__ __forceinline__ unsigned cvtpk(float lo, float hi) { const f32x2_t v = {lo, hi}; return __builtin_bit_cast(unsigned, __builtin_convertvector(v, bf16x2_t)); }
__device__ __forceinline__ bf16x8 pack_regs(const f32x16& x, int s) {
    v4u p; p.x = cvtpk(x[8 * s], x[8 * s + 1]); p.y = cvtpk(x[8 * s + 2], x[8 * s + 3]); p.z = cvtpk(x[8 * s + 4], x[8 * s + 5]); p.w = cvtpk(x[8 * s + 6], x[8 * s + 7]);
    return __builtin_bit_cast(bf16x8, p);
}
__device__ __forceinline__ s16x4 tr_read(const LAS unsigned char* p) { return __builtin_bit_cast(s16x4, __builtin_amdgcn_ds_read_tr16_b64_v4bf16((LAS bf16x4_t*)p)); }
__device__ __forceinline__ bf16x8 tr_pair(const LAS unsigned char* lo, const LAS unsigned char* hi) { const s16x4 a = tr_read(lo), b = tr_read(hi); return __builtin_shufflevector(a, b, 0, 1, 2, 3, 4, 5, 6, 7); }
constexpr float ATT_SCALE = 0.08838834764831845f;
constexpr int KP = 272, VP = 320;
constexpr int ATT_K_OFF = 0, ATT_V_OFF = 256 * KP, ATT_RPB_OFF = ATT_V_OFF + 256 * VP;
struct AttnW { f32x16 O[4]; float m, l; };
template <int MODE, bool QLDS>
__device__ __forceinline__ void attn_tile(AttnW& W, const bf16x8 (&qf)[8], const LAS unsigned char* Ql, const LAS unsigned char* Kl, const LAS unsigned char* Vl, int kt0, int lane, const LAS float* rpb_row, int kc0, int qc) {
    const int r = lane & 31, h = lane >> 5;
    f32x16 sacc;
#pragma unroll
    for (int i = 0; i < 16; ++i) sacc[i] = 0.f;
    const LAS unsigned char* kp = Kl + (kt0 + r) * KP + 16 * h;
#pragma unroll
    for (int ks = 0; ks < 8; ++ks) { const bf16x8 a = *(const LAS bf16x8*)(kp + 32 * ks); const bf16x8 q = QLDS ? *(const LAS bf16x8*)(Ql + 32 * ks) : qf[ks]; sacc = MFMA32(a, q, sacc); }
    float mt = -1.0e30f;
    if (MODE == 1) {
        const int c_start = min(max(qc - 8, 0), 48);
        const int kb = kc0 + 4 * h - c_start;
        const LAS float* bp = rpb_row + (kc0 + 4 * h - qc + 15);
#pragma unroll
        for (int i = 0; i < 16; ++i) { const int off = (i & 3) + 8 * (i >> 2); const bool ok = (unsigned)(kb + off) < 16u;
            const float bias = bp[ok ? off : (qc - kc0 - 4 * h)];
            const float v = ok ? (sacc[i] * ATT_SCALE + bias) : -1.0e30f; sacc[i] = v; mt = fmaxf(mt, v); }
    } else {
#pragma unroll
        for (int i = 0; i < 16; ++i) { sacc[i] *= ATT_SCALE; mt = fmaxf(mt, sacc[i]); }
    }
    mt = fmaxf(mt, __shfl_xor(mt, 32));
    const float mn = fmaxf(W.m, mt), alpha = __expf(W.m - mn);
    float ls = 0.f;
#pragma unroll
    for (int i = 0; i < 16; ++i) { const float e = (MODE == 1 && sacc[i] < -1.0e29f) ? 0.f : __expf(sacc[i] - mn); sacc[i] = e; ls += e; }
    ls += __shfl_xor(ls, 32);
    W.l = W.l * alpha + ls; W.m = mn;
    if (__any(alpha != 1.0f)) {
#pragma unroll
        for (int dt = 0; dt < 4; ++dt)
#pragma unroll
            for (int i = 0; i < 16; ++i) W.O[dt][i] *= alpha;
    }
    const bf16x8 pb0 = pack_regs(sacc, 0), pb1 = pack_regs(sacc, 1);
    const int g = (lane >> 4) & 1, q4 = (lane & 15) >> 2, p4 = lane & 3;
    const LAS unsigned char* vp = Vl + (kt0 + 4 * h + q4) * VP + 32 * g + 8 * p4;
#pragma unroll
    for (int dt = 0; dt < 4; ++dt) {
        const bf16x8 v0 = tr_pair(vp + 64 * dt, vp + 64 * dt + 8 * VP);
        const bf16x8 v1 = tr_pair(vp + 64 * dt + 16 * VP, vp + 64 * dt + 24 * VP);
        W.O[dt] = MFMA32(v0, pb0, W.O[dt]); W.O[dt] = MFMA32(v1, pb1, W.O[dt]);
    }
}
__device__ __forceinline__ void attn_init(AttnW& W) {
    W.m = -1.0e30f; W.l = 0.f;
#pragma unroll
    for (int dt = 0; dt < 4; ++dt)
#pragma unroll
        for (int i = 0; i < 16; ++i) W.O[dt][i] = 0.f;
}
__device__ __forceinline__ void attn_store_dt(const f32x16& O, float inv, bf16* yrow, int dt, int h) {
#pragma unroll
    for (int g4 = 0; g4 < 4; ++g4) { v2u w; w.x = cvtpk(O[4 * g4] * inv, O[4 * g4 + 1] * inv); w.y = cvtpk(O[4 * g4 + 2] * inv, O[4 * g4 + 3] * inv);
        *(v2u*)(yrow + 32 * dt + 8 * g4 + 4 * h) = w; }
}

__device__ __forceinline__ void unitAttnCtx(const Args& a, const Ctx& F, int unit) {
    const int hd = unit & 7, b = unit >> 3;
    const bf16* Z = (const bf16*)(a.ws + WS_Z); bf16* Y = (bf16*)(a.ws + WS_Y);
    const LAS unsigned char* Kl = F.lds + ATT_K_OFF; const LAS unsigned char* Vl = F.lds + ATT_V_OFF;
    for (int p = F.tid; p < 4096; p += NTHR) { const int key = p >> 4, c16 = p & 15; const bf16* src = Z + (size_t)(b * 256 + key) * INW + hd * 128 + 8 * c16;
        *(LAS v4u*)(F.lds + ATT_K_OFF + key * KP + 16 * c16) = *(const v4u*)(src + 3072); *(LAS v4u*)(F.lds + ATT_V_OFF + key * VP + 16 * c16) = *(const v4u*)(src + 4096); }
    AttnW W; attn_init(W); bf16x8 qf[8];
    const int r = F.lane & 31, h = F.lane >> 5;
    const int mq = b * 256 + 32 * F.wave + r;
    { const bf16* qp = Z + (size_t)mq * INW + 2048 + hd * 128 + 8 * h;
#pragma unroll
      for (int ks = 0; ks < 8; ++ks) qf[ks] = __builtin_bit_cast(bf16x8, *(const v4u*)(qp + 16 * ks)); }
    __syncthreads();
#pragma unroll 1
    for (int kt = 0; kt < 8; ++kt) attn_tile<0, false>(W, qf, nullptr, Kl, Vl, 32 * kt, F.lane, nullptr, 0, 0);
    const float inv = 1.0f / W.l;
    bf16* yrow = Y + (size_t)mq * YW + 1024 + hd * 128;
#pragma unroll
    for (int dt = 0; dt < 4; ++dt) attn_store_dt(W.O[dt], inv, yrow, dt, h);
    __syncthreads();
}
constexpr int LQ_OFF = 0, LK_OFF = 64 * KP, LV_OFF = LK_OFF + 128 * KP, LRPB_OFF = LV_OFF + 128 * VP;
__device__ __forceinline__ void unitAttnLat(const Args& a, const Ctx& F, int l, int unit) {
    const int gr = unit & 15, hd = (unit >> 4) & 7, b = unit >> 7;
    const bf16* Z = (const bf16*)(a.ws + WS_Z); bf16* Y = (bf16*)(a.ws + WS_Y);
    const float* ROPE = (const float*)(a.ws + WS_ROPE);
    const LAS unsigned char* Kl = F.lds + LK_OFF; const LAS unsigned char* Vl = F.lds + LV_OFF; LAS float* rp = (LAS float*)(F.lds + LRPB_OFF);
    const int r = F.lane & 31, h = F.lane >> 5, qh = F.wave & 1, kt = F.wave >> 1;
    const int qc = 32 * qh + r;
    const int r_start = min(max(gr - 4, 0), 8);
    const int mq = NCTX + b * 1024 + gr * 64 + qc;
    __syncthreads();
    for (int i = F.tid; i < 15 * 31; i += NTHR) rp[i] = a.rpb[(size_t)(l * 8 + hd) * 465 + i];
    {
        const int qq = F.tid >> 3, half = (F.tid >> 2) & 1, sp = F.tid & 3, pos = half ? qq : gr;
        const bf16* src = Z + (size_t)(NCTX + b * 1024 + gr * 64 + qq) * INW + 2048 + hd * 128 + 64 * half + 8 * sp;
        const float* rt = ROPE + 2 * (pos * 32 + 8 * sp);
        float x[8], y[8], lo[8], hi[8]; unpack8(*(const v4u*)src, x); unpack8(*(const v4u*)(src + 32), y);
#pragma unroll
        for (int j4 = 0; j4 < 4; ++j4) { const f32x4 cssn = *(const f32x4*)(rt + 4 * j4);
            lo[2 * j4] = x[2 * j4] * cssn.x - y[2 * j4] * cssn.y; hi[2 * j4] = y[2 * j4] * cssn.x + x[2 * j4] * cssn.y;
            lo[2 * j4 + 1] = x[2 * j4 + 1] * cssn.z - y[2 * j4 + 1] * cssn.w; hi[2 * j4 + 1] = y[2 * j4 + 1] * cssn.z + x[2 * j4 + 1] * cssn.w; }
        LAS unsigned char* d = F.lds + LQ_OFF + qq * KP + 2 * (64 * half + 8 * sp);
        *(LAS v4u*)d = pack8(lo); *(LAS v4u*)(d + 64) = pack8(hi);
    }
    AttnW W; attn_init(W);
    const LAS unsigned char* Ql = F.lds + LQ_OFF + qc * KP + 16 * h;
    const bf16x8 qdummy[8] = {};
#pragma unroll 1
    for (int chn = 0; chn < 8; ++chn) {
        __syncthreads();
        if (chn < 4) {
#pragma unroll 1
            for (int job = F.tid; job < 1024; job += NTHR) {
                const int key = job >> 3, half = (job >> 2) & 1, sp = job & 3;
                const int kr = r_start + 2 * chn + (key >> 6), kc = key & 63, pos = half ? kc : kr;
                const bf16* src = Z + (size_t)(NCTX + b * 1024 + kr * 64 + kc) * INW + 3072 + hd * 128 + 64 * half + 8 * sp;
                const float* rt = ROPE + 2 * (pos * 32 + 8 * sp);
                float x[8], y[8], lo[8], hi[8]; unpack8(*(const v4u*)src, x); unpack8(*(const v4u*)(src + 32), y);
#pragma unroll
                for (int j4 = 0; j4 < 4; ++j4) { const f32x4 cssn = *(const f32x4*)(rt + 4 * j4);
                    lo[2 * j4] = x[2 * j4] * cssn.x - y[2 * j4] * cssn.y; hi[2 * j4] = y[2 * j4] * cssn.x + x[2 * j4] * cssn.y;
                    lo[2 * j4 + 1] = x[2 * j4 + 1] * cssn.z - y[2 * j4 + 1] * cssn.w; hi[2 * j4 + 1] = y[2 * j4 + 1] * cssn.z + x[2 * j4 + 1] * cssn.w; }
                LAS unsigned char* d = F.lds + LK_OFF + key * KP + 2 * (64 * half + 8 * sp);
                *(LAS v4u*)d = pack8(lo); *(LAS v4u*)(d + 64) = pack8(hi);
            }
#pragma unroll 2
            for (int p = F.tid; p < 2048; p += NTHR) { const int key = p >> 4, c16 = p & 15; const int kr = r_start + 2 * chn + (key >> 6), kc = key & 63;
                *(LAS v4u*)(F.lds + LV_OFF + key * VP + 16 * c16) = *(const v4u*)(Z + (size_t)(NCTX + b * 1024 + kr * 64 + kc) * INW + 4096 + hd * 128 + 8 * c16); }
        } else {
#pragma unroll 2
            for (int p = F.tid; p < 2048; p += NTHR) { const int key = p >> 4, c16 = p & 15;
                const size_t off = ((size_t)(b * 4 + l) * 512 + 128 * (chn - 4) + key) * 1024 + hd * 128 + 8 * c16;
                const f32x4 k0 = *(const f32x4*)(a.cache_k + off), k1 = *(const f32x4*)(a.cache_k + off + 4), v0 = *(const f32x4*)(a.cache_v + off), v1 = *(const f32x4*)(a.cache_v + off + 4);
                v4u kw, vw; kw.x = cvtpk(k0.x, k0.y); kw.y = cvtpk(k0.z, k0.w); kw.z = cvtpk(k1.x, k1.y); kw.w = cvtpk(k1.z, k1.w);
                vw.x = cvtpk(v0.x, v0.y); vw.y = cvtpk(v0.z, v0.w); vw.z = cvtpk(v1.x, v1.y); vw.w = cvtpk(v1.z, v1.w);
                *(LAS v4u*)(F.lds + LK_OFF + key * KP + 16 * c16) = kw; *(LAS v4u*)(F.lds + LV_OFF + key * VP + 16 * c16) = vw; }
        }
        __syncthreads();
        if (chn < 4) {
            const int kr = r_start + 2 * chn + (kt >> 1), dr = kr - gr + 7;
            attn_tile<1, true>(W, qdummy, Ql, Kl, Vl, 32 * kt, F.lane, rp + dr * 31, 32 * (kt & 1), qc);
        } else {
            attn_tile<0, true>(W, qdummy, Ql, Kl, Vl, 32 * kt, F.lane, nullptr, 0, 0);
        }
    }
    __syncthreads();
    LAS float* ML = (LAS float*)F.lds; LAS float* OB = (LAS float*)(F.lds + 4096);
    ML[(F.wave * 2 + 0) * 64 + F.lane] = W.m; ML[(F.wave * 2 + 1) * 64 + F.lane] = W.l;
#pragma unroll
    for (int dt = 0; dt < 4; ++dt)
#pragma unroll
        for (int i = 0; i < 16; ++i) OB[(F.wave * 64 + dt * 16 + i) * 64 + F.lane] = W.O[dt][i];
    __syncthreads();
    {
        float mi[4], li[4], mt = -1.0e30f;
#pragma unroll
        for (int k = 0; k < 4; ++k) { const int w2 = 2 * k + qh; mi[k] = ML[(w2 * 2 + 0) * 64 + F.lane]; li[k] = ML[(w2 * 2 + 1) * 64 + F.lane]; mt = fmaxf(mt, mi[k]); }
        float wk[4], lt = 0.f;
#pragma unroll
        for (int k = 0; k < 4; ++k) { wk[k] = __expf(mi[k] - mt); lt += wk[k] * li[k]; }
        const float inv = 1.0f / lt;
#pragma unroll
        for (int k = 0; k < 4; ++k) wk[k] *= inv;
        bf16* yrow = Y + (size_t)mq * YW + 1024 + hd * 128 + 32 * kt + 4 * h;
#pragma unroll
        for (int g4 = 0; g4 < 4; ++g4) {
            float o[4];
#pragma unroll
            for (int i = 0; i < 4; ++i) { float sacc = 0.f;
#pragma unroll
                for (int k = 0; k < 4; ++k) sacc += wk[k] * OB[((2 * k + qh) * 64 + kt * 16 + 4 * g4 + i) * 64 + F.lane];
                o[i] = sacc; }
            v2u w; w.x = cvtpk(o[0], o[1]); w.y = cvtpk(o[2], o[3]);
            *(v2u*)(yrow + 8 * g4) = w;
            asm volatile("" ::: "memory");
        }
    }
    __syncthreads();
}

constexpr int AW_OFF = 0, AV_OFF = 128 * KP, AST_OFF = AV_OFF + 128 * VP;
__device__ __forceinline__ void unitA(const Args& a, const Ctx& F, int l, int unit) {
    const int ch = unit >> 3, g = unit & 7, m0 = ch * 128;
    const bf16* Z = (const bf16*)(a.ws + WS_Z); bf16* Y = (bf16*)(a.ws + WS_Y);
    LAS float* st = (LAS float*)(F.lds + AST_OFF);
    __syncthreads();
#pragma unroll 4
    for (int i = 0; i < 16; ++i) {
        const int s = 16 * F.wave + i;
        const bf16* rp = Z + (size_t)(m0 + s) * INW + 1024 + 16 * F.lane;
        float x0[8], x1[8]; unpack8(*(const v4u*)rp, x0); unpack8(*(const v4u*)(rp + 8), x1);
        float sm = 0.f, sq = 0.f;
#pragma unroll
        for (int j = 0; j < 8; ++j) { sm += x0[j] + x1[j]; sq += x0[j] * x0[j] + x1[j] * x1[j]; }
        sm = wave_sum(sm); sq = wave_sum(sq);
        const float mean = sm * (1.0f / 1024.0f), var = fmaxf(sq * (1.0f / 1024.0f) - mean * mean, 0.f);
        if (F.lane == 0) { st[s] = mean; st[128 + s] = 1.0f / sqrtf(var + EPS); }
    }
    {
        const int t = F.tid >> 2, s0 = 32 * (F.tid & 3);
        const float* wp = a.a_w + ((size_t)(l * 8 + g) * 128 + t) * 128 + s0;
#pragma unroll
        for (int q = 0; q < 4; ++q) { const f32x4 w0 = *(const f32x4*)(wp + 8 * q), w1 = *(const f32x4*)(wp + 8 * q + 4);
            v4u o; o.x = cvtpk(w0.x, w0.y); o.y = cvtpk(w0.z, w0.w); o.z = cvtpk(w1.x, w1.y); o.w = cvtpk(w1.z, w1.w);
            *(LAS v4u*)(F.lds + AW_OFF + t * KP + 2 * (s0 + 8 * q)) = o; }
    }
    __syncthreads();
    {
        const int s = F.tid >> 2, c0 = 32 * (F.tid & 3);
        const float mean = st[s], rstd = st[128 + s];
        const bf16* rp = Z + (size_t)(m0 + s) * INW + 1024 + 128 * g + c0;
#pragma unroll
        for (int q = 0; q < 4; ++q) { float x[8]; unpack8(*(const v4u*)(rp + 8 * q), x);
#pragma unroll
            for (int j = 0; j < 8; ++j) x[j] = (x[j] - mean) * rstd;
            *(LAS v4u*)(F.lds + AV_OFF + s * VP + 2 * (c0 + 8 * q)) = pack8(x); }
    }
    __syncthreads();
    const int lane = F.lane, r = lane & 31, h = lane >> 5, gq = (lane >> 4) & 1, q4 = (lane & 15) >> 2, p4 = lane & 3;
    const int ttile = F.wave & 3, ct0 = 2 * (F.wave >> 2);
    f32x16 acc[2];
#pragma unroll
    for (int c2 = 0; c2 < 2; ++c2)
#pragma unroll
        for (int i = 0; i < 16; ++i) acc[c2][i] = 0.f;
    {
        const LAS unsigned char* wp = F.lds + AW_OFF + (32 * ttile + r) * KP + 16 * h;
        const LAS unsigned char* vp = F.lds + AV_OFF + (8 * h + q4) * VP + 2 * (32 * ct0 + 16 * gq) + 8 * p4;
#pragma unroll
        for (int ks = 0; ks < 8; ++ks) {
            const bf16x8 wb = *(const LAS bf16x8*)(wp + 32 * ks);
#pragma unroll
            for (int c2 = 0; c2 < 2; ++c2) {
                const LAS unsigned char* v0 = vp + 16 * ks * VP + 64 * c2;
                acc[c2] = MFMA32(tr_pair(v0, v0 + 4 * VP), wb, acc[c2]);
            }
        }
    }
    {
        const int t = 32 * ttile + r; const float bsv = a.a_b[(l * 8 + g) * 128 + t];
        const bf16* up = Z + (size_t)(m0 + t) * INW + 128 * g + 4 * h; bf16* yp = Y + (size_t)(m0 + t) * YW + 128 * g + 4 * h;
#pragma unroll
        for (int c2 = 0; c2 < 2; ++c2)
#pragma unroll
            for (int g4 = 0; g4 < 4; ++g4) {
                const int c = 32 * (ct0 + c2) + 8 * g4;
                const v2u uw = *(const v2u*)(up + c);
                v2u o; o.x = cvtpk(bf2f_lo(uw.x) * (acc[c2][4 * g4] + bsv), bf2f_hi(uw.x) * (acc[c2][4 * g4 + 1] + bsv));
                o.y = cvtpk(bf2f_lo(uw.y) * (acc[c2][4 * g4 + 2] + bsv), bf2f_hi(uw.y) * (acc[c2][4 * g4 + 3] + bsv));
                *(v2u*)(yp + c) = o;
            }
    }
    __syncthreads();
}

constexpr int HG_QD = 0, HG_KD = 32 * KP, HG_KL = 2 * 32 * KP, HG_V = HG_KL + 32 * VP, HG_TOT = HG_V + 32 * VP, HG_G = HG_TOT + 2048, HG_DIR = HG_G + 512;
__device__ __forceinline__ void unitHgrn(const Args& a, const Ctx& F, int l, bool lat, int b, int hd) {
    const bf16* Z = (const bf16*)(a.ws + WS_Z); const float* LOGF = (const float*)(a.ws + WS_LOGF); bf16* Y = (bf16*)(a.ws + WS_Y);
    const int dir = F.wave >> 2, w4 = F.wave & 3, tl = F.tid & 255, lane = F.lane, r = lane & 31, h = lane >> 5;
    float* Og = (float*)(a.ws + (dir ? WS_OB : WS_OF));
    LAS unsigned char* base = F.lds + dir * HG_DIR;
    const int n = lat ? 1024 : 256, mbase = lat ? NCTX + b * 1024 : b * 256, nch = n >> 5;
    const int tt = tl >> 3, dc = tl & 7;
    const int ttw = lane >> 3;
    f32x16 S[4];
    if (lat) {
        const float* sp = a.state + ((((size_t)b * 4 + l) * 2 + dir) * 8 + hd) * 16384 + 32 * w4 + r;
#pragma unroll
        for (int dt = 0; dt < 4; ++dt)
#pragma unroll
            for (int i = 0; i < 16; ++i) S[dt][i] = sp[(size_t)(32 * dt + (i & 3) + 8 * (i >> 2) + 4 * h) * 128];
    } else {
#pragma unroll
        for (int dt = 0; dt < 4; ++dt)
#pragma unroll
            for (int i = 0; i < 16; ++i) S[dt][i] = 0.f;
    }
    v4u pq[2], pv[2]; f32x4 pf[4];
    {   const size_t m = (size_t)(mbase + (dir ? (n - 1 - tt) : tt));
        const bf16* zr = Z + m * INW + hd * 128 + 16 * dc; const float* fr = LOGF + m * 2048 + dir * 1024 + hd * 128 + 16 * dc;
        pq[0] = *(const v4u*)(zr + 5120); pq[1] = *(const v4u*)(zr + 5128); pv[0] = *(const v4u*)(zr + 8192); pv[1] = *(const v4u*)(zr + 8200);
#pragma unroll
        for (int j = 0; j < 4; ++j) pf[j] = *(const f32x4*)(fr + 4 * j); }
    __syncthreads();
#pragma unroll 1
    for (int c = 0; c < nch; ++c) {
        float bl[16], q[16];
        { float t0[8], t1[8]; unpack8(pq[0], t0); unpack8(pq[1], t1);
#pragma unroll
          for (int j = 0; j < 8; ++j) { q[j] = t0[j]; q[8 + j] = t1[j]; } }
#pragma unroll
        for (int j = 0; j < 16; ++j) bl[j] = pf[j >> 2][j & 3];
        const v4u vraw0 = pv[0], vraw1 = pv[1];
        float lf[16];
#pragma unroll
        for (int j = 0; j < 16; ++j) lf[j] = bl[j];
#pragma unroll
        for (int sh = 8; sh < 64; sh <<= 1) {
#pragma unroll
            for (int j = 0; j < 16; ++j) { const float o = __shfl_up(bl[j], sh); bl[j] += (lane >= sh) ? o : 0.f; }
        }
        LAS float* TOT = (LAS float*)(base + HG_TOT);
        if (ttw == 7) {
#pragma unroll
            for (int j4 = 0; j4 < 4; ++j4) *(LAS f32x4*)(TOT + w4 * 128 + 16 * dc + 4 * j4) = (f32x4){bl[4 * j4], bl[4 * j4 + 1], bl[4 * j4 + 2], bl[4 * j4 + 3]};
        }
        __syncthreads();
        float bC[16];
#pragma unroll
        for (int j = 0; j < 16; ++j) bC[j] = 0.f;
#pragma unroll
        for (int w = 0; w < 4; ++w) {
#pragma unroll
            for (int j4 = 0; j4 < 4; ++j4) { const f32x4 tv = *(const LAS f32x4*)(TOT + w * 128 + 16 * dc + 4 * j4);
#pragma unroll
                for (int jj = 0; jj < 4; ++jj) { bC[4 * j4 + jj] += tv[jj]; if (w < w4) bl[4 * j4 + jj] += tv[jj]; } }
        }
        {
            float qd[16], kd[16], kl[16];
#pragma unroll
            for (int j = 0; j < 16; ++j) { const float k = 1.0f - __expf(lf[j]); qd[j] = q[j] * __expf(bl[j]); kd[j] = k * __expf(fminf(-bl[j], 80.0f)); kl[j] = k * __expf(bC[j] - bl[j]); }
            float t0[8], t1[8];
#pragma unroll
            for (int j = 0; j < 8; ++j) { t0[j] = qd[j]; t1[j] = qd[8 + j]; }
            *(LAS v4u*)(base + HG_QD + tt * KP + 32 * dc) = pack8(t0); *(LAS v4u*)(base + HG_QD + tt * KP + 32 * dc + 16) = pack8(t1);
#pragma unroll
            for (int j = 0; j < 8; ++j) { t0[j] = kd[j]; t1[j] = kd[8 + j]; }
            *(LAS v4u*)(base + HG_KD + tt * KP + 32 * dc) = pack8(t0); *(LAS v4u*)(base + HG_KD + tt * KP + 32 * dc + 16) = pack8(t1);
#pragma unroll
            for (int j = 0; j < 8; ++j) { t0[j] = kl[j]; t1[j] = kl[8 + j]; }
            *(LAS v4u*)(base + HG_KL + tt * VP + 32 * dc) = pack8(t0); *(LAS v4u*)(base + HG_KL + tt * VP + 32 * dc + 16) = pack8(t1);
            *(LAS v4u*)(base + HG_V + tt * VP + 32 * dc) = vraw0; *(LAS v4u*)(base + HG_V + tt * VP + 32 * dc + 16) = vraw1;
            if (tt == 31) {
#pragma unroll
                for (int j4 = 0; j4 < 4; ++j4) *(LAS f32x4*)(base + HG_G + 4 * (16 * dc + 4 * j4)) = (f32x4){__expf(bC[4 * j4]), __expf(bC[4 * j4 + 1]), __expf(bC[4 * j4 + 2]), __expf(bC[4 * j4 + 3])};
            }
        }
        if (c + 1 < nch) {
            const int p = 32 * (c + 1) + tt; const size_t m = (size_t)(mbase + (dir ? (n - 1 - p) : p));
            const bf16* zr = Z + m * INW + hd * 128 + 16 * dc; const float* fr = LOGF + m * 2048 + dir * 1024 + hd * 128 + 16 * dc;
            pq[0] = *(const v4u*)(zr + 5120); pq[1] = *(const v4u*)(zr + 5128); pv[0] = *(const v4u*)(zr + 8192); pv[1] = *(const v4u*)(zr + 8200);
#pragma unroll
            for (int j = 0; j < 4; ++j) pf[j] = *(const f32x4*)(fr + 4 * j);
        }
        __syncthreads();
        const int g = (lane >> 4) & 1, q4 = (lane & 15) >> 2, p4 = lane & 3;
        f32x16 X;
#pragma unroll
        for (int i = 0; i < 16; ++i) X[i] = 0.f;
        {   const LAS unsigned char* kp = base + HG_KD + r * KP + 16 * h; const LAS unsigned char* qp = base + HG_QD + r * KP + 16 * h;
#pragma unroll
            for (int ks = 0; ks < 8; ++ks) X = MFMA32(*(const LAS bf16x8*)(kp + 32 * ks), *(const LAS bf16x8*)(qp + 32 * ks), X); }
#pragma unroll
        for (int i = 0; i < 16; ++i) { const int srow = (i & 3) + 8 * (i >> 2) + 4 * h; X[i] = (srow <= r) ? X[i] : 0.f; }
        f32x16 O;
#pragma unroll
        for (int i = 0; i < 16; ++i) O[i] = 0.f;
        {
            const LAS unsigned char* vp = base + HG_V + (4 * h + q4) * VP + 2 * (32 * w4 + 16 * g) + 8 * p4;
            O = MFMA32(pack_regs(X, 0), tr_pair(vp, vp + 8 * VP), O);
            O = MFMA32(pack_regs(X, 1), tr_pair(vp + 16 * VP, vp + 24 * VP), O);
        }
        {
            const LAS unsigned char* qp = base + HG_QD + r * KP + 8 * h;
#pragma unroll
            for (int dt = 0; dt < 4; ++dt)
#pragma unroll
                for (int st = 0; st < 2; ++st) {
                    const s16x4 lo = *(const LAS s16x4*)(qp + 2 * (32 * dt + 16 * st)), hi = *(const LAS s16x4*)(qp + 2 * (32 * dt + 16 * st + 8));
                    O = MFMA32(__builtin_shufflevector(lo, hi, 0, 1, 2, 3, 4, 5, 6, 7), pack_regs(S[dt], st), O);
                }
        }
        {
            const LAS float* G = (const LAS float*)(base + HG_G);
            const LAS unsigned char* vp = base + HG_V + (8 * h + q4) * VP + 2 * (32 * w4 + 16 * g) + 8 * p4;
            const bf16x8 vb0 = tr_pair(vp, vp + 4 * VP), vb1 = tr_pair(vp + 16 * VP, vp + 20 * VP);
#pragma unroll
            for (int dt = 0; dt < 4; ++dt) {
#pragma unroll
                for (int g4 = 0; g4 < 4; ++g4) { const f32x4 gv = *(const LAS f32x4*)(G + 32 * dt + 8 * g4 + 4 * h);
#pragma unroll
                    for (int jj = 0; jj < 4; ++jj) S[dt][4 * g4 + jj] *= gv[jj]; }
                const LAS unsigned char* kp = base + HG_KL + (8 * h + q4) * VP + 2 * (32 * dt + 16 * g) + 8 * p4;
                S[dt] = MFMA32(tr_pair(kp, kp + 4 * VP), vb0, S[dt]);
                S[dt] = MFMA32(tr_pair(kp + 16 * VP, kp + 20 * VP), vb1, S[dt]);
            }
        }
        {
#pragma unroll
            for (int i = 0; i < 16; ++i) { const int t = 32 * c + (i & 3) + 8 * (i >> 2) + 4 * h; const int pos = dir ? (n - 1 - t) : t;
                Og[(size_t)(mbase + pos) * 1024 + hd * 128 + 32 * w4 + r] = O[i]; }
        }
        __syncthreads();
    }
    if (!lat) {
        float* so = a.out + OUT_S + ((((size_t)b * 4 + l) * 2 + dir) * 8 + hd) * 16384 + 32 * w4 + r;
#pragma unroll
        for (int dt = 0; dt < 4; ++dt)
#pragma unroll
            for (int i = 0; i < 16; ++i) so[(size_t)(32 * dt + (i & 3) + 8 * (i >> 2) + 4 * h) * 128] = S[dt][i];
    }
    __syncthreads();
    {
        const float* OFp = (const float*)(a.ws + WS_OF); const float* OBp = (const float*)(a.ws + WS_OB);
        const int e16 = 16 * (F.tid & 7);
        for (int t0 = 0; t0 < n; t0 += 64) {
            const size_t m = (size_t)(mbase + t0 + (F.tid >> 3));
            float o[16]; float ss = 0.f;
#pragma unroll
            for (int j = 0; j < 4; ++j) { const f32x4 p = *((const f32x4*)(OFp + m * 1024 + hd * 128 + e16) + j), qv = *((const f32x4*)(OBp + m * 1024 + hd * 128 + e16) + j);
                const f32x4 sv = p + qv; o[4 * j] = sv.x; o[4 * j + 1] = sv.y; o[4 * j + 2] = sv.z; o[4 * j + 3] = sv.w; ss += (sv.x * sv.x + sv.y * sv.y) + (sv.z * sv.z + sv.w * sv.w); }
            ss += __shfl_xor(ss, 1); ss += __shfl_xor(ss, 2); ss += __shfl_xor(ss, 4);
            const float rn = 1.0f / sqrtf(ss * (1.0f / 128.0f) + EPS);
            float g0[8], g1[8];
            unpack8(*(const v4u*)(Z + m * INW + 9216 + hd * 128 + e16), g0); unpack8(*(const v4u*)(Z + m * INW + 9216 + hd * 128 + e16 + 8), g1);
            float y0[8], y1[8];
#pragma unroll
            for (int j = 0; j < 8; ++j) { y0[j] = o[j] * rn * g0[j]; y1[j] = o[8 + j] * rn * g1[j]; }
            *(v4u*)(Y + m * YW + 2048 + hd * 128 + e16) = pack8(y0); *(v4u*)(Y + m * YW + 2048 + hd * 128 + e16 + 8) = pack8(y1);
        }
    }
    __syncthreads();
}

__device__ __forceinline__ const Args* args_ptr() { unsigned long long p = (unsigned long long)__builtin_amdgcn_kernarg_segment_ptr(); asm volatile("" : "+s"(p)); return (const Args*)(const void __attribute__((address_space(4)))*)p; }
__device__ __forceinline__ Ctx make_ctx() {
    Ctx F; int t = threadIdx.x; asm volatile("" : "+v"(t));
    unsigned z = 0; asm volatile("" : "+s"(z));
    F.lds = (LAS unsigned char*)(uintptr_t)z;
    F.tid = t; F.lane = t & 63; F.wave = __builtin_amdgcn_readfirstlane(t >> 6);
    F.G = gridDim.x; { const int bx = blockIdx.x; F.vcu = (F.G % 8 == 0) ? (bx % 8) * (F.G / 8) + bx / 8 : bx; }
    return F;
}
constexpr int NU_HL = 16, NU_AL = 256, NU_HC = 256, NU_AC = 256, NU_A = 640, NU_M1 = NU_HL + NU_AL + NU_HC + NU_AC + NU_A;
#ifndef PROBE_UT
#define PROBE_UT (-1)
#endif
__device__ __forceinline__ void phase_mixers(int l, int qslot) {
    for (;;) {
        int u;
        {   const Args& a = *args_ptr(); const Ctx F = make_ctx();
            unsigned* head = (unsigned*)(a.ws + WS_CTL) + CW_Q + 64 * qslot;
            volatile LAS unsigned* bc = (volatile LAS unsigned*)(F.lds + LDSCTL_OFF) + 4;
            __syncthreads();
            if (F.tid == 0) bc[0] = __hip_atomic_fetch_add(head, 1u, __ATOMIC_RELAXED, __HIP_MEMORY_SCOPE_AGENT);
            __syncthreads();
            u = (int)bc[0]; }
        u = __builtin_amdgcn_readfirstlane(u);
        if (u >= NU_M1) break;
        if (u < NU_HL) { for (int rr = 0; rr < (PROBE_UT == 0 ? 2 : 1); ++rr) { const Args& a = *args_ptr(); const Ctx F = make_ctx(); unitHgrn(a, F, l, true, u >> 3, u & 7); } continue; }
        u -= NU_HL;
        if (u < NU_AL) { for (int rr = 0; rr < (PROBE_UT == 1 ? 2 : 1); ++rr) { const Args& a = *args_ptr(); const Ctx F = make_ctx(); unitAttnLat(a, F, l, u); } continue; }
        u -= NU_AL;
        if (u < NU_HC) { for (int rr = 0; rr < (PROBE_UT == 2 ? 2 : 1); ++rr) { const Args& a = *args_ptr(); const Ctx F = make_ctx(); unitHgrn(a, F, l, false, u >> 3, u & 7); } continue; }
        u -= NU_HC;
        if (u < NU_AC) { for (int rr = 0; rr < (PROBE_UT == 3 ? 2 : 1); ++rr) { const Args& a = *args_ptr(); const Ctx F = make_ctx(); unitAttnCtx(a, F, u); } continue; }
        u -= NU_AC;
        for (int rr = 0; rr < (PROBE_UT == 4 ? 2 : 1); ++rr) { const Args& a = *args_ptr(); const Ctx F = make_ctx(); unitA(a, F, l, u); }
    }
}

__global__ void __launch_bounds__(NTHR, 2) fwd(Args a_in) {
    extern __shared__ __attribute__((aligned(16))) unsigned char lds_raw[];
    volatile LAS unsigned* MISC = (volatile LAS unsigned*)((LAS unsigned char*)lds_raw + LDSCTL_OFF);
    for (int u = threadIdx.x; u < 256; u += NTHR) MISC[u] = 0u;
    __syncthreads();
    const int lo = a_in.ph_lo, hi = a_in.ph_hi;
    const bool multi = (hi - lo) > 1;
    XcdBarrier bar; bar.bar = (unsigned*)(a_in.ws + WS_CTL) + CW_BAR; bar.x = 0; bar.st = MISC;
    if (multi) bar = xcd_barrier_post((unsigned*)(a_in.ws + WS_CTL) + CW_BAR, MISC);
#ifndef PMASK
#define PMASK 0xFFFFFFFFu
#endif
#define PM(b) ((PMASK >> (b)) & 1u)
#define IN(k) (lo <= (k) && (k) < hi)
#define SEAM(k) do { if (IN(k) && IN((k) + 1)) xcd_barrier(bar); } while (0)
#ifndef PROBE_P
#define PROBE_P (-1)
#define PROBE_N 0
#define PROBE_L 1
#endif
#define REP_BEGIN(k) for (int rep = 0; rep < ((PROBE_P == (k) && l == PROBE_L) ? 1 + PROBE_N : 1); ++rep) {
#define REP_END(k) if (PROBE_P == (k) && l == PROBE_L && rep < PROBE_N) xcd_barrier(bar); }

    if (PM(0) && IN(PH_PRO)) { const int l = PROBE_L; REP_BEGIN(0) const Args& a = *args_ptr(); const Ctx F = make_ctx(); phase_prologue(a, F); REP_END(0) SEAM(PH_PRO); }
    if (PM(1) && IN(PH_T1)) { const int l = PROBE_L; REP_BEGIN(1) const Args& a = *args_ptr(); const Ctx F = make_ctx(); const float* MOD = (const float*)(a.ws + WS_MOD);
        rownorm_phase(a, F, true, nullptr, nullptr, nullptr, true, a.norm_g + 0, MOD + 1 * 2048, MOD + 0 * 2048); REP_END(1) SEAM(PH_T1); }

    for (int l = 0; l < DEPTH; ++l) {
        const int pb = PH_L0 + l * PH_PER_LAYER;
        if (PM(2) && IN(pb + 0)) { REP_BEGIN(2)
            const Args& a = *args_ptr(); const Ctx F = make_ctx(); unsigned char* ws = a.ws; const bf16* wl = (const bf16*)(ws + WS_WT) + (size_t)l * WL_ELEMS;
            pg8::Gemm g{(const bf16*)(ws + WS_H), wl + OFF_IN, MTOK, INW, DM, DM, DM, 0}; pg8::StaticOrder S; S.init(MTOK, INW, F.G, (int)blockIdx.x);
            EpiIn E{(bf16*)(ws + WS_Z), (float*)(ws + WS_LOGF), (const float*)(ws + WS_LB) + l * 1024, a.out + OUT_K + (size_t)l * 262144, a.out + OUT_V + (size_t)l * 262144};
            pg8::gemm_phase<EpiIn, pg8::StaticOrder, true, true>(F.lds, g, S, E);
            REP_END(2) SEAM(pb + 0);
        }
        if (PM(3) && IN(pb + 1)) { REP_BEGIN(3) phase_mixers(l, l + 4 * rep); REP_END(3) SEAM(pb + 1); }
        if (PM(5) && IN(pb + 3)) { REP_BEGIN(5)
            const Args& a = *args_ptr(); const Ctx F = make_ctx(); unsigned char* ws = a.ws; const bf16* wl = (const bf16*)(ws + WS_WT) + (size_t)l * WL_ELEMS;
            pg8::StaticOrder S; S.init(MTOK, DM, F.G, (int)blockIdx.x);
            pg8::Gemm g{(const bf16*)(ws + WS_Y), wl + OFF_UP, MTOK, DM, YW, YW, YW, 0}; EpiUpK E{(const bf16*)(ws + WS_Z) + 10240, (bf16*)(ws + WS_MG)};
            pg8::gemm_phase<EpiUpK, pg8::StaticOrder, true, true>(F.lds, g, S, E);
            REP_END(5) SEAM(pb + 3);
        }
        if (PM(6) && IN(pb + 4)) { REP_BEGIN(6)
            {   const Args& a = *args_ptr(); const Ctx F = make_ctx(); unsigned char* ws = a.ws; const bf16* wl = (const bf16*)(ws + WS_WT) + (size_t)l * WL_ELEMS;
                pg8::Gemm g{(const bf16*)(ws + WS_MG), wl + OFF_OUT, NCTX, DM, DM, DM, DM, 0}; pg8::StaticOrder S; S.init(NCTX, DM, F.G, (int)blockIdx.x);
                EpiF32P E{(float*)(ws + WS_T), DM, 0}; pg8::gemm_phase<EpiF32P, pg8::StaticOrder, true, true>(F.lds, g, S, E); }
            {   const Args& a = *args_ptr(); const Ctx F = make_ctx(); unsigned char* ws = a.ws; const bf16* wl = (const bf16*)(ws + WS_WT) + (size_t)l * WL_ELEMS;
                pg8::Gemm g{(const bf16*)(ws + WS_MG) + (size_t)NCTX * DM, wl + OFF_OUT, NLAT, DM, DM / 4, DM, DM, (DM / 4) * 2}; pg8::SplitOrder S; S.init(F.G, (int)blockIdx.x);
                EpiF32P E{(float*)(ws + WS_TP), DM, TPQ}; pg8::gemm_phase<EpiF32P, pg8::SplitOrder, true, true>(F.lds, g, S, E); }
            REP_END(6) SEAM(pb + 4);
        }
        if (PM(7) && IN(pb + 5)) { REP_BEGIN(7) const Args& a = *args_ptr(); const Ctx F = make_ctx(); const float* modl = (const float*)(a.ws + WS_MOD) + (size_t)l * 3 * 12288; const float* gl = a.norm_g + (size_t)l * 4 * DM;
            rownorm_phase(a, F, false, (const float*)(a.ws + WS_T), modl + 2 * 2048, gl + 1 * DM, true, gl + 2 * DM, modl + 4 * 2048, modl + 3 * 2048); REP_END(7) SEAM(pb + 5); }
        if (PM(8) && IN(pb + 6)) { REP_BEGIN(8)
            const Args& a = *args_ptr(); const Ctx F = make_ctx(); unsigned char* ws = a.ws; const bf16* wl = (const bf16*)(ws + WS_WT) + (size_t)l * WL_ELEMS;
            pg8::Gemm g{(const bf16*)(ws + WS_H), wl + OFF_FI, MTOK, NFI, DM, DM, DM, 0}; pg8::StaticOrder S; S.init(MTOK, NFI, F.G, (int)blockIdx.x);
            EpiSwi E{(bf16*)(ws + WS_ACT)}; pg8::gemm_phase<EpiSwi, pg8::StaticOrder, true, true>(F.lds, g, S, E);
            REP_END(8) SEAM(pb + 6);
        }
        if (PM(9) && IN(pb + 7)) { REP_BEGIN(9)
            {   const Args& a = *args_ptr(); const Ctx F = make_ctx(); unsigned char* ws = a.ws; const bf16* wl = (const bf16*)(ws + WS_WT) + (size_t)l * WL_ELEMS;
                pg8::Gemm g{(const bf16*)(ws + WS_ACT), wl + OFF_FO, NCTX, DM, DFF, DFF, DFF, 0}; pg8::StaticOrder S; S.init(NCTX, DM, F.G, (int)blockIdx.x);
                EpiF32P E{(float*)(ws + WS_T), DM, 0}; pg8::gemm_phase<EpiF32P, pg8::StaticOrder, true, true>(F.lds, g, S, E); }
            {   const Args& a = *args_ptr(); const Ctx F = make_ctx(); unsigned char* ws = a.ws; const bf16* wl = (const bf16*)(ws + WS_WT) + (size_t)l * WL_ELEMS;
                pg8::Gemm g{(const bf16*)(ws + WS_ACT) + (size_t)NCTX * DFF, wl + OFF_FO, NLAT, DM, DFF / 4, DFF, DFF, (DFF / 4) * 2}; pg8::SplitOrder S; S.init(F.G, (int)blockIdx.x);
                EpiF32P E{(float*)(ws + WS_TP), DM, TPQ}; pg8::gemm_phase<EpiF32P, pg8::SplitOrder, true, true>(F.lds, g, S, E); }
            REP_END(9) SEAM(pb + 7);
        }
        if (PM(10) && IN(pb + 8)) { REP_BEGIN(10)
            const Args& a = *args_ptr(); const Ctx F = make_ctx(); const float* MOD = (const float*)(a.ws + WS_MOD);
            const bool last = (l == DEPTH - 1); const int ln = last ? l : l + 1;
            const float* modl = MOD + (size_t)l * 3 * 12288; const float* gl = a.norm_g + (size_t)l * 4 * DM;
            const float* modn = MOD + (size_t)ln * 3 * 12288; const float* gnn = a.norm_g + (size_t)ln * 4 * DM;
            rownorm_phase(a, F, false, (const float*)(a.ws + WS_T), modl + 5 * 2048, gl + 3 * DM, !last, gnn + 0, modn + 1 * 2048, modn + 0 * 2048);
            REP_END(10) SEAM(pb + 8);
        }
    }
#undef IN
#undef SEAM
#undef REP_BEGIN
#undef REP_END
}

#ifndef MK_ONE_LAUNCH
#define MK_ONE_LAUNCH 1
#endif
extern "C" void kernel_launch(void* const* d_in, const int* in_sizes, int n_in, void* d_out, int out_size, void* d_ws, size_t ws_size, hipStream_t stream) {
    static int grid = 0;
    if (grid == 0) {
        if (n_in != 21 || (size_t)out_size != OUT_END || ws_size < WS_END) { fprintf(stderr, "kernel_launch: unexpected shapes: n_in %d out %d ws %zu\n", n_in, out_size, ws_size); grid = -1; return; }
        int dev = 0, cus = 0, per_cu = 0;
        if (hipGetDevice(&dev) != hipSuccess || hipDeviceGetAttribute(&cus, hipDeviceAttributeMultiprocessorCount, dev) != hipSuccess) { grid = -1; return; }
        if (hipFuncSetAttribute((const void*)fwd, hipFuncAttributeMaxDynamicSharedMemorySize, LDS_BYTES) != hipSuccess) { fprintf(stderr, "kernel_launch: hipFuncSetAttribute failed\n"); grid = -1; return; }
        if (hipOccupancyMaxActiveBlocksPerMultiprocessor(&per_cu, (const void*)fwd, NTHR, LDS_BYTES) != hipSuccess || per_cu < 1) fprintf(stderr, "kernel_launch: occupancy query says %d\n", per_cu);
        (void)hipGetLastError();
        grid = cus;
    }
    if (grid < 0) return;
    (void)hipMemsetAsync((char*)d_ws + WS_CTL, 0, CTL_ZERO_BYTES, stream);
    Args a{};
    const float** ap = (const float**)&a;
    for (int i = 0; i < 21; ++i) ap[i] = (const float*)d_in[i];
    a.out = (float*)d_out; a.ws = (unsigned char*)d_ws;
#if MK_ONE_LAUNCH
    a.ph_lo = 0; a.ph_hi = PH_END;
    hipLaunchKernelGGL(fwd, dim3(grid), dim3(NTHR), LDS_BYTES, stream, a);
#else
    for (int p = 0; p < PH_END; ++p) { a.ph_lo = p; a.ph_hi = p + 1; hipLaunchKernelGGL(fwd, dim3(grid), dim3(NTHR), LDS_BYTES, stream, a); }
#endif
}
```

```cpp
#include <hip/hip_runtime.h>
#include <cstdio>
#include <cstdint>
namespace pg8 {
#define PG8_LAS __attribute__((address_space(3)))
typedef unsigned short bf16_t;
typedef short bf16x8 __attribute__((ext_vector_type(8)));
typedef float f32x4 __attribute__((ext_vector_type(4)));
typedef unsigned u32x4 __attribute__((ext_vector_type(4)));
constexpr int BM = 256, BK = 64, HALF = 128, HTB = HALF * BK * 2  , STAGE_BYTES = 8 * HTB, NXCD = 8, WGM = 8;

__host__ __device__ __forceinline__ int lds_byte(int r, int c) { const int st = (r >> 4) * 2 + (c >> 5), rr = r & 15, cc = c & 31, ob = rr * 64 + cc * 2; return st * 1024 + (ob ^ (((ob >> 9) & 1) << 5)); }
__host__ __device__ __forceinline__ void stage_rc(int b, int& R, int& C) { const int st = b / 1024, sb = b % 1024, swz = sb ^ (((sb >> 9) & 1) << 5); R = (st >> 1) * 16 + swz / 64; C = (st & 1) * 32 + (swz % 64) / 2; }
__host__ __device__ __forceinline__ int perm32(int rho) { const int n = rho >> 4, i = rho & 15; return 8 * (i >> 2) + 4 * n + (i & 3); }

struct Unit { int pm, pn, kq; };
struct SplitOrder {
    int G, c;
    __host__ __device__ void init(int G_, int c_) { G = G_; c = c_; }
    __host__ __device__ bool next(int i, Unit& u) const { const long L = (long)i * G + c; if (L >= 256) return false; const int t = (int)L >> 2; u.kq = (int)L & 3; u.pm = t & 7; u.pn = t >> 3; return true; }
    __device__ __forceinline__ void a_ready(const Unit&) const {}
    __device__ __forceinline__ void done(const Unit&) const {}
};
struct Gemm { const bf16_t* A; const bf16_t* Bt; int M, N, K, lda, ldb, koff; };

struct StaticOrder {
    int nM, nN, nwg, G, c;
    __host__ __device__ void init(int M, int N, int G_, int c_) { nM = M / BM; nN = N / BM; nwg = nM * nN; G = G_; c = c_; }
    __host__ __device__ bool next(int i, Unit& u) const {
        const long L = (long)i * G + c; if (L >= nwg) return false;
        int wgid = (int)L; { const int q = nwg / NXCD, r = nwg % NXCD, xcd = wgid % NXCD, off = wgid / NXCD; wgid = (xcd < r ? xcd * (q + 1) : r * (q + 1) + (xcd - r) * q) + off; }
        const int nig = WGM * nN, gid = wgid / nig, fm = gid * WGM, gsz = (nM - fm) < WGM ? (nM - fm) : WGM;
        u.pm = fm + ((wgid % nig) % gsz); u.pn = (wgid % nig) / gsz; u.kq = 0; return true;
    }
    __device__ __forceinline__ void a_ready(const Unit&) const {}
    __device__ __forceinline__ void done(const Unit&) const {}
};
template <class Epi, class Sched, bool ALIGN_EPI = false, bool SP2 = false>
__device__ __forceinline__ void gemm_phase(PG8_LAS unsigned char* lds, const Gemm g, const Sched& S, const Epi& E) {
    int tid_ = threadIdx.x; asm volatile("" : "+v"(tid_));
    const int tid = tid_, wid = __builtin_amdgcn_readfirstlane(tid >> 6), lane = tid & 63, wr = wid >> 2, wc = wid & 3, fr = lane & 15, fq = lane >> 4;
    const int K = g.K, nt = K / BK;
    unsigned voffA[2], voffB[2];
#pragma unroll
    for (int i = 0; i < 2; ++i) { int R, C; stage_rc(tid * 16 + i * 8192, R, C); const int Rb = Epi::PERM ? ((R & ~31) + perm32(R & 31)) : R;
        voffA[i] = (unsigned)(R * g.lda + C) * 2u; voffB[i] = (unsigned)(Rb * g.ldb + C) * 2u; }
    const size_t kstep = (size_t)(BK * 2);
    const size_t hstepA = (size_t)HALF * g.lda * 2, hstepB = (size_t)HALF * g.ldb * 2;
    const size_t tstepA = 2 * hstepA, tstepB = 2 * hstepB;
    const unsigned ldsw = (unsigned)wid * 1024u;
    const int aoff = lds_byte(wr * 64 + fr, fq * 8), boff = lds_byte(wc * 32 + fr, fq * 8);
#define PG8_SA(b, h) (((b) * 2 + (h)) * HTB)
#define PG8_SB(b, h) ((4 + (b) * 2 + (h)) * HTB)
#define PG8_STAGE(bufoff, gbase, voff) do { _Pragma("unroll") for (int _i = 0; _i < 2; ++_i) \
        __builtin_amdgcn_global_load_lds((const unsigned*)((const char*)(gbase) + (voff)[_i]), (PG8_LAS unsigned*)(lds + (bufoff) + ldsw + _i * 8192), 16, 0, 0); } while (0)
#define PG8_LDA(dst, b, h) do { _Pragma("unroll") for (int m = 0; m < 4; ++m) _Pragma("unroll") for (int k = 0; k < 2; ++k) dst[m][k] = *(const PG8_LAS bf16x8*)(lds + PG8_SA(b, h) + aoff + m * 2048 + k * 1024); } while (0)
#define PG8_LDB(dst, b, h) do { _Pragma("unroll") for (int n = 0; n < 2; ++n) _Pragma("unroll") for (int k = 0; k < 2; ++k) dst[n][k] = *(const PG8_LAS bf16x8*)(lds + PG8_SB(b, h) + boff + n * 2048 + k * 1024); } while (0)
#define PG8_MMA(ai, bj, At, Bt) do { __builtin_amdgcn_s_setprio(1); _Pragma("unroll") for (int m = 0; m < 4; ++m) _Pragma("unroll") for (int n = 0; n < 2; ++n) _Pragma("unroll") for (int k = 0; k < 2; ++k) \
        acc[ai][bj][m][n] = __builtin_amdgcn_mfma_f32_16x16x32_bf16(Bt[n][k], At[m][k], acc[ai][bj][m][n], 0, 0, 0); __builtin_amdgcn_s_setprio(0); } while (0)
#define PG8_WAIT_V(n) asm volatile("s_waitcnt vmcnt(" #n ")" ::: "memory")
#define PG8_WAIT_L(n) asm volatile("s_waitcnt lgkmcnt(" #n ")" ::: "memory")
#define PG8_BAR __builtin_amdgcn_s_barrier()
#define PG8_SCHED __builtin_amdgcn_sched_barrier(0)
    Unit cur, nxt; int ui = 0;
    if (!S.next(0, cur)) return;
    f32x4 acc[2][2][4][2];
#pragma unroll
    for (int a = 0; a < 2; ++a)
#pragma unroll
        for (int b = 0; b < 2; ++b)
#pragma unroll
            for (int m = 0; m < 4; ++m)
#pragma unroll
                for (int n = 0; n < 2; ++n) acc[a][b][m][n] = (f32x4){0.f, 0.f, 0.f, 0.f};
    bf16x8 At[4][2], B0[2][2], B1[2][2];
    const char* cA = (const char*)g.A + (size_t)cur.pm * tstepA + (size_t)cur.kq * g.koff; const char* cB = (const char*)g.Bt + (size_t)cur.pn * tstepB + (size_t)cur.kq * g.koff;
    S.a_ready(cur);
    if constexpr (SP2) {
        PG8_STAGE(PG8_SB(0, 0), cB, voffB); PG8_STAGE(PG8_SB(0, 1), cB + hstepB, voffB); PG8_STAGE(PG8_SA(0, 0), cA, voffA); PG8_STAGE(PG8_SA(0, 1), cA + hstepA, voffA);
        if (wr == 1) PG8_BAR;
        PG8_WAIT_V(2); PG8_BAR;
        PG8_STAGE(PG8_SB(1, 0), cB + kstep, voffB); PG8_STAGE(PG8_SA(1, 0), cA + kstep, voffA); PG8_STAGE(PG8_SB(1, 1), cB + hstepB + kstep, voffB);
        PG8_WAIT_V(6); PG8_BAR;
    } else {
        PG8_STAGE(PG8_SB(0, 0), cB, voffB); PG8_STAGE(PG8_SA(0, 0), cA, voffA); PG8_STAGE(PG8_SB(0, 1), cB + hstepB, voffB); PG8_STAGE(PG8_SA(0, 1), cA + hstepA, voffA);
        if (wr == 1) PG8_BAR;
        PG8_WAIT_V(4); PG8_BAR;
        PG8_STAGE(PG8_SB(1, 0), cB + kstep, voffB); PG8_STAGE(PG8_SA(1, 0), cA + kstep, voffA); PG8_STAGE(PG8_SB(1, 1), cB + hstepB + kstep, voffB);
        PG8_WAIT_V(6); PG8_BAR;
    }
    for (;;) {
        const bool has_next = S.next(ui + 1, nxt);
        const char* nA = has_next ? (const char*)g.A + (size_t)nxt.pm * tstepA + (size_t)nxt.kq * g.koff : cA; const char* nB = has_next ? (const char*)g.Bt + (size_t)nxt.pn * tstepB + (size_t)nxt.kq * g.koff : cB;
        for (int t = 0; t < nt; t += 2) {
            const bool last = (t == nt - 2);
            const char* a1 = cA + (size_t)(t + 1) * kstep;
            const char* a2 = last ? nA : cA + (size_t)(t + 2) * kstep; const char* b2 = last ? nB : cB + (size_t)(t + 2) * kstep;
            const char* a3 = a2 + kstep; const char* b3 = b2 + kstep;
            if (last && has_next) S.a_ready(nxt);
            if constexpr (Epi::HOOK) { if (t == Epi::H1 || t == Epi::H2) E.hook(acc, cur, t, wr, wc, fr, fq); }
            if constexpr (SP2) {
            PG8_LDB(B0, 0, 0); PG8_LDB(B1, 0, 1); PG8_SCHED; PG8_LDA(At, 0, 0); PG8_STAGE(PG8_SA(1, 1), a1 + hstepA, voffA);
            PG8_WAIT_V(8); PG8_WAIT_L(0); PG8_BAR; PG8_MMA(0, 0, At, B0); PG8_MMA(0, 1, At, B1); PG8_BAR; PG8_SCHED;
            PG8_LDA(At, 0, 1); PG8_STAGE(PG8_SB(0, 0), b2, voffB); PG8_STAGE(PG8_SB(0, 1), b2 + hstepB, voffB); PG8_STAGE(PG8_SA(0, 0), a2, voffA);
            PG8_WAIT_V(8); PG8_WAIT_L(0); PG8_BAR; PG8_MMA(1, 0, At, B0); PG8_MMA(1, 1, At, B1); PG8_BAR; PG8_SCHED;
            PG8_LDB(B0, 1, 0); PG8_LDB(B1, 1, 1); PG8_SCHED; PG8_LDA(At, 1, 0); PG8_STAGE(PG8_SA(0, 1), a2 + hstepA, voffA);
            PG8_WAIT_V(8); PG8_WAIT_L(0); PG8_BAR; PG8_MMA(0, 0, At, B0); PG8_MMA(0, 1, At, B1); PG8_BAR; PG8_SCHED;
            PG8_LDA(At, 1, 1); PG8_STAGE(PG8_SB(1, 0), b3, voffB); PG8_STAGE(PG8_SB(1, 1), b3 + hstepB, voffB); PG8_STAGE(PG8_SA(1, 0), a3, voffA);
            PG8_WAIT_V(8); PG8_WAIT_L(0); PG8_BAR; PG8_MMA(1, 0, At, B0); PG8_MMA(1, 1, At, B1); PG8_BAR; PG8_SCHED;
            } else {
            PG8_LDB(B0, 0, 0); PG8_SCHED; PG8_LDA(At, 0, 0); PG8_STAGE(PG8_SA(1, 1), a1 + hstepA, voffA);
            PG8_WAIT_L(8); PG8_BAR; PG8_WAIT_L(0); PG8_MMA(0, 0, At, B0); PG8_BAR; PG8_SCHED;
            PG8_LDB(B1, 0, 1); PG8_STAGE(PG8_SB(0, 0), b2, voffB);
            PG8_BAR; PG8_WAIT_L(0); PG8_MMA(0, 1, At, B1); PG8_BAR;
            PG8_LDA(At, 0, 1); PG8_STAGE(PG8_SA(0, 0), a2, voffA);
            PG8_BAR; PG8_WAIT_L(0); PG8_MMA(1, 0, At, B0); PG8_BAR; PG8_SCHED;
            PG8_STAGE(PG8_SB(0, 1), b2 + hstepB, voffB);
            PG8_WAIT_V(6); PG8_BAR; PG8_MMA(1, 1, At, B1); PG8_BAR;
            PG8_LDB(B0, 1, 0); PG8_SCHED; PG8_LDA(At, 1, 0); PG8_STAGE(PG8_SA(0, 1), a2 + hstepA, voffA);
            PG8_WAIT_L(8); PG8_BAR; PG8_WAIT_L(0); PG8_MMA(0, 0, At, B0); PG8_BAR; PG8_SCHED;
            PG8_LDB(B1, 1, 1); PG8_STAGE(PG8_SB(1, 0), b3, voffB);
            PG8_BAR; PG8_WAIT_L(0); PG8_MMA(0, 1, At, B1); PG8_BAR;
            PG8_LDA(At, 1, 1); PG8_STAGE(PG8_SA(1, 0), a3, voffA);
            PG8_BAR; PG8_WAIT_L(0); PG8_MMA(1, 0, At, B0); PG8_BAR; PG8_SCHED;
            PG8_STAGE(PG8_SB(1, 1), b3 + hstepB, voffB);
            PG8_WAIT_V(6); PG8_BAR; PG8_MMA(1, 1, At, B1); PG8_BAR;
            }
        }
        if constexpr (ALIGN_EPI) { if (wr == 0) PG8_BAR; }
        if constexpr (!Epi::AFTER_DRAIN) { E(acc, cur, wr, wc, fr, fq); S.done(cur); }
        if (!has_next) break;
#pragma unroll
        for (int a = 0; a < 2; ++a)
#pragma unroll
            for (int b = 0; b < 2; ++b)
#pragma unroll
                for (int m = 0; m < 4; ++m)
#pragma unroll
                    for (int n = 0; n < 2; ++n) acc[a][b][m][n] = (f32x4){0.f, 0.f, 0.f, 0.f};
        cur = nxt; cA = nA; cB = nB; ++ui;
        if constexpr (ALIGN_EPI) { if (wr == 1) PG8_BAR; }
    }
    PG8_WAIT_V(0);
    if constexpr (!ALIGN_EPI) { if (wr == 0) PG8_BAR; }
    PG8_BAR;
    if constexpr (Epi::AFTER_DRAIN) { E.fused(acc, cur, wr, wc, fr, fq, lds, wid, lane); S.done(cur); }
#undef PG8_SA
#undef PG8_SB
#undef PG8_STAGE
#undef PG8_LDA
#undef PG8_LDB
#undef PG8_MMA
#undef PG8_WAIT_V
#undef PG8_WAIT_L
#undef PG8_BAR
#undef PG8_SCHED
}
}

#define GAS __attribute__((address_space(1)))
#define LAS __attribute__((address_space(3)))
typedef unsigned short bf16;
typedef unsigned v4u __attribute__((ext_vector_type(4)));
typedef unsigned v2u __attribute__((ext_vector_type(2)));
typedef float f32x4 __attribute__((ext_vector_type(4)));

constexpr int DM = 2048, NCTX = 8192, NLAT = 2048, MTOK = 10240, DEPTH = 4;
constexpr int INW = 16384, DFF = 5632, NFI = 11264, YW = 3072;
constexpr float EPS = 1e-6f;
constexpr int NWAVES = 8, NTHR = 512;

constexpr size_t MiB = 1u << 20;
constexpr size_t WS_CTL = 0, CTL_ZERO_BYTES = 1 * MiB;
constexpr size_t WS_MOD = 1 * MiB;
constexpr size_t WS_LB = 2 * MiB;
constexpr size_t WS_ROPE = 2 * MiB + 65536;
constexpr size_t WS_WT = 4 * MiB;
constexpr size_t WL_ELEMS = 78643200;
constexpr size_t OFF_IN = 0, OFF_UP = 33554432, OFF_OUT = 39845888, OFF_FI = 44040192, OFF_FO = 67108864;
constexpr size_t WS_Z = 604 * MiB;
constexpr size_t WS_LOGF = 924 * MiB;
constexpr size_t WS_H = 1004 * MiB;
constexpr size_t WS_Y = 1044 * MiB;
constexpr size_t WS_OF = 1104 * MiB;
constexpr size_t WS_OB = 1144 * MiB;
constexpr size_t WS_TP = 1184 * MiB;
constexpr size_t TPQ = 2048 * 2048;
constexpr size_t WS_MG = 1264 * MiB;
constexpr size_t WS_T = 1304 * MiB;
constexpr size_t WS_ACT = 1384 * MiB;
constexpr size_t WS_END = 1494 * MiB;
constexpr int CW_BAR = 4096;
constexpr int CW_Q = 16384;
constexpr size_t OUT_Y = 0, OUT_K = 20971520, OUT_V = OUT_K + 33554432, OUT_S = OUT_V + 33554432, OUT_END = OUT_S + 33554432;

constexpr int LDS_BYTES = 155648;
constexpr int LDSCTL_OFF = 154624;

constexpr int PH_PRO = 0, PH_T1 = 1, PH_L0 = 2, PH_PER_LAYER = 9, PH_END = PH_L0 + DEPTH * PH_PER_LAYER;

struct Args {
    const float *x_prompt, *x_sample, *cache_k, *cache_v, *state, *c, *c_ctx, *w_ada, *b_ada, *norm_g, *w_in, *a_w, *a_b, *rpb, *lb_logits, *w_up_a, *w_up_b, *w_up_c, *w_out, *w_fi, *w_fo;
    float* out; unsigned char* ws; int ph_lo, ph_hi;
};

__device__ __forceinline__ float bf2f_lo(unsigned w) { return __uint_as_float(w << 16); }
__device__ __forceinline__ float bf2f_hi(unsigned w) { return __uint_as_float(w & 0xffff0000u); }
__device__ __forceinline__ unsigned f2bf(float f) { unsigned u = __float_as_uint(f); return (u + 0x7fffu + ((u >> 16) & 1u)) >> 16; }
typedef __bf16 bf16x2_t __attribute__((ext_vector_type(2)));
typedef float f32x2_t __attribute__((ext_vector_type(2)));
__device__ __forceinline__ unsigned cvtpk(float lo, float hi) { const f32x2_t v = {lo, hi}; return __builtin_bit_cast(unsigned, __builtin_convertvector(v, bf16x2_t)); }
__device__ __forceinline__ unsigned pk2(float lo, float hi) { return cvtpk(lo, hi); }
__device__ __forceinline__ void unpack8(const v4u w, float (&f)[8]) {
    f[0] = bf2f_lo(w.x); f[1] = bf2f_hi(w.x); f[2] = bf2f_lo(w.y); f[3] = bf2f_hi(w.y); f[4] = bf2f_lo(w.z); f[5] = bf2f_hi(w.z); f[6] = bf2f_lo(w.w); f[7] = bf2f_hi(w.w); }
__device__ __forceinline__ v4u pack8(const float (&f)[8]) { v4u w; w.x = pk2(f[0], f[1]); w.y = pk2(f[2], f[3]); w.z = pk2(f[4], f[5]); w.w = pk2(f[6], f[7]); return w; }
__device__ __forceinline__ float wave_sum(float v) {
#pragma unroll
    for (int o = 1; o < 64; o <<= 1) v += __shfl_xor(v, o);
    return v;
}
__device__ __forceinline__ float sigmoidf_(float x) { return __builtin_amdgcn_rcpf(1.0f + __builtin_amdgcn_exp2f(-1.4426950408889634f * x)); }
__device__ __forceinline__ float siluf_(float x) { return x * __builtin_amdgcn_rcpf(1.0f + __builtin_amdgcn_exp2f(-1.4426950408889634f * x)); }
__device__ __forceinline__ float gelu_tanh_(float x) { const float y = (-1.4426950408889634f * 1.5957691216057308f) * (x + 0.044715f * x * x * x); return x * __builtin_amdgcn_rcpf(1.0f + __builtin_amdgcn_exp2f(y)); }

#define XB_TMO      128
#define XB_XCNT(j)  (256  + 64 * (j))
#define XB_XSUB(j)  (1280 + 64 * (j))
#define XB_XGEN(j)  (2304 + 64 * (j))
#define XB_TOP      3328
#define XB_TOPGEN   3392
#define XCD_BAR_WORDS 3456
#define XB_SPIN_CAP (1u << 18)
__device__ __forceinline__ unsigned xb_ld(unsigned* p)              { return __hip_atomic_load(p, __ATOMIC_RELAXED, __HIP_MEMORY_SCOPE_AGENT); }
__device__ __forceinline__ unsigned xb_add(unsigned* p, unsigned v) { return __hip_atomic_fetch_add(p, v, __ATOMIC_RELAXED, __HIP_MEMORY_SCOPE_AGENT); }
__device__ __forceinline__ unsigned xb_xcc_id() { return (unsigned)__builtin_amdgcn_s_getreg((3 << 11) | 20) & 0xFu; }
#define XB_SPIN(cond, bar) do { unsigned _sp = 0; while (cond) { __builtin_amdgcn_s_sleep(1); \
    if ((++_sp & 255u) == 0u) { if (xb_ld(&(bar)[XB_TMO])) break; if (_sp > XB_SPIN_CAP) { atomicAdd(&(bar)[XB_TMO], 1u); break; } } } } while (0)
struct XcdBarrier { unsigned* bar; unsigned x; volatile LAS unsigned* st; };
__device__ __forceinline__ XcdBarrier xcd_barrier_post(unsigned* bar, volatile LAS unsigned* st) {
    XcdBarrier b; b.bar = bar; b.x = xb_xcc_id(); b.st = st;
    if (threadIdx.x == 0) (void)xb_add(&bar[XB_XCNT(b.x)], 1u);
    return b;
}
__device__ __forceinline__ void xcd_barrier_complete(unsigned* bar, unsigned x, unsigned& nloc, unsigned& nx) {
    const unsigned G = gridDim.x * gridDim.y * gridDim.z;
    unsigned sum, cnt, mine, sp = 0u;
    for (;;) {
        sum = 0u; cnt = 0u; mine = 0u;
#pragma unroll
        for (unsigned j = 0; j < 16; ++j) { const unsigned c = xb_ld(&bar[XB_XCNT(j)]); sum += c; cnt += (c > 0u) ? 1u : 0u; mine = (j == x) ? c : mine; }
        if (sum == G) break;
        __builtin_amdgcn_s_sleep(1);
        if ((++sp & 255u) == 0u) { if (xb_ld(&bar[XB_TMO])) break; if (sp > XB_SPIN_CAP) { atomicAdd(&bar[XB_TMO], 1u); break; } }
    }
    nloc = mine > 0u ? mine : 1u; nx = cnt > 0u ? cnt : 1u;
}
__device__ __forceinline__ void xcd_barrier(const XcdBarrier& b) {
    asm volatile("s_waitcnt vmcnt(0)" ::: "memory");
    __syncthreads();
    if (threadIdx.x == 0) {
        unsigned* bar = b.bar;
        __builtin_amdgcn_s_waitcnt(0);
        unsigned nloc = b.st[0], nx = b.st[1];
        if (nloc == 0u) { xcd_barrier_complete(bar, b.x, nloc, nx); b.st[0] = nloc; b.st[1] = nx; }
        const unsigned old = xb_add(&bar[XB_XSUB(b.x)], 1u);
        const unsigned gen = old / nloc;
        if (old + 1u == (gen + 1u) * nloc) {
            __builtin_amdgcn_fence(__ATOMIC_RELEASE, "agent");
            asm volatile("s_waitcnt vmcnt(0)" ::: "memory");
            const unsigned og = xb_add(&bar[XB_TOP], 1u);
            const unsigned tg = og / nx;
            if (og + 1u == (tg + 1u) * nx) xb_add(&bar[XB_TOPGEN], 1u);
            else XB_SPIN(xb_ld(&bar[XB_TOPGEN]) == tg, bar);
            __builtin_amdgcn_fence(__ATOMIC_ACQUIRE, "agent");
            xb_add(&bar[XB_XGEN(b.x)], 1u);
            asm volatile("s_waitcnt vmcnt(0)" ::: "memory");
        } else {
            XB_SPIN(xb_ld(&bar[XB_XGEN(b.x)]) == gen, bar);
            __builtin_amdgcn_fence(__ATOMIC_ACQUIRE, "agent");
            asm volatile("s_waitcnt vmcnt(0)" ::: "memory");
        }
    }
    __syncthreads();
}

struct EpiIn {
    static constexpr bool PERM = true, AFTER_DRAIN = false, HOOK = false; static constexpr int H1 = -1, H2 = -1;
    bf16* Z; float* LOGF; const float* lbp  ; float* outK; float* outV;
    template <int KIND>
    __device__ __forceinline__ void body(const f32x4 (&acc)[2][2][4][2], const pg8::Unit& u, int wr, int wc, int fr, int fq) const {
        const int row0 = u.pm * 256 + wr * 64 + fr, colt = u.pn * 256 + wc * 32 + 8 * fq;
        const int seg = u.pn >> 2;
#pragma unroll
        for (int ai = 0; ai < 2; ++ai)
#pragma unroll
            for (int m = 0; m < 4; ++m) {
                const int row = row0 + ai * 128 + m * 16;
                bf16* zrow = Z + (size_t)row * INW + colt;
#pragma unroll
                for (int bj = 0; bj < 2; ++bj) {
                    float v[8];
#pragma unroll
                    for (int j = 0; j < 4; ++j) { v[j] = acc[ai][bj][m][0][j]; v[4 + j] = acc[ai][bj][m][1][j]; }
                    if (KIND == 5) {
                        const int c2 = colt + bj * 128 - 6144;
                        const float* lb = lbp + (seg - 6) * 4096 + (c2 & 1023);
                        float o[8];
#pragma unroll
                        for (int j = 0; j < 8; ++j) { const float b = lb[j]; o[j] = logf(b + (1.0f - b) * sigmoidf_(v[j])); }
                        float* dst = LOGF + (size_t)row * 2048 + c2;
                        *(f32x4*)dst = (f32x4){o[0], o[1], o[2], o[3]}; *(f32x4*)(dst + 4) = (f32x4){o[4], o[5], o[6], o[7]};
                    } else {
                        if (KIND == 4) {
                            if (row < NCTX) { float* dst = (seg == 3 ? outK : outV) + ((size_t)(row >> 8) * 1024 + (row & 255)) * 1024 + (colt + bj * 128 - (seg == 3 ? 3072 : 4096));
                                *(f32x4*)dst = (f32x4){v[0], v[1], v[2], v[3]}; *(f32x4*)(dst + 4) = (f32x4){v[4], v[5], v[6], v[7]}; }
                        }
                        if (KIND == 1) {
#pragma unroll
                            for (int j = 0; j < 8; ++j) v[j] = gelu_tanh_(v[j]);
                        }
                        if (KIND == 2) {
#pragma unroll
                            for (int j = 0; j < 8; ++j) v[j] = siluf_(v[j]);
                        }
                        if (KIND == 3) {
#pragma unroll
                            for (int j = 0; j < 8; ++j) v[j] = sigmoidf_(v[j]);
                        }
                        *(v4u*)(zrow + bj * 128) = pack8(v);
                    }
                }
                asm volatile("" ::: "memory");
            }
    }
    __device__ __forceinline__ void operator()(const f32x4 (&acc)[2][2][4][2], const pg8::Unit& u, int wr, int wc, int fr, int fq) const {
        const int seg = u.pn >> 2;
        if (seg >= 10) body<3>(acc, u, wr, wc, fr, fq);
        else if (seg == 0 || seg == 1) body<1>(acc, u, wr, wc, fr, fq);
        else if (seg == 5 || seg == 9) body<2>(acc, u, wr, wc, fr, fq);
        else if (seg == 3 || seg == 4) body<4>(acc, u, wr, wc, fr, fq);
        else if (seg == 6 || seg == 7) body<5>(acc, u, wr, wc, fr, fq);
        else body<0>(acc, u, wr, wc, fr, fq);
    }
};
struct EpiUpK {
    static constexpr bool PERM = true, AFTER_DRAIN = false, HOOK = true; static constexpr int H1 = 16, H2 = 32;
    const bf16* Zg  ; bf16* MG;
    __device__ __forceinline__ void hook(f32x4 (&acc)[2][2][4][2], const pg8::Unit& u, int t, int wr, int wc, int fr, int fq) const {
        int frl = fr, fql = fq; asm volatile("" : "+v"(frl), "+v"(fql));
        const int row0 = u.pm * 256 + wr * 64 + frl, colt = u.pn * 256 + wc * 32 + 8 * fql;
        const bf16* zn = Zg + (t == 16 ? 0 : 2048);
#pragma unroll
        for (int ai = 0; ai < 2; ++ai) {
            v4u nw[4][2], dw[4][2];
#pragma unroll
            for (int m = 0; m < 4; ++m)
#pragma unroll
                for (int bj = 0; bj < 2; ++bj) { const size_t ro = (size_t)(row0 + ai * 128 + m * 16) * INW + colt + bj * 128; nw[m][bj] = *(const v4u*)(zn + ro); dw[m][bj] = *(const v4u*)(zn + 2048 + ro); }
#pragma unroll
            for (int m = 0; m < 4; ++m)
#pragma unroll
                for (int bj = 0; bj < 2; ++bj) {
                    float gn[8], gd[8]; unpack8(nw[m][bj], gn); unpack8(dw[m][bj], gd);
#pragma unroll
                    for (int j = 0; j < 4; ++j) { acc[ai][bj][m][0][j] *= gn[j] * __builtin_amdgcn_rcpf(gd[j]); acc[ai][bj][m][1][j] *= gn[4 + j] * __builtin_amdgcn_rcpf(gd[4 + j]); }
                }
            asm volatile("" ::: "memory");
        }
    }
    __device__ __forceinline__ void operator()(const f32x4 (&acc)[2][2][4][2], const pg8::Unit& u, int wr, int wc, int fr, int fq) const {
        const int row0 = u.pm * 256 + wr * 64 + fr, colt = u.pn * 256 + wc * 32 + 8 * fq;
#pragma unroll
        for (int ai = 0; ai < 2; ++ai)
#pragma unroll
            for (int m = 0; m < 4; ++m) {
                const int row = row0 + ai * 128 + m * 16;
#pragma unroll
                for (int bj = 0; bj < 2; ++bj) {
                    const int col = colt + bj * 128;
                    float g[8]; unpack8(*(const v4u*)(Zg + 4096 + (size_t)row * INW + col), g);
                    float v[8];
#pragma unroll
                    for (int j = 0; j < 4; ++j) { v[j] = acc[ai][bj][m][0][j] * g[j]; v[4 + j] = acc[ai][bj][m][1][j] * g[4 + j]; }
                    *(v4u*)(MG + (size_t)row * DM + col) = pack8(v);
                }
                asm volatile("" ::: "memory");
            }
    }
};
struct EpiBf16P {
    static constexpr bool PERM = true, AFTER_DRAIN = false, HOOK = false; static constexpr int H1 = -1, H2 = -1;
    bf16* C; int ldc; size_t kq_stride;
    __device__ __forceinline__ void operator()(const f32x4 (&acc)[2][2][4][2], const pg8::Unit& u, int wr, int wc, int fr, int fq) const {
        const int row0 = u.pm * 256 + wr * 64 + fr, colt = u.pn * 256 + wc * 32 + 8 * fq;
#pragma unroll
        for (int ai = 0; ai < 2; ++ai)
#pragma unroll
            for (int m = 0; m < 4; ++m) {
                bf16* rp = C + (size_t)u.kq * kq_stride + (size_t)(row0 + ai * 128 + m * 16) * ldc + colt;
#pragma unroll
                for (int bj = 0; bj < 2; ++bj) { float v[8];
#pragma unroll
                    for (int j = 0; j < 4; ++j) { v[j] = acc[ai][bj][m][0][j]; v[4 + j] = acc[ai][bj][m][1][j]; }
                    *(v4u*)(rp + bj * 128) = pack8(v); }
            }
    }
};
struct EpiSwi {
    static constexpr bool PERM = true, AFTER_DRAIN = false, HOOK = false; static constexpr int H1 = -1, H2 = -1;
    bf16* ACT;
    __device__ __forceinline__ void operator()(const f32x4 (&acc)[2][2][4][2], const pg8::Unit& u, int wr, int wc, int fr, int fq) const {
        const int row0 = u.pm * 256 + wr * 64 + fr, colt = u.pn * 128 + wc * 32 + 8 * fq;
#pragma unroll
        for (int ai = 0; ai < 2; ++ai)
#pragma unroll
            for (int m = 0; m < 4; ++m) {
                float v[8];
#pragma unroll
                for (int j = 0; j < 4; ++j) { v[j] = siluf_(acc[ai][1][m][0][j]) * acc[ai][0][m][0][j]; v[4 + j] = siluf_(acc[ai][1][m][1][j]) * acc[ai][0][m][1][j]; }
                *(v4u*)(ACT + (size_t)(row0 + ai * 128 + m * 16) * DFF + colt) = pack8(v);
            }
    }
};

struct Ctx {
    LAS unsigned char* lds; int tid, lane, wave, vcu, G;
};

__device__ __forceinline__ void cvt_item(const float* W, int N, int k0, int n0, bf16* dst, int dld, int drow0, int dcol0, LAS float* scr, int lane) {
    const float* src = W + (size_t)(k0 + (lane >> 4)) * N + n0 + 4 * (lane & 15);
    f32x4 v[16];
#pragma unroll
    for (int i = 0; i < 16; ++i) v[i] = *(const f32x4*)(src + (size_t)(4 * i) * N);
#pragma unroll
    for (int i = 0; i < 16; ++i) { LAS float* s = scr + (4 * i + (lane >> 4)) * 65 + 4 * (lane & 15); s[0] = v[i].x; s[1] = v[i].y; s[2] = v[i].z; s[3] = v[i].w; }
    asm volatile("s_waitcnt lgkmcnt(0)" ::: "memory");
    const int c = lane & 7;
#pragma unroll
    for (int j = 0; j < 8; ++j) { const int n = (lane >> 3) + 8 * j; const LAS float* s = scr + (8 * c) * 65 + n;
        v4u o; o.x = pk2(s[0 * 65], s[1 * 65]); o.y = pk2(s[2 * 65], s[3 * 65]); o.z = pk2(s[4 * 65], s[5 * 65]); o.w = pk2(s[6 * 65], s[7 * 65]);
        *(v4u*)(dst + (size_t)(drow0 + n) * dld + dcol0 + 8 * c) = o; }
    asm volatile("s_waitcnt lgkmcnt(0)" ::: "memory");
}
constexpr int IT_IN = 32 * 256, IT_UP = 16 * 32, IT_OUT = 32 * 32, IT_FI = 32 * 176, IT_FO = 88 * 32, IT_LAYER = IT_IN + 3 * IT_UP + IT_OUT + IT_FI + IT_FO;
__device__ __forceinline__ void cvt_layer_item(const Args& a, int l, int r, LAS float* scr, int lane) {
    bf16* wl = (bf16*)(a.ws + WS_WT) + (size_t)l * WL_ELEMS;
    if (r < IT_IN) { const int kb = r / 256, nb = r % 256; cvt_item(a.w_in + (size_t)l * DM * INW, INW, 64 * kb, 64 * nb, wl + OFF_IN, DM, 64 * nb, 64 * kb, scr, lane); return; }
    r -= IT_IN;
    if (r < 3 * IT_UP) { const int br = r / IT_UP, q = r % IT_UP, kb = q / 32, nb = q % 32;
        const float* w = (br == 0 ? a.w_up_a : (br == 1 ? a.w_up_b : a.w_up_c)) + (size_t)l * 1024 * DM;
        cvt_item(w, DM, 64 * kb, 64 * nb, wl + OFF_UP, YW, 64 * nb, 1024 * br + 64 * kb, scr, lane); return; }
    r -= 3 * IT_UP;
    if (r < IT_OUT) { const int kb = r / 32, nb = r % 32; cvt_item(a.w_out + (size_t)l * DM * DM, DM, 64 * kb, 64 * nb, wl + OFF_OUT, DM, 64 * nb, 64 * kb, scr, lane); return; }
    r -= IT_OUT;
    if (r < IT_FI) { const int kb = r / 176, nb = r % 176; const int n0 = 64 * nb;
        const int drow = (n0 < DFF) ? (256 * (n0 / 128) + (n0 % 128)) : (256 * ((n0 - DFF) / 128) + 128 + ((n0 - DFF) % 128));
        cvt_item(a.w_fi + (size_t)l * DM * NFI, NFI, 64 * kb, n0, wl + OFF_FI, DM, drow, 64 * kb, scr, lane); return; }
    r -= IT_FI;
    { const int kb = r / 32, nb = r % 32; cvt_item(a.w_fo + (size_t)l * DFF * DM, DM, 64 * kb, 64 * nb, wl + OFF_FO, DFF, 64 * nb, 64 * kb, scr, lane); }
}
__device__ __forceinline__ void phase_prologue(const Args& a, const Ctx& F) {
    unsigned char* ws = a.ws;
    {
        LAS float* scr = (LAS float*)(F.lds + F.wave * 16640);
        const int gw = F.vcu * NWAVES + F.wave, NGW = F.G * NWAVES;
        for (int it = gw; it < IT_LAYER; it += NGW) cvt_layer_item(a, 0, it, scr, F.lane);
    }
    __syncthreads();
    {
        LAS float* sc = (LAS float*)F.lds;
        LAS float* red = (LAS float*)(F.lds + 24576);
        float* MOD = (float*)(ws + WS_MOD);
        for (int i = F.tid; i < 3 * DM; i += NTHR) { const int ci = i / DM, k = i % DM; const float x = (ci == 0) ? a.c_ctx[k] : a.c[(ci - 1) * DM + k]; sc[i] = x / (1.0f + expf(-x)); }
        __syncthreads();
        const int cx = F.tid & 31, kg = F.tid >> 5;
        for (int u = F.vcu; u < 4 * 96; u += F.G) {
            const int l = u / 96, cb = u % 96;
            const float* wp = a.w_ada + ((size_t)l * DM + 128 * kg) * 12288 + 128 * cb + 4 * cx;
            f32x4 a0 = {0.f, 0.f, 0.f, 0.f}, a1 = a0, a2 = a0;
#pragma unroll 8
            for (int k = 0; k < 128; ++k) { const f32x4 w = *(const f32x4*)(wp + (size_t)k * 12288);
                const float s0 = sc[128 * kg + k], s1 = sc[DM + 128 * kg + k], s2 = sc[2 * DM + 128 * kg + k];
                a0 += w * s0; a1 += w * s1; a2 += w * s2; }
#pragma unroll
            for (int j = 0; j < 4; ++j) { red[(kg * 3 + 0) * 128 + 4 * cx + j] = a0[j]; red[(kg * 3 + 1) * 128 + 4 * cx + j] = a1[j]; red[(kg * 3 + 2) * 128 + 4 * cx + j] = a2[j]; }
            __syncthreads();
            if (F.tid < 384) { const int ci = F.tid / 128, col = F.tid % 128; float s = 0.f;
#pragma unroll
                for (int g = 0; g < 16; ++g) s += red[(g * 3 + ci) * 128 + col];
                MOD[(size_t)(l * 3 + ci) * 12288 + 128 * cb + col] = s + a.b_ada[l * 12288 + 128 * cb + col]; }
            __syncthreads();
        }
    }
    {
        float* LB = (float*)(ws + WS_LB); float* ROPE = (float*)(ws + WS_ROPE);
        for (int i = F.vcu * NTHR + F.tid; i < 2048; i += F.G * NTHR) {
            const int dir = i / 1024, f = i % 1024;
            float x[4], mx = -3.0e38f;
#pragma unroll
            for (int l = 0; l < 4; ++l) { x[l] = a.lb_logits[(dir * 4 + l) * 1024 + f]; mx = fmaxf(mx, x[l]); }
            float e[4], s = 0.f;
#pragma unroll
            for (int l = 0; l < 4; ++l) { e[l] = expf(x[l] - mx); s += e[l]; }
            float cs = 0.f;
#pragma unroll
            for (int l = 0; l < 4; ++l) { if (l > 0) cs += e[l] / s; LB[(dir * 4 + l) * 1024 + f] = cs; }
            const int p = i / 32, fi = i % 32;
            const float inv = powf(10000.0f, -(float)(2 * fi) / 64.0f), ang = (float)p * inv;
            ROPE[2 * i] = cosf(ang); ROPE[2 * i + 1] = sinf(ang);
        }
    }
}

__device__ __forceinline__ void rownorm_phase(const Args& a, const Ctx& F, bool first, const bf16* T, const float* gate  , const float* gpost,
                                              bool write_h, const float* gn, const float* scv, const float* shv  ) {
    float* X = a.out + OUT_Y; bf16* H = (bf16*)(a.ws + WS_H); const bf16* TP = (const bf16*)(a.ws + WS_TP);
    LAS float* V1 = (LAS float*)F.lds; LAS float* V2 = V1 + 3 * DM; LAS float* V3 = V2 + 3 * DM;
    __syncthreads();
    for (int i = F.tid; i < 3 * DM; i += NTHR) { const int ci = i / DM, c = i % DM;
        if (T) V1[i] = gate[(size_t)ci * 12288 + c] * gpost[c];
        if (write_h) { V2[i] = gn[c] * (1.0f + scv[(size_t)ci * 12288 + c]); V3[i] = shv[(size_t)ci * 12288 + c]; } }
    __syncthreads();
    const int gw = F.vcu * NWAVES + F.wave, NGW = F.G * NWAVES;
    for (int m = gw; m < MTOK; m += NGW) {
        const int ci = (m < NCTX) ? 0 : 1 + ((m - NCTX) >> 10);
        const float* xr = first ? ((m < NCTX) ? a.x_prompt + (size_t)m * DM : a.x_sample + (size_t)(m - NCTX) * DM) : X + (size_t)m * DM;
        f32x4 x[8];
#pragma unroll
        for (int j = 0; j < 8; ++j) x[j] = *((const f32x4*)xr + F.lane + 64 * j);
        if (T) {
            f32x4 t[8]; float ss = 0.f;
#pragma unroll
            for (int j = 0; j < 8; ++j) {
                if (m < NCTX) { const v2u w = *((const v2u*)(T + (size_t)m * DM) + F.lane + 64 * j); t[j] = (f32x4){bf2f_lo(w.x), bf2f_hi(w.x), bf2f_lo(w.y), bf2f_hi(w.y)}; }
                else { const v2u* tp = (const v2u*)(TP + (size_t)(m - NCTX) * DM) + F.lane + 64 * j; const v2u w0 = tp[0], w1 = tp[TPQ / 4], w2 = tp[2 * (TPQ / 4)], w3 = tp[3 * (TPQ / 4)];
                    t[j] = (f32x4){(bf2f_lo(w0.x) + bf2f_lo(w1.x)) + (bf2f_lo(w2.x) + bf2f_lo(w3.x)), (bf2f_hi(w0.x) + bf2f_hi(w1.x)) + (bf2f_hi(w2.x) + bf2f_hi(w3.x)),
                                   (bf2f_lo(w0.y) + bf2f_lo(w1.y)) + (bf2f_lo(w2.y) + bf2f_lo(w3.y)), (bf2f_hi(w0.y) + bf2f_hi(w1.y)) + (bf2f_hi(w2.y) + bf2f_hi(w3.y))}; }
                ss += (t[j].x * t[j].x + t[j].y * t[j].y) + (t[j].z * t[j].z + t[j].w * t[j].w); }
            const float r = 1.0f / sqrtf(wave_sum(ss) * (1.0f / DM) + EPS);
#pragma unroll
            for (int j = 0; j < 8; ++j) { const f32x4 v1 = *((const LAS f32x4*)(V1 + ci * DM) + F.lane + 64 * j); x[j] += v1 * (t[j] * r); }
        }
        if (T || first) {
#pragma unroll
            for (int j = 0; j < 8; ++j) *((f32x4*)(X + (size_t)m * DM) + F.lane + 64 * j) = x[j];
        }
        if (write_h) {
            float ss = 0.f;
#pragma unroll
            for (int j = 0; j < 8; ++j) ss += (x[j].x * x[j].x + x[j].y * x[j].y) + (x[j].z * x[j].z + x[j].w * x[j].w);
            const float r = 1.0f / sqrtf(wave_sum(ss) * (1.0f / DM) + EPS);
#pragma unroll
            for (int j = 0; j < 8; ++j) { const f32x4 v2 = *((const LAS f32x4*)(V2 + ci * DM) + F.lane + 64 * j), v3 = *((const LAS f32x4*)(V3 + ci * DM) + F.lane + 64 * j);
                const f32x4 h = x[j] * r * v2 + v3;
                v2u w; w.x = pk2(h.x, h.y); w.y = pk2(h.z, h.w);
                *((v2u*)(H + (size_t)m * DM) + F.lane + 64 * j) = w; }
        }
    }
    __syncthreads();
}

__device__ __forceinline__ void phase_ycnorm(const Args& a, const Ctx& F) {
    const float* OFp = (const float*)(a.ws + WS_OF); const float* OBp = (const float*)(a.ws + WS_OB);
    const bf16* Z = (const bf16*)(a.ws + WS_Z); bf16* Y = (bf16*)(a.ws + WS_Y);
    const int gw = F.vcu * NWAVES + F.wave, NGW = F.G * NWAVES;
    for (int m = gw; m < MTOK; m += NGW) {
        float o[16]; float ss = 0.f;
#pragma unroll
        for (int j = 0; j < 4; ++j) { const f32x4 p = *((const f32x4*)(OFp + (size_t)m * 1024 + 16 * F.lane) + j), q = *((const f32x4*)(OBp + (size_t)m * 1024 + 16 * F.lane) + j);
            const f32x4 s = p + q; o[4 * j] = s.x; o[4 * j + 1] = s.y; o[4 * j + 2] = s.z; o[4 * j + 3] = s.w; ss += (s.x * s.x + s.y * s.y) + (s.z * s.z + s.w * s.w); }
        ss += __shfl_xor(ss, 1); ss += __shfl_xor(ss, 2); ss += __shfl_xor(ss, 4);
        const float r = 1.0f / sqrtf(ss * (1.0f / 128.0f) + EPS);
        float g0[8], g1[8];
        unpack8(*(const v4u*)(Z + (size_t)m * INW + 9216 + 16 * F.lane), g0); unpack8(*(const v4u*)(Z + (size_t)m * INW + 9216 + 16 * F.lane + 8), g1);
        float y0[8], y1[8];
#pragma unroll
        for (int j = 0; j < 8; ++j) { y0[j] = o[j] * r * g0[j]; y1[j] = o[8 + j] * r * g1[j]; }
        *(v4u*)(Y + (size_t)m * YW + 2048 + 16 * F.lane) = pack8(y0); *(v4u*)(Y + (size_t)m * YW + 2048 + 16 * F.lane + 8) = pack8(y1);
    }
}

typedef short bf16x8 __attribute__((ext_vector_type(8)));
typedef short s16x4 __attribute__((ext_vector_type(4)));
typedef float f32x16 __attribute__((ext_vector_type(16)));
typedef __bf16 bf16x4_t __attribute__((ext_vector_type(4)));
#define MFMA32(a, b, c) __builtin_amdgcn_mfma_f32_32x32x16_bf16((a), (b), (c), 0, 0, 0)
__device__ __forceinline__ bf16x8 pack_regs(const f32x16& x, int s) {
    v4u p; p.x = cvtpk(x[8 * s], x[8 * s + 1]); p.y = cvtpk(x[8 * s + 2], x[8 * s + 3]); p.z = cvtpk(x[8 * s + 4], x[8 * s + 5]); p.w = cvtpk(x[8 * s + 6], x[8 * s + 7]);
    return __builtin_bit_cast(bf16x8, p);
}
__device__ __forceinline__ s16x4 tr_read(const LAS unsigned char* p) { return __builtin_bit_cast(s16x4, __builtin_amdgcn_ds_read_tr16_b64_v4bf16((LAS bf16x4_t*)p)); }
__device__ __forceinline__ bf16x8 tr_pair(const LAS unsigned char* lo, const LAS unsigned char* hi) { const s16x4 a = tr_read(lo), b = tr_read(hi); return __builtin_shufflevector(a, b, 0, 1, 2, 3, 4, 5, 6, 7); }
constexpr float ATT_SCALE = 0.08838834764831845f;
constexpr int KP = 272, VP = 320;
constexpr int ATT_K_OFF = 0, ATT_V_OFF = 256 * KP, ATT_RPB_OFF = ATT_V_OFF + 256 * VP;
struct AttnW { f32x16 O[4]; float m, l; };
template <int MODE, bool QLDS>
__device__ __forceinline__ void attn_tile(AttnW& W, const bf16x8 (&qf)[8], const LAS unsigned char* Ql, const LAS unsigned char* Kl, const LAS unsigned char* Vl, int kt0, int lane, const LAS float* rpb_row, int kc0, int qc) {
    const int r = lane & 31, h = lane >> 5;
    f32x16 sacc;
#pragma unroll
    for (int i = 0; i < 16; ++i) sacc[i] = 0.f;
    const LAS unsigned char* kp = Kl + (kt0 + r) * KP + 16 * h;
#pragma unroll
    for (int ks = 0; ks < 8; ++ks) { const bf16x8 a = *(const LAS bf16x8*)(kp + 32 * ks); const bf16x8 q = QLDS ? *(const LAS bf16x8*)(Ql + 32 * ks) : qf[ks]; sacc = MFMA32(a, q, sacc); }
    float mt = -1.0e30f;
    if (MODE == 1) {
        const int c_start = min(max(qc - 8, 0), 48);
        const int kb = kc0 + 4 * h - c_start;
        const LAS float* bp = rpb_row + (kc0 + 4 * h - qc + 15);
#pragma unroll
        for (int i = 0; i < 16; ++i) { const int off = (i & 3) + 8 * (i >> 2); const bool ok = (unsigned)(kb + off) < 16u;
            const float bias = bp[ok ? off : (qc - kc0 - 4 * h)];
            const float v = ok ? (sacc[i] * ATT_SCALE + bias) : -1.0e30f; sacc[i] = v; mt = fmaxf(mt, v); }
    } else {
#pragma unroll
        for (int i = 0; i < 16; ++i) { sacc[i] *= ATT_SCALE; mt = fmaxf(mt, sacc[i]); }
    }
    mt = fmaxf(mt, __shfl_xor(mt, 32));
    const float mn = fmaxf(W.m, mt), alpha = __expf(W.m - mn);
    float ls = 0.f;
#pragma unroll
    for (int i = 0; i < 16; ++i) { const float e = (MODE == 1 && sacc[i] < -1.0e29f) ? 0.f : __expf(sacc[i] - mn); sacc[i] = e; ls += e; }
    ls += __shfl_xor(ls, 32);
    W.l = W.l * alpha + ls; W.m = mn;
    if (__any(alpha != 1.0f)) {
#pragma unroll
        for (int dt = 0; dt < 4; ++dt)
#pragma unroll
            for (int i = 0; i < 16; ++i) W.O[dt][i] *= alpha;
    }
    const bf16x8 pb0 = pack_regs(sacc, 0), pb1 = pack_regs(sacc, 1);
    const int g = (lane >> 4) & 1, q4 = (lane & 15) >> 2, p4 = lane & 3;
    const LAS unsigned char* vp = Vl + (kt0 + 4 * h + q4) * VP + 32 * g + 8 * p4;
#pragma unroll
    for (int dt = 0; dt < 4; ++dt) {
        const bf16x8 v0 = tr_pair(vp + 64 * dt, vp + 64 * dt + 8 * VP);
        const bf16x8 v1 = tr_pair(vp + 64 * dt + 16 * VP, vp + 64 * dt + 24 * VP);
        W.O[dt] = MFMA32(v0, pb0, W.O[dt]); W.O[dt] = MFMA32(v1, pb1, W.O[dt]);
    }
}
__device__ __forceinline__ void attn_init(AttnW& W) {
    W.m = -1.0e30f; W.l = 0.f;
#pragma unroll
    for (int dt = 0; dt < 4; ++dt)
#pragma unroll
        for (int i = 0; i < 16; ++i) W.O[dt][i] = 0.f;
}
__device__ __forceinline__ void attn_store_dt(const f32x16& O, float inv, bf16* yrow, int dt, int h) {
#pragma unroll
    for (int g4 = 0; g4 < 4; ++g4) { v2u w; w.x = cvtpk(O[4 * g4] * inv, O[4 * g4 + 1] * inv); w.y = cvtpk(O[4 * g4 + 2] * inv, O[4 * g4 + 3] * inv);
        *(v2u*)(yrow + 32 * dt + 8 * g4 + 4 * h) = w; }
}

__device__ __forceinline__ void unitAttnCtx(const Args& a, const Ctx& F, int unit) {
    const int hd = unit & 7, b = unit >> 3;
    const bf16* Z = (const bf16*)(a.ws + WS_Z); bf16* Y = (bf16*)(a.ws + WS_Y);
    const LAS unsigned char* Kl = F.lds + ATT_K_OFF; const LAS unsigned char* Vl = F.lds + ATT_V_OFF;
    for (int p = F.tid; p < 4096; p += NTHR) { const int key = p >> 4, c16 = p & 15; const bf16* src = Z + (size_t)(b * 256 + key) * INW + hd * 128 + 8 * c16;
        *(LAS v4u*)(F.lds + ATT_K_OFF + key * KP + 16 * c16) = *(const v4u*)(src + 3072); *(LAS v4u*)(F.lds + ATT_V_OFF + key * VP + 16 * c16) = *(const v4u*)(src + 4096); }
    AttnW W; attn_init(W); bf16x8 qf[8];
    const int r = F.lane & 31, h = F.lane >> 5;
    const int mq = b * 256 + 32 * F.wave + r;
    { const bf16* qp = Z + (size_t)mq * INW + 2048 + hd * 128 + 8 * h;
#pragma unroll
      for (int ks = 0; ks < 8; ++ks) qf[ks] = __builtin_bit_cast(bf16x8, *(const v4u*)(qp + 16 * ks)); }
    __syncthreads();
#pragma unroll 1
    for (int kt = 0; kt < 8; ++kt) attn_tile<0, false>(W, qf, nullptr, Kl, Vl, 32 * kt, F.lane, nullptr, 0, 0);
    const float inv = 1.0f / W.l;
    bf16* yrow = Y + (size_t)mq * YW + 1024 + hd * 128;
#pragma unroll
    for (int dt = 0; dt < 4; ++dt) attn_store_dt(W.O[dt], inv, yrow, dt, h);
    __syncthreads();
}
constexpr int LQ_OFF = 0, LK_OFF = 64 * KP, LV_OFF = LK_OFF + 128 * KP, LRPB_OFF = LV_OFF + 128 * VP;
__device__ __forceinline__ void unitAttnLat(const Args& a, const Ctx& F, int l, int unit) {
    const int gr = unit & 15, hd = (unit >> 4) & 7, b = unit >> 7;
    const bf16* Z = (const bf16*)(a.ws + WS_Z); bf16* Y = (bf16*)(a.ws + WS_Y);
    const float* ROPE = (const float*)(a.ws + WS_ROPE);
    const LAS unsigned char* Kl = F.lds + LK_OFF; const LAS unsigned char* Vl = F.lds + LV_OFF; LAS float* rp = (LAS float*)(F.lds + LRPB_OFF);
    const int r = F.lane & 31, h = F.lane >> 5, qh = F.wave & 1, kt = F.wave >> 1;
    const int qc = 32 * qh + r;
    const int r_start = min(max(gr - 4, 0), 8);
    const int mq = NCTX + b * 1024 + gr * 64 + qc;
    __syncthreads();
    for (int i = F.tid; i < 15 * 31; i += NTHR) rp[i] = a.rpb[(size_t)(l * 8 + hd) * 465 + i];
    {
        const int qq = F.tid >> 3, half = (F.tid >> 2) & 1, sp = F.tid & 3, pos = half ? qq : gr;
        const bf16* src = Z + (size_t)(NCTX + b * 1024 + gr * 64 + qq) * INW + 2048 + hd * 128 + 64 * half + 8 * sp;
        const float* rt = ROPE + 2 * (pos * 32 + 8 * sp);
        float x[8], y[8], lo[8], hi[8]; unpack8(*(const v4u*)src, x); unpack8(*(const v4u*)(src + 32), y);
#pragma unroll
        for (int j4 = 0; j4 < 4; ++j4) { const f32x4 cssn = *(const f32x4*)(rt + 4 * j4);
            lo[2 * j4] = x[2 * j4] * cssn.x - y[2 * j4] * cssn.y; hi[2 * j4] = y[2 * j4] * cssn.x + x[2 * j4] * cssn.y;
            lo[2 * j4 + 1] = x[2 * j4 + 1] * cssn.z - y[2 * j4 + 1] * cssn.w; hi[2 * j4 + 1] = y[2 * j4 + 1] * cssn.z + x[2 * j4 + 1] * cssn.w; }
        LAS unsigned char* d = F.lds + LQ_OFF + qq * KP + 2 * (64 * half + 8 * sp);
        *(LAS v4u*)d = pack8(lo); *(LAS v4u*)(d + 64) = pack8(hi);
    }
    AttnW W; attn_init(W);
    const LAS unsigned char* Ql = F.lds + LQ_OFF + qc * KP + 16 * h;
    const bf16x8 qdummy[8] = {};
#pragma unroll 1
    for (int chn = 0; chn < 8; ++chn) {
        __syncthreads();
        if (chn < 4) {
#pragma unroll 1
            for (int job = F.tid; job < 1024; job += NTHR) {
                const int key = job >> 3, half = (job >> 2) & 1, sp = job & 3;
                const int kr = r_start + 2 * chn + (key >> 6), kc = key & 63, pos = half ? kc : kr;
                const bf16* src = Z + (size_t)(NCTX + b * 1024 + kr * 64 + kc) * INW + 3072 + hd * 128 + 64 * half + 8 * sp;
                const float* rt = ROPE + 2 * (pos * 32 + 8 * sp);
                float x[8], y[8], lo[8], hi[8]; unpack8(*(const v4u*)src, x); unpack8(*(const v4u*)(src + 32), y);
#pragma unroll
                for (int j4 = 0; j4 < 4; ++j4) { const f32x4 cssn = *(const f32x4*)(rt + 4 * j4);
                    lo[2 * j4] = x[2 * j4] * cssn.x - y[2 * j4] * cssn.y; hi[2 * j4] = y[2 * j4] * cssn.x + x[2 * j4] * cssn.y;
                    lo[2 * j4 + 1] = x[2 * j4 + 1] * cssn.z - y[2 * j4 + 1] * cssn.w; hi[2 * j4 + 1] = y[2 * j4 + 1] * cssn.z + x[2 * j4 + 1] * cssn.w; }
                LAS unsigned char* d = F.lds + LK_OFF + key * KP + 2 * (64 * half + 8 * sp);
                *(LAS v4u*)d = pack8(lo); *(LAS v4u*)(d + 64) = pack8(hi);
            }
#pragma unroll 2
            for (int p = F.tid; p < 2048; p += NTHR) { const int key = p >> 4, c16 = p & 15; const int kr = r_start + 2 * chn + (key >> 6), kc = key & 63;
                *(LAS v4u*)(F.lds + LV_OFF + key * VP + 16 * c16) = *(const v4u*)(Z + (size_t)(NCTX + b * 1024 + kr * 64 + kc) * INW + 4096 + hd * 128 + 8 * c16); }
        } else {
#pragma unroll 2
            for (int p = F.tid; p < 2048; p += NTHR) { const int key = p >> 4, c16 = p & 15;
                const size_t off = ((size_t)(b * 4 + l) * 512 + 128 * (chn - 4) + key) * 1024 + hd * 128 + 8 * c16;
                const f32x4 k0 = *(const f32x4*)(a.cache_k + off), k1 = *(const f32x4*)(a.cache_k + off + 4), v0 = *(const f32x4*)(a.cache_v + off), v1 = *(const f32x4*)(a.cache_v + off + 4);
                v4u kw, vw; kw.x = cvtpk(k0.x, k0.y); kw.y = cvtpk(k0.z, k0.w); kw.z = cvtpk(k1.x, k1.y); kw.w = cvtpk(k1.z, k1.w);
                vw.x = cvtpk(v0.x, v0.y); vw.y = cvtpk(v0.z, v0.w); vw.z = cvtpk(v1.x, v1.y); vw.w = cvtpk(v1.z, v1.w);
                *(LAS v4u*)(F.lds + LK_OFF + key * KP + 16 * c16) = kw; *(LAS v4u*)(F.lds + LV_OFF + key * VP + 16 * c16) = vw; }
        }
        __syncthreads();
        if (chn < 4) {
            const int kr = r_start + 2 * chn + (kt >> 1), dr = kr - gr + 7;
            attn_tile<1, true>(W, qdummy, Ql, Kl, Vl, 32 * kt, F.lane, rp + dr * 31, 32 * (kt & 1), qc);
        } else {
            attn_tile<0, true>(W, qdummy, Ql, Kl, Vl, 32 * kt, F.lane, nullptr, 0, 0);
        }
    }
    __syncthreads();
    LAS float* ML = (LAS float*)F.lds; LAS float* OB = (LAS float*)(F.lds + 4096);
    ML[(F.wave * 2 + 0) * 64 + F.lane] = W.m; ML[(F.wave * 2 + 1) * 64 + F.lane] = W.l;
#pragma unroll
    for (int dt = 0; dt < 4; ++dt)
#pragma unroll
        for (int i = 0; i < 16; ++i) OB[(F.wave * 64 + dt * 16 + i) * 64 + F.lane] = W.O[dt][i];
    __syncthreads();
    {
        float mi[4], li[4], mt = -1.0e30f;
#pragma unroll
        for (int k = 0; k < 4; ++k) { const int w2 = 2 * k + qh; mi[k] = ML[(w2 * 2 + 0) * 64 + F.lane]; li[k] = ML[(w2 * 2 + 1) * 64 + F.lane]; mt = fmaxf(mt, mi[k]); }
        float wk[4], lt = 0.f;
#pragma unroll
        for (int k = 0; k < 4; ++k) { wk[k] = __expf(mi[k] - mt); lt += wk[k] * li[k]; }
        const float inv = 1.0f / lt;
#pragma unroll
        for (int k = 0; k < 4; ++k) wk[k] *= inv;
        bf16* yrow = Y + (size_t)mq * YW + 1024 + hd * 128 + 32 * kt + 4 * h;
#pragma unroll
        for (int g4 = 0; g4 < 4; ++g4) {
            float o[4];
#pragma unroll
            for (int i = 0; i < 4; ++i) { float sacc = 0.f;
#pragma unroll
                for (int k = 0; k < 4; ++k) sacc += wk[k] * OB[((2 * k + qh) * 64 + kt * 16 + 4 * g4 + i) * 64 + F.lane];
                o[i] = sacc; }
            v2u w; w.x = cvtpk(o[0], o[1]); w.y = cvtpk(o[2], o[3]);
            *(v2u*)(yrow + 8 * g4) = w;
            asm volatile("" ::: "memory");
        }
    }
    __syncthreads();
}

constexpr int AW_OFF = 0, AV_OFF = 128 * KP, AST_OFF = AV_OFF + 128 * VP;
__device__ __forceinline__ void unitA(const Args& a, const Ctx& F, int l, int unit) {
    const int ch = unit >> 3, g = unit & 7, m0 = ch * 128;
    const bf16* Z = (const bf16*)(a.ws + WS_Z); bf16* Y = (bf16*)(a.ws + WS_Y);
    LAS float* st = (LAS float*)(F.lds + AST_OFF);
    __syncthreads();
#pragma unroll 4
    for (int i = 0; i < 16; ++i) {
        const int s = 16 * F.wave + i;
        const bf16* rp = Z + (size_t)(m0 + s) * INW + 1024 + 16 * F.lane;
        float x0[8], x1[8]; unpack8(*(const v4u*)rp, x0); unpack8(*(const v4u*)(rp + 8), x1);
        float sm = 0.f, sq = 0.f;
#pragma unroll
        for (int j = 0; j < 8; ++j) { sm += x0[j] + x1[j]; sq += x0[j] * x0[j] + x1[j] * x1[j]; }
        sm = wave_sum(sm); sq = wave_sum(sq);
        const float mean = sm * (1.0f / 1024.0f), var = fmaxf(sq * (1.0f / 1024.0f) - mean * mean, 0.f);
        if (F.lane == 0) { st[s] = mean; st[128 + s] = 1.0f / sqrtf(var + EPS); }
    }
    {
        const int t = F.tid >> 2, s0 = 32 * (F.tid & 3);
        const float* wp = a.a_w + ((size_t)(l * 8 + g) * 128 + t) * 128 + s0;
#pragma unroll
        for (int q = 0; q < 4; ++q) { const f32x4 w0 = *(const f32x4*)(wp + 8 * q), w1 = *(const f32x4*)(wp + 8 * q + 4);
            v4u o; o.x = cvtpk(w0.x, w0.y); o.y = cvtpk(w0.z, w0.w); o.z = cvtpk(w1.x, w1.y); o.w = cvtpk(w1.z, w1.w);
            *(LAS v4u*)(F.lds + AW_OFF + t * KP + 2 * (s0 + 8 * q)) = o; }
    }
    __syncthreads();
    {
        const int s = F.tid >> 2, c0 = 32 * (F.tid & 3);
        const float mean = st[s], rstd = st[128 + s];
        const bf16* rp = Z + (size_t)(m0 + s) * INW + 1024 + 128 * g + c0;
#pragma unroll
        for (int q = 0; q < 4; ++q) { float x[8]; unpack8(*(const v4u*)(rp + 8 * q), x);
#pragma unroll
            for (int j = 0; j < 8; ++j) x[j] = (x[j] - mean) * rstd;
            *(LAS v4u*)(F.lds + AV_OFF + s * VP + 2 * (c0 + 8 * q)) = pack8(x); }
    }
    __syncthreads();
    const int lane = F.lane, r = lane & 31, h = lane >> 5, gq = (lane >> 4) & 1, q4 = (lane & 15) >> 2, p4 = lane & 3;
    const int ttile = F.wave & 3, ct0 = 2 * (F.wave >> 2);
    f32x16 acc[2];
#pragma unroll
    for (int c2 = 0; c2 < 2; ++c2)
#pragma unroll
        for (int i = 0; i < 16; ++i) acc[c2][i] = 0.f;
    {
        const LAS unsigned char* wp = F.lds + AW_OFF + (32 * ttile + r) * KP + 16 * h;
        const LAS unsigned char* vp = F.lds + AV_OFF + (8 * h + q4) * VP + 2 * (32 * ct0 + 16 * gq) + 8 * p4;
#pragma unroll
        for (int ks = 0; ks < 8; ++ks) {
            const bf16x8 wb = *(const LAS bf16x8*)(wp + 32 * ks);
#pragma unroll
            for (int c2 = 0; c2 < 2; ++c2) {
                const LAS unsigned char* v0 = vp + 16 * ks * VP + 64 * c2;
                acc[c2] = MFMA32(tr_pair(v0, v0 + 4 * VP), wb, acc[c2]);
            }
        }
    }
    {
        const int t = 32 * ttile + r; const float bsv = a.a_b[(l * 8 + g) * 128 + t];
        const bf16* up = Z + (size_t)(m0 + t) * INW + 128 * g + 4 * h; bf16* yp = Y + (size_t)(m0 + t) * YW + 128 * g + 4 * h;
#pragma unroll
        for (int c2 = 0; c2 < 2; ++c2)
#pragma unroll
            for (int g4 = 0; g4 < 4; ++g4) {
                const int c = 32 * (ct0 + c2) + 8 * g4;
                const v2u uw = *(const v2u*)(up + c);
                v2u o; o.x = cvtpk(bf2f_lo(uw.x) * (acc[c2][4 * g4] + bsv), bf2f_hi(uw.x) * (acc[c2][4 * g4 + 1] + bsv));
                o.y = cvtpk(bf2f_lo(uw.y) * (acc[c2][4 * g4 + 2] + bsv), bf2f_hi(uw.y) * (acc[c2][4 * g4 + 3] + bsv));
                *(v2u*)(yp + c) = o;
            }
    }
    __syncthreads();
}

constexpr int HP = 272;
constexpr int HG_QD = 0, HG_KD = 32 * HP, HG_KL = 2 * 32 * HP, HG_V = 3 * 32 * HP, HG_G = 4 * 32 * HP, HG_BUF = HG_G + 512, HG_DIR = 2 * HG_BUF;
struct HgPre { v4u q[2], v[2]; f32x4 f[4]; };
__device__ __forceinline__ void hg_load(HgPre& P, const bf16* Z, const float* LOGF, size_t m, int dir, int hd, int d0) {
    const bf16* zr = Z + m * INW + hd * 128 + d0; const float* fr = LOGF + m * 2048 + dir * 1024 + hd * 128 + d0;
    P.q[0] = *(const v4u*)(zr + 5120); P.q[1] = *(const v4u*)(zr + 5128); P.v[0] = *(const v4u*)(zr + 8192); P.v[1] = *(const v4u*)(zr + 8200);
#pragma unroll
    for (int j = 0; j < 4; ++j) P.f[j] = *(const f32x4*)(fr + 4 * j);
}
template <int CTRL, int ROWMASK> __device__ __forceinline__ float dpp_add(float x) {
    return x + __int_as_float(__builtin_amdgcn_update_dpp(0, __float_as_int(x), CTRL, ROWMASK, 0xF, true)); }
__device__ __forceinline__ float scan32(float x) {
    x = dpp_add<0x111, 0xF>(x); x = dpp_add<0x112, 0xF>(x); x = dpp_add<0x114, 0xF>(x); x = dpp_add<0x118, 0xF>(x); x = dpp_add<0x142, 0xA>(x); return x; }
__device__ __forceinline__ void hg_estep(const HgPre& P, LAS unsigned char* buf, int lane_, int w4) {
    int lane = lane_; asm volatile("" : "+v"(lane));
    const int tt = lane & 31, hf = lane >> 5, d0 = 32 * w4 + 16 * hf;
    float bl[16];
#pragma unroll
    for (int j = 0; j < 16; ++j) bl[j] = scan32(P.f[j >> 2][j & 3]);
    LAS unsigned char* row = buf + tt * HP + 2 * d0;
#pragma unroll
    for (int hh = 0; hh < 2; ++hh) {
        float qd[8], kd[8], kl[8];
        float q[8]; unpack8(P.q[hh], q);
#pragma unroll
        for (int j = 0; j < 8; ++j) { const int jj = 8 * hh + j; const float bC0 = __int_as_float(__builtin_amdgcn_readlane(__float_as_int(bl[jj]), 31)), bC1 = __int_as_float(__builtin_amdgcn_readlane(__float_as_int(bl[jj]), 63)); const float bC = hf ? bC1 : bC0; const float k = 1.0f - __expf(P.f[jj >> 2][jj & 3]);
            qd[j] = q[j] * __expf(bl[jj]); kd[j] = k * __expf(fminf(-bl[jj], 80.0f)); kl[j] = k * __expf(bC - bl[jj]); }
        *(LAS v4u*)(row + HG_QD + 16 * hh) = pack8(qd); *(LAS v4u*)(row + HG_KD + 16 * hh) = pack8(kd); *(LAS v4u*)(row + HG_KL + 16 * hh) = pack8(kl);
        asm volatile("" ::: "memory");
    }
    *(LAS v4u*)(row + HG_V) = P.v[0]; *(LAS v4u*)(row + HG_V + 16) = P.v[1];
    if (tt == 31) {
#pragma unroll
        for (int j4 = 0; j4 < 4; ++j4) *(LAS f32x4*)(buf + HG_G + 4 * (d0 + 4 * j4)) = (f32x4){__expf(bl[4 * j4]), __expf(bl[4 * j4 + 1]), __expf(bl[4 * j4 + 2]), __expf(bl[4 * j4 + 3])};
    }
}
__device__ __forceinline__ void hg_mstep(f32x16 (&S)[4], const LAS unsigned char* buf, int lane_, int w4, float* Og, int c, int n, int dir, int mbase, int hd) {
    int lane = lane_; asm volatile("" : "+v"(lane));
    const int r = lane & 31, h = lane >> 5, g = (lane >> 4) & 1, q4 = (lane & 15) >> 2, p4 = lane & 3;
    f32x16 X0;
#pragma unroll
    for (int i = 0; i < 16; ++i) X0[i] = 0.f;
    {   const LAS unsigned char* kp = buf + HG_KD + r * HP + 16 * h; const LAS unsigned char* qp = buf + HG_QD + r * HP + 16 * h;
#pragma unroll
        for (int ks = 0; ks < 8; ++ks) X0 = MFMA32(*(const LAS bf16x8*)(kp + 32 * ks), *(const LAS bf16x8*)(qp + 32 * ks), X0); }
    f32x16 O0;
#pragma unroll
    for (int i = 0; i < 16; ++i) O0[i] = 0.f;
    {
        const LAS unsigned char* qp = buf + HG_QD + r * HP + 8 * h;
#pragma unroll
        for (int dt = 0; dt < 4; ++dt)
#pragma unroll
            for (int st = 0; st < 2; ++st) {
                const s16x4 lo = *(const LAS s16x4*)(qp + 2 * (32 * dt + 16 * st)), hi = *(const LAS s16x4*)(qp + 2 * (32 * dt + 16 * st + 8));
                O0 = MFMA32(__builtin_shufflevector(lo, hi, 0, 1, 2, 3, 4, 5, 6, 7), pack_regs(S[dt], st), O0);
            }
    }
#pragma unroll
    for (int i = 0; i < 16; ++i) { const int srow = (i & 3) + 8 * (i >> 2) + 4 * h; X0[i] = (srow <= r) ? X0[i] : 0.f; }
    {
        const LAS unsigned char* vp = buf + HG_V + (4 * h + q4) * HP + 2 * (32 * w4 + 16 * g) + 8 * p4;
        O0 = MFMA32(pack_regs(X0, 0), tr_pair(vp, vp + 8 * HP), O0);
        O0 = MFMA32(pack_regs(X0, 1), tr_pair(vp + 16 * HP, vp + 24 * HP), O0);
    }
    asm volatile("" ::: "memory");
    {
        const LAS float* G = (const LAS float*)(buf + HG_G);
        const LAS unsigned char* vp = buf + HG_V + (8 * h + q4) * HP + 2 * (32 * w4 + 16 * g) + 8 * p4;
        const bf16x8 vb0 = tr_pair(vp, vp + 4 * HP), vb1 = tr_pair(vp + 16 * HP, vp + 20 * HP);
#pragma unroll
        for (int dt = 0; dt < 4; ++dt) {
#pragma unroll
            for (int g4 = 0; g4 < 4; ++g4) { const f32x4 gv = *(const LAS f32x4*)(G + 32 * dt + 8 * g4 + 4 * h);
#pragma unroll
                for (int jj = 0; jj < 4; ++jj) S[dt][4 * g4 + jj] *= gv[jj]; }
            const LAS unsigned char* kp = buf + HG_KL + (8 * h + q4) * HP + 2 * (32 * dt + 16 * g) + 8 * p4;
            S[dt] = MFMA32(tr_pair(kp, kp + 4 * HP), vb0, S[dt]);
            S[dt] = MFMA32(tr_pair(kp + 16 * HP, kp + 20 * HP), vb1, S[dt]);
                }
    }
    {
        const int tb = 32 * c + 4 * h; const int p0 = dir ? (n - 1 - tb) : tb, stp = dir ? -1024 : 1024;
        float* ob = Og + (size_t)mbase * 1024 + hd * 128 + 32 * w4;
        const int o0 = p0 * 1024 + r;
#pragma unroll
        for (int i = 0; i < 16; ++i) ob[o0 + ((i & 3) + 8 * (i >> 2)) * stp] = O0[i];
    }
}
__device__ __forceinline__ void unitHgrn(const Args& a, const Ctx& F, int l, bool lat, int b, int hd) {
    const bf16* Z = (const bf16*)(a.ws + WS_Z); const float* LOGF = (const float*)(a.ws + WS_LOGF); bf16* Y = (bf16*)(a.ws + WS_Y);
    const int w4 = F.wave & 3, lane = F.lane;
    LAS unsigned char* base = F.lds;
    const int n = lat ? 1024 : 256, mbase = lat ? NCTX + b * 1024 : b * 256, nch = n >> 5, ng = 2 * nch;
    __syncthreads();
    if (F.wave < 4) {
        const int tt = lane & 31, d0 = 32 * w4 + 16 * (lane >> 5);
        HgPre P;
        hg_load(P, Z, LOGF, (size_t)(mbase + tt), 0, hd, d0);
        hg_estep(P, base, lane, w4);
        {   const int g1 = 1, dir1 = (g1 >= nch), c1 = g1 - dir1 * nch, p1 = 32 * c1 + tt; hg_load(P, Z, LOGF, (size_t)(mbase + (dir1 ? (n - 1 - p1) : p1)), dir1, hd, d0); }
        asm volatile("s_waitcnt lgkmcnt(0)" ::: "memory"); __builtin_amdgcn_s_barrier(); asm volatile("" ::: "memory");
#pragma unroll 1
        for (int g = 0; g < ng; ++g) {
            if (g + 1 < ng) {
                hg_estep(P, base + ((g + 1) & 1) * HG_BUF, lane, w4);
                if (g + 2 < ng) { const int g2 = g + 2, dir2 = (g2 >= nch), c2 = g2 - dir2 * nch, p2 = 32 * c2 + tt; hg_load(P, Z, LOGF, (size_t)(mbase + (dir2 ? (n - 1 - p2) : p2)), dir2, hd, d0); }
            }
            asm volatile("s_waitcnt lgkmcnt(0)" ::: "memory"); __builtin_amdgcn_s_barrier(); asm volatile("" ::: "memory");
        }
    } else {
        const int r = lane & 31, h = lane >> 5, h512 = 512 * h;
        f32x16 S[4];
        if (lat) {
            const float* sp = a.state + ((((size_t)b * 4 + l) * 2 + 0) * 8 + hd) * 16384 + 32 * w4 + r;
#pragma unroll
            for (int dt = 0; dt < 4; ++dt)
#pragma unroll
                for (int i = 0; i < 16; ++i) S[dt][i] = sp[(32 * dt + (i & 3) + 8 * (i >> 2)) * 128 + h512];
        } else {
#pragma unroll
            for (int dt = 0; dt < 4; ++dt)
#pragma unroll
                for (int i = 0; i < 16; ++i) S[dt][i] = 0.f;
        }
        asm volatile("s_waitcnt lgkmcnt(0)" ::: "memory"); __builtin_amdgcn_s_barrier(); asm volatile("" ::: "memory");
#pragma unroll 1
        for (int g = 0; g < ng; ++g) {
            const int dir = (g >= nch), c = g - dir * nch;
            if (g == nch) {
                if (!lat) {
                    float* so = a.out + OUT_S + ((((size_t)b * 4 + l) * 2 + 0) * 8 + hd) * 16384 + 32 * w4 + r;
#pragma unroll
                    for (int dt = 0; dt < 4; ++dt)
#pragma unroll
                        for (int i = 0; i < 16; ++i) { so[(32 * dt + (i & 3) + 8 * (i >> 2)) * 128 + h512] = S[dt][i]; S[dt][i] = 0.f; }
                } else {
                    const float* sp = a.state + ((((size_t)b * 4 + l) * 2 + 1) * 8 + hd) * 16384 + 32 * w4 + r;
#pragma unroll
                    for (int dt = 0; dt < 4; ++dt)
#pragma unroll
                        for (int i = 0; i < 16; ++i) S[dt][i] = sp[(32 * dt + (i & 3) + 8 * (i >> 2)) * 128 + h512];
                }
            }
            hg_mstep(S, base + (g & 1) * HG_BUF, lane, w4, (float*)(a.ws + (dir ? WS_OB : WS_OF)), c, n, dir, mbase, hd);
            asm volatile("s_waitcnt lgkmcnt(0)" ::: "memory"); __builtin_amdgcn_s_barrier(); asm volatile("" ::: "memory");
        }
        if (!lat) {
            float* so = a.out + OUT_S + ((((size_t)b * 4 + l) * 2 + 1) * 8 + hd) * 16384 + 32 * w4 + r;
#pragma unroll
            for (int dt = 0; dt < 4; ++dt)
#pragma unroll
                for (int i = 0; i < 16; ++i) so[(32 * dt + (i & 3) + 8 * (i >> 2)) * 128 + h512] = S[dt][i];
        }
    }
    __syncthreads();
    {
        const float* OFp = (const float*)(a.ws + WS_OF); const float* OBp = (const float*)(a.ws + WS_OB);
        const int e16 = 16 * (F.tid & 7);
        for (int t0 = 0; t0 < n; t0 += 64) {
            const size_t m = (size_t)(mbase + t0 + (F.tid >> 3));
            float o[16]; float ss = 0.f;
#pragma unroll
            for (int j = 0; j < 4; ++j) { const f32x4 p = *((const f32x4*)(OFp + m * 1024 + hd * 128 + e16) + j), qv = *((const f32x4*)(OBp + m * 1024 + hd * 128 + e16) + j);
                const f32x4 sv = p + qv; o[4 * j] = sv.x; o[4 * j + 1] = sv.y; o[4 * j + 2] = sv.z; o[4 * j + 3] = sv.w; ss += (sv.x * sv.x + sv.y * sv.y) + (sv.z * sv.z + sv.w * sv.w); }
            ss += __shfl_xor(ss, 1); ss += __shfl_xor(ss, 2); ss += __shfl_xor(ss, 4);
            const float rn = 1.0f / sqrtf(ss * (1.0f / 128.0f) + EPS);
            float g0[8], g1[8];
            unpack8(*(const v4u*)(Z + m * INW + 9216 + hd * 128 + e16), g0); unpack8(*(const v4u*)(Z + m * INW + 9216 + hd * 128 + e16 + 8), g1);
            float y0[8], y1[8];
#pragma unroll
            for (int j = 0; j < 8; ++j) { y0[j] = o[j] * rn * g0[j]; y1[j] = o[8 + j] * rn * g1[j]; }
            *(v4u*)(Y + m * YW + 2048 + hd * 128 + e16) = pack8(y0); *(v4u*)(Y + m * YW + 2048 + hd * 128 + e16 + 8) = pack8(y1);
        }
    }
    __syncthreads();
}

__device__ __forceinline__ const Args* args_ptr() { unsigned long long p = (unsigned long long)__builtin_amdgcn_kernarg_segment_ptr(); asm volatile("" : "+s"(p)); return (const Args*)(const void __attribute__((address_space(4)))*)p; }
__device__ __forceinline__ Ctx make_ctx() {
    Ctx F; int t = threadIdx.x; asm volatile("" : "+v"(t));
    unsigned z = 0; asm volatile("" : "+s"(z));
    F.lds = (LAS unsigned char*)(uintptr_t)z;
    F.tid = t; F.lane = t & 63; F.wave = __builtin_amdgcn_readfirstlane(t >> 6);
    F.G = gridDim.x; { const int bx = blockIdx.x; F.vcu = (F.G % 8 == 0) ? (bx % 8) * (F.G / 8) + bx / 8 : bx; }
    return F;
}
constexpr int NU_CV = 400, NU_HL = 16, NU_AL = 256, NU_HC = 256, NU_AC = 256, NU_A = 640, NU_M1 = NU_HL + NU_AL + NU_HC + NU_AC + NU_A;
#ifndef PROBE_UT
#define PROBE_UT (-1)
#endif
__device__ __forceinline__ void phase_mixers(int l, int qslot) {
    for (;;) {
        int u;
        {   const Args& a = *args_ptr(); const Ctx F = make_ctx();
            unsigned* head = (unsigned*)(a.ws + WS_CTL) + CW_Q + 64 * qslot;
            volatile LAS unsigned* bc = (volatile LAS unsigned*)(F.lds + LDSCTL_OFF) + 4;
            __syncthreads();
            if (F.tid == 0) bc[0] = __hip_atomic_fetch_add(head, 1u, __ATOMIC_RELAXED, __HIP_MEMORY_SCOPE_AGENT);
            __syncthreads();
            u = (int)bc[0]; }
        u = __builtin_amdgcn_readfirstlane(u);
        if (u >= NU_M1) {
            const int cu = u - NU_M1;
            if (l >= DEPTH - 1 || cu >= NU_CV) break;
            const Args& a = *args_ptr(); const Ctx F = make_ctx();
            LAS float* scr = (LAS float*)(F.lds + F.wave * 16640);
            for (int k = 0; k < 6; ++k) cvt_layer_item(a, l + 1, cu * 48 + k * 8 + F.wave, scr, F.lane);
            continue;
        }
        if (u < NU_HL) { for (int rr = 0; rr < (PROBE_UT == 0 ? 2 : 1); ++rr) { const Args& a = *args_ptr(); const Ctx F = make_ctx(); unitHgrn(a, F, l, true, u >> 3, u & 7); } continue; }
        u -= NU_HL;
        if (u < NU_AL) { for (int rr = 0; rr < (PROBE_UT == 1 ? 2 : 1); ++rr) { const Args& a = *args_ptr(); const Ctx F = make_ctx(); unitAttnLat(a, F, l, u); } continue; }
        u -= NU_AL;
        if (u < NU_HC) { for (int rr = 0; rr < (PROBE_UT == 2 ? 2 : 1); ++rr) { const Args& a = *args_ptr(); const Ctx F = make_ctx(); unitHgrn(a, F, l, false, u >> 3, u & 7); } continue; }
        u -= NU_HC;
        if (u < NU_AC) { for (int rr = 0; rr < (PROBE_UT == 3 ? 2 : 1); ++rr) { const Args& a = *args_ptr(); const Ctx F = make_ctx(); unitAttnCtx(a, F, u); } continue; }
        u -= NU_AC;
        for (int rr = 0; rr < (PROBE_UT == 4 ? 2 : 1); ++rr) { const Args& a = *args_ptr(); const Ctx F = make_ctx(); unitA(a, F, l, u); }
    }
}

__global__ void __launch_bounds__(NTHR, 2) fwd(Args a_in) {
    extern __shared__ __attribute__((aligned(16))) unsigned char lds_raw[];
    volatile LAS unsigned* MISC = (volatile LAS unsigned*)((LAS unsigned char*)lds_raw + LDSCTL_OFF);
    for (int u = threadIdx.x; u < 256; u += NTHR) MISC[u] = 0u;
    __syncthreads();
    const int lo = a_in.ph_lo, hi = a_in.ph_hi;
    const bool multi = (hi - lo) > 1;
    XcdBarrier bar; bar.bar = (unsigned*)(a_in.ws + WS_CTL) + CW_BAR; bar.x = 0; bar.st = MISC;
    if (multi) bar = xcd_barrier_post((unsigned*)(a_in.ws + WS_CTL) + CW_BAR, MISC);
#ifndef PMASK
#define PMASK 0xFFFFFFFFu
#endif
#define PM(b) ((PMASK >> (b)) & 1u)
#define IN(k) (lo <= (k) && (k) < hi)
#define SEAM(k) do { if (IN(k) && IN((k) + 1)) xcd_barrier(bar); } while (0)
#ifndef PROBE_P
#define PROBE_P (-1)
#define PROBE_N 0
#define PROBE_L 1
#endif
#define REP_BEGIN(k) for (int rep = 0; rep < ((PROBE_P == (k) && l == PROBE_L) ? 1 + PROBE_N : 1); ++rep) {
#define REP_END(k) if (PROBE_P == (k) && l == PROBE_L && rep < PROBE_N) xcd_barrier(bar); }

    if (PM(0) && IN(PH_PRO)) { const int l = PROBE_L; REP_BEGIN(0) const Args& a = *args_ptr(); const Ctx F = make_ctx(); phase_prologue(a, F); REP_END(0) SEAM(PH_PRO); }
    if (PM(1) && IN(PH_T1)) { const int l = PROBE_L; REP_BEGIN(1) const Args& a = *args_ptr(); const Ctx F = make_ctx(); const float* MOD = (const float*)(a.ws + WS_MOD);
        rownorm_phase(a, F, true, nullptr, nullptr, nullptr, true, a.norm_g + 0, MOD + 1 * 2048, MOD + 0 * 2048); REP_END(1) SEAM(PH_T1); }

    for (int l = 0; l < DEPTH; ++l) {
        const int pb = PH_L0 + l * PH_PER_LAYER;
        if (PM(2) && IN(pb + 0)) { REP_BEGIN(2)
            const Args& a = *args_ptr(); const Ctx F = make_ctx(); unsigned char* ws = a.ws; const bf16* wl = (const bf16*)(ws + WS_WT) + (size_t)l * WL_ELEMS;
            pg8::Gemm g{(const bf16*)(ws + WS_H), wl + OFF_IN, MTOK, INW, DM, DM, DM, 0}; pg8::StaticOrder S; S.init(MTOK, INW, F.G, (int)blockIdx.x);
            EpiIn E{(bf16*)(ws + WS_Z), (float*)(ws + WS_LOGF), (const float*)(ws + WS_LB) + l * 1024, a.out + OUT_K + (size_t)l * 262144, a.out + OUT_V + (size_t)l * 262144};
            pg8::gemm_phase<EpiIn, pg8::StaticOrder, true, true>(F.lds, g, S, E);
            REP_END(2) SEAM(pb + 0);
        }
        if (PM(3) && IN(pb + 1)) { REP_BEGIN(3) phase_mixers(l, l + 4 * rep); REP_END(3) SEAM(pb + 1); }
        if (PM(5) && IN(pb + 3)) { REP_BEGIN(5)
            const Args& a = *args_ptr(); const Ctx F = make_ctx(); unsigned char* ws = a.ws; const bf16* wl = (const bf16*)(ws + WS_WT) + (size_t)l * WL_ELEMS;
            pg8::StaticOrder S; S.init(MTOK, DM, F.G, (int)blockIdx.x);
            pg8::Gemm g{(const bf16*)(ws + WS_Y), wl + OFF_UP, MTOK, DM, YW, YW, YW, 0}; EpiUpK E{(const bf16*)(ws + WS_Z) + 10240, (bf16*)(ws + WS_MG)};
            pg8::gemm_phase<EpiUpK, pg8::StaticOrder, true, true>(F.lds, g, S, E);
            REP_END(5) SEAM(pb + 3);
        }
        if (PM(6) && IN(pb + 4)) { REP_BEGIN(6)
            {   const Args& a = *args_ptr(); const Ctx F = make_ctx(); unsigned char* ws = a.ws; const bf16* wl = (const bf16*)(ws + WS_WT) + (size_t)l * WL_ELEMS;
                pg8::Gemm g{(const bf16*)(ws + WS_MG), wl + OFF_OUT, NCTX, DM, DM, DM, DM, 0}; pg8::StaticOrder S; S.init(NCTX, DM, F.G, (int)blockIdx.x);
                EpiBf16P E{(bf16*)(ws + WS_T), DM, 0}; pg8::gemm_phase<EpiBf16P, pg8::StaticOrder, true, true>(F.lds, g, S, E); }
            {   const Args& a = *args_ptr(); const Ctx F = make_ctx(); unsigned char* ws = a.ws; const bf16* wl = (const bf16*)(ws + WS_WT) + (size_t)l * WL_ELEMS;
                pg8::Gemm g{(const bf16*)(ws + WS_MG) + (size_t)NCTX * DM, wl + OFF_OUT, NLAT, DM, DM / 4, DM, DM, (DM / 4) * 2}; pg8::SplitOrder S; S.init(F.G, (int)blockIdx.x);
                EpiBf16P E{(bf16*)(ws + WS_TP), DM, TPQ}; pg8::gemm_phase<EpiBf16P, pg8::SplitOrder, true, true>(F.lds, g, S, E); }
            REP_END(6) SEAM(pb + 4);
        }
        if (PM(7) && IN(pb + 5)) { REP_BEGIN(7) const Args& a = *args_ptr(); const Ctx F = make_ctx(); const float* modl = (const float*)(a.ws + WS_MOD) + (size_t)l * 3 * 12288; const float* gl = a.norm_g + (size_t)l * 4 * DM;
            rownorm_phase(a, F, false, (const bf16*)(a.ws + WS_T), modl + 2 * 2048, gl + 1 * DM, true, gl + 2 * DM, modl + 4 * 2048, modl + 3 * 2048); REP_END(7) SEAM(pb + 5); }
        if (PM(8) && IN(pb + 6)) { REP_BEGIN(8)
            const Args& a = *args_ptr(); const Ctx F = make_ctx(); unsigned char* ws = a.ws; const bf16* wl = (const bf16*)(ws + WS_WT) + (size_t)l * WL_ELEMS;
            pg8::Gemm g{(const bf16*)(ws + WS_H), wl + OFF_FI, MTOK, NFI, DM, DM, DM, 0}; pg8::StaticOrder S; S.init(MTOK, NFI, F.G, (int)blockIdx.x);
            EpiSwi E{(bf16*)(ws + WS_ACT)}; pg8::gemm_phase<EpiSwi, pg8::StaticOrder, true, true>(F.lds, g, S, E);
            REP_END(8) SEAM(pb + 6);
        }
        if (PM(9) && IN(pb + 7)) { REP_BEGIN(9)
            {   const Args& a = *args_ptr(); const Ctx F = make_ctx(); unsigned char* ws = a.ws; const bf16* wl = (const bf16*)(ws + WS_WT) + (size_t)l * WL_ELEMS;
                pg8::Gemm g{(const bf16*)(ws + WS_ACT), wl + OFF_FO, NCTX, DM, DFF, DFF, DFF, 0}; pg8::StaticOrder S; S.init(NCTX, DM, F.G, (int)blockIdx.x);
                EpiBf16P E{(bf16*)(ws + WS_T), DM, 0}; pg8::gemm_phase<EpiBf16P, pg8::StaticOrder, true, true>(F.lds, g, S, E); }
            {   const Args& a = *args_ptr(); const Ctx F = make_ctx(); unsigned char* ws = a.ws; const bf16* wl = (const bf16*)(ws + WS_WT) + (size_t)l * WL_ELEMS;
                pg8::Gemm g{(const bf16*)(ws + WS_ACT) + (size_t)NCTX * DFF, wl + OFF_FO, NLAT, DM, DFF / 4, DFF, DFF, (DFF / 4) * 2}; pg8::SplitOrder S; S.init(F.G, (int)blockIdx.x);
                EpiBf16P E{(bf16*)(ws + WS_TP), DM, TPQ}; pg8::gemm_phase<EpiBf16P, pg8::SplitOrder, true, true>(F.lds, g, S, E); }
            REP_END(9) SEAM(pb + 7);
        }
        if (PM(10) && IN(pb + 8)) { REP_BEGIN(10)
            const Args& a = *args_ptr(); const Ctx F = make_ctx(); const float* MOD = (const float*)(a.ws + WS_MOD);
            const bool last = (l == DEPTH - 1); const int ln = last ? l : l + 1;
            const float* modl = MOD + (size_t)l * 3 * 12288; const float* gl = a.norm_g + (size_t)l * 4 * DM;
            const float* modn = MOD + (size_t)ln * 3 * 12288; const float* gnn = a.norm_g + (size_t)ln * 4 * DM;
            rownorm_phase(a, F, false, (const bf16*)(a.ws + WS_T), modl + 5 * 2048, gl + 3 * DM, !last, gnn + 0, modn + 1 * 2048, modn + 0 * 2048);
            REP_END(10) SEAM(pb + 8);
        }
    }
#undef IN
#undef SEAM
#undef REP_BEGIN
#undef REP_END
}

#ifndef MK_ONE_LAUNCH
#define MK_ONE_LAUNCH 1
#endif
extern "C" void kernel_launch(void* const* d_in, const int* in_sizes, int n_in, void* d_out, int out_size, void* d_ws, size_t ws_size, hipStream_t stream) {
    static int grid = 0;
    if (grid == 0) {
        if (n_in != 21 || (size_t)out_size != OUT_END || ws_size < WS_END) { fprintf(stderr, "kernel_launch: unexpected shapes: n_in %d out %d ws %zu\n", n_in, out_size, ws_size); grid = -1; return; }
        int dev = 0, cus = 0, per_cu = 0;
        if (hipGetDevice(&dev) != hipSuccess || hipDeviceGetAttribute(&cus, hipDeviceAttributeMultiprocessorCount, dev) != hipSuccess) { grid = -1; return; }
        if (hipFuncSetAttribute((const void*)fwd, hipFuncAttributeMaxDynamicSharedMemorySize, LDS_BYTES) != hipSuccess) { fprintf(stderr, "kernel_launch: hipFuncSetAttribute failed\n"); grid = -1; return; }
        if (hipOccupancyMaxActiveBlocksPerMultiprocessor(&per_cu, (const void*)fwd, NTHR, LDS_BYTES) != hipSuccess || per_cu < 1) fprintf(stderr, "kernel_launch: occupancy query says %d\n", per_cu);
        (void)hipGetLastError();
        grid = cus;
    }
    if (grid < 0) return;
    (void)hipMemsetAsync((char*)d_ws + WS_CTL, 0, CTL_ZERO_BYTES, stream);
    Args a{};
    const float** ap = (const float**)&a;
    for (int i = 0; i < 21; ++i) ap[i] = (const float*)d_in[i];
    a.out = (float*)d_out; a.ws = (unsigned char*)d_ws;
#if MK_ONE_LAUNCH
    a.ph_lo = 0; a.ph_hi = PH_END;
    hipLaunchKernelGGL(fwd, dim3(grid), dim3(NTHR), LDS_BYTES, stream, a);
#else
    for (int p = 0; p < PH_END; ++p) { a.ph_lo = p; a.ph_hi = p + 1; hipLaunchKernelGGL(fwd, dim3(grid), dim3(NTHR), LDS_BYTES, stream, a); }
#endif
}
```

```cpp
#include <hip/hip_runtime.h>
#include <cstdio>
#include <cstdint>
namespace pg8 {
#define PG8_LAS __attribute__((address_space(3)))
typedef unsigned short bf16_t;
typedef short bf16x8 __attribute__((ext_vector_type(8)));
typedef float f32x4 __attribute__((ext_vector_type(4)));
typedef unsigned u32x4 __attribute__((ext_vector_type(4)));
constexpr int BM = 256, BK = 64, HALF = 128, HTB = HALF * BK * 2  , STAGE_BYTES = 8 * HTB, NXCD = 8, WGM = 8;

__host__ __device__ __forceinline__ int lds_byte(int r, int c) { const int st = (r >> 4) * 2 + (c >> 5), rr = r & 15, cc = c & 31, ob = rr * 64 + cc * 2; return st * 1024 + (ob ^ (((ob >> 9) & 1) << 5)); }
__host__ __device__ __forceinline__ void stage_rc(int b, int& R, int& C) { const int st = b / 1024, sb = b % 1024, swz = sb ^ (((sb >> 9) & 1) << 5); R = (st >> 1) * 16 + swz / 64; C = (st & 1) * 32 + (swz % 64) / 2; }
__host__ __device__ __forceinline__ int perm32(int rho) { const int n = rho >> 4, i = rho & 15; return 8 * (i >> 2) + 4 * n + (i & 3); }

struct Unit { int pm, pn, kq; };
struct SplitOrder {
    int G, c;
    __host__ __device__ void init(int G_, int c_) { G = G_; c = c_; }
    __host__ __device__ bool next(int i, Unit& u) const { const long L = (long)i * G + c; if (L >= 256) return false; const int t = (int)L >> 2; u.kq = (int)L & 3; u.pm = t & 7; u.pn = t >> 3; return true; }
    __device__ __forceinline__ void a_ready(const Unit&) const {}
    __device__ __forceinline__ void done(const Unit&) const {}
};
struct Gemm { const bf16_t* A; const bf16_t* Bt; int M, N, K, lda, ldb, koff; };

struct StaticOrder {
    int nM, nN, nwg, G, c;
    __host__ __device__ void init(int M, int N, int G_, int c_) { nM = M / BM; nN = N / BM; nwg = nM * nN; G = G_; c = c_; }
    __host__ __device__ bool next(int i, Unit& u) const {
        const long L = (long)i * G + c; if (L >= nwg) return false;
        int wgid = (int)L; { const int q = nwg / NXCD, r = nwg % NXCD, xcd = wgid % NXCD, off = wgid / NXCD; wgid = (xcd < r ? xcd * (q + 1) : r * (q + 1) + (xcd - r) * q) + off; }
        const int nig = WGM * nN, gid = wgid / nig, fm = gid * WGM, gsz = (nM - fm) < WGM ? (nM - fm) : WGM;
        u.pm = fm + ((wgid % nig) % gsz); u.pn = (wgid % nig) / gsz; u.kq = 0; return true;
    }
    __device__ __forceinline__ void a_ready(const Unit&) const {}
    __device__ __forceinline__ void done(const Unit&) const {}
};
template <class Epi, class Sched, bool ALIGN_EPI = false, bool SP2 = false>
__device__ __forceinline__ void gemm_phase(PG8_LAS unsigned char* lds, const Gemm g, const Sched& S, const Epi& E) {
    int tid_ = threadIdx.x; asm volatile("" : "+v"(tid_));
    const int tid = tid_, wid = __builtin_amdgcn_readfirstlane(tid >> 6), lane = tid & 63, wr = wid >> 2, wc = wid & 3, fr = lane & 15, fq = lane >> 4;
    const int K = g.K, nt = K / BK;
    unsigned voffA[2], voffB[2];
#pragma unroll
    for (int i = 0; i < 2; ++i) { int R, C; stage_rc(tid * 16 + i * 8192, R, C); const int Rb = Epi::PERM ? ((R & ~31) + perm32(R & 31)) : R;
        voffA[i] = (unsigned)(R * g.lda + C) * 2u; voffB[i] = (unsigned)(Rb * g.ldb + C) * 2u; }
    const size_t kstep = (size_t)(BK * 2);
    const size_t hstepA = (size_t)HALF * g.lda * 2, hstepB = (size_t)HALF * g.ldb * 2;
    const size_t tstepA = 2 * hstepA, tstepB = 2 * hstepB;
    const unsigned ldsw = (unsigned)wid * 1024u;
    const int aoff = lds_byte(wr * 64 + fr, fq * 8), boff = lds_byte(wc * 32 + fr, fq * 8);
#define PG8_SA(b, h) (((b) * 2 + (h)) * HTB)
#define PG8_SB(b, h) ((4 + (b) * 2 + (h)) * HTB)
#define PG8_STAGE(bufoff, gbase, voff) do { _Pragma("unroll") for (int _i = 0; _i < 2; ++_i) \
        __builtin_amdgcn_global_load_lds((const unsigned*)((const char*)(gbase) + (voff)[_i]), (PG8_LAS unsigned*)(lds + (bufoff) + ldsw + _i * 8192), 16, 0, 0); } while (0)
#define PG8_LDA(dst, b, h) do { _Pragma("unroll") for (int m = 0; m < 4; ++m) _Pragma("unroll") for (int k = 0; k < 2; ++k) dst[m][k] = *(const PG8_LAS bf16x8*)(lds + PG8_SA(b, h) + aoff + m * 2048 + k * 1024); } while (0)
#define PG8_LDB(dst, b, h) do { _Pragma("unroll") for (int n = 0; n < 2; ++n) _Pragma("unroll") for (int k = 0; k < 2; ++k) dst[n][k] = *(const PG8_LAS bf16x8*)(lds + PG8_SB(b, h) + boff + n * 2048 + k * 1024); } while (0)
#define PG8_MMA(ai, bj, At, Bt) do { __builtin_amdgcn_s_setprio(1); _Pragma("unroll") for (int m = 0; m < 4; ++m) _Pragma("unroll") for (int n = 0; n < 2; ++n) _Pragma("unroll") for (int k = 0; k < 2; ++k) \
        acc[ai][bj][m][n] = __builtin_amdgcn_mfma_f32_16x16x32_bf16(Bt[n][k], At[m][k], acc[ai][bj][m][n], 0, 0, 0); __builtin_amdgcn_s_setprio(0); } while (0)
#define PG8_WAIT_V(n) asm volatile("s_waitcnt vmcnt(" #n ")" ::: "memory")
#define PG8_WAIT_L(n) asm volatile("s_waitcnt lgkmcnt(" #n ")" ::: "memory")
#define PG8_BAR __builtin_amdgcn_s_barrier()
#define PG8_SCHED __builtin_amdgcn_sched_barrier(0)
    Unit cur, nxt; int ui = 0;
    if (!S.next(0, cur)) return;
    f32x4 acc[2][2][4][2];
#pragma unroll
    for (int a = 0; a < 2; ++a)
#pragma unroll
        for (int b = 0; b < 2; ++b)
#pragma unroll
            for (int m = 0; m < 4; ++m)
#pragma unroll
                for (int n = 0; n < 2; ++n) acc[a][b][m][n] = (f32x4){0.f, 0.f, 0.f, 0.f};
    bf16x8 At[4][2], B0[2][2], B1[2][2];
    const char* cA = (const char*)g.A + (size_t)cur.pm * tstepA + (size_t)cur.kq * g.koff; const char* cB = (const char*)g.Bt + (size_t)cur.pn * tstepB + (size_t)cur.kq * g.koff;
    S.a_ready(cur);
    if constexpr (SP2) {
        PG8_STAGE(PG8_SB(0, 0), cB, voffB); PG8_STAGE(PG8_SB(0, 1), cB + hstepB, voffB); PG8_STAGE(PG8_SA(0, 0), cA, voffA); PG8_STAGE(PG8_SA(0, 1), cA + hstepA, voffA);
        if (wr == 1) PG8_BAR;
        PG8_WAIT_V(2); PG8_BAR;
        PG8_STAGE(PG8_SB(1, 0), cB + kstep, voffB); PG8_STAGE(PG8_SA(1, 0), cA + kstep, voffA); PG8_STAGE(PG8_SB(1, 1), cB + hstepB + kstep, voffB);
        PG8_WAIT_V(6); PG8_BAR;
    } else {
        PG8_STAGE(PG8_SB(0, 0), cB, voffB); PG8_STAGE(PG8_SA(0, 0), cA, voffA); PG8_STAGE(PG8_SB(0, 1), cB + hstepB, voffB); PG8_STAGE(PG8_SA(0, 1), cA + hstepA, voffA);
        if (wr == 1) PG8_BAR;
        PG8_WAIT_V(4); PG8_BAR;
        PG8_STAGE(PG8_SB(1, 0), cB + kstep, voffB); PG8_STAGE(PG8_SA(1, 0), cA + kstep, voffA); PG8_STAGE(PG8_SB(1, 1), cB + hstepB + kstep, voffB);
        PG8_WAIT_V(6); PG8_BAR;
    }
    for (;;) {
        const bool has_next = S.next(ui + 1, nxt);
        const char* nA = has_next ? (const char*)g.A + (size_t)nxt.pm * tstepA + (size_t)nxt.kq * g.koff : cA; const char* nB = has_next ? (const char*)g.Bt + (size_t)nxt.pn * tstepB + (size_t)nxt.kq * g.koff : cB;
        for (int t = 0; t < nt; t += 2) {
            const bool last = (t == nt - 2);
            const char* a1 = cA + (size_t)(t + 1) * kstep;
            const char* a2 = last ? nA : cA + (size_t)(t + 2) * kstep; const char* b2 = last ? nB : cB + (size_t)(t + 2) * kstep;
            const char* a3 = a2 + kstep; const char* b3 = b2 + kstep;
            if (last && has_next) S.a_ready(nxt);
            if constexpr (Epi::HOOK) { if (t == Epi::H1 || t == Epi::H2) E.hook(acc, cur, t, wr, wc, fr, fq); }
            if constexpr (SP2) {
            PG8_LDB(B0, 0, 0); PG8_LDB(B1, 0, 1); PG8_SCHED; PG8_LDA(At, 0, 0); PG8_STAGE(PG8_SA(1, 1), a1 + hstepA, voffA);
            PG8_WAIT_V(8); PG8_WAIT_L(0); PG8_BAR; PG8_MMA(0, 0, At, B0); PG8_MMA(0, 1, At, B1); PG8_BAR; PG8_SCHED;
            PG8_LDA(At, 0, 1); PG8_STAGE(PG8_SB(0, 0), b2, voffB); PG8_STAGE(PG8_SB(0, 1), b2 + hstepB, voffB); PG8_STAGE(PG8_SA(0, 0), a2, voffA);
            PG8_WAIT_V(8); PG8_WAIT_L(0); PG8_BAR; PG8_MMA(1, 0, At, B0); PG8_MMA(1, 1, At, B1); PG8_BAR; PG8_SCHED;
            PG8_LDB(B0, 1, 0); PG8_LDB(B1, 1, 1); PG8_SCHED; PG8_LDA(At, 1, 0); PG8_STAGE(PG8_SA(0, 1), a2 + hstepA, voffA);
            PG8_WAIT_V(8); PG8_WAIT_L(0); PG8_BAR; PG8_MMA(0, 0, At, B0); PG8_MMA(0, 1, At, B1); PG8_BAR; PG8_SCHED;
            PG8_LDA(At, 1, 1); PG8_STAGE(PG8_SB(1, 0), b3, voffB); PG8_STAGE(PG8_SB(1, 1), b3 + hstepB, voffB); PG8_STAGE(PG8_SA(1, 0), a3, voffA);
            PG8_WAIT_V(8); PG8_WAIT_L(0); PG8_BAR; PG8_MMA(1, 0, At, B0); PG8_MMA(1, 1, At, B1); PG8_BAR; PG8_SCHED;
            } else {
            PG8_LDB(B0, 0, 0); PG8_SCHED; PG8_LDA(At, 0, 0); PG8_STAGE(PG8_SA(1, 1), a1 + hstepA, voffA);
            PG8_WAIT_L(8); PG8_BAR; PG8_WAIT_L(0); PG8_MMA(0, 0, At, B0); PG8_BAR; PG8_SCHED;
            PG8_LDB(B1, 0, 1); PG8_STAGE(PG8_SB(0, 0), b2, voffB);
            PG8_BAR; PG8_WAIT_L(0); PG8_MMA(0, 1, At, B1); PG8_BAR;
            PG8_LDA(At, 0, 1); PG8_STAGE(PG8_SA(0, 0), a2, voffA);
            PG8_BAR; PG8_WAIT_L(0); PG8_MMA(1, 0, At, B0); PG8_BAR; PG8_SCHED;
            PG8_STAGE(PG8_SB(0, 1), b2 + hstepB, voffB);
            PG8_WAIT_V(6); PG8_BAR; PG8_MMA(1, 1, At, B1); PG8_BAR;
            PG8_LDB(B0, 1, 0); PG8_SCHED; PG8_LDA(At, 1, 0); PG8_STAGE(PG8_SA(0, 1), a2 + hstepA, voffA);
            PG8_WAIT_L(8); PG8_BAR; PG8_WAIT_L(0); PG8_MMA(0, 0, At, B0); PG8_BAR; PG8_SCHED;
            PG8_LDB(B1, 1, 1); PG8_STAGE(PG8_SB(1, 0), b3, voffB);
            PG8_BAR; PG8_WAIT_L(0); PG8_MMA(0, 1, At, B1); PG8_BAR;
            PG8_LDA(At, 1, 1); PG8_STAGE(PG8_SA(1, 0), a3, voffA);
            PG8_BAR; PG8_WAIT_L(0); PG8_MMA(1, 0, At, B0); PG8_BAR; PG8_SCHED;
            PG8_STAGE(PG8_SB(1, 1), b3 + hstepB, voffB);
            PG8_WAIT_V(6); PG8_BAR; PG8_MMA(1, 1, At, B1); PG8_BAR;
            }
        }
        if constexpr (ALIGN_EPI) { if (wr == 0) PG8_BAR; }
        if constexpr (!Epi::AFTER_DRAIN) { E(acc, cur, wr, wc, fr, fq); S.done(cur); }
        if (!has_next) break;
#pragma unroll
        for (int a = 0; a < 2; ++a)
#pragma unroll
            for (int b = 0; b < 2; ++b)
#pragma unroll
                for (int m = 0; m < 4; ++m)
#pragma unroll
                    for (int n = 0; n < 2; ++n) acc[a][b][m][n] = (f32x4){0.f, 0.f, 0.f, 0.f};
        cur = nxt; cA = nA; cB = nB; ++ui;
        if constexpr (ALIGN_EPI) { if (wr == 1) PG8_BAR; }
    }
    PG8_WAIT_V(0);
    if constexpr (!ALIGN_EPI) { if (wr == 0) PG8_BAR; }
    PG8_BAR;
    if constexpr (Epi::AFTER_DRAIN) { E.fused(acc, cur, wr, wc, fr, fq, lds, wid, lane); S.done(cur); }
#undef PG8_SA
#undef PG8_SB
#undef PG8_STAGE
#undef PG8_LDA
#undef PG8_LDB
#undef PG8_MMA
#undef PG8_WAIT_V
#undef PG8_WAIT_L
#undef PG8_BAR
#undef PG8_SCHED
}
}

#define GAS __attribute__((address_space(1)))
#define LAS __attribute__((address_space(3)))
typedef unsigned short bf16;
typedef unsigned v4u __attribute__((ext_vector_type(4)));
typedef unsigned v2u __attribute__((ext_vector_type(2)));
typedef float f32x4 __attribute__((ext_vector_type(4)));

constexpr int DM = 2048, NCTX = 8192, NLAT = 2048, MTOK = 10240, DEPTH = 4;
constexpr int INW = 16384, DFF = 5632, NFI = 11264, YW = 3072;
constexpr float EPS = 1e-6f;
constexpr int NWAVES = 8, NTHR = 512;

constexpr size_t MiB = 1u << 20;
constexpr size_t WS_CTL = 0, CTL_ZERO_BYTES = 1 * MiB;
constexpr size_t WS_MOD = 1 * MiB;
constexpr size_t WS_LB = 2 * MiB;
constexpr size_t WS_ROPE = 2 * MiB + 65536;
constexpr size_t WS_WT = 4 * MiB;
constexpr size_t WL_ELEMS = 78643200;
constexpr size_t OFF_IN = 0, OFF_UP = 33554432, OFF_OUT = 39845888, OFF_FI = 44040192, OFF_FO = 67108864;
constexpr size_t WS_Z = 604 * MiB;
constexpr size_t WS_LOGF = 924 * MiB;
constexpr size_t WS_H = 1004 * MiB;
constexpr size_t WS_Y = 1044 * MiB;
constexpr size_t WS_OF = 1104 * MiB;
constexpr size_t WS_OB = 1144 * MiB;
constexpr size_t WS_TP = 1184 * MiB;
constexpr size_t TPQ = 2048 * 2048;
constexpr size_t WS_MG = 1264 * MiB;
constexpr size_t WS_T = 1304 * MiB;
constexpr size_t WS_ACT = 1384 * MiB;
constexpr size_t WS_END = 1494 * MiB;
constexpr int CW_BAR = 4096;
constexpr int CW_Q = 16384;
constexpr size_t OUT_Y = 0, OUT_K = 20971520, OUT_V = OUT_K + 33554432, OUT_S = OUT_V + 33554432, OUT_END = OUT_S + 33554432;

constexpr int LDS_BYTES = 155648;
constexpr int LDSCTL_OFF = 154624;

constexpr int PH_PRO = 0, PH_T1 = 1, PH_L0 = 2, PH_PER_LAYER = 9, PH_END = PH_L0 + DEPTH * PH_PER_LAYER;

struct Args {
    const float *x_prompt, *x_sample, *cache_k, *cache_v, *state, *c, *c_ctx, *w_ada, *b_ada, *norm_g, *w_in, *a_w, *a_b, *rpb, *lb_logits, *w_up_a, *w_up_b, *w_up_c, *w_out, *w_fi, *w_fo;
    float* out; unsigned char* ws; int ph_lo, ph_hi;
};

__device__ __forceinline__ float bf2f_lo(unsigned w) { return __uint_as_float(w << 16); }
__device__ __forceinline__ float bf2f_hi(unsigned w) { return __uint_as_float(w & 0xffff0000u); }
__device__ __forceinline__ unsigned f2bf(float f) { unsigned u = __float_as_uint(f); return (u + 0x7fffu + ((u >> 16) & 1u)) >> 16; }
typedef __bf16 bf16x2_t __attribute__((ext_vector_type(2)));
typedef float f32x2_t __attribute__((ext_vector_type(2)));
__device__ __forceinline__ unsigned cvtpk(float lo, float hi) { const f32x2_t v = {lo, hi}; return __builtin_bit_cast(unsigned, __builtin_convertvector(v, bf16x2_t)); }
__device__ __forceinline__ unsigned pk2(float lo, float hi) { return cvtpk(lo, hi); }
__device__ __forceinline__ void unpack8(const v4u w, float (&f)[8]) {
    f[0] = bf2f_lo(w.x); f[1] = bf2f_hi(w.x); f[2] = bf2f_lo(w.y); f[3] = bf2f_hi(w.y); f[4] = bf2f_lo(w.z); f[5] = bf2f_hi(w.z); f[6] = bf2f_lo(w.w); f[7] = bf2f_hi(w.w); }
__device__ __forceinline__ v4u pack8(const float (&f)[8]) { v4u w; w.x = pk2(f[0], f[1]); w.y = pk2(f[2], f[3]); w.z = pk2(f[4], f[5]); w.w = pk2(f[6], f[7]); return w; }
__device__ __forceinline__ float wave_sum(float v) {
#pragma unroll
    for (int o = 1; o < 64; o <<= 1) v += __shfl_xor(v, o);
    return v;
}
__device__ __forceinline__ float sigmoidf_(float x) { return __builtin_amdgcn_rcpf(1.0f + __builtin_amdgcn_exp2f(-1.4426950408889634f * x)); }
__device__ __forceinline__ float siluf_(float x) { return x * __builtin_amdgcn_rcpf(1.0f + __builtin_amdgcn_exp2f(-1.4426950408889634f * x)); }
__device__ __forceinline__ float gelu_tanh_(float x) { const float y = (-1.4426950408889634f * 1.5957691216057308f) * (x + 0.044715f * x * x * x); return x * __builtin_amdgcn_rcpf(1.0f + __builtin_amdgcn_exp2f(y)); }

#define XB_TMO      128
#define XB_XCNT(j)  (256  + 64 * (j))
#define XB_XSUB(j)  (1280 + 64 * (j))
#define XB_XGEN(j)  (2304 + 64 * (j))
#define XB_TOP      3328
#define XB_TOPGEN   3392
#define XCD_BAR_WORDS 3456
#define XB_SPIN_CAP (1u << 18)
__device__ __forceinline__ unsigned xb_ld(unsigned* p)              { return __hip_atomic_load(p, __ATOMIC_RELAXED, __HIP_MEMORY_SCOPE_AGENT); }
__device__ __forceinline__ unsigned xb_add(unsigned* p, unsigned v) { return __hip_atomic_fetch_add(p, v, __ATOMIC_RELAXED, __HIP_MEMORY_SCOPE_AGENT); }
__device__ __forceinline__ unsigned xb_xcc_id() { return (unsigned)__builtin_amdgcn_s_getreg((3 << 11) | 20) & 0xFu; }
#define XB_SPIN(cond, bar) do { unsigned _sp = 0; while (cond) { __builtin_amdgcn_s_sleep(1); \
    if ((++_sp & 255u) == 0u) { if (xb_ld(&(bar)[XB_TMO])) break; if (_sp > XB_SPIN_CAP) { atomicAdd(&(bar)[XB_TMO], 1u); break; } } } } while (0)
struct XcdBarrier { unsigned* bar; unsigned x; volatile LAS unsigned* st; };
__device__ __forceinline__ XcdBarrier xcd_barrier_post(unsigned* bar, volatile LAS unsigned* st) {
    XcdBarrier b; b.bar = bar; b.x = xb_xcc_id(); b.st = st;
    if (threadIdx.x == 0) (void)xb_add(&bar[XB_XCNT(b.x)], 1u);
    return b;
}
__device__ __forceinline__ void xcd_barrier_complete(unsigned* bar, unsigned x, unsigned& nloc, unsigned& nx) {
    const unsigned G = gridDim.x * gridDim.y * gridDim.z;
    unsigned sum, cnt, mine, sp = 0u;
    for (;;) {
        sum = 0u; cnt = 0u; mine = 0u;
#pragma unroll
        for (unsigned j = 0; j < 16; ++j) { const unsigned c = xb_ld(&bar[XB_XCNT(j)]); sum += c; cnt += (c > 0u) ? 1u : 0u; mine = (j == x) ? c : mine; }
        if (sum == G) break;
        __builtin_amdgcn_s_sleep(1);
        if ((++sp & 255u) == 0u) { if (xb_ld(&bar[XB_TMO])) break; if (sp > XB_SPIN_CAP) { atomicAdd(&bar[XB_TMO], 1u); break; } }
    }
    nloc = mine > 0u ? mine : 1u; nx = cnt > 0u ? cnt : 1u;
}
__device__ __forceinline__ void xcd_barrier(const XcdBarrier& b) {
    asm volatile("s_waitcnt vmcnt(0)" ::: "memory");
    __syncthreads();
    if (threadIdx.x == 0) {
        unsigned* bar = b.bar;
        __builtin_amdgcn_s_waitcnt(0);
        unsigned nloc = b.st[0], nx = b.st[1];
        if (nloc == 0u) { xcd_barrier_complete(bar, b.x, nloc, nx); b.st[0] = nloc; b.st[1] = nx; }
        const unsigned old = xb_add(&bar[XB_XSUB(b.x)], 1u);
        const unsigned gen = old / nloc;
        if (old + 1u == (gen + 1u) * nloc) {
            __builtin_amdgcn_fence(__ATOMIC_RELEASE, "agent");
            asm volatile("s_waitcnt vmcnt(0)" ::: "memory");
            const unsigned og = xb_add(&bar[XB_TOP], 1u);
            const unsigned tg = og / nx;
            if (og + 1u == (tg + 1u) * nx) xb_add(&bar[XB_TOPGEN], 1u);
            else XB_SPIN(xb_ld(&bar[XB_TOPGEN]) == tg, bar);
            __builtin_amdgcn_fence(__ATOMIC_ACQUIRE, "agent");
            xb_add(&bar[XB_XGEN(b.x)], 1u);
            asm volatile("s_waitcnt vmcnt(0)" ::: "memory");
        } else {
            XB_SPIN(xb_ld(&bar[XB_XGEN(b.x)]) == gen, bar);
            __builtin_amdgcn_fence(__ATOMIC_ACQUIRE, "agent");
            asm volatile("s_waitcnt vmcnt(0)" ::: "memory");
        }
    }
    __syncthreads();
}

struct EpiIn {
    static constexpr bool PERM = true, AFTER_DRAIN = false, HOOK = false; static constexpr int H1 = -1, H2 = -1, NST = 16;
    bf16* Z; float* LOGF; const float* lbp  ; float* outK; float* outV;
    template <int KIND>
    __device__ __forceinline__ void body(const f32x4 (&acc)[2][2][4][2], const pg8::Unit& u, int wr, int wc, int fr, int fq) const {
        const int row0 = u.pm * 256 + wr * 64 + fr, colt = u.pn * 256 + wc * 32 + 8 * fq;
        const int seg = u.pn >> 2;
#pragma unroll
        for (int ai = 0; ai < 2; ++ai)
#pragma unroll
            for (int m = 0; m < 4; ++m) {
                const int row = row0 + ai * 128 + m * 16;
                bf16* zrow = Z + (size_t)row * INW + colt;
#pragma unroll
                for (int bj = 0; bj < 2; ++bj) {
                    float v[8];
#pragma unroll
                    for (int j = 0; j < 4; ++j) { v[j] = acc[ai][bj][m][0][j]; v[4 + j] = acc[ai][bj][m][1][j]; }
                    if (KIND == 5) {
                        const int c2 = colt + bj * 128 - 6144;
                        const float* lb = lbp + (seg - 6) * 4096 + (c2 & 1023);
                        float o[8];
#pragma unroll
                        for (int j = 0; j < 8; ++j) { const float b = lb[j]; o[j] = 1.4426950408889634f * logf(b + (1.0f - b) * sigmoidf_(v[j])); }
                        float* dst = LOGF + (size_t)row * 2048 + c2;
                        *(f32x4*)dst = (f32x4){o[0], o[1], o[2], o[3]}; *(f32x4*)(dst + 4) = (f32x4){o[4], o[5], o[6], o[7]};
                    } else {
                        if (KIND == 4) {
                            if (row < NCTX) { float* dst = (seg == 3 ? outK : outV) + ((size_t)(row >> 8) * 1024 + (row & 255)) * 1024 + (colt + bj * 128 - (seg == 3 ? 3072 : 4096));
                                *(f32x4*)dst = (f32x4){v[0], v[1], v[2], v[3]}; *(f32x4*)(dst + 4) = (f32x4){v[4], v[5], v[6], v[7]}; }
                        }
                        if (KIND == 1) {
#pragma unroll
                            for (int j = 0; j < 8; ++j) v[j] = gelu_tanh_(v[j]);
                        }
                        if (KIND == 2) {
#pragma unroll
                            for (int j = 0; j < 8; ++j) v[j] = siluf_(v[j]);
                        }
                        if (KIND == 3) {
#pragma unroll
                            for (int j = 0; j < 8; ++j) v[j] = sigmoidf_(v[j]);
                        }
                        *(v4u*)(zrow + bj * 128) = pack8(v);
                    }
                }
                asm volatile("" ::: "memory");
            }
    }
    __device__ __forceinline__ void operator()(const f32x4 (&acc)[2][2][4][2], const pg8::Unit& u, int wr, int wc, int fr, int fq) const {
        const int seg = u.pn >> 2;
        if (seg >= 10) body<3>(acc, u, wr, wc, fr, fq);
        else if (seg == 0 || seg == 1) body<1>(acc, u, wr, wc, fr, fq);
        else if (seg == 5 || seg == 9) body<2>(acc, u, wr, wc, fr, fq);
        else if (seg == 3 || seg == 4) body<4>(acc, u, wr, wc, fr, fq);
        else if (seg == 6 || seg == 7) body<5>(acc, u, wr, wc, fr, fq);
        else body<0>(acc, u, wr, wc, fr, fq);
    }
};
struct EpiUpK {
    static constexpr bool PERM = true, AFTER_DRAIN = false, HOOK = true; static constexpr int H1 = 16, H2 = 32, NST = 16;
    const bf16* Zg  ; bf16* MG;
    __device__ __forceinline__ void hook(f32x4 (&acc)[2][2][4][2], const pg8::Unit& u, int t, int wr, int wc, int fr, int fq) const {
        int frl = fr, fql = fq; asm volatile("" : "+v"(frl), "+v"(fql));
        const int row0 = u.pm * 256 + wr * 64 + frl, colt = u.pn * 256 + wc * 32 + 8 * fql;
        const bf16* zn = Zg + (t == 16 ? 0 : 2048);
#pragma unroll
        for (int ai = 0; ai < 2; ++ai) {
            v4u nw[4][2], dw[4][2];
#pragma unroll
            for (int m = 0; m < 4; ++m)
#pragma unroll
                for (int bj = 0; bj < 2; ++bj) { const size_t ro = (size_t)(row0 + ai * 128 + m * 16) * INW + colt + bj * 128; nw[m][bj] = *(const v4u*)(zn + ro); dw[m][bj] = *(const v4u*)(zn + 2048 + ro); }
#pragma unroll
            for (int m = 0; m < 4; ++m)
#pragma unroll
                for (int bj = 0; bj < 2; ++bj) {
                    float gn[8], gd[8]; unpack8(nw[m][bj], gn); unpack8(dw[m][bj], gd);
#pragma unroll
                    for (int j = 0; j < 4; ++j) { acc[ai][bj][m][0][j] *= gn[j] * __builtin_amdgcn_rcpf(gd[j]); acc[ai][bj][m][1][j] *= gn[4 + j] * __builtin_amdgcn_rcpf(gd[4 + j]); }
                }
            asm volatile("" ::: "memory");
        }
    }
    __device__ __forceinline__ void operator()(const f32x4 (&acc)[2][2][4][2], const pg8::Unit& u, int wr, int wc, int fr, int fq) const {
        const int row0 = u.pm * 256 + wr * 64 + fr, colt = u.pn * 256 + wc * 32 + 8 * fq;
#pragma unroll
        for (int ai = 0; ai < 2; ++ai)
#pragma unroll
            for (int m = 0; m < 4; ++m) {
                const int row = row0 + ai * 128 + m * 16;
#pragma unroll
                for (int bj = 0; bj < 2; ++bj) {
                    const int col = colt + bj * 128;
                    float g[8]; unpack8(*(const v4u*)(Zg + 4096 + (size_t)row * INW + col), g);
                    float v[8];
#pragma unroll
                    for (int j = 0; j < 4; ++j) { v[j] = acc[ai][bj][m][0][j] * g[j]; v[4 + j] = acc[ai][bj][m][1][j] * g[4 + j]; }
                    *(v4u*)(MG + (size_t)row * DM + col) = pack8(v);
                }
                asm volatile("" ::: "memory");
            }
    }
};
struct EpiBf16P {
    static constexpr bool PERM = true, AFTER_DRAIN = false, HOOK = false; static constexpr int H1 = -1, H2 = -1, NST = 16;
    bf16* C; int ldc; size_t kq_stride;
    __device__ __forceinline__ void operator()(const f32x4 (&acc)[2][2][4][2], const pg8::Unit& u, int wr, int wc, int fr, int fq) const {
        const int row0 = u.pm * 256 + wr * 64 + fr, colt = u.pn * 256 + wc * 32 + 8 * fq;
#pragma unroll
        for (int ai = 0; ai < 2; ++ai)
#pragma unroll
            for (int m = 0; m < 4; ++m) {
                bf16* rp = C + (size_t)u.kq * kq_stride + (size_t)(row0 + ai * 128 + m * 16) * ldc + colt;
#pragma unroll
                for (int bj = 0; bj < 2; ++bj) { float v[8];
#pragma unroll
                    for (int j = 0; j < 4; ++j) { v[j] = acc[ai][bj][m][0][j]; v[4 + j] = acc[ai][bj][m][1][j]; }
                    *(v4u*)(rp + bj * 128) = pack8(v); }
            }
    }
};
struct EpiSwi {
    static constexpr bool PERM = true, AFTER_DRAIN = false, HOOK = false; static constexpr int H1 = -1, H2 = -1, NST = 16;
    bf16* ACT;
    __device__ __forceinline__ void operator()(const f32x4 (&acc)[2][2][4][2], const pg8::Unit& u, int wr, int wc, int fr, int fq) const {
        const int row0 = u.pm * 256 + wr * 64 + fr, colt = u.pn * 128 + wc * 32 + 8 * fq;
#pragma unroll
        for (int ai = 0; ai < 2; ++ai)
#pragma unroll
            for (int m = 0; m < 4; ++m) {
                float v[8];
#pragma unroll
                for (int j = 0; j < 4; ++j) { v[j] = siluf_(acc[ai][1][m][0][j]) * acc[ai][0][m][0][j]; v[4 + j] = siluf_(acc[ai][1][m][1][j]) * acc[ai][0][m][1][j]; }
                *(v4u*)(ACT + (size_t)(row0 + ai * 128 + m * 16) * DFF + colt) = pack8(v);
            }
    }
};

struct Ctx {
    LAS unsigned char* lds; int tid, lane, wave, vcu, G;
};

__device__ __forceinline__ void cvt_item(const float* W, int N, int k0, int n0, bf16* dst, int dld, int drow0, int dcol0, LAS float* scr, int lane) {
    const float* src = W + (size_t)(k0 + (lane >> 4)) * N + n0 + 4 * (lane & 15);
    f32x4 v[16];
#pragma unroll
    for (int i = 0; i < 16; ++i) v[i] = *(const f32x4*)(src + (size_t)(4 * i) * N);
#pragma unroll
    for (int i = 0; i < 16; ++i) { LAS float* s = scr + (4 * i + (lane >> 4)) * 65 + 4 * (lane & 15); s[0] = v[i].x; s[1] = v[i].y; s[2] = v[i].z; s[3] = v[i].w; }
    asm volatile("s_waitcnt lgkmcnt(0)" ::: "memory");
    const int c = lane & 7;
#pragma unroll
    for (int j = 0; j < 8; ++j) { const int n = (lane >> 3) + 8 * j; const LAS float* s = scr + (8 * c) * 65 + n;
        v4u o; o.x = pk2(s[0 * 65], s[1 * 65]); o.y = pk2(s[2 * 65], s[3 * 65]); o.z = pk2(s[4 * 65], s[5 * 65]); o.w = pk2(s[6 * 65], s[7 * 65]);
        *(v4u*)(dst + (size_t)(drow0 + n) * dld + dcol0 + 8 * c) = o; }
    asm volatile("s_waitcnt lgkmcnt(0)" ::: "memory");
}
constexpr int IT_IN = 32 * 256, IT_UP = 16 * 32, IT_OUT = 32 * 32, IT_FI = 32 * 176, IT_FO = 88 * 32, IT_LAYER = IT_IN + 3 * IT_UP + IT_OUT + IT_FI + IT_FO;
__device__ __forceinline__ void cvt_layer_item(const Args& a, int l, int r, LAS float* scr, int lane) {
    bf16* wl = (bf16*)(a.ws + WS_WT) + (size_t)l * WL_ELEMS;
    if (r < IT_IN) { const int kb = r / 256, nb = r % 256; cvt_item(a.w_in + (size_t)l * DM * INW, INW, 64 * kb, 64 * nb, wl + OFF_IN, DM, 64 * nb, 64 * kb, scr, lane); return; }
    r -= IT_IN;
    if (r < 3 * IT_UP) { const int br = r / IT_UP, q = r % IT_UP, kb = q / 32, nb = q % 32;
        const float* w = (br == 0 ? a.w_up_a : (br == 1 ? a.w_up_b : a.w_up_c)) + (size_t)l * 1024 * DM;
        cvt_item(w, DM, 64 * kb, 64 * nb, wl + OFF_UP, YW, 64 * nb, 1024 * br + 64 * kb, scr, lane); return; }
    r -= 3 * IT_UP;
    if (r < IT_OUT) { const int kb = r / 32, nb = r % 32; cvt_item(a.w_out + (size_t)l * DM * DM, DM, 64 * kb, 64 * nb, wl + OFF_OUT, DM, 64 * nb, 64 * kb, scr, lane); return; }
    r -= IT_OUT;
    if (r < IT_FI) { const int kb = r / 176, nb = r % 176; const int n0 = 64 * nb;
        const int drow = (n0 < DFF) ? (256 * (n0 / 128) + (n0 % 128)) : (256 * ((n0 - DFF) / 128) + 128 + ((n0 - DFF) % 128));
        cvt_item(a.w_fi + (size_t)l * DM * NFI, NFI, 64 * kb, n0, wl + OFF_FI, DM, drow, 64 * kb, scr, lane); return; }
    r -= IT_FI;
    { const int kb = r / 32, nb = r % 32; cvt_item(a.w_fo + (size_t)l * DFF * DM, DM, 64 * kb, 64 * nb, wl + OFF_FO, DFF, 64 * nb, 64 * kb, scr, lane); }
}
__device__ __forceinline__ void phase_prologue(const Args& a, const Ctx& F) {
    unsigned char* ws = a.ws;
    {
        LAS float* scr = (LAS float*)(F.lds + F.wave * 16640);
        const int gw = F.vcu * NWAVES + F.wave, NGW = F.G * NWAVES;
        for (int it = gw; it < IT_LAYER; it += NGW) cvt_layer_item(a, 0, it, scr, F.lane);
    }
    __syncthreads();
    {
        LAS float* sc = (LAS float*)F.lds;
        LAS float* red = (LAS float*)(F.lds + 24576);
        float* MOD = (float*)(ws + WS_MOD);
        for (int i = F.tid; i < 3 * DM; i += NTHR) { const int ci = i / DM, k = i % DM; const float x = (ci == 0) ? a.c_ctx[k] : a.c[(ci - 1) * DM + k]; sc[i] = x / (1.0f + expf(-x)); }
        __syncthreads();
        const int cx = F.tid & 31, kg = F.tid >> 5;
        for (int u = F.vcu; u < 4 * 96; u += F.G) {
            const int l = u / 96, cb = u % 96;
            const float* wp = a.w_ada + ((size_t)l * DM + 128 * kg) * 12288 + 128 * cb + 4 * cx;
            f32x4 a0 = {0.f, 0.f, 0.f, 0.f}, a1 = a0, a2 = a0;
#pragma unroll 8
            for (int k = 0; k < 128; ++k) { const f32x4 w = *(const f32x4*)(wp + (size_t)k * 12288);
                const float s0 = sc[128 * kg + k], s1 = sc[DM + 128 * kg + k], s2 = sc[2 * DM + 128 * kg + k];
                a0 += w * s0; a1 += w * s1; a2 += w * s2; }
#pragma unroll
            for (int j = 0; j < 4; ++j) { red[(kg * 3 + 0) * 128 + 4 * cx + j] = a0[j]; red[(kg * 3 + 1) * 128 + 4 * cx + j] = a1[j]; red[(kg * 3 + 2) * 128 + 4 * cx + j] = a2[j]; }
            __syncthreads();
            if (F.tid < 384) { const int ci = F.tid / 128, col = F.tid % 128; float s = 0.f;
#pragma unroll
                for (int g = 0; g < 16; ++g) s += red[(g * 3 + ci) * 128 + col];
                MOD[(size_t)(l * 3 + ci) * 12288 + 128 * cb + col] = s + a.b_ada[l * 12288 + 128 * cb + col]; }
            __syncthreads();
        }
    }
    {
        float* LB = (float*)(ws + WS_LB); float* ROPE = (float*)(ws + WS_ROPE);
        for (int i = F.vcu * NTHR + F.tid; i < 2048; i += F.G * NTHR) {
            const int dir = i / 1024, f = i % 1024;
            float x[4], mx = -3.0e38f;
#pragma unroll
            for (int l = 0; l < 4; ++l) { x[l] = a.lb_logits[(dir * 4 + l) * 1024 + f]; mx = fmaxf(mx, x[l]); }
            float e[4], s = 0.f;
#pragma unroll
            for (int l = 0; l < 4; ++l) { e[l] = expf(x[l] - mx); s += e[l]; }
            float cs = 0.f;
#pragma unroll
            for (int l = 0; l < 4; ++l) { if (l > 0) cs += e[l] / s; LB[(dir * 4 + l) * 1024 + f] = cs; }
            const int p = i / 32, fi = i % 32;
            const float inv = powf(10000.0f, -(float)(2 * fi) / 64.0f), ang = (float)p * inv;
            ROPE[2 * i] = cosf(ang); ROPE[2 * i + 1] = sinf(ang);
        }
    }
}

__device__ __forceinline__ void rownorm_phase(const Args& a, const Ctx& F, bool first, const bf16* T, const float* gate  , const float* gpost,
                                              bool write_h, const float* gn, const float* scv, const float* shv  ) {
    float* X = a.out + OUT_Y; bf16* H = (bf16*)(a.ws + WS_H); const bf16* TP = (const bf16*)(a.ws + WS_TP);
    LAS float* V1 = (LAS float*)F.lds; LAS float* V2 = V1 + 3 * DM; LAS float* V3 = V2 + 3 * DM;
    __syncthreads();
    for (int i = F.tid; i < 3 * DM; i += NTHR) { const int ci = i / DM, c = i % DM;
        if (T) V1[i] = gate[(size_t)ci * 12288 + c] * gpost[c];
        if (write_h) { V2[i] = gn[c] * (1.0f + scv[(size_t)ci * 12288 + c]); V3[i] = shv[(size_t)ci * 12288 + c]; } }
    __syncthreads();
    const int gw = F.vcu * NWAVES + F.wave, NGW = F.G * NWAVES;
    for (int m = gw; m < MTOK; m += NGW) {
        const int ci = (m < NCTX) ? 0 : 1 + ((m - NCTX) >> 10);
        const float* xr = first ? ((m < NCTX) ? a.x_prompt + (size_t)m * DM : a.x_sample + (size_t)(m - NCTX) * DM) : X + (size_t)m * DM;
        f32x4 x[8];
#pragma unroll
        for (int j = 0; j < 8; ++j) x[j] = *((const f32x4*)xr + F.lane + 64 * j);
        if (T) {
            f32x4 t[8]; float ss = 0.f;
#pragma unroll
            for (int j = 0; j < 8; ++j) {
                if (m < NCTX) { const v2u w = *((const v2u*)(T + (size_t)m * DM) + F.lane + 64 * j); t[j] = (f32x4){bf2f_lo(w.x), bf2f_hi(w.x), bf2f_lo(w.y), bf2f_hi(w.y)}; }
                else { const v2u* tp = (const v2u*)(TP + (size_t)(m - NCTX) * DM) + F.lane + 64 * j; const v2u w0 = tp[0], w1 = tp[TPQ / 4], w2 = tp[2 * (TPQ / 4)], w3 = tp[3 * (TPQ / 4)];
                    t[j] = (f32x4){(bf2f_lo(w0.x) + bf2f_lo(w1.x)) + (bf2f_lo(w2.x) + bf2f_lo(w3.x)), (bf2f_hi(w0.x) + bf2f_hi(w1.x)) + (bf2f_hi(w2.x) + bf2f_hi(w3.x)),
                                   (bf2f_lo(w0.y) + bf2f_lo(w1.y)) + (bf2f_lo(w2.y) + bf2f_lo(w3.y)), (bf2f_hi(w0.y) + bf2f_hi(w1.y)) + (bf2f_hi(w2.y) + bf2f_hi(w3.y))}; }
                ss += (t[j].x * t[j].x + t[j].y * t[j].y) + (t[j].z * t[j].z + t[j].w * t[j].w); }
            const float r = 1.0f / sqrtf(wave_sum(ss) * (1.0f / DM) + EPS);
#pragma unroll
            for (int j = 0; j < 8; ++j) { const f32x4 v1 = *((const LAS f32x4*)(V1 + ci * DM) + F.lane + 64 * j); x[j] += v1 * (t[j] * r); }
        }
        if (T || first) {
#pragma unroll
            for (int j = 0; j < 8; ++j) *((f32x4*)(X + (size_t)m * DM) + F.lane + 64 * j) = x[j];
        }
        if (write_h) {
            float ss = 0.f;
#pragma unroll
            for (int j = 0; j < 8; ++j) ss += (x[j].x * x[j].x + x[j].y * x[j].y) + (x[j].z * x[j].z + x[j].w * x[j].w);
            const float r = 1.0f / sqrtf(wave_sum(ss) * (1.0f / DM) + EPS);
#pragma unroll
            for (int j = 0; j < 8; ++j) { const f32x4 v2 = *((const LAS f32x4*)(V2 + ci * DM) + F.lane + 64 * j), v3 = *((const LAS f32x4*)(V3 + ci * DM) + F.lane + 64 * j);
                const f32x4 h = x[j] * r * v2 + v3;
                v2u w; w.x = pk2(h.x, h.y); w.y = pk2(h.z, h.w);
                *((v2u*)(H + (size_t)m * DM) + F.lane + 64 * j) = w; }
        }
    }
    __syncthreads();
}

__device__ __forceinline__ void phase_ycnorm(const Args& a, const Ctx& F) {
    const float* OFp = (const float*)(a.ws + WS_OF); const float* OBp = (const float*)(a.ws + WS_OB);
    const bf16* Z = (const bf16*)(a.ws + WS_Z); bf16* Y = (bf16*)(a.ws + WS_Y);
    const int gw = F.vcu * NWAVES + F.wave, NGW = F.G * NWAVES;
    for (int m = gw; m < MTOK; m += NGW) {
        float o[16]; float ss = 0.f;
#pragma unroll
        for (int j = 0; j < 4; ++j) { const f32x4 p = *((const f32x4*)(OFp + (size_t)m * 1024 + 16 * F.lane) + j), q = *((const f32x4*)(OBp + (size_t)m * 1024 + 16 * F.lane) + j);
            const f32x4 s = p + q; o[4 * j] = s.x; o[4 * j + 1] = s.y; o[4 * j + 2] = s.z; o[4 * j + 3] = s.w; ss += (s.x * s.x + s.y * s.y) + (s.z * s.z + s.w * s.w); }
        ss += __shfl_xor(ss, 1); ss += __shfl_xor(ss, 2); ss += __shfl_xor(ss, 4);
        const float r = 1.0f / sqrtf(ss * (1.0f / 128.0f) + EPS);
        float g0[8], g1[8];
        unpack8(*(const v4u*)(Z + (size_t)m * INW + 9216 + 16 * F.lane), g0); unpack8(*(const v4u*)(Z + (size_t)m * INW + 9216 + 16 * F.lane + 8), g1);
        float y0[8], y1[8];
#pragma unroll
        for (int j = 0; j < 8; ++j) { y0[j] = o[j] * r * g0[j]; y1[j] = o[8 + j] * r * g1[j]; }
        *(v4u*)(Y + (size_t)m * YW + 2048 + 16 * F.lane) = pack8(y0); *(v4u*)(Y + (size_t)m * YW + 2048 + 16 * F.lane + 8) = pack8(y1);
    }
}

typedef short bf16x8 __attribute__((ext_vector_type(8)));
typedef short s16x4 __attribute__((ext_vector_type(4)));
typedef float f32x16 __attribute__((ext_vector_type(16)));
typedef __bf16 bf16x4_t __attribute__((ext_vector_type(4)));
#define MFMA32(a, b, c) __builtin_amdgcn_mfma_f32_32x32x16_bf16((a), (b), (c), 0, 0, 0)
__device__ __forceinline__ bf16x8 pack_regs(const f32x16& x, int s) {
    v4u p; p.x = cvtpk(x[8 * s], x[8 * s + 1]); p.y = cvtpk(x[8 * s + 2], x[8 * s + 3]); p.z = cvtpk(x[8 * s + 4], x[8 * s + 5]); p.w = cvtpk(x[8 * s + 6], x[8 * s + 7]);
    return __builtin_bit_cast(bf16x8, p);
}
__device__ __forceinline__ s16x4 tr_read(const LAS unsigned char* p) { return __builtin_bit_cast(s16x4, __builtin_amdgcn_ds_read_tr16_b64_v4bf16((LAS bf16x4_t*)p)); }
__device__ __forceinline__ bf16x8 tr_pair(const LAS unsigned char* lo, const LAS unsigned char* hi) { const s16x4 a = tr_read(lo), b = tr_read(hi); return __builtin_shufflevector(a, b, 0, 1, 2, 3, 4, 5, 6, 7); }
constexpr float ATT_SCALE = 0.08838834764831845f;
constexpr int KP = 272, VP = 320;
constexpr int ATT_K_OFF = 0, ATT_V_OFF = 256 * KP, ATT_RPB_OFF = ATT_V_OFF + 256 * VP;
struct AttnW { f32x16 O[4]; float m, l; };
template <int MODE, bool QLDS>
__device__ __forceinline__ void attn_tile(AttnW& W, const bf16x8 (&qf)[8], const LAS unsigned char* Ql, const LAS unsigned char* Kl, const LAS unsigned char* Vl, int kt0, int lane, const LAS float* rpb_row, int kc0, int qc) {
    const int r = lane & 31, h = lane >> 5;
    f32x16 sacc;
#pragma unroll
    for (int i = 0; i < 16; ++i) sacc[i] = 0.f;
    const LAS unsigned char* kp = Kl + (kt0 + r) * KP + 16 * h;
#pragma unroll
    for (int ks = 0; ks < 8; ++ks) { const bf16x8 a = *(const LAS bf16x8*)(kp + 32 * ks); const bf16x8 q = QLDS ? *(const LAS bf16x8*)(Ql + 32 * ks) : qf[ks]; sacc = MFMA32(a, q, sacc); }
    float mt = -1.0e30f;
    if (MODE == 1) {
        const int c_start = min(max(qc - 8, 0), 48);
        const int kb = kc0 + 4 * h - c_start;
        const LAS float* bp = rpb_row + (kc0 + 4 * h - qc + 15);
#pragma unroll
        for (int i = 0; i < 16; ++i) { const int off = (i & 3) + 8 * (i >> 2); const bool ok = (unsigned)(kb + off) < 16u;
            const float bias = bp[ok ? off : (qc - kc0 - 4 * h)];
            const float v = ok ? (sacc[i] * ATT_SCALE + bias) : -1.0e30f; sacc[i] = v; mt = fmaxf(mt, v); }
    } else {
#pragma unroll
        for (int i = 0; i < 16; ++i) { sacc[i] *= ATT_SCALE; mt = fmaxf(mt, sacc[i]); }
    }
    mt = fmaxf(mt, __shfl_xor(mt, 32));
    const float mn = fmaxf(W.m, mt), alpha = __expf(W.m - mn);
    float ls = 0.f;
#pragma unroll
    for (int i = 0; i < 16; ++i) { const float e = (MODE == 1 && sacc[i] < -1.0e29f) ? 0.f : __expf(sacc[i] - mn); sacc[i] = e; ls += e; }
    ls += __shfl_xor(ls, 32);
    W.l = W.l * alpha + ls; W.m = mn;
    if (__any(alpha != 1.0f)) {
#pragma unroll
        for (int dt = 0; dt < 4; ++dt)
#pragma unroll
            for (int i = 0; i < 16; ++i) W.O[dt][i] *= alpha;
    }
    const bf16x8 pb0 = pack_regs(sacc, 0), pb1 = pack_regs(sacc, 1);
    const int g = (lane >> 4) & 1, q4 = (lane & 15) >> 2, p4 = lane & 3;
    const LAS unsigned char* vp = Vl + (kt0 + 4 * h + q4) * VP + 32 * g + 8 * p4;
#pragma unroll
    for (int dt = 0; dt < 4; ++dt) {
        const bf16x8 v0 = tr_pair(vp + 64 * dt, vp + 64 * dt + 8 * VP);
        const bf16x8 v1 = tr_pair(vp + 64 * dt + 16 * VP, vp + 64 * dt + 24 * VP);
        W.O[dt] = MFMA32(v0, pb0, W.O[dt]); W.O[dt] = MFMA32(v1, pb1, W.O[dt]);
    }
}
__device__ __forceinline__ void attn_init(AttnW& W) {
    W.m = -1.0e30f; W.l = 0.f;
#pragma unroll
    for (int dt = 0; dt < 4; ++dt)
#pragma unroll
        for (int i = 0; i < 16; ++i) W.O[dt][i] = 0.f;
}
__device__ __forceinline__ void attn_store_dt(const f32x16& O, float inv, bf16* yrow, int dt, int h) {
#pragma unroll
    for (int g4 = 0; g4 < 4; ++g4) { v2u w; w.x = cvtpk(O[4 * g4] * inv, O[4 * g4 + 1] * inv); w.y = cvtpk(O[4 * g4 + 2] * inv, O[4 * g4 + 3] * inv);
        *(v2u*)(yrow + 32 * dt + 8 * g4 + 4 * h) = w; }
}

__device__ __forceinline__ void unitAttnCtx(const Args& a, const Ctx& F, int unit) {
    const int hd = unit & 7, b = unit >> 3;
    const bf16* Z = (const bf16*)(a.ws + WS_Z); bf16* Y = (bf16*)(a.ws + WS_Y);
    const LAS unsigned char* Kl = F.lds + ATT_K_OFF; const LAS unsigned char* Vl = F.lds + ATT_V_OFF;
    for (int p = F.tid; p < 4096; p += NTHR) { const int key = p >> 4, c16 = p & 15; const bf16* src = Z + (size_t)(b * 256 + key) * INW + hd * 128 + 8 * c16;
        *(LAS v4u*)(F.lds + ATT_K_OFF + key * KP + 16 * c16) = *(const v4u*)(src + 3072); *(LAS v4u*)(F.lds + ATT_V_OFF + key * VP + 16 * c16) = *(const v4u*)(src + 4096); }
    AttnW W; attn_init(W); bf16x8 qf[8];
    const int r = F.lane & 31, h = F.lane >> 5;
    const int mq = b * 256 + 32 * F.wave + r;
    { const bf16* qp = Z + (size_t)mq * INW + 2048 + hd * 128 + 8 * h;
#pragma unroll
      for (int ks = 0; ks < 8; ++ks) qf[ks] = __builtin_bit_cast(bf16x8, *(const v4u*)(qp + 16 * ks)); }
    __syncthreads();
#pragma unroll 1
    for (int kt = 0; kt < 8; ++kt) attn_tile<0, false>(W, qf, nullptr, Kl, Vl, 32 * kt, F.lane, nullptr, 0, 0);
    const float inv = 1.0f / W.l;
    bf16* yrow = Y + (size_t)mq * YW + 1024 + hd * 128;
#pragma unroll
    for (int dt = 0; dt < 4; ++dt) attn_store_dt(W.O[dt], inv, yrow, dt, h);
    __syncthreads();
}
constexpr int LQ_OFF = 0, LK_OFF = 64 * KP, LV_OFF = LK_OFF + 128 * KP, LRPB_OFF = LV_OFF + 128 * VP;
__device__ __forceinline__ void unitAttnLat(const Args& a, const Ctx& F, int l, int unit) {
    const int gr = unit & 15, hd = (unit >> 4) & 7, b = unit >> 7;
    const bf16* Z = (const bf16*)(a.ws + WS_Z); bf16* Y = (bf16*)(a.ws + WS_Y);
    const float* ROPE = (const float*)(a.ws + WS_ROPE);
    const LAS unsigned char* Kl = F.lds + LK_OFF; const LAS unsigned char* Vl = F.lds + LV_OFF; LAS float* rp = (LAS float*)(F.lds + LRPB_OFF);
    const int r = F.lane & 31, h = F.lane >> 5, qh = F.wave & 1, kt = F.wave >> 1;
    const int qc = 32 * qh + r;
    const int r_start = min(max(gr - 4, 0), 8);
    const int mq = NCTX + b * 1024 + gr * 64 + qc;
    __syncthreads();
    for (int i = F.tid; i < 15 * 31; i += NTHR) rp[i] = a.rpb[(size_t)(l * 8 + hd) * 465 + i];
    {
        const int qq = F.tid >> 3, half = (F.tid >> 2) & 1, sp = F.tid & 3, pos = half ? qq : gr;
        const bf16* src = Z + (size_t)(NCTX + b * 1024 + gr * 64 + qq) * INW + 2048 + hd * 128 + 64 * half + 8 * sp;
        const float* rt = ROPE + 2 * (pos * 32 + 8 * sp);
        float x[8], y[8], lo[8], hi[8]; unpack8(*(const v4u*)src, x); unpack8(*(const v4u*)(src + 32), y);
#pragma unroll
        for (int j4 = 0; j4 < 4; ++j4) { const f32x4 cssn = *(const f32x4*)(rt + 4 * j4);
            lo[2 * j4] = x[2 * j4] * cssn.x - y[2 * j4] * cssn.y; hi[2 * j4] = y[2 * j4] * cssn.x + x[2 * j4] * cssn.y;
            lo[2 * j4 + 1] = x[2 * j4 + 1] * cssn.z - y[2 * j4 + 1] * cssn.w; hi[2 * j4 + 1] = y[2 * j4 + 1] * cssn.z + x[2 * j4 + 1] * cssn.w; }
        LAS unsigned char* d = F.lds + LQ_OFF + qq * KP + 2 * (64 * half + 8 * sp);
        *(LAS v4u*)d = pack8(lo); *(LAS v4u*)(d + 64) = pack8(hi);
    }
    AttnW W; attn_init(W);
    const LAS unsigned char* Ql = F.lds + LQ_OFF + qc * KP + 16 * h;
    const bf16x8 qdummy[8] = {};
#pragma unroll 1
    for (int chn = 0; chn < 8; ++chn) {
        __syncthreads();
        if (chn < 4) {
#pragma unroll 1
            for (int job = F.tid; job < 1024; job += NTHR) {
                const int key = job >> 3, half = (job >> 2) & 1, sp = job & 3;
                const int kr = r_start + 2 * chn + (key >> 6), kc = key & 63, pos = half ? kc : kr;
                const bf16* src = Z + (size_t)(NCTX + b * 1024 + kr * 64 + kc) * INW + 3072 + hd * 128 + 64 * half + 8 * sp;
                const float* rt = ROPE + 2 * (pos * 32 + 8 * sp);
                float x[8], y[8], lo[8], hi[8]; unpack8(*(const v4u*)src, x); unpack8(*(const v4u*)(src + 32), y);
#pragma unroll
                for (int j4 = 0; j4 < 4; ++j4) { const f32x4 cssn = *(const f32x4*)(rt + 4 * j4);
                    lo[2 * j4] = x[2 * j4] * cssn.x - y[2 * j4] * cssn.y; hi[2 * j4] = y[2 * j4] * cssn.x + x[2 * j4] * cssn.y;
                    lo[2 * j4 + 1] = x[2 * j4 + 1] * cssn.z - y[2 * j4 + 1] * cssn.w; hi[2 * j4 + 1] = y[2 * j4 + 1] * cssn.z + x[2 * j4 + 1] * cssn.w; }
                LAS unsigned char* d = F.lds + LK_OFF + key * KP + 2 * (64 * half + 8 * sp);
                *(LAS v4u*)d = pack8(lo); *(LAS v4u*)(d + 64) = pack8(hi);
            }
#pragma unroll 2
            for (int p = F.tid; p < 2048; p += NTHR) { const int key = p >> 4, c16 = p & 15; const int kr = r_start + 2 * chn + (key >> 6), kc = key & 63;
                *(LAS v4u*)(F.lds + LV_OFF + key * VP + 16 * c16) = *(const v4u*)(Z + (size_t)(NCTX + b * 1024 + kr * 64 + kc) * INW + 4096 + hd * 128 + 8 * c16); }
        } else {
#pragma unroll 2
            for (int p = F.tid; p < 2048; p += NTHR) { const int key = p >> 4, c16 = p & 15;
                const size_t off = ((size_t)(b * 4 + l) * 512 + 128 * (chn - 4) + key) * 1024 + hd * 128 + 8 * c16;
                const f32x4 k0 = *(const f32x4*)(a.cache_k + off), k1 = *(const f32x4*)(a.cache_k + off + 4), v0 = *(const f32x4*)(a.cache_v + off), v1 = *(const f32x4*)(a.cache_v + off + 4);
                v4u kw, vw; kw.x = cvtpk(k0.x, k0.y); kw.y = cvtpk(k0.z, k0.w); kw.z = cvtpk(k1.x, k1.y); kw.w = cvtpk(k1.z, k1.w);
                vw.x = cvtpk(v0.x, v0.y); vw.y = cvtpk(v0.z, v0.w); vw.z = cvtpk(v1.x, v1.y); vw.w = cvtpk(v1.z, v1.w);
                *(LAS v4u*)(F.lds + LK_OFF + key * KP + 16 * c16) = kw; *(LAS v4u*)(F.lds + LV_OFF + key * VP + 16 * c16) = vw; }
        }
        __syncthreads();
        if (chn < 4) {
            const int kr = r_start + 2 * chn + (kt >> 1), dr = kr - gr + 7;
            attn_tile<1, true>(W, qdummy, Ql, Kl, Vl, 32 * kt, F.lane, rp + dr * 31, 32 * (kt & 1), qc);
        } else {
            attn_tile<0, true>(W, qdummy, Ql, Kl, Vl, 32 * kt, F.lane, nullptr, 0, 0);
        }
    }
    __syncthreads();
    LAS float* ML = (LAS float*)F.lds; LAS float* OB = (LAS float*)(F.lds + 4096);
    ML[(F.wave * 2 + 0) * 64 + F.lane] = W.m; ML[(F.wave * 2 + 1) * 64 + F.lane] = W.l;
#pragma unroll
    for (int dt = 0; dt < 4; ++dt)
#pragma unroll
        for (int i = 0; i < 16; ++i) OB[(F.wave * 64 + dt * 16 + i) * 64 + F.lane] = W.O[dt][i];
    __syncthreads();
    {
        float mi[4], li[4], mt = -1.0e30f;
#pragma unroll
        for (int k = 0; k < 4; ++k) { const int w2 = 2 * k + qh; mi[k] = ML[(w2 * 2 + 0) * 64 + F.lane]; li[k] = ML[(w2 * 2 + 1) * 64 + F.lane]; mt = fmaxf(mt, mi[k]); }
        float wk[4], lt = 0.f;
#pragma unroll
        for (int k = 0; k < 4; ++k) { wk[k] = __expf(mi[k] - mt); lt += wk[k] * li[k]; }
        const float inv = 1.0f / lt;
#pragma unroll
        for (int k = 0; k < 4; ++k) wk[k] *= inv;
        bf16* yrow = Y + (size_t)mq * YW + 1024 + hd * 128 + 32 * kt + 4 * h;
#pragma unroll
        for (int g4 = 0; g4 < 4; ++g4) {
            float o[4];
#pragma unroll
            for (int i = 0; i < 4; ++i) { float sacc = 0.f;
#pragma unroll
                for (int k = 0; k < 4; ++k) sacc += wk[k] * OB[((2 * k + qh) * 64 + kt * 16 + 4 * g4 + i) * 64 + F.lane];
                o[i] = sacc; }
            v2u w; w.x = cvtpk(o[0], o[1]); w.y = cvtpk(o[2], o[3]);
            *(v2u*)(yrow + 8 * g4) = w;
            asm volatile("" ::: "memory");
        }
    }
    __syncthreads();
}

constexpr int AW_OFF = 0, AV_OFF = 128 * KP, AST_OFF = AV_OFF + 128 * VP;
__device__ __forceinline__ void unitA(const Args& a, const Ctx& F, int l, int unit) {
    const int ch = unit >> 3, g = unit & 7, m0 = ch * 128;
    const bf16* Z = (const bf16*)(a.ws + WS_Z); bf16* Y = (bf16*)(a.ws + WS_Y);
    LAS float* st = (LAS float*)(F.lds + AST_OFF);
    __syncthreads();
#pragma unroll 4
    for (int i = 0; i < 16; ++i) {
        const int s = 16 * F.wave + i;
        const bf16* rp = Z + (size_t)(m0 + s) * INW + 1024 + 16 * F.lane;
        float x0[8], x1[8]; unpack8(*(const v4u*)rp, x0); unpack8(*(const v4u*)(rp + 8), x1);
        float sm = 0.f, sq = 0.f;
#pragma unroll
        for (int j = 0; j < 8; ++j) { sm += x0[j] + x1[j]; sq += x0[j] * x0[j] + x1[j] * x1[j]; }
        sm = wave_sum(sm); sq = wave_sum(sq);
        const float mean = sm * (1.0f / 1024.0f), var = fmaxf(sq * (1.0f / 1024.0f) - mean * mean, 0.f);
        if (F.lane == 0) { st[s] = mean; st[128 + s] = 1.0f / sqrtf(var + EPS); }
    }
    {
        const int t = F.tid >> 2, s0 = 32 * (F.tid & 3);
        const float* wp = a.a_w + ((size_t)(l * 8 + g) * 128 + t) * 128 + s0;
#pragma unroll
        for (int q = 0; q < 4; ++q) { const f32x4 w0 = *(const f32x4*)(wp + 8 * q), w1 = *(const f32x4*)(wp + 8 * q + 4);
            v4u o; o.x = cvtpk(w0.x, w0.y); o.y = cvtpk(w0.z, w0.w); o.z = cvtpk(w1.x, w1.y); o.w = cvtpk(w1.z, w1.w);
            *(LAS v4u*)(F.lds + AW_OFF + t * KP + 2 * (s0 + 8 * q)) = o; }
    }
    __syncthreads();
    {
        const int s = F.tid >> 2, c0 = 32 * (F.tid & 3);
        const float mean = st[s], rstd = st[128 + s];
        const bf16* rp = Z + (size_t)(m0 + s) * INW + 1024 + 128 * g + c0;
#pragma unroll
        for (int q = 0; q < 4; ++q) { float x[8]; unpack8(*(const v4u*)(rp + 8 * q), x);
#pragma unroll
            for (int j = 0; j < 8; ++j) x[j] = (x[j] - mean) * rstd;
            *(LAS v4u*)(F.lds + AV_OFF + s * VP + 2 * (c0 + 8 * q)) = pack8(x); }
    }
    __syncthreads();
    const int lane = F.lane, r = lane & 31, h = lane >> 5, gq = (lane >> 4) & 1, q4 = (lane & 15) >> 2, p4 = lane & 3;
    const int ttile = F.wave & 3, ct0 = 2 * (F.wave >> 2);
    f32x16 acc[2];
#pragma unroll
    for (int c2 = 0; c2 < 2; ++c2)
#pragma unroll
        for (int i = 0; i < 16; ++i) acc[c2][i] = 0.f;
    {
        const LAS unsigned char* wp = F.lds + AW_OFF + (32 * ttile + r) * KP + 16 * h;
        const LAS unsigned char* vp = F.lds + AV_OFF + (8 * h + q4) * VP + 2 * (32 * ct0 + 16 * gq) + 8 * p4;
#pragma unroll
        for (int ks = 0; ks < 8; ++ks) {
            const bf16x8 wb = *(const LAS bf16x8*)(wp + 32 * ks);
#pragma unroll
            for (int c2 = 0; c2 < 2; ++c2) {
                const LAS unsigned char* v0 = vp + 16 * ks * VP + 64 * c2;
                acc[c2] = MFMA32(tr_pair(v0, v0 + 4 * VP), wb, acc[c2]);
            }
        }
    }
    {
        const int t = 32 * ttile + r; const float bsv = a.a_b[(l * 8 + g) * 128 + t];
        const bf16* up = Z + (size_t)(m0 + t) * INW + 128 * g + 4 * h; bf16* yp = Y + (size_t)(m0 + t) * YW + 128 * g + 4 * h;
#pragma unroll
        for (int c2 = 0; c2 < 2; ++c2)
#pragma unroll
            for (int g4 = 0; g4 < 4; ++g4) {
                const int c = 32 * (ct0 + c2) + 8 * g4;
                const v2u uw = *(const v2u*)(up + c);
                v2u o; o.x = cvtpk(bf2f_lo(uw.x) * (acc[c2][4 * g4] + bsv), bf2f_hi(uw.x) * (acc[c2][4 * g4 + 1] + bsv));
                o.y = cvtpk(bf2f_lo(uw.y) * (acc[c2][4 * g4 + 2] + bsv), bf2f_hi(uw.y) * (acc[c2][4 * g4 + 3] + bsv));
                *(v2u*)(yp + c) = o;
            }
    }
    __syncthreads();
}

constexpr int HP = 272;
constexpr int HG_QD = 0, HG_KD = 32 * HP, HG_KL = 2 * 32 * HP, HG_V = 3 * 32 * HP, HG_G = 4 * 32 * HP, HG_BUF = HG_G + 512, HG_DIR = 2 * HG_BUF;
struct HgPre { v4u q[2], v[2]; f32x4 f[4]; };
__device__ __forceinline__ void hg_load(HgPre& P, const bf16* Z, const float* LOGF, size_t m, int dir, int hd, int d0) {
    const bf16* zr = Z + m * INW + hd * 128 + d0; const float* fr = LOGF + m * 2048 + dir * 1024 + hd * 128 + d0;
    P.q[0] = *(const v4u*)(zr + 5120); P.q[1] = *(const v4u*)(zr + 5128); P.v[0] = *(const v4u*)(zr + 8192); P.v[1] = *(const v4u*)(zr + 8200);
#pragma unroll
    for (int j = 0; j < 4; ++j) P.f[j] = *(const f32x4*)(fr + 4 * j);
}
template <int CTRL, int ROWMASK> __device__ __forceinline__ float dpp_add(float x) {
    return x + __int_as_float(__builtin_amdgcn_update_dpp(0, __float_as_int(x), CTRL, ROWMASK, 0xF, true)); }
__device__ __forceinline__ float scan32(float x) {
    x = dpp_add<0x111, 0xF>(x); x = dpp_add<0x112, 0xF>(x); x = dpp_add<0x114, 0xF>(x); x = dpp_add<0x118, 0xF>(x); x = dpp_add<0x142, 0xA>(x); return x; }
__device__ __forceinline__ void hg_estep(const HgPre& P, LAS unsigned char* buf, int lane_, int w4) {
    int lane = lane_; asm volatile("" : "+v"(lane));
    const int tt = lane & 31, hf = lane >> 5, d0 = 32 * w4 + 16 * hf;
    float bl[16];
#pragma unroll
    for (int j = 0; j < 16; ++j) bl[j] = scan32(P.f[j >> 2][j & 3]);
    LAS unsigned char* row = buf + tt * HP + 2 * d0;
#pragma unroll
    for (int hh = 0; hh < 2; ++hh) {
        float qd[8], kd[8], kl[8];
        float q[8]; unpack8(P.q[hh], q);
#pragma unroll
        for (int j = 0; j < 8; ++j) { const int jj = 8 * hh + j; const float bC0 = __int_as_float(__builtin_amdgcn_readlane(__float_as_int(bl[jj]), 31)), bC1 = __int_as_float(__builtin_amdgcn_readlane(__float_as_int(bl[jj]), 63)); const float bC = hf ? bC1 : bC0; const float k = 1.0f - __builtin_amdgcn_exp2f(P.f[jj >> 2][jj & 3]);
            qd[j] = q[j] * __builtin_amdgcn_exp2f(bl[jj]); kd[j] = k * __builtin_amdgcn_exp2f(fminf(-bl[jj], 115.0f)); kl[j] = k * __builtin_amdgcn_exp2f(bC - bl[jj]); }
        *(LAS v4u*)(row + HG_QD + 16 * hh) = pack8(qd); *(LAS v4u*)(row + HG_KD + 16 * hh) = pack8(kd); *(LAS v4u*)(row + HG_KL + 16 * hh) = pack8(kl);
        asm volatile("" ::: "memory");
    }
    *(LAS v4u*)(row + HG_V) = P.v[0]; *(LAS v4u*)(row + HG_V + 16) = P.v[1];
    if (tt == 31) {
#pragma unroll
        for (int j4 = 0; j4 < 4; ++j4) *(LAS f32x4*)(buf + HG_G + 4 * (d0 + 4 * j4)) = (f32x4){__builtin_amdgcn_exp2f(bl[4 * j4]), __builtin_amdgcn_exp2f(bl[4 * j4 + 1]), __builtin_amdgcn_exp2f(bl[4 * j4 + 2]), __builtin_amdgcn_exp2f(bl[4 * j4 + 3])};
    }
}
__device__ __forceinline__ void hg_mstep(f32x16 (&S)[4], const LAS unsigned char* buf, int lane_, int w4, float* Og, int c, int n, int dir, int mbase, int hd) {
    int lane = lane_; asm volatile("" : "+v"(lane));
    const int r = lane & 31, h = lane >> 5, g = (lane >> 4) & 1, q4 = (lane & 15) >> 2, p4 = lane & 3;
    f32x16 X0;
#pragma unroll
    for (int i = 0; i < 16; ++i) X0[i] = 0.f;
    {   const LAS unsigned char* kp = buf + HG_KD + r * HP + 16 * h; const LAS unsigned char* qp = buf + HG_QD + r * HP + 16 * h;
#pragma unroll
        for (int ks = 0; ks < 8; ++ks) X0 = MFMA32(*(const LAS bf16x8*)(kp + 32 * ks), *(const LAS bf16x8*)(qp + 32 * ks), X0); }
    f32x16 O0;
#pragma unroll
    for (int i = 0; i < 16; ++i) O0[i] = 0.f;
    {
        const LAS unsigned char* qp = buf + HG_QD + r * HP + 8 * h;
#pragma unroll
        for (int dt = 0; dt < 4; ++dt)
#pragma unroll
            for (int st = 0; st < 2; ++st) {
                const s16x4 lo = *(const LAS s16x4*)(qp + 2 * (32 * dt + 16 * st)), hi = *(const LAS s16x4*)(qp + 2 * (32 * dt + 16 * st + 8));
                O0 = MFMA32(__builtin_shufflevector(lo, hi, 0, 1, 2, 3, 4, 5, 6, 7), pack_regs(S[dt], st), O0);
            }
    }
#pragma unroll
    for (int i = 0; i < 16; ++i) { const int srow = (i & 3) + 8 * (i >> 2) + 4 * h; X0[i] = (srow <= r) ? X0[i] : 0.f; }
    {
        const LAS unsigned char* vp = buf + HG_V + (4 * h + q4) * HP + 2 * (32 * w4 + 16 * g) + 8 * p4;
        O0 = MFMA32(pack_regs(X0, 0), tr_pair(vp, vp + 8 * HP), O0);
        O0 = MFMA32(pack_regs(X0, 1), tr_pair(vp + 16 * HP, vp + 24 * HP), O0);
    }
    asm volatile("" ::: "memory");
    {
        const LAS float* G = (const LAS float*)(buf + HG_G);
        const LAS unsigned char* vp = buf + HG_V + (8 * h + q4) * HP + 2 * (32 * w4 + 16 * g) + 8 * p4;
        const bf16x8 vb0 = tr_pair(vp, vp + 4 * HP), vb1 = tr_pair(vp + 16 * HP, vp + 20 * HP);
#pragma unroll
        for (int dt = 0; dt < 4; ++dt) {
#pragma unroll
            for (int g4 = 0; g4 < 4; ++g4) { const f32x4 gv = *(const LAS f32x4*)(G + 32 * dt + 8 * g4 + 4 * h);
#pragma unroll
                for (int jj = 0; jj < 4; ++jj) S[dt][4 * g4 + jj] *= gv[jj]; }
            const LAS unsigned char* kp = buf + HG_KL + (8 * h + q4) * HP + 2 * (32 * dt + 16 * g) + 8 * p4;
            S[dt] = MFMA32(tr_pair(kp, kp + 4 * HP), vb0, S[dt]);
            S[dt] = MFMA32(tr_pair(kp + 16 * HP, kp + 20 * HP), vb1, S[dt]);
                }
    }
    {
        const int tb = 32 * c + 4 * h; const int p0 = dir ? (n - 1 - tb) : tb, stp = dir ? -1024 : 1024;
        float* ob = Og + (size_t)mbase * 1024 + hd * 128 + 32 * w4;
        const int o0 = p0 * 1024 + r;
#pragma unroll
        for (int i = 0; i < 16; ++i) ob[o0 + ((i & 3) + 8 * (i >> 2)) * stp] = O0[i];
    }
}
__device__ __forceinline__ void unitHgrn(const Args& a, const Ctx& F, int l, bool lat, int b, int hd) {
    const bf16* Z = (const bf16*)(a.ws + WS_Z); const float* LOGF = (const float*)(a.ws + WS_LOGF); bf16* Y = (bf16*)(a.ws + WS_Y);
    const int w4 = F.wave >> 1, lane = F.lane;
    LAS unsigned char* base = F.lds;
    const int n = lat ? 1024 : 256, mbase = lat ? NCTX + b * 1024 : b * 256, nch = n >> 5, ng = 2 * nch;
    __syncthreads();
    if ((F.wave & 1) == 0) {
        const int tt = lane & 31, d0 = 32 * w4 + 16 * (lane >> 5);
        HgPre P;
        hg_load(P, Z, LOGF, (size_t)(mbase + tt), 0, hd, d0);
        hg_estep(P, base, lane, w4);
        {   const int g1 = 1, dir1 = (g1 >= nch), c1 = g1 - dir1 * nch, p1 = 32 * c1 + tt; hg_load(P, Z, LOGF, (size_t)(mbase + (dir1 ? (n - 1 - p1) : p1)), dir1, hd, d0); }
        asm volatile("s_waitcnt lgkmcnt(0)" ::: "memory"); __builtin_amdgcn_s_barrier(); asm volatile("" ::: "memory");
#pragma unroll 1
        for (int g = 0; g < ng; ++g) {
            if (g + 1 < ng) {
                hg_estep(P, base + ((g + 1) & 1) * HG_BUF, lane, w4);
                if (g + 2 < ng) { const int g2 = g + 2, dir2 = (g2 >= nch), c2 = g2 - dir2 * nch, p2 = 32 * c2 + tt; hg_load(P, Z, LOGF, (size_t)(mbase + (dir2 ? (n - 1 - p2) : p2)), dir2, hd, d0); }
            }
            asm volatile("s_waitcnt lgkmcnt(0)" ::: "memory"); __builtin_amdgcn_s_barrier(); asm volatile("" ::: "memory");
        }
    } else {
        const int r = lane & 31, h = lane >> 5, h512 = 512 * h;
        f32x16 S[4];
        if (lat) {
            const float* sp = a.state + ((((size_t)b * 4 + l) * 2 + 0) * 8 + hd) * 16384 + 32 * w4 + r;
#pragma unroll
            for (int dt = 0; dt < 4; ++dt)
#pragma unroll
                for (int i = 0; i < 16; ++i) S[dt][i] = sp[(32 * dt + (i & 3) + 8 * (i >> 2)) * 128 + h512];
        } else {
#pragma unroll
            for (int dt = 0; dt < 4; ++dt)
#pragma unroll
                for (int i = 0; i < 16; ++i) S[dt][i] = 0.f;
        }
        asm volatile("s_waitcnt lgkmcnt(0)" ::: "memory"); __builtin_amdgcn_s_barrier(); asm volatile("" ::: "memory");
#pragma unroll 1
        for (int g = 0; g < ng; ++g) {
            const int dir = (g >= nch), c = g - dir * nch;
            if (g == nch) {
                if (!lat) {
                    float* so = a.out + OUT_S + ((((size_t)b * 4 + l) * 2 + 0) * 8 + hd) * 16384 + 32 * w4 + r;
#pragma unroll
                    for (int dt = 0; dt < 4; ++dt)
#pragma unroll
                        for (int i = 0; i < 16; ++i) { so[(32 * dt + (i & 3) + 8 * (i >> 2)) * 128 + h512] = S[dt][i]; S[dt][i] = 0.f; }
                } else {
                    const float* sp = a.state + ((((size_t)b * 4 + l) * 2 + 1) * 8 + hd) * 16384 + 32 * w4 + r;
#pragma unroll
                    for (int dt = 0; dt < 4; ++dt)
#pragma unroll
                        for (int i = 0; i < 16; ++i) S[dt][i] = sp[(32 * dt + (i & 3) + 8 * (i >> 2)) * 128 + h512];
                }
            }
            hg_mstep(S, base + (g & 1) * HG_BUF, lane, w4, (float*)(a.ws + (dir ? WS_OB : WS_OF)), c, n, dir, mbase, hd);
            asm volatile("s_waitcnt lgkmcnt(0)" ::: "memory"); __builtin_amdgcn_s_barrier(); asm volatile("" ::: "memory");
        }
        if (!lat) {
            float* so = a.out + OUT_S + ((((size_t)b * 4 + l) * 2 + 1) * 8 + hd) * 16384 + 32 * w4 + r;
#pragma unroll
            for (int dt = 0; dt < 4; ++dt)
#pragma unroll
                for (int i = 0; i < 16; ++i) so[(32 * dt + (i & 3) + 8 * (i >> 2)) * 128 + h512] = S[dt][i];
        }
    }
    __syncthreads();
    {
        const float* OFp = (const float*)(a.ws + WS_OF); const float* OBp = (const float*)(a.ws + WS_OB);
        const int e16 = 16 * (F.tid & 7);
        for (int t0 = 0; t0 < n; t0 += 64) {
            const size_t m = (size_t)(mbase + t0 + (F.tid >> 3));
            float o[16]; float ss = 0.f;
#pragma unroll
            for (int j = 0; j < 4; ++j) { const f32x4 p = *((const f32x4*)(OFp + m * 1024 + hd * 128 + e16) + j), qv = *((const f32x4*)(OBp + m * 1024 + hd * 128 + e16) + j);
                const f32x4 sv = p + qv; o[4 * j] = sv.x; o[4 * j + 1] = sv.y; o[4 * j + 2] = sv.z; o[4 * j + 3] = sv.w; ss += (sv.x * sv.x + sv.y * sv.y) + (sv.z * sv.z + sv.w * sv.w); }
            ss += __shfl_xor(ss, 1); ss += __shfl_xor(ss, 2); ss += __shfl_xor(ss, 4);
            const float rn = 1.0f / sqrtf(ss * (1.0f / 128.0f) + EPS);
            float g0[8], g1[8];
            unpack8(*(const v4u*)(Z + m * INW + 9216 + hd * 128 + e16), g0); unpack8(*(const v4u*)(Z + m * INW + 9216 + hd * 128 + e16 + 8), g1);
            float y0[8], y1[8];
#pragma unroll
            for (int j = 0; j < 8; ++j) { y0[j] = o[j] * rn * g0[j]; y1[j] = o[8 + j] * rn * g1[j]; }
            *(v4u*)(Y + m * YW + 2048 + hd * 128 + e16) = pack8(y0); *(v4u*)(Y + m * YW + 2048 + hd * 128 + e16 + 8) = pack8(y1);
        }
    }
    __syncthreads();
}

__device__ __forceinline__ const Args* args_ptr() { unsigned long long p = (unsigned long long)__builtin_amdgcn_kernarg_segment_ptr(); asm volatile("" : "+s"(p)); return (const Args*)(const void __attribute__((address_space(4)))*)p; }
__device__ __forceinline__ Ctx make_ctx() {
    Ctx F; int t = threadIdx.x; asm volatile("" : "+v"(t));
    unsigned z = 0; asm volatile("" : "+s"(z));
    F.lds = (LAS unsigned char*)(uintptr_t)z;
    F.tid = t; F.lane = t & 63; F.wave = __builtin_amdgcn_readfirstlane(t >> 6);
    F.G = gridDim.x; { const int bx = blockIdx.x; F.vcu = (F.G % 8 == 0) ? (bx % 8) * (F.G / 8) + bx / 8 : bx; }
    return F;
}
constexpr int NU_CV = 800, NU_HL = 16, NU_AL = 256, NU_HC = 256, NU_AC = 256, NU_A = 640, NU_M1 = NU_HL + NU_AL + NU_HC + NU_AC + NU_A;
#ifndef PROBE_UT
#define PROBE_UT (-1)
#endif
__device__ __forceinline__ void phase_mixers(int l, int qslot) {
    for (;;) {
        int u;
        {   const Args& a = *args_ptr(); const Ctx F = make_ctx();
            unsigned* head = (unsigned*)(a.ws + WS_CTL) + CW_Q + 64 * qslot;
            volatile LAS unsigned* bc = (volatile LAS unsigned*)(F.lds + LDSCTL_OFF) + 4;
            __syncthreads();
            if (F.tid == 0) bc[0] = __hip_atomic_fetch_add(head, 1u, __ATOMIC_RELAXED, __HIP_MEMORY_SCOPE_AGENT);
            __syncthreads();
            u = (int)bc[0]; }
        u = __builtin_amdgcn_readfirstlane(u);
        if (u < NU_HL) { for (int rr = 0; rr < (PROBE_UT == 0 ? 2 : 1); ++rr) { const Args& a = *args_ptr(); const Ctx F = make_ctx(); unitHgrn(a, F, l, true, u >> 3, u & 7); } continue; }
        u -= NU_HL;
        if (l < DEPTH - 1) {
            if (u >= 3 * NU_CV) break;
            const int trip = u / 3, pos = u - 3 * trip;
            if (pos == 2) {
                const Args& a = *args_ptr(); const Ctx F = make_ctx();
                LAS float* scr = (LAS float*)(F.lds + F.wave * 16640);
                for (int k = 0; k < 3; ++k) cvt_layer_item(a, l + 1, trip * 24 + k * 8 + F.wave, scr, F.lane);
                continue;
            }
            u = 2 * trip + pos;
            if (u >= NU_M1 - NU_HL) continue;
        } else if (u >= NU_M1 - NU_HL) break;
        if (u < NU_AL) { for (int rr = 0; rr < (PROBE_UT == 1 ? 2 : 1); ++rr) { const Args& a = *args_ptr(); const Ctx F = make_ctx(); unitAttnLat(a, F, l, u); } continue; }
        u -= NU_AL;
        if (u < NU_HC) { for (int rr = 0; rr < (PROBE_UT == 2 ? 2 : 1); ++rr) { const Args& a = *args_ptr(); const Ctx F = make_ctx(); unitHgrn(a, F, l, false, u >> 3, u & 7); } continue; }
        u -= NU_HC;
        if (u < NU_AC) { for (int rr = 0; rr < (PROBE_UT == 3 ? 2 : 1); ++rr) { const Args& a = *args_ptr(); const Ctx F = make_ctx(); unitAttnCtx(a, F, u); } continue; }
        u -= NU_AC;
        for (int rr = 0; rr < (PROBE_UT == 4 ? 2 : 1); ++rr) { const Args& a = *args_ptr(); const Ctx F = make_ctx(); unitA(a, F, l, u); }
    }
}

__global__ void __launch_bounds__(NTHR, 2) fwd(Args a_in) {
    extern __shared__ __attribute__((aligned(16))) unsigned char lds_raw[];
    volatile LAS unsigned* MISC = (volatile LAS unsigned*)((LAS unsigned char*)lds_raw + LDSCTL_OFF);
    for (int u = threadIdx.x; u < 256; u += NTHR) MISC[u] = 0u;
    __syncthreads();
    const int lo = a_in.ph_lo, hi = a_in.ph_hi;
    const bool multi = (hi - lo) > 1;
    XcdBarrier bar; bar.bar = (unsigned*)(a_in.ws + WS_CTL) + CW_BAR; bar.x = 0; bar.st = MISC;
    if (multi) bar = xcd_barrier_post((unsigned*)(a_in.ws + WS_CTL) + CW_BAR, MISC);
#ifndef PMASK
#define PMASK 0xFFFFFFFFu
#endif
#define PM(b) ((PMASK >> (b)) & 1u)
#define IN(k) (lo <= (k) && (k) < hi)
#define SEAM(k) do { if (IN(k) && IN((k) + 1)) xcd_barrier(bar); } while (0)
#ifndef PROBE_P
#define PROBE_P (-1)
#define PROBE_N 0
#define PROBE_L 1
#endif
#define REP_BEGIN(k) for (int rep = 0; rep < ((PROBE_P == (k) && l == PROBE_L) ? 1 + PROBE_N : 1); ++rep) {
#define REP_END(k) if (PROBE_P == (k) && l == PROBE_L && rep < PROBE_N) xcd_barrier(bar); }

    if (PM(0) && IN(PH_PRO)) { const int l = PROBE_L; REP_BEGIN(0) const Args& a = *args_ptr(); const Ctx F = make_ctx(); phase_prologue(a, F); REP_END(0) SEAM(PH_PRO); }
    if (PM(1) && IN(PH_T1)) { const int l = PROBE_L; REP_BEGIN(1) const Args& a = *args_ptr(); const Ctx F = make_ctx(); const float* MOD = (const float*)(a.ws + WS_MOD);
        rownorm_phase(a, F, true, nullptr, nullptr, nullptr, true, a.norm_g + 0, MOD + 1 * 2048, MOD + 0 * 2048); REP_END(1) SEAM(PH_T1); }

    for (int l = 0; l < DEPTH; ++l) {
        const int pb = PH_L0 + l * PH_PER_LAYER;
        if (PM(2) && IN(pb + 0)) { REP_BEGIN(2)
            const Args& a = *args_ptr(); const Ctx F = make_ctx(); unsigned char* ws = a.ws; const bf16* wl = (const bf16*)(ws + WS_WT) + (size_t)l * WL_ELEMS;
            pg8::Gemm g{(const bf16*)(ws + WS_H), wl + OFF_IN, MTOK, INW, DM, DM, DM, 0}; pg8::StaticOrder S; S.init(MTOK, INW, F.G, (int)blockIdx.x);
            EpiIn E{(bf16*)(ws + WS_Z), (float*)(ws + WS_LOGF), (const float*)(ws + WS_LB) + l * 1024, a.out + OUT_K + (size_t)l * 262144, a.out + OUT_V + (size_t)l * 262144};
            pg8::gemm_phase<EpiIn, pg8::StaticOrder, true, true>(F.lds, g, S, E);
            REP_END(2) SEAM(pb + 0);
        }
        if (PM(3) && IN(pb + 1)) { REP_BEGIN(3) phase_mixers(l, l + 4 * rep); REP_END(3) SEAM(pb + 1); }
        if (PM(5) && IN(pb + 3)) { REP_BEGIN(5)
            const Args& a = *args_ptr(); const Ctx F = make_ctx(); unsigned char* ws = a.ws; const bf16* wl = (const bf16*)(ws + WS_WT) + (size_t)l * WL_ELEMS;
            pg8::StaticOrder S; S.init(MTOK, DM, F.G, (int)blockIdx.x);
            pg8::Gemm g{(const bf16*)(ws + WS_Y), wl + OFF_UP, MTOK, DM, YW, YW, YW, 0}; EpiUpK E{(const bf16*)(ws + WS_Z) + 10240, (bf16*)(ws + WS_MG)};
            pg8::gemm_phase<EpiUpK, pg8::StaticOrder, true, true>(F.lds, g, S, E);
            REP_END(5) SEAM(pb + 3);
        }
        if (PM(6) && IN(pb + 4)) { REP_BEGIN(6)
            {   const Args& a = *args_ptr(); const Ctx F = make_ctx(); unsigned char* ws = a.ws; const bf16* wl = (const bf16*)(ws + WS_WT) + (size_t)l * WL_ELEMS;
                pg8::Gemm g{(const bf16*)(ws + WS_MG), wl + OFF_OUT, NCTX, DM, DM, DM, DM, 0}; pg8::StaticOrder S; S.init(NCTX, DM, F.G, (int)blockIdx.x);
                EpiBf16P E{(bf16*)(ws + WS_T), DM, 0}; pg8::gemm_phase<EpiBf16P, pg8::StaticOrder, true, true>(F.lds, g, S, E); }
            {   const Args& a = *args_ptr(); const Ctx F = make_ctx(); unsigned char* ws = a.ws; const bf16* wl = (const bf16*)(ws + WS_WT) + (size_t)l * WL_ELEMS;
                pg8::Gemm g{(const bf16*)(ws + WS_MG) + (size_t)NCTX * DM, wl + OFF_OUT, NLAT, DM, DM / 4, DM, DM, (DM / 4) * 2}; pg8::SplitOrder S; S.init(F.G, (int)blockIdx.x);
                EpiBf16P E{(bf16*)(ws + WS_TP), DM, TPQ}; pg8::gemm_phase<EpiBf16P, pg8::SplitOrder, true, true>(F.lds, g, S, E); }
            REP_END(6) SEAM(pb + 4);
        }
        if (PM(7) && IN(pb + 5)) { REP_BEGIN(7) const Args& a = *args_ptr(); const Ctx F = make_ctx(); const float* modl = (const float*)(a.ws + WS_MOD) + (size_t)l * 3 * 12288; const float* gl = a.norm_g + (size_t)l * 4 * DM;
            rownorm_phase(a, F, false, (const bf16*)(a.ws + WS_T), modl + 2 * 2048, gl + 1 * DM, true, gl + 2 * DM, modl + 4 * 2048, modl + 3 * 2048); REP_END(7) SEAM(pb + 5); }
        if (PM(8) && IN(pb + 6)) { REP_BEGIN(8)
            const Args& a = *args_ptr(); const Ctx F = make_ctx(); unsigned char* ws = a.ws; const bf16* wl = (const bf16*)(ws + WS_WT) + (size_t)l * WL_ELEMS;
            pg8::Gemm g{(const bf16*)(ws + WS_H), wl + OFF_FI, MTOK, NFI, DM, DM, DM, 0}; pg8::StaticOrder S; S.init(MTOK, NFI, F.G, (int)blockIdx.x);
            EpiSwi E{(bf16*)(ws + WS_ACT)}; pg8::gemm_phase<EpiSwi, pg8::StaticOrder, true, true>(F.lds, g, S, E);
            REP_END(8) SEAM(pb + 6);
        }
        if (PM(9) && IN(pb + 7)) { REP_BEGIN(9)
            {   const Args& a = *args_ptr(); const Ctx F = make_ctx(); unsigned char* ws = a.ws; const bf16* wl = (const bf16*)(ws + WS_WT) + (size_t)l * WL_ELEMS;
                pg8::Gemm g{(const bf16*)(ws + WS_ACT), wl + OFF_FO, NCTX, DM, DFF, DFF, DFF, 0}; pg8::StaticOrder S; S.init(NCTX, DM, F.G, (int)blockIdx.x);
                EpiBf16P E{(bf16*)(ws + WS_T), DM, 0}; pg8::gemm_phase<EpiBf16P, pg8::StaticOrder, true, true>(F.lds, g, S, E); }
            {   const Args& a = *args_ptr(); const Ctx F = make_ctx(); unsigned char* ws = a.ws; const bf16* wl = (const bf16*)(ws + WS_WT) + (size_t)l * WL_ELEMS;
                pg8::Gemm g{(const bf16*)(ws + WS_ACT) + (size_t)NCTX * DFF, wl + OFF_FO, NLAT, DM, DFF / 4, DFF, DFF, (DFF / 4) * 2}; pg8::SplitOrder S; S.init(F.G, (int)blockIdx.x);
                EpiBf16P E{(bf16*)(ws + WS_TP), DM, TPQ}; pg8::gemm_phase<EpiBf16P, pg8::SplitOrder, true, true>(F.lds, g, S, E); }
            REP_END(9) SEAM(pb + 7);
        }
        if (PM(10) && IN(pb + 8)) { REP_BEGIN(10)
            const Args& a = *args_ptr(); const Ctx F = make_ctx(); const float* MOD = (const float*)(a.ws + WS_MOD);
            const bool last = (l == DEPTH - 1); const int ln = last ? l : l + 1;
            const float* modl = MOD + (size_t)l * 3 * 12288; const float* gl = a.norm_g + (size_t)l * 4 * DM;
            const float* modn = MOD + (size_t)ln * 3 * 12288; const float* gnn = a.norm_g + (size_t)ln * 4 * DM;
            rownorm_phase(a, F, false, (const bf16*)(a.ws + WS_T), modl + 5 * 2048, gl + 3 * DM, !last, gnn + 0, modn + 1 * 2048, modn + 0 * 2048);
            REP_END(10) SEAM(pb + 8);
        }
    }
#undef IN
#undef SEAM
#undef REP_BEGIN
#undef REP_END
}

#ifndef MK_ONE_LAUNCH
#define MK_ONE_LAUNCH 1
#endif
extern "C" void kernel_launch(void* const* d_in, const int* in_sizes, int n_in, void* d_out, int out_size, void* d_ws, size_t ws_size, hipStream_t stream) {
    static int grid = 0;
    if (grid == 0) {
        if (n_in != 21 || (size_t)out_size != OUT_END || ws_size < WS_END) { fprintf(stderr, "kernel_launch: unexpected shapes: n_in %d out %d ws %zu\n", n_in, out_size, ws_size); grid = -1; return; }
        int dev = 0, cus = 0, per_cu = 0;
        if (hipGetDevice(&dev) != hipSuccess || hipDeviceGetAttribute(&cus, hipDeviceAttributeMultiprocessorCount, dev) != hipSuccess) { grid = -1; return; }
        if (hipFuncSetAttribute((const void*)fwd, hipFuncAttributeMaxDynamicSharedMemorySize, LDS_BYTES) != hipSuccess) { fprintf(stderr, "kernel_launch: hipFuncSetAttribute failed\n"); grid = -1; return; }
        if (hipOccupancyMaxActiveBlocksPerMultiprocessor(&per_cu, (const void*)fwd, NTHR, LDS_BYTES) != hipSuccess || per_cu < 1) fprintf(stderr, "kernel_launch: occupancy query says %d\n", per_cu);
        (void)hipGetLastError();
        grid = cus;
    }
    if (grid < 0) return;
    (void)hipMemsetAsync((char*)d_ws + WS_CTL, 0, CTL_ZERO_BYTES, stream);
    Args a{};
    const float** ap = (const float**)&a;
    for (int i = 0; i < 21; ++i) ap[i] = (const float*)d_in[i];
    a.out = (float*)d_out; a.ws = (unsigned char*)d_ws;
#if MK_ONE_LAUNCH
    a.ph_lo = 0; a.ph_hi = PH_END;
    hipLaunchKernelGGL(fwd, dim3(grid), dim3(NTHR), LDS_BYTES, stream, a);
#else
    for (int p = 0; p < PH_END; ++p) { a.ph_lo = p; a.ph_hi = p + 1; hipLaunchKernelGGL(fwd, dim3(grid), dim3(NTHR), LDS_BYTES, stream, a); }
#endif
}
```

```cpp
#include <hip/hip_runtime.h>
#include <cstdio>
#include <cstdint>
namespace pg8 {
#define PG8_LAS __attribute__((address_space(3)))
typedef unsigned short bf16_t;
typedef short bf16x8 __attribute__((ext_vector_type(8)));
typedef float f32x4 __attribute__((ext_vector_type(4)));
typedef unsigned u32x4 __attribute__((ext_vector_type(4)));
constexpr int BM = 256, BK = 64, HALF = 128, HTB = HALF * BK * 2  , STAGE_BYTES = 8 * HTB, NXCD = 8, WGM = 8;

__host__ __device__ __forceinline__ int lds_byte(int r, int c) { const int st = (r >> 4) * 2 + (c >> 5), rr = r & 15, cc = c & 31, ob = rr * 64 + cc * 2; return st * 1024 + (ob ^ (((ob >> 9) & 1) << 5)); }
__host__ __device__ __forceinline__ void stage_rc(int b, int& R, int& C) { const int st = b / 1024, sb = b % 1024, swz = sb ^ (((sb >> 9) & 1) << 5); R = (st >> 1) * 16 + swz / 64; C = (st & 1) * 32 + (swz % 64) / 2; }
__host__ __device__ __forceinline__ int perm32(int rho) { const int n = rho >> 4, i = rho & 15; return 8 * (i >> 2) + 4 * n + (i & 3); }

struct Unit { int pm, pn, kq; };
struct SplitOrder {
    int G, c;
    __host__ __device__ void init(int G_, int c_) { G = G_; c = c_; }
    __host__ __device__ bool next(int i, Unit& u) const { const long L = (long)i * G + c; if (L >= 256) return false; const int t = (int)L >> 2; u.kq = (int)L & 3; u.pm = t & 7; u.pn = t >> 3; return true; }
    __device__ __forceinline__ void a_ready(const Unit&) const {}
    __device__ __forceinline__ void done(const Unit&) const {}
};
struct Gemm { const bf16_t* A; const bf16_t* Bt; int M, N, K, lda, ldb, koff; };

struct StaticOrder {
    int nM, nN, nwg, G, c;
    __host__ __device__ void init(int M, int N, int G_, int c_) { nM = M / BM; nN = N / BM; nwg = nM * nN; G = G_; c = c_; }
    __host__ __device__ bool next(int i, Unit& u) const {
        const long L = (long)i * G + c; if (L >= nwg) return false;
        int wgid = (int)L; { const int q = nwg / NXCD, r = nwg % NXCD, xcd = wgid % NXCD, off = wgid / NXCD; wgid = (xcd < r ? xcd * (q + 1) : r * (q + 1) + (xcd - r) * q) + off; }
        const int nig = WGM * nN, gid = wgid / nig, fm = gid * WGM, gsz = (nM - fm) < WGM ? (nM - fm) : WGM;
        u.pm = fm + ((wgid % nig) % gsz); u.pn = (wgid % nig) / gsz; u.kq = 0; return true;
    }
    __device__ __forceinline__ void a_ready(const Unit&) const {}
    __device__ __forceinline__ void done(const Unit&) const {}
};
template <class Epi, class Sched, bool ALIGN_EPI = false, bool SP2 = false>
__device__ __forceinline__ void gemm_phase(PG8_LAS unsigned char* lds, const Gemm g, const Sched& S, const Epi& E) {
    int tid_ = threadIdx.x; asm volatile("" : "+v"(tid_));
    const int tid = tid_, wid = __builtin_amdgcn_readfirstlane(tid >> 6), lane = tid & 63, wr = wid >> 2, wc = wid & 3, fr = lane & 15, fq = lane >> 4;
    const int K = g.K, nt = K / BK;
    unsigned voffA[2], voffB[2];
#pragma unroll
    for (int i = 0; i < 2; ++i) { int R, C; stage_rc(tid * 16 + i * 8192, R, C); const int Rb = Epi::PERM ? ((R & ~31) + perm32(R & 31)) : R;
        voffA[i] = (unsigned)(R * g.lda + C) * 2u; voffB[i] = (unsigned)(Rb * g.ldb + C) * 2u; }
    const size_t kstep = (size_t)(BK * 2);
    const size_t hstepA = (size_t)HALF * g.lda * 2, hstepB = (size_t)HALF * g.ldb * 2;
    const size_t tstepA = 2 * hstepA, tstepB = 2 * hstepB;
    const unsigned ldsw = (unsigned)wid * 1024u;
    const int aoff = lds_byte(wr * 64 + fr, fq * 8), boff = lds_byte(wc * 32 + fr, fq * 8);
#define PG8_SA(b, h) (((b) * 2 + (h)) * HTB)
#define PG8_SB(b, h) ((4 + (b) * 2 + (h)) * HTB)
#define PG8_STAGE(bufoff, gbase, voff) do { _Pragma("unroll") for (int _i = 0; _i < 2; ++_i) \
        __builtin_amdgcn_global_load_lds((const unsigned*)((const char*)(gbase) + (voff)[_i]), (PG8_LAS unsigned*)(lds + (bufoff) + ldsw + _i * 8192), 16, 0, 0); } while (0)
#define PG8_LDA(dst, b, h) do { _Pragma("unroll") for (int m = 0; m < 4; ++m) _Pragma("unroll") for (int k = 0; k < 2; ++k) dst[m][k] = *(const PG8_LAS bf16x8*)(lds + PG8_SA(b, h) + aoff + m * 2048 + k * 1024); } while (0)
#define PG8_LDB(dst, b, h) do { _Pragma("unroll") for (int n = 0; n < 2; ++n) _Pragma("unroll") for (int k = 0; k < 2; ++k) dst[n][k] = *(const PG8_LAS bf16x8*)(lds + PG8_SB(b, h) + boff + n * 2048 + k * 1024); } while (0)
#define PG8_MMA(ai, bj, At, Bt) do { __builtin_amdgcn_s_setprio(1); _Pragma("unroll") for (int m = 0; m < 4; ++m) _Pragma("unroll") for (int n = 0; n < 2; ++n) _Pragma("unroll") for (int k = 0; k < 2; ++k) \
        acc[ai][bj][m][n] = __builtin_amdgcn_mfma_f32_16x16x32_bf16(Bt[n][k], At[m][k], acc[ai][bj][m][n], 0, 0, 0); __builtin_amdgcn_s_setprio(0); } while (0)
#define PG8_WAIT_V(n) asm volatile("s_waitcnt vmcnt(" #n ")" ::: "memory")
#define PG8_WAIT_L(n) asm volatile("s_waitcnt lgkmcnt(" #n ")" ::: "memory")
#define PG8_BAR __builtin_amdgcn_s_barrier()
#define PG8_SCHED __builtin_amdgcn_sched_barrier(0)
    Unit cur, nxt; int ui = 0;
    if (!S.next(0, cur)) return;
    f32x4 acc[2][2][4][2];
#pragma unroll
    for (int a = 0; a < 2; ++a)
#pragma unroll
        for (int b = 0; b < 2; ++b)
#pragma unroll
            for (int m = 0; m < 4; ++m)
#pragma unroll
                for (int n = 0; n < 2; ++n) acc[a][b][m][n] = (f32x4){0.f, 0.f, 0.f, 0.f};
    bf16x8 At[4][2], B0[2][2], B1[2][2];
    const char* cA = (const char*)g.A + (size_t)cur.pm * tstepA + (size_t)cur.kq * g.koff; const char* cB = (const char*)g.Bt + (size_t)cur.pn * tstepB + (size_t)cur.kq * g.koff;
    S.a_ready(cur);
    if constexpr (SP2) {
        PG8_STAGE(PG8_SB(0, 0), cB, voffB); PG8_STAGE(PG8_SB(0, 1), cB + hstepB, voffB); PG8_STAGE(PG8_SA(0, 0), cA, voffA); PG8_STAGE(PG8_SA(0, 1), cA + hstepA, voffA);
        if (wr == 1) PG8_BAR;
        PG8_WAIT_V(2); PG8_BAR;
        PG8_STAGE(PG8_SB(1, 0), cB + kstep, voffB); PG8_STAGE(PG8_SA(1, 0), cA + kstep, voffA); PG8_STAGE(PG8_SB(1, 1), cB + hstepB + kstep, voffB);
        PG8_WAIT_V(6); PG8_BAR;
    } else {
        PG8_STAGE(PG8_SB(0, 0), cB, voffB); PG8_STAGE(PG8_SA(0, 0), cA, voffA); PG8_STAGE(PG8_SB(0, 1), cB + hstepB, voffB); PG8_STAGE(PG8_SA(0, 1), cA + hstepA, voffA);
        if (wr == 1) PG8_BAR;
        PG8_WAIT_V(4); PG8_BAR;
        PG8_STAGE(PG8_SB(1, 0), cB + kstep, voffB); PG8_STAGE(PG8_SA(1, 0), cA + kstep, voffA); PG8_STAGE(PG8_SB(1, 1), cB + hstepB + kstep, voffB);
        PG8_WAIT_V(6); PG8_BAR;
    }
    for (;;) {
        const bool has_next = S.next(ui + 1, nxt);
        const char* nA = has_next ? (const char*)g.A + (size_t)nxt.pm * tstepA + (size_t)nxt.kq * g.koff : cA; const char* nB = has_next ? (const char*)g.Bt + (size_t)nxt.pn * tstepB + (size_t)nxt.kq * g.koff : cB;
        for (int t = 0; t < nt; t += 2) {
            const bool last = (t == nt - 2);
            const char* a1 = cA + (size_t)(t + 1) * kstep;
            const char* a2 = last ? nA : cA + (size_t)(t + 2) * kstep; const char* b2 = last ? nB : cB + (size_t)(t + 2) * kstep;
            const char* a3 = a2 + kstep; const char* b3 = b2 + kstep;
            if (last && has_next) S.a_ready(nxt);
            if constexpr (Epi::HOOK) { if (t == Epi::H1 || t == Epi::H2) E.hook(acc, cur, t, wr, wc, fr, fq); }
            if constexpr (SP2) {
            PG8_LDB(B0, 0, 0); PG8_LDB(B1, 0, 1); PG8_SCHED; PG8_LDA(At, 0, 0); PG8_STAGE(PG8_SA(1, 1), a1 + hstepA, voffA);
            PG8_WAIT_V(8); PG8_WAIT_L(0); PG8_BAR; PG8_MMA(0, 0, At, B0); PG8_MMA(0, 1, At, B1); PG8_BAR; PG8_SCHED;
            PG8_LDA(At, 0, 1); PG8_STAGE(PG8_SB(0, 0), b2, voffB); PG8_STAGE(PG8_SB(0, 1), b2 + hstepB, voffB); PG8_STAGE(PG8_SA(0, 0), a2, voffA);
            PG8_WAIT_V(8); PG8_WAIT_L(0); PG8_BAR; PG8_MMA(1, 0, At, B0); PG8_MMA(1, 1, At, B1); PG8_BAR; PG8_SCHED;
            PG8_LDB(B0, 1, 0); PG8_LDB(B1, 1, 1); PG8_SCHED; PG8_LDA(At, 1, 0); PG8_STAGE(PG8_SA(0, 1), a2 + hstepA, voffA);
            PG8_WAIT_V(8); PG8_WAIT_L(0); PG8_BAR; PG8_MMA(0, 0, At, B0); PG8_MMA(0, 1, At, B1); PG8_BAR; PG8_SCHED;
            PG8_LDA(At, 1, 1); PG8_STAGE(PG8_SB(1, 0), b3, voffB); PG8_STAGE(PG8_SB(1, 1), b3 + hstepB, voffB); PG8_STAGE(PG8_SA(1, 0), a3, voffA);
            PG8_WAIT_V(8); PG8_WAIT_L(0); PG8_BAR; PG8_MMA(1, 0, At, B0); PG8_MMA(1, 1, At, B1); PG8_BAR; PG8_SCHED;
            } else {
            PG8_LDB(B0, 0, 0); PG8_SCHED; PG8_LDA(At, 0, 0); PG8_STAGE(PG8_SA(1, 1), a1 + hstepA, voffA);
            PG8_WAIT_L(8); PG8_BAR; PG8_WAIT_L(0); PG8_MMA(0, 0, At, B0); PG8_BAR; PG8_SCHED;
            PG8_LDB(B1, 0, 1); PG8_STAGE(PG8_SB(0, 0), b2, voffB);
            PG8_BAR; PG8_WAIT_L(0); PG8_MMA(0, 1, At, B1); PG8_BAR;
            PG8_LDA(At, 0, 1); PG8_STAGE(PG8_SA(0, 0), a2, voffA);
            PG8_BAR; PG8_WAIT_L(0); PG8_MMA(1, 0, At, B0); PG8_BAR; PG8_SCHED;
            PG8_STAGE(PG8_SB(0, 1), b2 + hstepB, voffB);
            PG8_WAIT_V(6); PG8_BAR; PG8_MMA(1, 1, At, B1); PG8_BAR;
            PG8_LDB(B0, 1, 0); PG8_SCHED; PG8_LDA(At, 1, 0); PG8_STAGE(PG8_SA(0, 1), a2 + hstepA, voffA);
            PG8_WAIT_L(8); PG8_BAR; PG8_WAIT_L(0); PG8_MMA(0, 0, At, B0); PG8_BAR; PG8_SCHED;
            PG8_LDB(B1, 1, 1); PG8_STAGE(PG8_SB(1, 0), b3, voffB);
            PG8_BAR; PG8_WAIT_L(0); PG8_MMA(0, 1, At, B1); PG8_BAR;
            PG8_LDA(At, 1, 1); PG8_STAGE(PG8_SA(1, 0), a3, voffA);
            PG8_BAR; PG8_WAIT_L(0); PG8_MMA(1, 0, At, B0); PG8_BAR; PG8_SCHED;
            PG8_STAGE(PG8_SB(1, 1), b3 + hstepB, voffB);
            PG8_WAIT_V(6); PG8_BAR; PG8_MMA(1, 1, At, B1); PG8_BAR;
            }
        }
        if constexpr (ALIGN_EPI) { if (wr == 0) PG8_BAR; }
        if constexpr (!Epi::AFTER_DRAIN) { E(acc, cur, wr, wc, fr, fq); S.done(cur); }
        if (!has_next) break;
#pragma unroll
        for (int a = 0; a < 2; ++a)
#pragma unroll
            for (int b = 0; b < 2; ++b)
#pragma unroll
                for (int m = 0; m < 4; ++m)
#pragma unroll
                    for (int n = 0; n < 2; ++n) acc[a][b][m][n] = (f32x4){0.f, 0.f, 0.f, 0.f};
        cur = nxt; cA = nA; cB = nB; ++ui;
        if constexpr (ALIGN_EPI) { if (wr == 1) PG8_BAR; }
    }
    PG8_WAIT_V(0);
    if constexpr (!ALIGN_EPI) { if (wr == 0) PG8_BAR; }
    PG8_BAR;
    if constexpr (Epi::AFTER_DRAIN) { E.fused(acc, cur, wr, wc, fr, fq, lds, wid, lane); S.done(cur); }
#undef PG8_SA
#undef PG8_SB
#undef PG8_STAGE
#undef PG8_LDA
#undef PG8_LDB
#undef PG8_MMA
#undef PG8_WAIT_V
#undef PG8_WAIT_L
#undef PG8_BAR
#undef PG8_SCHED
}
}

#define GAS __attribute__((address_space(1)))
#define LAS __attribute__((address_space(3)))
typedef unsigned short bf16;
typedef unsigned v4u __attribute__((ext_vector_type(4)));
typedef unsigned v2u __attribute__((ext_vector_type(2)));
typedef float f32x4 __attribute__((ext_vector_type(4)));

constexpr int DM = 2048, NCTX = 8192, NLAT = 2048, MTOK = 10240, DEPTH = 4;
constexpr int INW = 16384, DFF = 5632, NFI = 11264, YW = 3072;
constexpr float EPS = 1e-6f;
constexpr int NWAVES = 8, NTHR = 512;

constexpr size_t MiB = 1u << 20;
constexpr size_t WS_CTL = 0, CTL_ZERO_BYTES = 1 * MiB;
constexpr size_t WS_MOD = 1 * MiB;
constexpr size_t WS_LB = 2 * MiB;
constexpr size_t WS_ROPE = 2 * MiB + 65536;
constexpr size_t WS_AST = 2 * MiB + 131072;
constexpr size_t WS_WT = 4 * MiB;
constexpr size_t WL_ELEMS = 78643200;
constexpr size_t OFF_IN = 0, OFF_UP = 33554432, OFF_OUT = 39845888, OFF_FI = 44040192, OFF_FO = 67108864;
constexpr size_t WS_Z = 604 * MiB;
constexpr size_t WS_LOGF = 924 * MiB;
constexpr size_t WS_H = 1004 * MiB;
constexpr size_t WS_Y = 1044 * MiB;
constexpr size_t WS_OF = 1104 * MiB;
constexpr size_t WS_OB = 1144 * MiB;
constexpr size_t WS_TP = 1184 * MiB;
constexpr size_t TPQ = 2048 * 2048;
constexpr size_t WS_MG = 1264 * MiB;
constexpr size_t WS_T = 1304 * MiB;
constexpr size_t WS_ACT = 1384 * MiB;
constexpr size_t WS_END = 1494 * MiB;
constexpr int CW_BAR = 4096;
constexpr int CW_Q = 16384;
constexpr size_t OUT_Y = 0, OUT_K = 20971520, OUT_V = OUT_K + 33554432, OUT_S = OUT_V + 33554432, OUT_END = OUT_S + 33554432;

constexpr int LDS_BYTES = 155648;
constexpr int LDSCTL_OFF = 154624;

constexpr int PH_PRO = 0, PH_T1 = 1, PH_L0 = 2, PH_PER_LAYER = 9, PH_END = PH_L0 + DEPTH * PH_PER_LAYER;

struct Args {
    const float *x_prompt, *x_sample, *cache_k, *cache_v, *state, *c, *c_ctx, *w_ada, *b_ada, *norm_g, *w_in, *a_w, *a_b, *rpb, *lb_logits, *w_up_a, *w_up_b, *w_up_c, *w_out, *w_fi, *w_fo;
    float* out; unsigned char* ws; int ph_lo, ph_hi;
};

__device__ __forceinline__ float bf2f_lo(unsigned w) { return __uint_as_float(w << 16); }
__device__ __forceinline__ float bf2f_hi(unsigned w) { return __uint_as_float(w & 0xffff0000u); }
__device__ __forceinline__ unsigned f2bf(float f) { unsigned u = __float_as_uint(f); return (u + 0x7fffu + ((u >> 16) & 1u)) >> 16; }
typedef __bf16 bf16x2_t __attribute__((ext_vector_type(2)));
typedef float f32x2_t __attribute__((ext_vector_type(2)));
__device__ __forceinline__ unsigned cvtpk(float lo, float hi) { const f32x2_t v = {lo, hi}; return __builtin_bit_cast(unsigned, __builtin_convertvector(v, bf16x2_t)); }
__device__ __forceinline__ unsigned pk2(float lo, float hi) { return cvtpk(lo, hi); }
__device__ __forceinline__ void unpack8(const v4u w, float (&f)[8]) {
    f[0] = bf2f_lo(w.x); f[1] = bf2f_hi(w.x); f[2] = bf2f_lo(w.y); f[3] = bf2f_hi(w.y); f[4] = bf2f_lo(w.z); f[5] = bf2f_hi(w.z); f[6] = bf2f_lo(w.w); f[7] = bf2f_hi(w.w); }
__device__ __forceinline__ v4u pack8(const float (&f)[8]) { v4u w; w.x = pk2(f[0], f[1]); w.y = pk2(f[2], f[3]); w.z = pk2(f[4], f[5]); w.w = pk2(f[6], f[7]); return w; }
__device__ __forceinline__ float wave_sum(float v) {
#pragma unroll
    for (int o = 1; o < 64; o <<= 1) v += __shfl_xor(v, o);
    return v;
}
__device__ __forceinline__ float sigmoidf_(float x) { return __builtin_amdgcn_rcpf(1.0f + __builtin_amdgcn_exp2f(-1.4426950408889634f * x)); }
__device__ __forceinline__ float siluf_(float x) { return x * __builtin_amdgcn_rcpf(1.0f + __builtin_amdgcn_exp2f(-1.4426950408889634f * x)); }
__device__ __forceinline__ float gelu_tanh_(float x) { const float y = (-1.4426950408889634f * 1.5957691216057308f) * (x + 0.044715f * x * x * x); return x * __builtin_amdgcn_rcpf(1.0f + __builtin_amdgcn_exp2f(y)); }

#define XB_TMO      128
#define XB_XCNT(j)  (256  + 64 * (j))
#define XB_XSUB(j)  (1280 + 64 * (j))
#define XB_XGEN(j)  (2304 + 64 * (j))
#define XB_TOP      3328
#define XB_TOPGEN   3392
#define XCD_BAR_WORDS 3456
#define XB_SPIN_CAP (1u << 18)
__device__ __forceinline__ unsigned xb_ld(unsigned* p)              { return __hip_atomic_load(p, __ATOMIC_RELAXED, __HIP_MEMORY_SCOPE_AGENT); }
__device__ __forceinline__ unsigned xb_add(unsigned* p, unsigned v) { return __hip_atomic_fetch_add(p, v, __ATOMIC_RELAXED, __HIP_MEMORY_SCOPE_AGENT); }
__device__ __forceinline__ unsigned xb_xcc_id() { return (unsigned)__builtin_amdgcn_s_getreg((3 << 11) | 20) & 0xFu; }
#define XB_SPIN(cond, bar) do { unsigned _sp = 0; while (cond) { __builtin_amdgcn_s_sleep(1); \
    if ((++_sp & 255u) == 0u) { if (xb_ld(&(bar)[XB_TMO])) break; if (_sp > XB_SPIN_CAP) { atomicAdd(&(bar)[XB_TMO], 1u); break; } } } } while (0)
struct XcdBarrier { unsigned* bar; unsigned x; volatile LAS unsigned* st; };
__device__ __forceinline__ XcdBarrier xcd_barrier_post(unsigned* bar, volatile LAS unsigned* st) {
    XcdBarrier b; b.bar = bar; b.x = xb_xcc_id(); b.st = st;
    if (threadIdx.x == 0) (void)xb_add(&bar[XB_XCNT(b.x)], 1u);
    return b;
}
__device__ __forceinline__ void xcd_barrier_complete(unsigned* bar, unsigned x, unsigned& nloc, unsigned& nx) {
    const unsigned G = gridDim.x * gridDim.y * gridDim.z;
    unsigned sum, cnt, mine, sp = 0u;
    for (;;) {
        sum = 0u; cnt = 0u; mine = 0u;
#pragma unroll
        for (unsigned j = 0; j < 16; ++j) { const unsigned c = xb_ld(&bar[XB_XCNT(j)]); sum += c; cnt += (c > 0u) ? 1u : 0u; mine = (j == x) ? c : mine; }
        if (sum == G) break;
        __builtin_amdgcn_s_sleep(1);
        if ((++sp & 255u) == 0u) { if (xb_ld(&bar[XB_TMO])) break; if (sp > XB_SPIN_CAP) { atomicAdd(&bar[XB_TMO], 1u); break; } }
    }
    nloc = mine > 0u ? mine : 1u; nx = cnt > 0u ? cnt : 1u;
}
__device__ __forceinline__ void xcd_barrier(const XcdBarrier& b) {
    asm volatile("s_waitcnt vmcnt(0)" ::: "memory");
    __syncthreads();
    if (threadIdx.x == 0) {
        unsigned* bar = b.bar;
        __builtin_amdgcn_s_waitcnt(0);
        unsigned nloc = b.st[0], nx = b.st[1];
        if (nloc == 0u) { xcd_barrier_complete(bar, b.x, nloc, nx); b.st[0] = nloc; b.st[1] = nx; }
        const unsigned old = xb_add(&bar[XB_XSUB(b.x)], 1u);
        const unsigned gen = old / nloc;
        if (old + 1u == (gen + 1u) * nloc) {
            __builtin_amdgcn_fence(__ATOMIC_RELEASE, "agent");
            asm volatile("s_waitcnt vmcnt(0)" ::: "memory");
            const unsigned og = xb_add(&bar[XB_TOP], 1u);
            const unsigned tg = og / nx;
            if (og + 1u == (tg + 1u) * nx) xb_add(&bar[XB_TOPGEN], 1u);
            else XB_SPIN(xb_ld(&bar[XB_TOPGEN]) == tg, bar);
            __builtin_amdgcn_fence(__ATOMIC_ACQUIRE, "agent");
            xb_add(&bar[XB_XGEN(b.x)], 1u);
            asm volatile("s_waitcnt vmcnt(0)" ::: "memory");
        } else {
            XB_SPIN(xb_ld(&bar[XB_XGEN(b.x)]) == gen, bar);
            __builtin_amdgcn_fence(__ATOMIC_ACQUIRE, "agent");
            asm volatile("s_waitcnt vmcnt(0)" ::: "memory");
        }
    }
    __syncthreads();
}

struct EpiIn {
    static constexpr bool PERM = true, AFTER_DRAIN = false, HOOK = false; static constexpr int H1 = -1, H2 = -1, NST = 16;
    bf16* Z; float* LOGF; const float* lbp  ; float* outK; float* outV; float* AST;
    template <int KIND>
    __device__ __forceinline__ void body(const f32x4 (&acc)[2][2][4][2], const pg8::Unit& u, int wr, int wc, int fr, int fq) const {
        const int row0 = u.pm * 256 + wr * 64 + fr, colt = u.pn * 256 + wc * 32 + 8 * fq;
        const int seg = u.pn >> 2;
#pragma unroll
        for (int ai = 0; ai < 2; ++ai)
#pragma unroll
            for (int m = 0; m < 4; ++m) {
                const int row = row0 + ai * 128 + m * 16;
                bf16* zrow = Z + (size_t)row * INW + colt;
                float rs = 0.f, rq = 0.f;
#pragma unroll
                for (int bj = 0; bj < 2; ++bj) {
                    float v[8];
#pragma unroll
                    for (int j = 0; j < 4; ++j) { v[j] = acc[ai][bj][m][0][j]; v[4 + j] = acc[ai][bj][m][1][j]; }
                    if (KIND == 5) {
                        const int c2 = colt + bj * 128 - 6144;
                        const float* lb = lbp + (seg - 6) * 4096 + (c2 & 1023);
                        float o[8];
#pragma unroll
                        for (int j = 0; j < 8; ++j) { const float b = lb[j]; o[j] = __builtin_amdgcn_logf(b + (1.0f - b) * sigmoidf_(v[j])); }
                        float* dst = LOGF + (size_t)row * 2048 + c2;
                        *(f32x4*)dst = (f32x4){o[0], o[1], o[2], o[3]}; *(f32x4*)(dst + 4) = (f32x4){o[4], o[5], o[6], o[7]};
                    } else {
                        if (KIND == 4) {
                            if (row < NCTX) { float* dst = (seg == 3 ? outK : outV) + ((size_t)(row >> 8) * 1024 + (row & 255)) * 1024 + (colt + bj * 128 - (seg == 3 ? 3072 : 4096));
                                *(f32x4*)dst = (f32x4){v[0], v[1], v[2], v[3]}; *(f32x4*)(dst + 4) = (f32x4){v[4], v[5], v[6], v[7]}; }
                        }
                        if (KIND == 1 || KIND == 6) {
#pragma unroll
                            for (int j = 0; j < 8; ++j) v[j] = gelu_tanh_(v[j]);
                        }
                        if (KIND == 6) {
#pragma unroll
                            for (int j = 0; j < 8; ++j) { rs += v[j]; rq += v[j] * v[j]; }
                        }
                        if (KIND == 2) {
#pragma unroll
                            for (int j = 0; j < 8; ++j) v[j] = siluf_(v[j]);
                        }
                        if (KIND == 3) {
#pragma unroll
                            for (int j = 0; j < 8; ++j) v[j] = sigmoidf_(v[j]);
                        }
                        *(v4u*)(zrow + bj * 128) = pack8(v);
                    }
                }
                if (KIND == 6) {
                    rs += __shfl_xor(rs, 16); rs += __shfl_xor(rs, 32); rq += __shfl_xor(rq, 16); rq += __shfl_xor(rq, 32);
                    if (fq == 0) { float* d = AST + ((size_t)row * 16 + (u.pn & 3) * 4 + wc) * 2; d[0] = rs; d[1] = rq; }
                }
                asm volatile("" ::: "memory");
            }
    }
    __device__ __forceinline__ void operator()(const f32x4 (&acc)[2][2][4][2], const pg8::Unit& u, int wr, int wc, int fr, int fq) const {
        const int seg = u.pn >> 2;
        if (seg >= 10) body<3>(acc, u, wr, wc, fr, fq);
        else if (seg == 0) body<1>(acc, u, wr, wc, fr, fq);
        else if (seg == 1) body<6>(acc, u, wr, wc, fr, fq);
        else if (seg == 5 || seg == 9) body<2>(acc, u, wr, wc, fr, fq);
        else if (seg == 3 || seg == 4) body<4>(acc, u, wr, wc, fr, fq);
        else if (seg == 6 || seg == 7) body<5>(acc, u, wr, wc, fr, fq);
        else body<0>(acc, u, wr, wc, fr, fq);
    }
};
struct EpiUpK {
    static constexpr bool PERM = true, AFTER_DRAIN = false, HOOK = true; static constexpr int H1 = 16, H2 = 32, NST = 16;
    const bf16* Zg  ; bf16* MG;
    __device__ __forceinline__ void hook(f32x4 (&acc)[2][2][4][2], const pg8::Unit& u, int t, int wr, int wc, int fr, int fq) const {
        int frl = fr, fql = fq; asm volatile("" : "+v"(frl), "+v"(fql));
        const int row0 = u.pm * 256 + wr * 64 + frl, colt = u.pn * 256 + wc * 32 + 8 * fql;
        const bf16* zn = Zg + (t == 16 ? 0 : 2048);
#pragma unroll
        for (int ai = 0; ai < 2; ++ai) {
            v4u nw[4][2], dw[4][2];
#pragma unroll
            for (int m = 0; m < 4; ++m)
#pragma unroll
                for (int bj = 0; bj < 2; ++bj) { const size_t ro = (size_t)(row0 + ai * 128 + m * 16) * INW + colt + bj * 128; nw[m][bj] = *(const v4u*)(zn + ro); dw[m][bj] = *(const v4u*)(zn + 2048 + ro); }
#pragma unroll
            for (int m = 0; m < 4; ++m)
#pragma unroll
                for (int bj = 0; bj < 2; ++bj) {
                    float gn[8], gd[8]; unpack8(nw[m][bj], gn); unpack8(dw[m][bj], gd);
#pragma unroll
                    for (int j = 0; j < 4; ++j) { acc[ai][bj][m][0][j] *= gn[j] * __builtin_amdgcn_rcpf(gd[j]); acc[ai][bj][m][1][j] *= gn[4 + j] * __builtin_amdgcn_rcpf(gd[4 + j]); }
                }
            asm volatile("" ::: "memory");
        }
    }
    __device__ __forceinline__ void operator()(const f32x4 (&acc)[2][2][4][2], const pg8::Unit& u, int wr, int wc, int fr, int fq) const {
        const int row0 = u.pm * 256 + wr * 64 + fr, colt = u.pn * 256 + wc * 32 + 8 * fq;
#pragma unroll
        for (int ai = 0; ai < 2; ++ai)
#pragma unroll
            for (int m = 0; m < 4; ++m) {
                const int row = row0 + ai * 128 + m * 16;
#pragma unroll
                for (int bj = 0; bj < 2; ++bj) {
                    const int col = colt + bj * 128;
                    float g[8]; unpack8(*(const v4u*)(Zg + 4096 + (size_t)row * INW + col), g);
                    float v[8];
#pragma unroll
                    for (int j = 0; j < 4; ++j) { v[j] = acc[ai][bj][m][0][j] * g[j]; v[4 + j] = acc[ai][bj][m][1][j] * g[4 + j]; }
                    *(v4u*)(MG + (size_t)row * DM + col) = pack8(v);
                }
                asm volatile("" ::: "memory");
            }
    }
};
struct EpiBf16P {
    static constexpr bool PERM = true, AFTER_DRAIN = false, HOOK = false; static constexpr int H1 = -1, H2 = -1, NST = 16;
    bf16* C; int ldc; size_t kq_stride;
    __device__ __forceinline__ void operator()(const f32x4 (&acc)[2][2][4][2], const pg8::Unit& u, int wr, int wc, int fr, int fq) const {
        const int row0 = u.pm * 256 + wr * 64 + fr, colt = u.pn * 256 + wc * 32 + 8 * fq;
#pragma unroll
        for (int ai = 0; ai < 2; ++ai)
#pragma unroll
            for (int m = 0; m < 4; ++m) {
                bf16* rp = C + (size_t)u.kq * kq_stride + (size_t)(row0 + ai * 128 + m * 16) * ldc + colt;
#pragma unroll
                for (int bj = 0; bj < 2; ++bj) { float v[8];
#pragma unroll
                    for (int j = 0; j < 4; ++j) { v[j] = acc[ai][bj][m][0][j]; v[4 + j] = acc[ai][bj][m][1][j]; }
                    *(v4u*)(rp + bj * 128) = pack8(v); }
            }
    }
};
struct EpiSwi {
    static constexpr bool PERM = true, AFTER_DRAIN = false, HOOK = false; static constexpr int H1 = -1, H2 = -1, NST = 16;
    bf16* ACT;
    __device__ __forceinline__ void operator()(const f32x4 (&acc)[2][2][4][2], const pg8::Unit& u, int wr, int wc, int fr, int fq) const {
        const int row0 = u.pm * 256 + wr * 64 + fr, colt = u.pn * 128 + wc * 32 + 8 * fq;
#pragma unroll
        for (int ai = 0; ai < 2; ++ai)
#pragma unroll
            for (int m = 0; m < 4; ++m) {
                float v[8];
#pragma unroll
                for (int j = 0; j < 4; ++j) { v[j] = siluf_(acc[ai][1][m][0][j]) * acc[ai][0][m][0][j]; v[4 + j] = siluf_(acc[ai][1][m][1][j]) * acc[ai][0][m][1][j]; }
                *(v4u*)(ACT + (size_t)(row0 + ai * 128 + m * 16) * DFF + colt) = pack8(v);
            }
    }
};

struct Ctx {
    LAS unsigned char* lds; int tid, lane, wave, vcu, G;
};

struct CvtDesc { const float* src; int N; bf16* dst; int dld; };
__device__ __forceinline__ void cvt_load(const CvtDesc& d, f32x4 (&v)[16]) {
#pragma unroll
    for (int i = 0; i < 16; ++i) v[i] = *(const f32x4*)(d.src + (size_t)(4 * i) * d.N);
}
__device__ __forceinline__ void cvt_finish(const CvtDesc& d, const f32x4 (&v)[16], LAS float* scr, int lane) {
#pragma unroll
    for (int i = 0; i < 16; ++i) { LAS float* s = scr + (4 * i + (lane >> 4)) * 65 + 4 * (lane & 15); s[0] = v[i].x; s[1] = v[i].y; s[2] = v[i].z; s[3] = v[i].w; }
    asm volatile("s_waitcnt lgkmcnt(0)" ::: "memory");
    const int c = lane & 7;
#pragma unroll
    for (int j = 0; j < 8; ++j) { const int n = (lane >> 3) + 8 * j; const LAS float* s = scr + (8 * c) * 65 + n;
        v4u o; o.x = pk2(s[0 * 65], s[1 * 65]); o.y = pk2(s[2 * 65], s[3 * 65]); o.z = pk2(s[4 * 65], s[5 * 65]); o.w = pk2(s[6 * 65], s[7 * 65]);
        *(v4u*)(d.dst + (size_t)n * d.dld + 8 * c) = o; }
    asm volatile("s_waitcnt lgkmcnt(0)" ::: "memory");
}
constexpr int IT_IN = 32 * 256, IT_UP = 16 * 32, IT_OUT = 32 * 32, IT_FI = 32 * 176, IT_FO = 88 * 32, IT_LAYER = IT_IN + 3 * IT_UP + IT_OUT + IT_FI + IT_FO;
__device__ __forceinline__ CvtDesc cvt_desc(const Args& a, int l, int r, int lane) {
    bf16* wl = (bf16*)(a.ws + WS_WT) + (size_t)l * WL_ELEMS;
    const float* W; int N, k0, n0, dld, drow0, dcol0; bf16* dst;
    if (r < IT_IN) { const int kb = r / 256, nb = r % 256; W = a.w_in + (size_t)l * DM * INW; N = INW; k0 = 64 * kb; n0 = 64 * nb; dst = wl + OFF_IN; dld = DM; drow0 = n0; dcol0 = k0; }
    else { r -= IT_IN;
    if (r < 3 * IT_UP) { const int br = r / IT_UP, q = r % IT_UP, kb = q / 32, nb = q % 32;
        W = (br == 0 ? a.w_up_a : (br == 1 ? a.w_up_b : a.w_up_c)) + (size_t)l * 1024 * DM; N = DM; k0 = 64 * kb; n0 = 64 * nb; dst = wl + OFF_UP; dld = YW; drow0 = n0; dcol0 = 1024 * br + k0; }
    else { r -= 3 * IT_UP;
    if (r < IT_OUT) { const int kb = r / 32, nb = r % 32; W = a.w_out + (size_t)l * DM * DM; N = DM; k0 = 64 * kb; n0 = 64 * nb; dst = wl + OFF_OUT; dld = DM; drow0 = n0; dcol0 = k0; }
    else { r -= IT_OUT;
    if (r < IT_FI) { const int kb = r / 176, nb = r % 176; n0 = 64 * nb; k0 = 64 * kb; W = a.w_fi + (size_t)l * DM * NFI; N = NFI; dst = wl + OFF_FI; dld = DM;
        drow0 = (n0 < DFF) ? (256 * (n0 / 128) + (n0 % 128)) : (256 * ((n0 - DFF) / 128) + 128 + ((n0 - DFF) % 128)); dcol0 = k0; }
    else { r -= IT_FI; const int kb = r / 32, nb = r % 32; W = a.w_fo + (size_t)l * DFF * DM; N = DM; k0 = 64 * kb; n0 = 64 * nb; dst = wl + OFF_FO; dld = DFF; drow0 = n0; dcol0 = k0; } } } }
    CvtDesc d; d.src = W + (size_t)(k0 + (lane >> 4)) * N + n0 + 4 * (lane & 15); d.N = N; d.dst = dst + (size_t)drow0 * dld + dcol0; d.dld = dld; return d;
}
__device__ __forceinline__ void cvt_three(const Args& a, int l, int r0, int rstep, LAS float* scr, int lane) {
    const CvtDesc d0 = cvt_desc(a, l, r0, lane), d1 = cvt_desc(a, l, r0 + rstep, lane), d2 = cvt_desc(a, l, r0 + 2 * rstep, lane);
    f32x4 v0[16], v1[16], v2[16];
    cvt_load(d0, v0); cvt_load(d1, v1); cvt_load(d2, v2);
    cvt_finish(d0, v0, scr, lane); cvt_finish(d1, v1, scr, lane); cvt_finish(d2, v2, scr, lane);
}
__device__ __forceinline__ void phase_prologue(const Args& a, const Ctx& F) {
    unsigned char* ws = a.ws;
    {
        LAS float* scr = (LAS float*)(F.lds + F.wave * 16640);
        const int gw = F.vcu * NWAVES + F.wave, NGW = F.G * NWAVES;
        for (int it = gw; it < IT_LAYER / 3; it += NGW) cvt_three(a, 0, it, IT_LAYER / 3, scr, F.lane);
    }
    __syncthreads();
    {
        LAS float* sc = (LAS float*)F.lds;
        LAS float* red = (LAS float*)(F.lds + 24576);
        float* MOD = (float*)(ws + WS_MOD);
        for (int i = F.tid; i < 3 * DM; i += NTHR) { const int ci = i / DM, k = i % DM; const float x = (ci == 0) ? a.c_ctx[k] : a.c[(ci - 1) * DM + k]; sc[i] = x / (1.0f + expf(-x)); }
        __syncthreads();
        const int cx = F.tid & 31, kg = F.tid >> 5;
        for (int u = F.vcu; u < 4 * 96; u += F.G) {
            const int l = u / 96, cb = u % 96;
            const float* wp = a.w_ada + ((size_t)l * DM + 128 * kg) * 12288 + 128 * cb + 4 * cx;
            f32x4 a0 = {0.f, 0.f, 0.f, 0.f}, a1 = a0, a2 = a0;
#pragma unroll 8
            for (int k = 0; k < 128; ++k) { const f32x4 w = *(const f32x4*)(wp + (size_t)k * 12288);
                const float s0 = sc[128 * kg + k], s1 = sc[DM + 128 * kg + k], s2 = sc[2 * DM + 128 * kg + k];
                a0 += w * s0; a1 += w * s1; a2 += w * s2; }
#pragma unroll
            for (int j = 0; j < 4; ++j) { red[(kg * 3 + 0) * 128 + 4 * cx + j] = a0[j]; red[(kg * 3 + 1) * 128 + 4 * cx + j] = a1[j]; red[(kg * 3 + 2) * 128 + 4 * cx + j] = a2[j]; }
            __syncthreads();
            if (F.tid < 384) { const int ci = F.tid / 128, col = F.tid % 128; float s = 0.f;
#pragma unroll
                for (int g = 0; g < 16; ++g) s += red[(g * 3 + ci) * 128 + col];
                MOD[(size_t)(l * 3 + ci) * 12288 + 128 * cb + col] = s + a.b_ada[l * 12288 + 128 * cb + col]; }
            __syncthreads();
        }
    }
    {
        float* LB = (float*)(ws + WS_LB); float* ROPE = (float*)(ws + WS_ROPE);
        for (int i = F.vcu * NTHR + F.tid; i < 2048; i += F.G * NTHR) {
            const int dir = i / 1024, f = i % 1024;
            float x[4], mx = -3.0e38f;
#pragma unroll
            for (int l = 0; l < 4; ++l) { x[l] = a.lb_logits[(dir * 4 + l) * 1024 + f]; mx = fmaxf(mx, x[l]); }
            float e[4], s = 0.f;
#pragma unroll
            for (int l = 0; l < 4; ++l) { e[l] = expf(x[l] - mx); s += e[l]; }
            float cs = 0.f;
#pragma unroll
            for (int l = 0; l < 4; ++l) { if (l > 0) cs += e[l] / s; LB[(dir * 4 + l) * 1024 + f] = cs; }
            const int p = i / 32, fi = i % 32;
            const float inv = powf(10000.0f, -(float)(2 * fi) / 64.0f), ang = (float)p * inv;
            ROPE[2 * i] = cosf(ang); ROPE[2 * i + 1] = sinf(ang);
        }
    }
}

__device__ __forceinline__ void rownorm_phase(const Args& a, const Ctx& F, bool first, const bf16* T, const float* gate  , const float* gpost,
                                              bool write_h, const float* gn, const float* scv, const float* shv  ) {
    float* X = a.out + OUT_Y; bf16* H = (bf16*)(a.ws + WS_H); const bf16* TP = (const bf16*)(a.ws + WS_TP);
    LAS float* V1 = (LAS float*)F.lds; LAS float* V2 = V1 + 3 * DM; LAS float* V3 = V2 + 3 * DM;
    __syncthreads();
    for (int i = F.tid; i < 3 * DM; i += NTHR) { const int ci = i / DM, c = i % DM;
        if (T) V1[i] = gate[(size_t)ci * 12288 + c] * gpost[c];
        if (write_h) { V2[i] = gn[c] * (1.0f + scv[(size_t)ci * 12288 + c]); V3[i] = shv[(size_t)ci * 12288 + c]; } }
    __syncthreads();
    const int gw = F.vcu * NWAVES + F.wave, NGW = F.G * NWAVES;
    for (int m = gw; m < MTOK; m += NGW) {
        const int ci = (m < NCTX) ? 0 : 1 + ((m - NCTX) >> 10);
        const float* xr = first ? ((m < NCTX) ? a.x_prompt + (size_t)m * DM : a.x_sample + (size_t)(m - NCTX) * DM) : X + (size_t)m * DM;
        f32x4 x[8];
#pragma unroll
        for (int j = 0; j < 8; ++j) x[j] = *((const f32x4*)xr + F.lane + 64 * j);
        if (T) {
            f32x4 t[8]; float ss = 0.f;
#pragma unroll
            for (int j = 0; j < 8; ++j) {
                if (m < NCTX) { const v2u w = *((const v2u*)(T + (size_t)m * DM) + F.lane + 64 * j); t[j] = (f32x4){bf2f_lo(w.x), bf2f_hi(w.x), bf2f_lo(w.y), bf2f_hi(w.y)}; }
                else { const v2u* tp = (const v2u*)(TP + (size_t)(m - NCTX) * DM) + F.lane + 64 * j; const v2u w0 = tp[0], w1 = tp[TPQ / 4], w2 = tp[2 * (TPQ / 4)], w3 = tp[3 * (TPQ / 4)];
                    t[j] = (f32x4){(bf2f_lo(w0.x) + bf2f_lo(w1.x)) + (bf2f_lo(w2.x) + bf2f_lo(w3.x)), (bf2f_hi(w0.x) + bf2f_hi(w1.x)) + (bf2f_hi(w2.x) + bf2f_hi(w3.x)),
                                   (bf2f_lo(w0.y) + bf2f_lo(w1.y)) + (bf2f_lo(w2.y) + bf2f_lo(w3.y)), (bf2f_hi(w0.y) + bf2f_hi(w1.y)) + (bf2f_hi(w2.y) + bf2f_hi(w3.y))}; }
                ss += (t[j].x * t[j].x + t[j].y * t[j].y) + (t[j].z * t[j].z + t[j].w * t[j].w); }
            const float r = 1.0f / sqrtf(wave_sum(ss) * (1.0f / DM) + EPS);
#pragma unroll
            for (int j = 0; j < 8; ++j) { const f32x4 v1 = *((const LAS f32x4*)(V1 + ci * DM) + F.lane + 64 * j); x[j] += v1 * (t[j] * r); }
        }
        if (T || first) {
#pragma unroll
            for (int j = 0; j < 8; ++j) *((f32x4*)(X + (size_t)m * DM) + F.lane + 64 * j) = x[j];
        }
        if (write_h) {
            float ss = 0.f;
#pragma unroll
            for (int j = 0; j < 8; ++j) ss += (x[j].x * x[j].x + x[j].y * x[j].y) + (x[j].z * x[j].z + x[j].w * x[j].w);
            const float r = 1.0f / sqrtf(wave_sum(ss) * (1.0f / DM) + EPS);
#pragma unroll
            for (int j = 0; j < 8; ++j) { const f32x4 v2 = *((const LAS f32x4*)(V2 + ci * DM) + F.lane + 64 * j), v3 = *((const LAS f32x4*)(V3 + ci * DM) + F.lane + 64 * j);
                const f32x4 h = x[j] * r * v2 + v3;
                v2u w; w.x = pk2(h.x, h.y); w.y = pk2(h.z, h.w);
                *((v2u*)(H + (size_t)m * DM) + F.lane + 64 * j) = w; }
        }
    }
    __syncthreads();
}

__device__ __forceinline__ void phase_ycnorm(const Args& a, const Ctx& F) {
    const float* OFp = (const float*)(a.ws + WS_OF); const float* OBp = (const float*)(a.ws + WS_OB);
    const bf16* Z = (const bf16*)(a.ws + WS_Z); bf16* Y = (bf16*)(a.ws + WS_Y);
    const int gw = F.vcu * NWAVES + F.wave, NGW = F.G * NWAVES;
    for (int m = gw; m < MTOK; m += NGW) {
        float o[16]; float ss = 0.f;
#pragma unroll
        for (int j = 0; j < 4; ++j) { const f32x4 p = *((const f32x4*)(OFp + (size_t)m * 1024 + 16 * F.lane) + j), q = *((const f32x4*)(OBp + (size_t)m * 1024 + 16 * F.lane) + j);
            const f32x4 s = p + q; o[4 * j] = s.x; o[4 * j + 1] = s.y; o[4 * j + 2] = s.z; o[4 * j + 3] = s.w; ss += (s.x * s.x + s.y * s.y) + (s.z * s.z + s.w * s.w); }
        ss += __shfl_xor(ss, 1); ss += __shfl_xor(ss, 2); ss += __shfl_xor(ss, 4);
        const float r = 1.0f / sqrtf(ss * (1.0f / 128.0f) + EPS);
        float g0[8], g1[8];
        unpack8(*(const v4u*)(Z + (size_t)m * INW + 9216 + 16 * F.lane), g0); unpack8(*(const v4u*)(Z + (size_t)m * INW + 9216 + 16 * F.lane + 8), g1);
        float y0[8], y1[8];
#pragma unroll
        for (int j = 0; j < 8; ++j) { y0[j] = o[j] * r * g0[j]; y1[j] = o[8 + j] * r * g1[j]; }
        *(v4u*)(Y + (size_t)m * YW + 2048 + 16 * F.lane) = pack8(y0); *(v4u*)(Y + (size_t)m * YW + 2048 + 16 * F.lane + 8) = pack8(y1);
    }
}

typedef short bf16x8 __attribute__((ext_vector_type(8)));
typedef short s16x4 __attribute__((ext_vector_type(4)));
typedef float f32x16 __attribute__((ext_vector_type(16)));
typedef __bf16 bf16x4_t __attribute__((ext_vector_type(4)));
#define MFMA32(a, b, c) __builtin_amdgcn_mfma_f32_32x32x16_bf16((a), (b), (c), 0, 0, 0)
__device__ __forceinline__ bf16x8 pack_regs(const f32x16& x, int s) {
    v4u p; p.x = cvtpk(x[8 * s], x[8 * s + 1]); p.y = cvtpk(x[8 * s + 2], x[8 * s + 3]); p.z = cvtpk(x[8 * s + 4], x[8 * s + 5]); p.w = cvtpk(x[8 * s + 6], x[8 * s + 7]);
    return __builtin_bit_cast(bf16x8, p);
}
__device__ __forceinline__ s16x4 tr_read(const LAS unsigned char* p) { return __builtin_bit_cast(s16x4, __builtin_amdgcn_ds_read_tr16_b64_v4bf16((LAS bf16x4_t*)p)); }
__device__ __forceinline__ bf16x8 tr_pair(const LAS unsigned char* lo, const LAS unsigned char* hi) { const s16x4 a = tr_read(lo), b = tr_read(hi); return __builtin_shufflevector(a, b, 0, 1, 2, 3, 4, 5, 6, 7); }
constexpr float ATT_SCALE = 0.08838834764831845f;
constexpr int KP = 272, VP = 320;
constexpr int ATT_K_OFF = 0, ATT_V_OFF = 256 * KP, ATT_RPB_OFF = ATT_V_OFF + 256 * VP;
struct AttnW { f32x16 O[4]; float m, l; };
template <int MODE, bool QLDS>
__device__ __forceinline__ void attn_tile(AttnW& W, const bf16x8 (&qf)[8], const LAS unsigned char* Ql, const LAS unsigned char* Kl, const LAS unsigned char* Vl, int kt0, int lane, const LAS float* rpb_row, int kc0, int qc) {
    const int r = lane & 31, h = lane >> 5;
    f32x16 sacc;
#pragma unroll
    for (int i = 0; i < 16; ++i) sacc[i] = 0.f;
    const LAS unsigned char* kp = Kl + (kt0 + r) * KP + 16 * h;
#pragma unroll
    for (int ks = 0; ks < 8; ++ks) { const bf16x8 a = *(const LAS bf16x8*)(kp + 32 * ks); const bf16x8 q = QLDS ? *(const LAS bf16x8*)(Ql + 32 * ks) : qf[ks]; sacc = MFMA32(a, q, sacc); }
    float mt = -1.0e30f;
    if (MODE == 1) {
        const int c_start = min(max(qc - 8, 0), 48);
        const int kb = kc0 + 4 * h - c_start;
        const LAS float* bp = rpb_row + (kc0 + 4 * h - qc + 15);
#pragma unroll
        for (int i = 0; i < 16; ++i) { const int off = (i & 3) + 8 * (i >> 2); const bool ok = (unsigned)(kb + off) < 16u;
            const float bias = bp[ok ? off : (qc - kc0 - 4 * h)];
            const float v = ok ? (sacc[i] * ATT_SCALE + bias) : -1.0e30f; sacc[i] = v; mt = fmaxf(mt, v); }
    } else {
#pragma unroll
        for (int i = 0; i < 16; ++i) { sacc[i] *= ATT_SCALE; mt = fmaxf(mt, sacc[i]); }
    }
    mt = fmaxf(mt, __shfl_xor(mt, 32));
    const float mn = fmaxf(W.m, mt), alpha = __expf(W.m - mn);
    float ls = 0.f;
#pragma unroll
    for (int i = 0; i < 16; ++i) { const float e = (MODE == 1 && sacc[i] < -1.0e29f) ? 0.f : __expf(sacc[i] - mn); sacc[i] = e; ls += e; }
    ls += __shfl_xor(ls, 32);
    W.l = W.l * alpha + ls; W.m = mn;
    if (__any(alpha != 1.0f)) {
#pragma unroll
        for (int dt = 0; dt < 4; ++dt)
#pragma unroll
            for (int i = 0; i < 16; ++i) W.O[dt][i] *= alpha;
    }
    const bf16x8 pb0 = pack_regs(sacc, 0), pb1 = pack_regs(sacc, 1);
    const int g = (lane >> 4) & 1, q4 = (lane & 15) >> 2, p4 = lane & 3;
    const LAS unsigned char* vp = Vl + (kt0 + 4 * h + q4) * VP + 32 * g + 8 * p4;
#pragma unroll
    for (int dt = 0; dt < 4; ++dt) {
        const bf16x8 v0 = tr_pair(vp + 64 * dt, vp + 64 * dt + 8 * VP);
        const bf16x8 v1 = tr_pair(vp + 64 * dt + 16 * VP, vp + 64 * dt + 24 * VP);
        W.O[dt] = MFMA32(v0, pb0, W.O[dt]); W.O[dt] = MFMA32(v1, pb1, W.O[dt]);
    }
}
__device__ __forceinline__ void attn_init(AttnW& W) {
    W.m = -1.0e30f; W.l = 0.f;
#pragma unroll
    for (int dt = 0; dt < 4; ++dt)
#pragma unroll
        for (int i = 0; i < 16; ++i) W.O[dt][i] = 0.f;
}
__device__ __forceinline__ void attn_store_dt(const f32x16& O, float inv, bf16* yrow, int dt, int h) {
#pragma unroll
    for (int g4 = 0; g4 < 4; ++g4) { v2u w; w.x = cvtpk(O[4 * g4] * inv, O[4 * g4 + 1] * inv); w.y = cvtpk(O[4 * g4 + 2] * inv, O[4 * g4 + 3] * inv);
        *(v2u*)(yrow + 32 * dt + 8 * g4 + 4 * h) = w; }
}

__device__ __forceinline__ void unitAttnCtx(const Args& a, const Ctx& F, int unit) {
    const int hd = unit & 7, b = unit >> 3;
    const bf16* Z = (const bf16*)(a.ws + WS_Z); bf16* Y = (bf16*)(a.ws + WS_Y);
    const LAS unsigned char* Kl = F.lds + ATT_K_OFF; const LAS unsigned char* Vl = F.lds + ATT_V_OFF;
    for (int p = F.tid; p < 4096; p += NTHR) { const int key = p >> 4, c16 = p & 15; const bf16* src = Z + (size_t)(b * 256 + key) * INW + hd * 128 + 8 * c16;
        *(LAS v4u*)(F.lds + ATT_K_OFF + key * KP + 16 * c16) = *(const v4u*)(src + 3072); *(LAS v4u*)(F.lds + ATT_V_OFF + key * VP + 16 * c16) = *(const v4u*)(src + 4096); }
    AttnW W; attn_init(W); bf16x8 qf[8];
    const int r = F.lane & 31, h = F.lane >> 5;
    const int mq = b * 256 + 32 * F.wave + r;
    { const bf16* qp = Z + (size_t)mq * INW + 2048 + hd * 128 + 8 * h;
#pragma unroll
      for (int ks = 0; ks < 8; ++ks) qf[ks] = __builtin_bit_cast(bf16x8, *(const v4u*)(qp + 16 * ks)); }
    __syncthreads();
#pragma unroll 1
    for (int kt = 0; kt < 8; ++kt) attn_tile<0, false>(W, qf, nullptr, Kl, Vl, 32 * kt, F.lane, nullptr, 0, 0);
    const float inv = 1.0f / W.l;
    bf16* yrow = Y + (size_t)mq * YW + 1024 + hd * 128;
#pragma unroll
    for (int dt = 0; dt < 4; ++dt) attn_store_dt(W.O[dt], inv, yrow, dt, h);
    __syncthreads();
}
constexpr int LQ_OFF = 0, LK_OFF = 64 * KP, LV_OFF = LK_OFF + 128 * KP, LRPB_OFF = LV_OFF + 128 * VP;
__device__ __forceinline__ void unitAttnLat(const Args& a, const Ctx& F, int l, int unit) {
    const int gr = unit & 15, hd = (unit >> 4) & 7, b = unit >> 7;
    const bf16* Z = (const bf16*)(a.ws + WS_Z); bf16* Y = (bf16*)(a.ws + WS_Y);
    const float* ROPE = (const float*)(a.ws + WS_ROPE);
    const LAS unsigned char* Kl = F.lds + LK_OFF; const LAS unsigned char* Vl = F.lds + LV_OFF; LAS float* rp = (LAS float*)(F.lds + LRPB_OFF);
    const int r = F.lane & 31, h = F.lane >> 5, qh = F.wave & 1, kt = F.wave >> 1;
    const int qc = 32 * qh + r;
    const int r_start = min(max(gr - 4, 0), 8);
    const int mq = NCTX + b * 1024 + gr * 64 + qc;
    __syncthreads();
    for (int i = F.tid; i < 15 * 31; i += NTHR) rp[i] = a.rpb[(size_t)(l * 8 + hd) * 465 + i];
    {
        const int qq = F.tid >> 3, half = (F.tid >> 2) & 1, sp = F.tid & 3, pos = half ? qq : gr;
        const bf16* src = Z + (size_t)(NCTX + b * 1024 + gr * 64 + qq) * INW + 2048 + hd * 128 + 64 * half + 8 * sp;
        const float* rt = ROPE + 2 * (pos * 32 + 8 * sp);
        float x[8], y[8], lo[8], hi[8]; unpack8(*(const v4u*)src, x); unpack8(*(const v4u*)(src + 32), y);
#pragma unroll
        for (int j4 = 0; j4 < 4; ++j4) { const f32x4 cssn = *(const f32x4*)(rt + 4 * j4);
            lo[2 * j4] = x[2 * j4] * cssn.x - y[2 * j4] * cssn.y; hi[2 * j4] = y[2 * j4] * cssn.x + x[2 * j4] * cssn.y;
            lo[2 * j4 + 1] = x[2 * j4 + 1] * cssn.z - y[2 * j4 + 1] * cssn.w; hi[2 * j4 + 1] = y[2 * j4 + 1] * cssn.z + x[2 * j4 + 1] * cssn.w; }
        LAS unsigned char* d = F.lds + LQ_OFF + qq * KP + 2 * (64 * half + 8 * sp);
        *(LAS v4u*)d = pack8(lo); *(LAS v4u*)(d + 64) = pack8(hi);
    }
    AttnW W; attn_init(W);
    const LAS unsigned char* Ql = F.lds + LQ_OFF + qc * KP + 16 * h;
    const bf16x8 qdummy[8] = {};
    f32x4 R[16];
    const int jk0 = F.tid, jk1 = F.tid + NTHR;
#define LAT_PREFETCH(cn) do { \
        if ((cn) < 4) { \
            _Pragma("unroll") for (int q = 0; q < 2; ++q) { const int job = q ? jk1 : jk0; const int key = job >> 3, half = (job >> 2) & 1, sp = job & 3; \
                const int kr = r_start + 2 * (cn) + (key >> 6), kc = key & 63, pos = half ? kc : kr; \
                const bf16* src = Z + (size_t)(NCTX + b * 1024 + kr * 64 + kc) * INW + 3072 + hd * 128 + 64 * half + 8 * sp; \
                const float* rt = ROPE + 2 * (pos * 32 + 8 * sp); \
                R[2 * q] = __builtin_bit_cast(f32x4, *(const v4u*)src); R[2 * q + 1] = __builtin_bit_cast(f32x4, *(const v4u*)(src + 32)); \
                _Pragma("unroll") for (int j4 = 0; j4 < 4; ++j4) R[8 + 4 * q + j4] = *(const f32x4*)(rt + 4 * j4); } \
            _Pragma("unroll") for (int q = 0; q < 4; ++q) { const int pc = F.tid + q * NTHR; const int key = pc >> 4, c16 = pc & 15; const int kr = r_start + 2 * (cn) + (key >> 6), kc = key & 63; \
                R[4 + q] = __builtin_bit_cast(f32x4, *(const v4u*)(Z + (size_t)(NCTX + b * 1024 + kr * 64 + kc) * INW + 4096 + hd * 128 + 8 * c16)); } \
        } else { \
            _Pragma("unroll") for (int q = 0; q < 4; ++q) { const int pc = F.tid + q * NTHR; const int key = pc >> 4, c16 = pc & 15; \
                const size_t off = ((size_t)(b * 4 + l) * 512 + 128 * ((cn) - 4) + key) * 1024 + hd * 128 + 8 * c16; \
                R[4 * q] = *(const f32x4*)(a.cache_k + off); R[4 * q + 1] = *(const f32x4*)(a.cache_k + off + 4); R[4 * q + 2] = *(const f32x4*)(a.cache_v + off); R[4 * q + 3] = *(const f32x4*)(a.cache_v + off + 4); } \
        } } while (0)
#pragma unroll 1
    for (int chn = 0; chn < 8; ++chn) {
        LAT_PREFETCH(chn);
        __syncthreads();
        if (chn < 4) {
#pragma unroll
            for (int q = 0; q < 2; ++q) { const int job = q ? jk1 : jk0; const int key = job >> 3, half = (job >> 2) & 1, sp = job & 3;
                float x[8], y[8], lo[8], hi[8]; unpack8(__builtin_bit_cast(v4u, R[2 * q]), x); unpack8(__builtin_bit_cast(v4u, R[2 * q + 1]), y);
#pragma unroll
                for (int j4 = 0; j4 < 4; ++j4) { const f32x4 cssn = R[8 + 4 * q + j4];
                    lo[2 * j4] = x[2 * j4] * cssn.x - y[2 * j4] * cssn.y; hi[2 * j4] = y[2 * j4] * cssn.x + x[2 * j4] * cssn.y;
                    lo[2 * j4 + 1] = x[2 * j4 + 1] * cssn.z - y[2 * j4 + 1] * cssn.w; hi[2 * j4 + 1] = y[2 * j4 + 1] * cssn.z + x[2 * j4 + 1] * cssn.w; }
                LAS unsigned char* d = F.lds + LK_OFF + key * KP + 2 * (64 * half + 8 * sp);
                *(LAS v4u*)d = pack8(lo); *(LAS v4u*)(d + 64) = pack8(hi); }
#pragma unroll
            for (int q = 0; q < 4; ++q) { const int pc = F.tid + q * NTHR; const int key = pc >> 4, c16 = pc & 15;
                *(LAS v4u*)(F.lds + LV_OFF + key * VP + 16 * c16) = __builtin_bit_cast(v4u, R[4 + q]); }
        } else {
#pragma unroll
            for (int q = 0; q < 4; ++q) { const int pc = F.tid + q * NTHR; const int key = pc >> 4, c16 = pc & 15;
                const f32x4 k0 = R[4 * q], k1 = R[4 * q + 1], v0 = R[4 * q + 2], v1 = R[4 * q + 3];
                v4u kw, vw; kw.x = cvtpk(k0.x, k0.y); kw.y = cvtpk(k0.z, k0.w); kw.z = cvtpk(k1.x, k1.y); kw.w = cvtpk(k1.z, k1.w);
                vw.x = cvtpk(v0.x, v0.y); vw.y = cvtpk(v0.z, v0.w); vw.z = cvtpk(v1.x, v1.y); vw.w = cvtpk(v1.z, v1.w);
                *(LAS v4u*)(F.lds + LK_OFF + key * KP + 16 * c16) = kw; *(LAS v4u*)(F.lds + LV_OFF + key * VP + 16 * c16) = vw; }
        }
        __syncthreads();
        if (chn < 4) {
            const int kr = r_start + 2 * chn + (kt >> 1), dr = kr - gr + 7;
            attn_tile<1, true>(W, qdummy, Ql, Kl, Vl, 32 * kt, F.lane, rp + dr * 31, 32 * (kt & 1), qc);
        } else {
            attn_tile<0, true>(W, qdummy, Ql, Kl, Vl, 32 * kt, F.lane, nullptr, 0, 0);
        }
    }
#undef LAT_PREFETCH
    __syncthreads();
    LAS float* ML = (LAS float*)F.lds; LAS float* OB = (LAS float*)(F.lds + 4096);
    ML[(F.wave * 2 + 0) * 64 + F.lane] = W.m; ML[(F.wave * 2 + 1) * 64 + F.lane] = W.l;
#pragma unroll
    for (int dt = 0; dt < 4; ++dt)
#pragma unroll
        for (int i = 0; i < 16; ++i) OB[(F.wave * 64 + dt * 16 + i) * 64 + F.lane] = W.O[dt][i];
    __syncthreads();
    {
        float mi[4], li[4], mt = -1.0e30f;
#pragma unroll
        for (int k = 0; k < 4; ++k) { const int w2 = 2 * k + qh; mi[k] = ML[(w2 * 2 + 0) * 64 + F.lane]; li[k] = ML[(w2 * 2 + 1) * 64 + F.lane]; mt = fmaxf(mt, mi[k]); }
        float wk[4], lt = 0.f;
#pragma unroll
        for (int k = 0; k < 4; ++k) { wk[k] = __expf(mi[k] - mt); lt += wk[k] * li[k]; }
        const float inv = 1.0f / lt;
#pragma unroll
        for (int k = 0; k < 4; ++k) wk[k] *= inv;
        bf16* yrow = Y + (size_t)mq * YW + 1024 + hd * 128 + 32 * kt + 4 * h;
#pragma unroll
        for (int g4 = 0; g4 < 4; ++g4) {
            float o[4];
#pragma unroll
            for (int i = 0; i < 4; ++i) { float sacc = 0.f;
#pragma unroll
                for (int k = 0; k < 4; ++k) sacc += wk[k] * OB[((2 * k + qh) * 64 + kt * 16 + 4 * g4 + i) * 64 + F.lane];
                o[i] = sacc; }
            v2u w; w.x = cvtpk(o[0], o[1]); w.y = cvtpk(o[2], o[3]);
            *(v2u*)(yrow + 8 * g4) = w;
            asm volatile("" ::: "memory");
        }
    }
    __syncthreads();
}

constexpr int AW_OFF = 0, AV_OFF = 128 * KP, AST_OFF = AV_OFF + 128 * VP;
__device__ __forceinline__ void unitA(const Args& a, const Ctx& F, int l, int unit) {
    const int ch = unit >> 3, g = unit & 7, m0 = ch * 128;
    const bf16* Z = (const bf16*)(a.ws + WS_Z); bf16* Y = (bf16*)(a.ws + WS_Y);
    LAS float* st = (LAS float*)(F.lds + AST_OFF);
    __syncthreads();
    if (F.tid < 128) {
        const float* ap = (const float*)(a.ws + WS_AST) + (size_t)(m0 + F.tid) * 32;
        float sm = 0.f, sq = 0.f;
#pragma unroll
        for (int q = 0; q < 8; ++q) { const f32x4 v = *(const f32x4*)(ap + 4 * q); sm += v.x + v.z; sq += v.y + v.w; }
        const float mean = sm * (1.0f / 1024.0f), var = fmaxf(sq * (1.0f / 1024.0f) - mean * mean, 0.f);
        st[F.tid] = mean; st[128 + F.tid] = 1.0f / sqrtf(var + EPS);
    }
    {
        const int t = F.tid >> 2, s0 = 32 * (F.tid & 3);
        const float* wp = a.a_w + ((size_t)(l * 8 + g) * 128 + t) * 128 + s0;
#pragma unroll
        for (int q = 0; q < 4; ++q) { const f32x4 w0 = *(const f32x4*)(wp + 8 * q), w1 = *(const f32x4*)(wp + 8 * q + 4);
            v4u o; o.x = cvtpk(w0.x, w0.y); o.y = cvtpk(w0.z, w0.w); o.z = cvtpk(w1.x, w1.y); o.w = cvtpk(w1.z, w1.w);
            *(LAS v4u*)(F.lds + AW_OFF + t * KP + 2 * (s0 + 8 * q)) = o; }
    }
    __syncthreads();
    {
        const int s = F.tid >> 2, c0 = 32 * (F.tid & 3);
        const float mean = st[s], rstd = st[128 + s];
        const bf16* rp = Z + (size_t)(m0 + s) * INW + 1024 + 128 * g + c0;
#pragma unroll
        for (int q = 0; q < 4; ++q) { float x[8]; unpack8(*(const v4u*)(rp + 8 * q), x);
#pragma unroll
            for (int j = 0; j < 8; ++j) x[j] = (x[j] - mean) * rstd;
            *(LAS v4u*)(F.lds + AV_OFF + s * VP + 2 * (c0 + 8 * q)) = pack8(x); }
    }
    __syncthreads();
    const int lane = F.lane, r = lane & 31, h = lane >> 5, gq = (lane >> 4) & 1, q4 = (lane & 15) >> 2, p4 = lane & 3;
    const int ttile = F.wave & 3, ct0 = 2 * (F.wave >> 2);
    f32x16 acc[2];
#pragma unroll
    for (int c2 = 0; c2 < 2; ++c2)
#pragma unroll
        for (int i = 0; i < 16; ++i) acc[c2][i] = 0.f;
    {
        const LAS unsigned char* wp = F.lds + AW_OFF + (32 * ttile + r) * KP + 16 * h;
        const LAS unsigned char* vp = F.lds + AV_OFF + (8 * h + q4) * VP + 2 * (32 * ct0 + 16 * gq) + 8 * p4;
#pragma unroll
        for (int ks = 0; ks < 8; ++ks) {
            const bf16x8 wb = *(const LAS bf16x8*)(wp + 32 * ks);
#pragma unroll
            for (int c2 = 0; c2 < 2; ++c2) {
                const LAS unsigned char* v0 = vp + 16 * ks * VP + 64 * c2;
                acc[c2] = MFMA32(tr_pair(v0, v0 + 4 * VP), wb, acc[c2]);
            }
        }
    }
    {
        const int t = 32 * ttile + r; const float bsv = a.a_b[(l * 8 + g) * 128 + t];
        const bf16* up = Z + (size_t)(m0 + t) * INW + 128 * g + 4 * h; bf16* yp = Y + (size_t)(m0 + t) * YW + 128 * g + 4 * h;
#pragma unroll
        for (int c2 = 0; c2 < 2; ++c2)
#pragma unroll
            for (int g4 = 0; g4 < 4; ++g4) {
                const int c = 32 * (ct0 + c2) + 8 * g4;
                const v2u uw = *(const v2u*)(up + c);
                v2u o; o.x = cvtpk(bf2f_lo(uw.x) * (acc[c2][4 * g4] + bsv), bf2f_hi(uw.x) * (acc[c2][4 * g4 + 1] + bsv));
                o.y = cvtpk(bf2f_lo(uw.y) * (acc[c2][4 * g4 + 2] + bsv), bf2f_hi(uw.y) * (acc[c2][4 * g4 + 3] + bsv));
                *(v2u*)(yp + c) = o;
            }
    }
    __syncthreads();
}

constexpr int HP = 272;
constexpr int HG_QD = 0, HG_KD = 32 * HP, HG_KL = 2 * 32 * HP, HG_V = 3 * 32 * HP, HG_G = 4 * 32 * HP, HG_BUF = HG_G + 512, HG_DIR = 2 * HG_BUF;
struct HgPre { v4u q[2], v[2]; f32x4 f[4]; };
__device__ __forceinline__ void hg_load(HgPre& P, const bf16* Z, const float* LOGF, size_t m, int dir, int hd, int d0) {
    const bf16* zr = Z + m * INW + hd * 128 + d0; const float* fr = LOGF + m * 2048 + dir * 1024 + hd * 128 + d0;
    P.q[0] = *(const v4u*)(zr + 5120); P.q[1] = *(const v4u*)(zr + 5128); P.v[0] = *(const v4u*)(zr + 8192); P.v[1] = *(const v4u*)(zr + 8200);
#pragma unroll
    for (int j = 0; j < 4; ++j) P.f[j] = *(const f32x4*)(fr + 4 * j);
}
template <int CTRL, int ROWMASK> __device__ __forceinline__ float dpp_add(float x) {
    return x + __int_as_float(__builtin_amdgcn_update_dpp(0, __float_as_int(x), CTRL, ROWMASK, 0xF, true)); }
__device__ __forceinline__ float scan32(float x) {
    x = dpp_add<0x111, 0xF>(x); x = dpp_add<0x112, 0xF>(x); x = dpp_add<0x114, 0xF>(x); x = dpp_add<0x118, 0xF>(x); x = dpp_add<0x142, 0xA>(x); return x; }
__device__ __forceinline__ void hg_estep(const HgPre& P, LAS unsigned char* buf, int lane_, int w4) {
    int lane = lane_; asm volatile("" : "+v"(lane));
    const int tt = lane & 31, hf = lane >> 5, d0 = 32 * w4 + 16 * hf;
    float bl[16];
#pragma unroll
    for (int j = 0; j < 16; ++j) bl[j] = scan32(P.f[j >> 2][j & 3]);
    LAS unsigned char* row = buf + tt * HP + 2 * d0;
#pragma unroll
    for (int hh = 0; hh < 2; ++hh) {
        float qd[8], kd[8], kl[8];
        float q[8]; unpack8(P.q[hh], q);
#pragma unroll
        for (int j = 0; j < 8; ++j) { const int jj = 8 * hh + j; const float bC0 = __int_as_float(__builtin_amdgcn_readlane(__float_as_int(bl[jj]), 31)), bC1 = __int_as_float(__builtin_amdgcn_readlane(__float_as_int(bl[jj]), 63)); const float bC = hf ? bC1 : bC0; const float k = 1.0f - __builtin_amdgcn_exp2f(P.f[jj >> 2][jj & 3]);
            qd[j] = q[j] * __builtin_amdgcn_exp2f(bl[jj]); kd[j] = k * __builtin_amdgcn_exp2f(fminf(-bl[jj], 115.0f)); kl[j] = k * __builtin_amdgcn_exp2f(bC - bl[jj]); }
        *(LAS v4u*)(row + HG_QD + 16 * hh) = pack8(qd); *(LAS v4u*)(row + HG_KD + 16 * hh) = pack8(kd); *(LAS v4u*)(row + HG_KL + 16 * hh) = pack8(kl);
        asm volatile("" ::: "memory");
    }
    *(LAS v4u*)(row + HG_V) = P.v[0]; *(LAS v4u*)(row + HG_V + 16) = P.v[1];
    if (tt == 31) {
#pragma unroll
        for (int j4 = 0; j4 < 4; ++j4) *(LAS f32x4*)(buf + HG_G + 4 * (d0 + 4 * j4)) = (f32x4){__builtin_amdgcn_exp2f(bl[4 * j4]), __builtin_amdgcn_exp2f(bl[4 * j4 + 1]), __builtin_amdgcn_exp2f(bl[4 * j4 + 2]), __builtin_amdgcn_exp2f(bl[4 * j4 + 3])};
    }
}
__device__ __forceinline__ void hg_mstep(f32x16 (&S)[4], const LAS unsigned char* buf, int lane_, int w4, bf16* Og, int c, int n, int dir, int mbase, int hd) {
    int lane = lane_; asm volatile("" : "+v"(lane));
    const int r = lane & 31, h = lane >> 5, g = (lane >> 4) & 1, q4 = (lane & 15) >> 2, p4 = lane & 3;
    f32x16 X0;
#pragma unroll
    for (int i = 0; i < 16; ++i) X0[i] = 0.f;
    {   const LAS unsigned char* kp = buf + HG_KD + r * HP + 16 * h; const LAS unsigned char* qp = buf + HG_QD + r * HP + 16 * h;
#pragma unroll
        for (int ks = 0; ks < 8; ++ks) X0 = MFMA32(*(const LAS bf16x8*)(kp + 32 * ks), *(const LAS bf16x8*)(qp + 32 * ks), X0); }
    f32x16 O0;
#pragma unroll
    for (int i = 0; i < 16; ++i) O0[i] = 0.f;
    {
        const LAS unsigned char* qp = buf + HG_QD + r * HP + 8 * h;
#pragma unroll
        for (int dt = 0; dt < 4; ++dt)
#pragma unroll
            for (int st = 0; st < 2; ++st) {
                const s16x4 lo = *(const LAS s16x4*)(qp + 2 * (32 * dt + 16 * st)), hi = *(const LAS s16x4*)(qp + 2 * (32 * dt + 16 * st + 8));
                O0 = MFMA32(__builtin_shufflevector(lo, hi, 0, 1, 2, 3, 4, 5, 6, 7), pack_regs(S[dt], st), O0);
            }
    }
#pragma unroll
    for (int i = 0; i < 16; ++i) { const int srow = (i & 3) + 8 * (i >> 2) + 4 * h; X0[i] = (srow <= r) ? X0[i] : 0.f; }
    {
        const LAS unsigned char* vp = buf + HG_V + (4 * h + q4) * HP + 2 * (32 * w4 + 16 * g) + 8 * p4;
        O0 = MFMA32(pack_regs(X0, 0), tr_pair(vp, vp + 8 * HP), O0);
        O0 = MFMA32(pack_regs(X0, 1), tr_pair(vp + 16 * HP, vp + 24 * HP), O0);
    }
    asm volatile("" ::: "memory");
    {
        const LAS float* G = (const LAS float*)(buf + HG_G);
        const LAS unsigned char* vp = buf + HG_V + (8 * h + q4) * HP + 2 * (32 * w4 + 16 * g) + 8 * p4;
        const bf16x8 vb0 = tr_pair(vp, vp + 4 * HP), vb1 = tr_pair(vp + 16 * HP, vp + 20 * HP);
#pragma unroll
        for (int dt = 0; dt < 4; ++dt) {
#pragma unroll
            for (int g4 = 0; g4 < 4; ++g4) { const f32x4 gv = *(const LAS f32x4*)(G + 32 * dt + 8 * g4 + 4 * h);
#pragma unroll
                for (int jj = 0; jj < 4; ++jj) S[dt][4 * g4 + jj] *= gv[jj]; }
            const LAS unsigned char* kp = buf + HG_KL + (8 * h + q4) * HP + 2 * (32 * dt + 16 * g) + 8 * p4;
            S[dt] = MFMA32(tr_pair(kp, kp + 4 * HP), vb0, S[dt]);
            S[dt] = MFMA32(tr_pair(kp + 16 * HP, kp + 20 * HP), vb1, S[dt]);
                }
    }
    {
        const int tb = 32 * c + 4 * h; const int p0 = dir ? (n - 1 - tb) : tb, stp = dir ? -1024 : 1024;
        bf16* ob = Og + (size_t)mbase * 1024 + hd * 128 + 32 * w4;
        const int o0 = p0 * 1024 + r;
#pragma unroll
        for (int i = 0; i < 16; ++i) ob[o0 + ((i & 3) + 8 * (i >> 2)) * stp] = (bf16)(cvtpk(O0[i], 0.f) & 0xffffu);
    }
}
__device__ __forceinline__ void unitHgrn(const Args& a, const Ctx& F, int l, bool lat, int b, int hd) {
    const bf16* Z = (const bf16*)(a.ws + WS_Z); const float* LOGF = (const float*)(a.ws + WS_LOGF); bf16* Y = (bf16*)(a.ws + WS_Y);
    const int w4 = F.wave >> 1, lane = F.lane;
    LAS unsigned char* base = F.lds;
    const int n = lat ? 1024 : 256, mbase = lat ? NCTX + b * 1024 : b * 256, nch = n >> 5, ng = 2 * nch;
    __syncthreads();
    if ((F.wave & 1) == 0) {
        const int tt = lane & 31, d0 = 32 * w4 + 16 * (lane >> 5);
        HgPre P;
        hg_load(P, Z, LOGF, (size_t)(mbase + tt), 0, hd, d0);
        hg_estep(P, base, lane, w4);
        {   const int g1 = 1, dir1 = (g1 >= nch), c1 = g1 - dir1 * nch, p1 = 32 * c1 + tt; hg_load(P, Z, LOGF, (size_t)(mbase + (dir1 ? (n - 1 - p1) : p1)), dir1, hd, d0); }
        asm volatile("s_waitcnt lgkmcnt(0)" ::: "memory"); __builtin_amdgcn_s_barrier(); asm volatile("" ::: "memory");
#pragma unroll 1
        for (int g = 0; g < ng; ++g) {
            if (g + 1 < ng) {
                hg_estep(P, base + ((g + 1) & 1) * HG_BUF, lane, w4);
                if (g + 2 < ng) { const int g2 = g + 2, dir2 = (g2 >= nch), c2 = g2 - dir2 * nch, p2 = 32 * c2 + tt; hg_load(P, Z, LOGF, (size_t)(mbase + (dir2 ? (n - 1 - p2) : p2)), dir2, hd, d0); }
            }
            asm volatile("s_waitcnt lgkmcnt(0)" ::: "memory"); __builtin_amdgcn_s_barrier(); asm volatile("" ::: "memory");
        }
    } else {
        const int r = lane & 31, h = lane >> 5, h512 = 512 * h;
        f32x16 S[4];
        if (lat) {
            const float* sp = a.state + ((((size_t)b * 4 + l) * 2 + 0) * 8 + hd) * 16384 + 32 * w4 + r;
#pragma unroll
            for (int dt = 0; dt < 4; ++dt)
#pragma unroll
                for (int i = 0; i < 16; ++i) S[dt][i] = sp[(32 * dt + (i & 3) + 8 * (i >> 2)) * 128 + h512];
        } else {
#pragma unroll
            for (int dt = 0; dt < 4; ++dt)
#pragma unroll
                for (int i = 0; i < 16; ++i) S[dt][i] = 0.f;
        }
        asm volatile("s_waitcnt lgkmcnt(0)" ::: "memory"); __builtin_amdgcn_s_barrier(); asm volatile("" ::: "memory");
#pragma unroll 1
        for (int g = 0; g < ng; ++g) {
            const int dir = (g >= nch), c = g - dir * nch;
            if (g == nch) {
                if (!lat) {
                    float* so = a.out + OUT_S + ((((size_t)b * 4 + l) * 2 + 0) * 8 + hd) * 16384 + 32 * w4 + r;
#pragma unroll
                    for (int dt = 0; dt < 4; ++dt)
#pragma unroll
                        for (int i = 0; i < 16; ++i) { so[(32 * dt + (i & 3) + 8 * (i >> 2)) * 128 + h512] = S[dt][i]; S[dt][i] = 0.f; }
                } else {
                    const float* sp = a.state + ((((size_t)b * 4 + l) * 2 + 1) * 8 + hd) * 16384 + 32 * w4 + r;
#pragma unroll
                    for (int dt = 0; dt < 4; ++dt)
#pragma unroll
                        for (int i = 0; i < 16; ++i) S[dt][i] = sp[(32 * dt + (i & 3) + 8 * (i >> 2)) * 128 + h512];
                }
            }
            hg_mstep(S, base + (g & 1) * HG_BUF, lane, w4, (bf16*)(a.ws + (dir ? WS_OB : WS_OF)), c, n, dir, mbase, hd);
            asm volatile("s_waitcnt lgkmcnt(0)" ::: "memory"); __builtin_amdgcn_s_barrier(); asm volatile("" ::: "memory");
        }
        if (!lat) {
            float* so = a.out + OUT_S + ((((size_t)b * 4 + l) * 2 + 1) * 8 + hd) * 16384 + 32 * w4 + r;
#pragma unroll
            for (int dt = 0; dt < 4; ++dt)
#pragma unroll
                for (int i = 0; i < 16; ++i) so[(32 * dt + (i & 3) + 8 * (i >> 2)) * 128 + h512] = S[dt][i];
        }
    }
    __syncthreads();
    {
        const bf16* OFp = (const bf16*)(a.ws + WS_OF); const bf16* OBp = (const bf16*)(a.ws + WS_OB);
        const int e16 = 16 * (F.tid & 7);
        for (int t0 = 0; t0 < n; t0 += 64) {
            const size_t m = (size_t)(mbase + t0 + (F.tid >> 3));
            float o[16]; float ss = 0.f;
#pragma unroll
            for (int j = 0; j < 2; ++j) { float pf[8], pb[8]; unpack8(*((const v4u*)(OFp + m * 1024 + hd * 128 + e16) + j), pf); unpack8(*((const v4u*)(OBp + m * 1024 + hd * 128 + e16) + j), pb);
#pragma unroll
                for (int q = 0; q < 8; ++q) { const float sv = pf[q] + pb[q]; o[8 * j + q] = sv; ss += sv * sv; } }
            ss += __shfl_xor(ss, 1); ss += __shfl_xor(ss, 2); ss += __shfl_xor(ss, 4);
            const float rn = 1.0f / sqrtf(ss * (1.0f / 128.0f) + EPS);
            float g0[8], g1[8];
            unpack8(*(const v4u*)(Z + m * INW + 9216 + hd * 128 + e16), g0); unpack8(*(const v4u*)(Z + m * INW + 9216 + hd * 128 + e16 + 8), g1);
            float y0[8], y1[8];
#pragma unroll
            for (int j = 0; j < 8; ++j) { y0[j] = o[j] * rn * g0[j]; y1[j] = o[8 + j] * rn * g1[j]; }
            *(v4u*)(Y + m * YW + 2048 + hd * 128 + e16) = pack8(y0); *(v4u*)(Y + m * YW + 2048 + hd * 128 + e16 + 8) = pack8(y1);
        }
    }
    __syncthreads();
}

__device__ __forceinline__ const Args* args_ptr() { unsigned long long p = (unsigned long long)__builtin_amdgcn_kernarg_segment_ptr(); asm volatile("" : "+s"(p)); return (const Args*)(const void __attribute__((address_space(4)))*)p; }
__device__ __forceinline__ Ctx make_ctx() {
    Ctx F; int t = threadIdx.x; asm volatile("" : "+v"(t));
    unsigned z = 0; asm volatile("" : "+s"(z));
    F.lds = (LAS unsigned char*)(uintptr_t)z;
    F.tid = t; F.lane = t & 63; F.wave = __builtin_amdgcn_readfirstlane(t >> 6);
    F.G = gridDim.x; { const int bx = blockIdx.x; F.vcu = (F.G % 8 == 0) ? (bx % 8) * (F.G / 8) + bx / 8 : bx; }
    return F;
}
constexpr int NU_CV = 800, NU_HL = 16, NU_AL = 256, NU_HC = 256, NU_AC = 256, NU_A = 640, NU_M1 = NU_HL + NU_AL + NU_HC + NU_AC + NU_A;
#ifndef PROBE_UT
#define PROBE_UT (-1)
#endif
__device__ __forceinline__ void phase_mixers(int l, int qslot) {
    for (;;) {
        int u;
        {   const Args& a = *args_ptr(); const Ctx F = make_ctx();
            unsigned* head = (unsigned*)(a.ws + WS_CTL) + CW_Q + 64 * qslot;
            volatile LAS unsigned* bc = (volatile LAS unsigned*)(F.lds + LDSCTL_OFF) + 4;
            __syncthreads();
            if (F.tid == 0) bc[0] = __hip_atomic_fetch_add(head, 1u, __ATOMIC_RELAXED, __HIP_MEMORY_SCOPE_AGENT);
            __syncthreads();
            u = (int)bc[0]; }
        u = __builtin_amdgcn_readfirstlane(u);
        if (u < NU_HL) { for (int rr = 0; rr < (PROBE_UT == 0 ? 2 : 1); ++rr) { const Args& a = *args_ptr(); const Ctx F = make_ctx(); unitHgrn(a, F, l, true, u >> 3, u & 7); } continue; }
        u -= NU_HL;
        if (l < DEPTH - 1) {
            if (u >= 3 * NU_CV) break;
            const int trip = u / 3, pos = u - 3 * trip;
            if (pos == 2) {
                const Args& a = *args_ptr(); const Ctx F = make_ctx();
                LAS float* scr = (LAS float*)(F.lds + F.wave * 16640);
                cvt_three(a, l + 1, trip * 24 + F.wave, 8, scr, F.lane);
                continue;
            }
            u = 2 * trip + pos;
            if (u >= NU_M1 - NU_HL) continue;
        } else if (u >= NU_M1 - NU_HL) break;
        if (u < NU_HC) { for (int rr = 0; rr < (PROBE_UT == 2 ? 2 : 1); ++rr) { const Args& a = *args_ptr(); const Ctx F = make_ctx(); unitHgrn(a, F, l, false, u >> 3, u & 7); } continue; }
        u -= NU_HC;
        if (u < NU_AL) { for (int rr = 0; rr < (PROBE_UT == 1 ? 2 : 1); ++rr) { const Args& a = *args_ptr(); const Ctx F = make_ctx(); unitAttnLat(a, F, l, u); } continue; }
        u -= NU_AL;
        if (u < NU_AC) { for (int rr = 0; rr < (PROBE_UT == 3 ? 2 : 1); ++rr) { const Args& a = *args_ptr(); const Ctx F = make_ctx(); unitAttnCtx(a, F, u); } continue; }
        u -= NU_AC;
        for (int rr = 0; rr < (PROBE_UT == 4 ? 2 : 1); ++rr) { const Args& a = *args_ptr(); const Ctx F = make_ctx(); unitA(a, F, l, u); }
    }
}

__global__ void __launch_bounds__(NTHR, 2) fwd(Args a_in) {
    extern __shared__ __attribute__((aligned(16))) unsigned char lds_raw[];
    volatile LAS unsigned* MISC = (volatile LAS unsigned*)((LAS unsigned char*)lds_raw + LDSCTL_OFF);
    for (int u = threadIdx.x; u < 256; u += NTHR) MISC[u] = 0u;
    __syncthreads();
    const int lo = a_in.ph_lo, hi = a_in.ph_hi;
    const bool multi = (hi - lo) > 1;
    XcdBarrier bar; bar.bar = (unsigned*)(a_in.ws + WS_CTL) + CW_BAR; bar.x = 0; bar.st = MISC;
    if (multi) bar = xcd_barrier_post((unsigned*)(a_in.ws + WS_CTL) + CW_BAR, MISC);
#ifndef PMASK
#define PMASK 0xFFFFFFFFu
#endif
#define PM(b) ((PMASK >> (b)) & 1u)
#define IN(k) (lo <= (k) && (k) < hi)
#define SEAM(k) do { if (IN(k) && IN((k) + 1)) xcd_barrier(bar); } while (0)
#ifndef PROBE_P
#define PROBE_P (-1)
#define PROBE_N 0
#define PROBE_L 1
#endif
#define REP_BEGIN(k) for (int rep = 0; rep < ((PROBE_P == (k) && l == PROBE_L) ? 1 + PROBE_N : 1); ++rep) {
#define REP_END(k) if (PROBE_P == (k) && l == PROBE_L && rep < PROBE_N) xcd_barrier(bar); }

    if (PM(0) && IN(PH_PRO)) { const int l = PROBE_L; REP_BEGIN(0) const Args& a = *args_ptr(); const Ctx F = make_ctx(); phase_prologue(a, F); REP_END(0) SEAM(PH_PRO); }
    if (PM(1) && IN(PH_T1)) { const int l = PROBE_L; REP_BEGIN(1) const Args& a = *args_ptr(); const Ctx F = make_ctx(); const float* MOD = (const float*)(a.ws + WS_MOD);
        rownorm_phase(a, F, true, nullptr, nullptr, nullptr, true, a.norm_g + 0, MOD + 1 * 2048, MOD + 0 * 2048); REP_END(1) SEAM(PH_T1); }

    for (int l = 0; l < DEPTH; ++l) {
        const int pb = PH_L0 + l * PH_PER_LAYER;
        if (PM(2) && IN(pb + 0)) { REP_BEGIN(2)
            const Args& a = *args_ptr(); const Ctx F = make_ctx(); unsigned char* ws = a.ws; const bf16* wl = (const bf16*)(ws + WS_WT) + (size_t)l * WL_ELEMS;
            pg8::Gemm g{(const bf16*)(ws + WS_H), wl + OFF_IN, MTOK, INW, DM, DM, DM, 0}; pg8::StaticOrder S; S.init(MTOK, INW, F.G, (int)blockIdx.x);
            EpiIn E{(bf16*)(ws + WS_Z), (float*)(ws + WS_LOGF), (const float*)(ws + WS_LB) + l * 1024, a.out + OUT_K + (size_t)l * 262144, a.out + OUT_V + (size_t)l * 262144, (float*)(ws + WS_AST)};
            pg8::gemm_phase<EpiIn, pg8::StaticOrder, true, true>(F.lds, g, S, E);
            REP_END(2) SEAM(pb + 0);
        }
        if (PM(3) && IN(pb + 1)) { REP_BEGIN(3) phase_mixers(l, l + 4 * rep); REP_END(3) SEAM(pb + 1); }
        if (PM(5) && IN(pb + 3)) { REP_BEGIN(5)
            const Args& a = *args_ptr(); const Ctx F = make_ctx(); unsigned char* ws = a.ws; const bf16* wl = (const bf16*)(ws + WS_WT) + (size_t)l * WL_ELEMS;
            pg8::StaticOrder S; S.init(MTOK, DM, F.G, (int)blockIdx.x);
            pg8::Gemm g{(const bf16*)(ws + WS_Y), wl + OFF_UP, MTOK, DM, YW, YW, YW, 0}; EpiUpK E{(const bf16*)(ws + WS_Z) + 10240, (bf16*)(ws + WS_MG)};
            pg8::gemm_phase<EpiUpK, pg8::StaticOrder, true, true>(F.lds, g, S, E);
            REP_END(5) SEAM(pb + 3);
        }
        if (PM(6) && IN(pb + 4)) { REP_BEGIN(6)
            {   const Args& a = *args_ptr(); const Ctx F = make_ctx(); unsigned char* ws = a.ws; const bf16* wl = (const bf16*)(ws + WS_WT) + (size_t)l * WL_ELEMS;
                pg8::Gemm g{(const bf16*)(ws + WS_MG), wl + OFF_OUT, NCTX, DM, DM, DM, DM, 0}; pg8::StaticOrder S; S.init(NCTX, DM, F.G, (int)blockIdx.x);
                EpiBf16P E{(bf16*)(ws + WS_T), DM, 0}; pg8::gemm_phase<EpiBf16P, pg8::StaticOrder, true, true>(F.lds, g, S, E); }
            {   const Args& a = *args_ptr(); const Ctx F = make_ctx(); unsigned char* ws = a.ws; const bf16* wl = (const bf16*)(ws + WS_WT) + (size_t)l * WL_ELEMS;
                pg8::Gemm g{(const bf16*)(ws + WS_MG) + (size_t)NCTX * DM, wl + OFF_OUT, NLAT, DM, DM / 4, DM, DM, (DM / 4) * 2}; pg8::SplitOrder S; S.init(F.G, (int)blockIdx.x);
                EpiBf16P E{(bf16*)(ws + WS_TP), DM, TPQ}; pg8::gemm_phase<EpiBf16P, pg8::SplitOrder, true, true>(F.lds, g, S, E); }
            REP_END(6) SEAM(pb + 4);
        }
        if (PM(7) && IN(pb + 5)) { REP_BEGIN(7) const Args& a = *args_ptr(); const Ctx F = make_ctx(); const float* modl = (const float*)(a.ws + WS_MOD) + (size_t)l * 3 * 12288; const float* gl = a.norm_g + (size_t)l * 4 * DM;
            rownorm_phase(a, F, false, (const bf16*)(a.ws + WS_T), modl + 2 * 2048, gl + 1 * DM, true, gl + 2 * DM, modl + 4 * 2048, modl + 3 * 2048); REP_END(7) SEAM(pb + 5); }
        if (PM(8) && IN(pb + 6)) { REP_BEGIN(8)
            const Args& a = *args_ptr(); const Ctx F = make_ctx(); unsigned char* ws = a.ws; const bf16* wl = (const bf16*)(ws + WS_WT) + (size_t)l * WL_ELEMS;
            pg8::Gemm g{(const bf16*)(ws + WS_H), wl + OFF_FI, MTOK, NFI, DM, DM, DM, 0}; pg8::StaticOrder S; S.init(MTOK, NFI, F.G, (int)blockIdx.x);
            EpiSwi E{(bf16*)(ws + WS_ACT)}; pg8::gemm_phase<EpiSwi, pg8::StaticOrder, true, true>(F.lds, g, S, E);
            REP_END(8) SEAM(pb + 6);
        }
        if (PM(9) && IN(pb + 7)) { REP_BEGIN(9)
            {   const Args& a = *args_ptr(); const Ctx F = make_ctx(); unsigned char* ws = a.ws; const bf16* wl = (const bf16*)(ws + WS_WT) + (size_t)l * WL_ELEMS;
                pg8::Gemm g{(const bf16*)(ws + WS_ACT), wl + OFF_FO, NCTX, DM, DFF, DFF, DFF, 0}; pg8::StaticOrder S; S.init(NCTX, DM, F.G, (int)blockIdx.x);
                EpiBf16P E{(bf16*)(ws + WS_T), DM, 0}; pg8::gemm_phase<EpiBf16P, pg8::StaticOrder, true, true>(F.lds, g, S, E); }
            {   const Args& a = *args_ptr(); const Ctx F = make_ctx(); unsigned char* ws = a.ws; const bf16* wl = (const bf16*)(ws + WS_WT) + (size_t)l * WL_ELEMS;
                pg8::Gemm g{(const bf16*)(ws + WS_ACT) + (size_t)NCTX * DFF, wl + OFF_FO, NLAT, DM, DFF / 4, DFF, DFF, (DFF / 4) * 2}; pg8::SplitOrder S; S.init(F.G, (int)blockIdx.x);
                EpiBf16P E{(bf16*)(ws + WS_TP), DM, TPQ}; pg8::gemm_phase<EpiBf16P, pg8::SplitOrder, true, true>(F.lds, g, S, E); }
            REP_END(9) SEAM(pb + 7);
        }
        if (PM(10) && IN(pb + 8)) { REP_BEGIN(10)
            const Args& a = *args_ptr(); const Ctx F = make_ctx(); const float* MOD = (const float*)(a.ws + WS_MOD);
            const bool last = (l == DEPTH - 1); const int ln = last ? l : l + 1;
            const float* modl = MOD + (size_t)l * 3 * 12288; const float* gl = a.norm_g + (size_t)l * 4 * DM;
            const float* modn = MOD + (size_t)ln * 3 * 12288; const float* gnn = a.norm_g + (size_t)ln * 4 * DM;
            rownorm_phase(a, F, false, (const bf16*)(a.ws + WS_T), modl + 5 * 2048, gl + 3 * DM, !last, gnn + 0, modn + 1 * 2048, modn + 0 * 2048);
            REP_END(10) SEAM(pb + 8);
        }
    }
#undef IN
#undef SEAM
#undef REP_BEGIN
#undef REP_END
}

#ifndef MK_ONE_LAUNCH
#define MK_ONE_LAUNCH 1
#endif
extern "C" void kernel_launch(void* const* d_in, const int* in_sizes, int n_in, void* d_out, int out_size, void* d_ws, size_t ws_size, hipStream_t stream) {
    static int grid = 0;
    if (grid == 0) {
        if (n_in != 21 || (size_t)out_size != OUT_END || ws_size < WS_END) { fprintf(stderr, "kernel_launch: unexpected shapes: n_in %d out %d ws %zu\n", n_in, out_size, ws_size); grid = -1; return; }
        int dev = 0, cus = 0, per_cu = 0;
        if (hipGetDevice(&dev) != hipSuccess || hipDeviceGetAttribute(&cus, hipDeviceAttributeMultiprocessorCount, dev) != hipSuccess) { grid = -1; return; }
        if (hipFuncSetAttribute((const void*)fwd, hipFuncAttributeMaxDynamicSharedMemorySize, LDS_BYTES) != hipSuccess) { fprintf(stderr, "kernel_launch: hipFuncSetAttribute failed\n"); grid = -1; return; }
        if (hipOccupancyMaxActiveBlocksPerMultiprocessor(&per_cu, (const void*)fwd, NTHR, LDS_BYTES) != hipSuccess || per_cu < 1) fprintf(stderr, "kernel_launch: occupancy query says %d\n", per_cu);
        (void)hipGetLastError();
        grid = cus;
    }
    if (grid < 0) return;
    (void)hipMemsetAsync((char*)d_ws + WS_CTL, 0, CTL_ZERO_BYTES, stream);
    Args a{};
    const float** ap = (const float**)&a;
    for (int i = 0; i < 21; ++i) ap[i] = (const float*)d_in[i];
    a.out = (float*)d_out; a.ws = (unsigned char*)d_ws;
#if MK_ONE_LAUNCH
    a.ph_lo = 0; a.ph_hi = PH_END;
    hipLaunchKernelGGL(fwd, dim3(grid), dim3(NTHR), LDS_BYTES, stream, a);
#else
    for (int p = 0; p < PH_END; ++p) { a.ph_lo = p; a.ph_hi = p + 1; hipLaunchKernelGGL(fwd, dim3(grid), dim3(NTHR), LDS_BYTES, stream, a); }
#endif
}
```

```cpp
#include <hip/hip_runtime.h>
#include <cstdio>
#include <cstdint>
namespace pg8 {
#define PG8_LAS __attribute__((address_space(3)))
typedef unsigned short bf16_t;
typedef short bf16x8 __attribute__((ext_vector_type(8)));
typedef float f32x4 __attribute__((ext_vector_type(4)));
typedef unsigned u32x4 __attribute__((ext_vector_type(4)));
constexpr int BM = 256, BK = 64, HALF = 128, HTB = HALF * BK * 2  , STAGE_BYTES = 8 * HTB, NXCD = 8, WGM = 8;

__host__ __device__ __forceinline__ int lds_byte(int r, int c) { const int st = (r >> 4) * 2 + (c >> 5), rr = r & 15, cc = c & 31, ob = rr * 64 + cc * 2; return st * 1024 + (ob ^ (((ob >> 9) & 1) << 5)); }
__host__ __device__ __forceinline__ void stage_rc(int b, int& R, int& C) { const int st = b / 1024, sb = b % 1024, swz = sb ^ (((sb >> 9) & 1) << 5); R = (st >> 1) * 16 + swz / 64; C = (st & 1) * 32 + (swz % 64) / 2; }
__host__ __device__ __forceinline__ int perm32(int rho) { const int n = rho >> 4, i = rho & 15; return 8 * (i >> 2) + 4 * n + (i & 3); }

struct Unit { int pm, pn, kq; };
struct SplitOrder {
    int G, c;
    __host__ __device__ void init(int G_, int c_) { G = G_; c = c_; }
    __host__ __device__ bool next(int i, Unit& u) const { const long L = (long)i * G + c; if (L >= 256) return false; const int t = (int)L >> 2; u.kq = (int)L & 3; u.pm = t & 7; u.pn = t >> 3; return true; }
    __device__ __forceinline__ void a_ready(const Unit&) const {}
    __device__ __forceinline__ void done(const Unit&) const {}
};
struct Gemm { const bf16_t* A; const bf16_t* Bt; int M, N, K, lda, ldb, koff; };

struct StaticOrder {
    int nM, nN, nwg, G, c;
    __host__ __device__ void init(int M, int N, int G_, int c_) { nM = M / BM; nN = N / BM; nwg = nM * nN; G = G_; c = c_; }
    __host__ __device__ bool next(int i, Unit& u) const {
        const long L = (long)i * G + c; if (L >= nwg) return false;
        int wgid = (int)L; { const int q = nwg / NXCD, r = nwg % NXCD, xcd = wgid % NXCD, off = wgid / NXCD; wgid = (xcd < r ? xcd * (q + 1) : r * (q + 1) + (xcd - r) * q) + off; }
        const int nig = WGM * nN, gid = wgid / nig, fm = gid * WGM, gsz = (nM - fm) < WGM ? (nM - fm) : WGM;
        u.pm = fm + ((wgid % nig) % gsz); u.pn = (wgid % nig) / gsz; u.kq = 0; return true;
    }
    __device__ __forceinline__ void a_ready(const Unit&) const {}
    __device__ __forceinline__ void done(const Unit&) const {}
};
template <class Epi, class Sched, bool ALIGN_EPI = false, bool SP2 = false>
__device__ __forceinline__ void gemm_phase(PG8_LAS unsigned char* lds, const Gemm g, const Sched& S, const Epi& E) {
    int tid_ = threadIdx.x; asm volatile("" : "+v"(tid_));
    const int tid = tid_, wid = __builtin_amdgcn_readfirstlane(tid >> 6), lane = tid & 63, wr = wid >> 2, wc = wid & 3, fr = lane & 15, fq = lane >> 4;
    const int K = g.K, nt = K / BK;
    unsigned voffA[2], voffB[2];
#pragma unroll
    for (int i = 0; i < 2; ++i) { int R, C; stage_rc(tid * 16 + i * 8192, R, C); const int Rb = Epi::PERM ? ((R & ~31) + perm32(R & 31)) : R;
        voffA[i] = (unsigned)(R * g.lda + C) * 2u; voffB[i] = (unsigned)(Rb * g.ldb + C) * 2u; }
    const size_t kstep = (size_t)(BK * 2);
    const size_t hstepA = (size_t)HALF * g.lda * 2, hstepB = (size_t)HALF * g.ldb * 2;
    const size_t tstepA = 2 * hstepA, tstepB = 2 * hstepB;
    const unsigned ldsw = (unsigned)wid * 1024u;
    const int aoff = lds_byte(wr * 64 + fr, fq * 8), boff = lds_byte(wc * 32 + fr, fq * 8);
#define PG8_SA(b, h) (((b) * 2 + (h)) * HTB)
#define PG8_SB(b, h) ((4 + (b) * 2 + (h)) * HTB)
#define PG8_STAGE(bufoff, gbase, voff) do { _Pragma("unroll") for (int _i = 0; _i < 2; ++_i) \
        __builtin_amdgcn_global_load_lds((const unsigned*)((const char*)(gbase) + (voff)[_i]), (PG8_LAS unsigned*)(lds + (bufoff) + ldsw + _i * 8192), 16, 0, 0); } while (0)
#define PG8_LDA(dst, b, h) do { _Pragma("unroll") for (int m = 0; m < 4; ++m) _Pragma("unroll") for (int k = 0; k < 2; ++k) dst[m][k] = *(const PG8_LAS bf16x8*)(lds + PG8_SA(b, h) + aoff + m * 2048 + k * 1024); } while (0)
#define PG8_LDB(dst, b, h) do { _Pragma("unroll") for (int n = 0; n < 2; ++n) _Pragma("unroll") for (int k = 0; k < 2; ++k) dst[n][k] = *(const PG8_LAS bf16x8*)(lds + PG8_SB(b, h) + boff + n * 2048 + k * 1024); } while (0)
#define PG8_MMA(ai, bj, At, Bt) do { __builtin_amdgcn_s_setprio(1); _Pragma("unroll") for (int m = 0; m < 4; ++m) _Pragma("unroll") for (int n = 0; n < 2; ++n) _Pragma("unroll") for (int k = 0; k < 2; ++k) \
        acc[ai][bj][m][n] = __builtin_amdgcn_mfma_f32_16x16x32_bf16(Bt[n][k], At[m][k], acc[ai][bj][m][n], 0, 0, 0); __builtin_amdgcn_s_setprio(0); } while (0)
#define PG8_WAIT_V(n) asm volatile("s_waitcnt vmcnt(" #n ")" ::: "memory")
#define PG8_WAIT_L(n) asm volatile("s_waitcnt lgkmcnt(" #n ")" ::: "memory")
#define PG8_BAR __builtin_amdgcn_s_barrier()
#define PG8_SCHED __builtin_amdgcn_sched_barrier(0)
    Unit cur, nxt; int ui = 0;
    if (!S.next(0, cur)) return;
    f32x4 acc[2][2][4][2];
#pragma unroll
    for (int a = 0; a < 2; ++a)
#pragma unroll
        for (int b = 0; b < 2; ++b)
#pragma unroll
            for (int m = 0; m < 4; ++m)
#pragma unroll
                for (int n = 0; n < 2; ++n) acc[a][b][m][n] = (f32x4){0.f, 0.f, 0.f, 0.f};
    bf16x8 At[4][2], B0[2][2], B1[2][2];
    const char* cA = (const char*)g.A + (size_t)cur.pm * tstepA + (size_t)cur.kq * g.koff; const char* cB = (const char*)g.Bt + (size_t)cur.pn * tstepB + (size_t)cur.kq * g.koff;
    S.a_ready(cur);
    if constexpr (SP2) {
        PG8_STAGE(PG8_SB(0, 0), cB, voffB); PG8_STAGE(PG8_SB(0, 1), cB + hstepB, voffB); PG8_STAGE(PG8_SA(0, 0), cA, voffA); PG8_STAGE(PG8_SA(0, 1), cA + hstepA, voffA);
        if (wr == 1) PG8_BAR;
        PG8_WAIT_V(2); PG8_BAR;
        PG8_STAGE(PG8_SB(1, 0), cB + kstep, voffB); PG8_STAGE(PG8_SA(1, 0), cA + kstep, voffA); PG8_STAGE(PG8_SB(1, 1), cB + hstepB + kstep, voffB);
        PG8_WAIT_V(6); PG8_BAR;
    } else {
        PG8_STAGE(PG8_SB(0, 0), cB, voffB); PG8_STAGE(PG8_SA(0, 0), cA, voffA); PG8_STAGE(PG8_SB(0, 1), cB + hstepB, voffB); PG8_STAGE(PG8_SA(0, 1), cA + hstepA, voffA);
        if (wr == 1) PG8_BAR;
        PG8_WAIT_V(4); PG8_BAR;
        PG8_STAGE(PG8_SB(1, 0), cB + kstep, voffB); PG8_STAGE(PG8_SA(1, 0), cA + kstep, voffA); PG8_STAGE(PG8_SB(1, 1), cB + hstepB + kstep, voffB);
        PG8_WAIT_V(6); PG8_BAR;
    }
    for (;;) {
        const bool has_next = S.next(ui + 1, nxt);
        const char* nA = has_next ? (const char*)g.A + (size_t)nxt.pm * tstepA + (size_t)nxt.kq * g.koff : cA; const char* nB = has_next ? (const char*)g.Bt + (size_t)nxt.pn * tstepB + (size_t)nxt.kq * g.koff : cB;
        for (int t = 0; t < nt; t += 2) {
            const bool last = (t == nt - 2);
            const char* a1 = cA + (size_t)(t + 1) * kstep;
            const char* a2 = last ? nA : cA + (size_t)(t + 2) * kstep; const char* b2 = last ? nB : cB + (size_t)(t + 2) * kstep;
            const char* a3 = a2 + kstep; const char* b3 = b2 + kstep;
            if (last && has_next) S.a_ready(nxt);
            if constexpr (Epi::HOOK) { if (t == Epi::H1 || t == Epi::H2) E.hook(acc, cur, t, wr, wc, fr, fq); }
            if constexpr (SP2) {
            PG8_LDB(B0, 0, 0); PG8_LDB(B1, 0, 1); PG8_SCHED; PG8_LDA(At, 0, 0); PG8_STAGE(PG8_SA(1, 1), a1 + hstepA, voffA);
            PG8_WAIT_V(8); PG8_WAIT_L(0); PG8_BAR; PG8_MMA(0, 0, At, B0); PG8_MMA(0, 1, At, B1); PG8_BAR; PG8_SCHED;
            PG8_LDA(At, 0, 1); PG8_STAGE(PG8_SB(0, 0), b2, voffB); PG8_STAGE(PG8_SB(0, 1), b2 + hstepB, voffB); PG8_STAGE(PG8_SA(0, 0), a2, voffA);
            PG8_WAIT_V(8); PG8_WAIT_L(0); PG8_BAR; PG8_MMA(1, 0, At, B0); PG8_MMA(1, 1, At, B1); PG8_BAR; PG8_SCHED;
            PG8_LDB(B0, 1, 0); PG8_LDB(B1, 1, 1); PG8_SCHED; PG8_LDA(At, 1, 0); PG8_STAGE(PG8_SA(0, 1), a2 + hstepA, voffA);
            PG8_WAIT_V(8); PG8_WAIT_L(0); PG8_BAR; PG8_MMA(0, 0, At, B0); PG8_MMA(0, 1, At, B1); PG8_BAR; PG8_SCHED;
            PG8_LDA(At, 1, 1); PG8_STAGE(PG8_SB(1, 0), b3, voffB); PG8_STAGE(PG8_SB(1, 1), b3 + hstepB, voffB); PG8_STAGE(PG8_SA(1, 0), a3, voffA);
            PG8_WAIT_V(8); PG8_WAIT_L(0); PG8_BAR; PG8_MMA(1, 0, At, B0); PG8_MMA(1, 1, At, B1); PG8_BAR; PG8_SCHED;
            } else {
            PG8_LDB(B0, 0, 0); PG8_SCHED; PG8_LDA(At, 0, 0); PG8_STAGE(PG8_SA(1, 1), a1 + hstepA, voffA);
            PG8_WAIT_L(8); PG8_BAR; PG8_WAIT_L(0); PG8_MMA(0, 0, At, B0); PG8_BAR; PG8_SCHED;
            PG8_LDB(B1, 0, 1); PG8_STAGE(PG8_SB(0, 0), b2, voffB);
            PG8_BAR; PG8_WAIT_L(0); PG8_MMA(0, 1, At, B1); PG8_BAR;
            PG8_LDA(At, 0, 1); PG8_STAGE(PG8_SA(0, 0), a2, voffA);
            PG8_BAR; PG8_WAIT_L(0); PG8_MMA(1, 0, At, B0); PG8_BAR; PG8_SCHED;
            PG8_STAGE(PG8_SB(0, 1), b2 + hstepB, voffB);
            PG8_WAIT_V(6); PG8_BAR; PG8_MMA(1, 1, At, B1); PG8_BAR;
            PG8_LDB(B0, 1, 0); PG8_SCHED; PG8_LDA(At, 1, 0); PG8_STAGE(PG8_SA(0, 1), a2 + hstepA, voffA);
            PG8_WAIT_L(8); PG8_BAR; PG8_WAIT_L(0); PG8_MMA(0, 0, At, B0); PG8_BAR; PG8_SCHED;
            PG8_LDB(B1, 1, 1); PG8_STAGE(PG8_SB(1, 0), b3, voffB);
            PG8_BAR; PG8_WAIT_L(0); PG8_MMA(0, 1, At, B1); PG8_BAR;
            PG8_LDA(At, 1, 1); PG8_STAGE(PG8_SA(1, 0), a3, voffA);
            PG8_BAR; PG8_WAIT_L(0); PG8_MMA(1, 0, At, B0); PG8_BAR; PG8_SCHED;
            PG8_STAGE(PG8_SB(1, 1), b3 + hstepB, voffB);
            PG8_WAIT_V(6); PG8_BAR; PG8_MMA(1, 1, At, B1); PG8_BAR;
            }
        }
        if constexpr (ALIGN_EPI) { if (wr == 0) PG8_BAR; }
        if constexpr (!Epi::AFTER_DRAIN) { E(acc, cur, wr, wc, fr, fq); S.done(cur); }
        if (!has_next) break;
#pragma unroll
        for (int a = 0; a < 2; ++a)
#pragma unroll
            for (int b = 0; b < 2; ++b)
#pragma unroll
                for (int m = 0; m < 4; ++m)
#pragma unroll
                    for (int n = 0; n < 2; ++n) acc[a][b][m][n] = (f32x4){0.f, 0.f, 0.f, 0.f};
        cur = nxt; cA = nA; cB = nB; ++ui;
        if constexpr (ALIGN_EPI) { if (wr == 1) PG8_BAR; }
    }
    PG8_WAIT_V(0);
    if constexpr (!ALIGN_EPI) { if (wr == 0) PG8_BAR; }
    PG8_BAR;
    if constexpr (Epi::AFTER_DRAIN) { E.fused(acc, cur, wr, wc, fr, fq, lds, wid, lane); S.done(cur); }
#undef PG8_SA
#undef PG8_SB
#undef PG8_STAGE
#undef PG8_LDA
#undef PG8_LDB
#undef PG8_MMA
#undef PG8_WAIT_V
#undef PG8_WAIT_L
#undef PG8_BAR
#undef PG8_SCHED
}
}

#define GAS __attribute__((address_space(1)))
#define LAS __attribute__((address_space(3)))
typedef unsigned short bf16;
typedef unsigned v4u __attribute__((ext_vector_type(4)));
typedef unsigned v2u __attribute__((ext_vector_type(2)));
typedef float f32x4 __attribute__((ext_vector_type(4)));

constexpr int DM = 2048, NCTX = 8192, NLAT = 2048, MTOK = 10240, DEPTH = 4;
constexpr int INW = 16384, DFF = 5632, NFI = 11264, YW = 3072;
constexpr float EPS = 1e-6f;
constexpr int NWAVES = 8, NTHR = 512;

constexpr size_t MiB = 1u << 20;
constexpr size_t WS_CTL = 0, CTL_ZERO_BYTES = 1 * MiB;
constexpr size_t WS_MOD = 1 * MiB;
constexpr size_t WS_LB = 2 * MiB;
constexpr size_t WS_ROPE = 2 * MiB + 65536;
constexpr size_t WS_AST = 2 * MiB + 131072;
constexpr size_t WS_WT = 4 * MiB;
constexpr size_t WL_ELEMS = 78643200;
constexpr size_t OFF_IN = 0, OFF_UP = 33554432, OFF_OUT = 39845888, OFF_FI = 44040192, OFF_FO = 67108864;
constexpr size_t WS_Z = 604 * MiB;
constexpr size_t WS_LOGF = 924 * MiB;
constexpr size_t WS_H = 1004 * MiB;
constexpr size_t WS_Y = 1044 * MiB;
constexpr size_t WS_OF = 1104 * MiB;
constexpr size_t WS_OB = 1144 * MiB;
constexpr size_t WS_TP = 1184 * MiB;
constexpr size_t TPQ = 2048 * 2048;
constexpr size_t WS_MG = 1264 * MiB;
constexpr size_t WS_T = 1304 * MiB;
constexpr size_t WS_XB = 1344 * MiB;
constexpr size_t WS_ACT = 1384 * MiB;
constexpr size_t WS_END = 1494 * MiB;
constexpr int CW_BAR = 4096;
constexpr int CW_Q = 16384;
constexpr size_t OUT_Y = 0, OUT_K = 20971520, OUT_V = OUT_K + 33554432, OUT_S = OUT_V + 33554432, OUT_END = OUT_S + 33554432;

constexpr int LDS_BYTES = 155648;
constexpr int LDSCTL_OFF = 154624;

constexpr int PH_PRO = 0, PH_T1 = 1, PH_L0 = 2, PH_PER_LAYER = 9, PH_END = PH_L0 + DEPTH * PH_PER_LAYER;

struct Args {
    const float *x_prompt, *x_sample, *cache_k, *cache_v, *state, *c, *c_ctx, *w_ada, *b_ada, *norm_g, *w_in, *a_w, *a_b, *rpb, *lb_logits, *w_up_a, *w_up_b, *w_up_c, *w_out, *w_fi, *w_fo;
    float* out; unsigned char* ws; int ph_lo, ph_hi;
};

__device__ __forceinline__ float bf2f_lo(unsigned w) { return __uint_as_float(w << 16); }
__device__ __forceinline__ float bf2f_hi(unsigned w) { return __uint_as_float(w & 0xffff0000u); }
__device__ __forceinline__ unsigned f2bf(float f) { unsigned u = __float_as_uint(f); return (u + 0x7fffu + ((u >> 16) & 1u)) >> 16; }
typedef __bf16 bf16x2_t __attribute__((ext_vector_type(2)));
typedef float f32x2_t __attribute__((ext_vector_type(2)));
__device__ __forceinline__ unsigned cvtpk(float lo, float hi) { const f32x2_t v = {lo, hi}; return __builtin_bit_cast(unsigned, __builtin_convertvector(v, bf16x2_t)); }
__device__ __forceinline__ unsigned pk2(float lo, float hi) { return cvtpk(lo, hi); }
__device__ __forceinline__ void unpack8(const v4u w, float (&f)[8]) {
    f[0] = bf2f_lo(w.x); f[1] = bf2f_hi(w.x); f[2] = bf2f_lo(w.y); f[3] = bf2f_hi(w.y); f[4] = bf2f_lo(w.z); f[5] = bf2f_hi(w.z); f[6] = bf2f_lo(w.w); f[7] = bf2f_hi(w.w); }
__device__ __forceinline__ v4u pack8(const float (&f)[8]) { v4u w; w.x = pk2(f[0], f[1]); w.y = pk2(f[2], f[3]); w.z = pk2(f[4], f[5]); w.w = pk2(f[6], f[7]); return w; }
__device__ __forceinline__ float wave_sum(float v) {
#pragma unroll
    for (int o = 1; o < 64; o <<= 1) v += __shfl_xor(v, o);
    return v;
}
__device__ __forceinline__ float sigmoidf_(float x) { return __builtin_amdgcn_rcpf(1.0f + __builtin_amdgcn_exp2f(-1.4426950408889634f * x)); }
__device__ __forceinline__ float siluf_(float x) { return x * __builtin_amdgcn_rcpf(1.0f + __builtin_amdgcn_exp2f(-1.4426950408889634f * x)); }
__device__ __forceinline__ float gelu_tanh_(float x) { const float y = (-1.4426950408889634f * 1.5957691216057308f) * (x + 0.044715f * x * x * x); return x * __builtin_amdgcn_rcpf(1.0f + __builtin_amdgcn_exp2f(y)); }

#define XB_TMO      128
#define XB_XCNT(j)  (256  + 64 * (j))
#define XB_XSUB(j)  (1280 + 64 * (j))
#define XB_XGEN(j)  (2304 + 64 * (j))
#define XB_TOP      3328
#define XB_TOPGEN   3392
#define XCD_BAR_WORDS 3456
#define XB_SPIN_CAP (1u << 18)
__device__ __forceinline__ unsigned xb_ld(unsigned* p)              { return __hip_atomic_load(p, __ATOMIC_RELAXED, __HIP_MEMORY_SCOPE_AGENT); }
__device__ __forceinline__ unsigned xb_add(unsigned* p, unsigned v) { return __hip_atomic_fetch_add(p, v, __ATOMIC_RELAXED, __HIP_MEMORY_SCOPE_AGENT); }
__device__ __forceinline__ unsigned xb_xcc_id() { return (unsigned)__builtin_amdgcn_s_getreg((3 << 11) | 20) & 0xFu; }
#define XB_SPIN(cond, bar) do { unsigned _sp = 0; while (cond) { __builtin_amdgcn_s_sleep(1); \
    if ((++_sp & 255u) == 0u) { if (xb_ld(&(bar)[XB_TMO])) break; if (_sp > XB_SPIN_CAP) { atomicAdd(&(bar)[XB_TMO], 1u); break; } } } } while (0)
struct XcdBarrier { unsigned* bar; unsigned x; volatile LAS unsigned* st; };
__device__ __forceinline__ XcdBarrier xcd_barrier_post(unsigned* bar, volatile LAS unsigned* st) {
    XcdBarrier b; b.bar = bar; b.x = xb_xcc_id(); b.st = st;
    if (threadIdx.x == 0) (void)xb_add(&bar[XB_XCNT(b.x)], 1u);
    return b;
}
__device__ __forceinline__ void xcd_barrier_complete(unsigned* bar, unsigned x, unsigned& nloc, unsigned& nx) {
    const unsigned G = gridDim.x * gridDim.y * gridDim.z;
    unsigned sum, cnt, mine, sp = 0u;
    for (;;) {
        sum = 0u; cnt = 0u; mine = 0u;
#pragma unroll
        for (unsigned j = 0; j < 16; ++j) { const unsigned c = xb_ld(&bar[XB_XCNT(j)]); sum += c; cnt += (c > 0u) ? 1u : 0u; mine = (j == x) ? c : mine; }
        if (sum == G) break;
        __builtin_amdgcn_s_sleep(1);
        if ((++sp & 255u) == 0u) { if (xb_ld(&bar[XB_TMO])) break; if (sp > XB_SPIN_CAP) { atomicAdd(&bar[XB_TMO], 1u); break; } }
    }
    nloc = mine > 0u ? mine : 1u; nx = cnt > 0u ? cnt : 1u;
}
__device__ __forceinline__ void xcd_barrier(const XcdBarrier& b) {
    asm volatile("s_waitcnt vmcnt(0)" ::: "memory");
    __syncthreads();
    if (threadIdx.x == 0) {
        unsigned* bar = b.bar;
        __builtin_amdgcn_s_waitcnt(0);
        unsigned nloc = b.st[0], nx = b.st[1];
        if (nloc == 0u) { xcd_barrier_complete(bar, b.x, nloc, nx); b.st[0] = nloc; b.st[1] = nx; }
        const unsigned old = xb_add(&bar[XB_XSUB(b.x)], 1u);
        const unsigned gen = old / nloc;
        if (old + 1u == (gen + 1u) * nloc) {
            __builtin_amdgcn_fence(__ATOMIC_RELEASE, "agent");
            asm volatile("s_waitcnt vmcnt(0)" ::: "memory");
            const unsigned og = xb_add(&bar[XB_TOP], 1u);
            const unsigned tg = og / nx;
            if (og + 1u == (tg + 1u) * nx) xb_add(&bar[XB_TOPGEN], 1u);
            else XB_SPIN(xb_ld(&bar[XB_TOPGEN]) == tg, bar);
            __builtin_amdgcn_fence(__ATOMIC_ACQUIRE, "agent");
            xb_add(&bar[XB_XGEN(b.x)], 1u);
            asm volatile("s_waitcnt vmcnt(0)" ::: "memory");
        } else {
            XB_SPIN(xb_ld(&bar[XB_XGEN(b.x)]) == gen, bar);
            __builtin_amdgcn_fence(__ATOMIC_ACQUIRE, "agent");
            asm volatile("s_waitcnt vmcnt(0)" ::: "memory");
        }
    }
    __syncthreads();
}

struct EpiIn {
    static constexpr bool PERM = true, AFTER_DRAIN = false, HOOK = false; static constexpr int H1 = -1, H2 = -1, NST = 16;
    bf16* Z; float* LOGF; const float* lbp  ; float* outK; float* outV; float* AST;
    template <int KIND>
    __device__ __forceinline__ void body(const f32x4 (&acc)[2][2][4][2], const pg8::Unit& u, int wr, int wc, int fr, int fq) const {
        const int row0 = u.pm * 256 + wr * 64 + fr, colt = u.pn * 256 + wc * 32 + 8 * fq;
        const int seg = u.pn >> 2;
#pragma unroll
        for (int ai = 0; ai < 2; ++ai)
#pragma unroll
            for (int m = 0; m < 4; ++m) {
                const int row = row0 + ai * 128 + m * 16;
                bf16* zrow = Z + (size_t)row * INW + colt;
                float rs = 0.f, rq = 0.f;
#pragma unroll
                for (int bj = 0; bj < 2; ++bj) {
                    float v[8];
#pragma unroll
                    for (int j = 0; j < 4; ++j) { v[j] = acc[ai][bj][m][0][j]; v[4 + j] = acc[ai][bj][m][1][j]; }
                    if (KIND == 5) {
                        const int c2 = colt + bj * 128 - 6144;
                        const float* lb = lbp + (seg - 6) * 4096 + (c2 & 1023);
                        float o[8];
#pragma unroll
                        for (int j = 0; j < 8; ++j) { const float b = lb[j]; o[j] = __builtin_amdgcn_logf(b + (1.0f - b) * sigmoidf_(v[j])); }
                        float* dst = LOGF + (size_t)row * 2048 + c2;
                        *(f32x4*)dst = (f32x4){o[0], o[1], o[2], o[3]}; *(f32x4*)(dst + 4) = (f32x4){o[4], o[5], o[6], o[7]};
                    } else {
                        if (KIND == 4) {
                            if (row < NCTX) { float* dst = (seg == 3 ? outK : outV) + ((size_t)(row >> 8) * 1024 + (row & 255)) * 1024 + (colt + bj * 128 - (seg == 3 ? 3072 : 4096));
                                *(f32x4*)dst = (f32x4){v[0], v[1], v[2], v[3]}; *(f32x4*)(dst + 4) = (f32x4){v[4], v[5], v[6], v[7]}; }
                        }
                        if (KIND == 1 || KIND == 6) {
#pragma unroll
                            for (int j = 0; j < 8; ++j) v[j] = gelu_tanh_(v[j]);
                        }
                        if (KIND == 6) {
#pragma unroll
                            for (int j = 0; j < 8; ++j) { rs += v[j]; rq += v[j] * v[j]; }
                        }
                        if (KIND == 2) {
#pragma unroll
                            for (int j = 0; j < 8; ++j) v[j] = siluf_(v[j]);
                        }
                        if (KIND == 3) {
#pragma unroll
                            for (int j = 0; j < 8; ++j) v[j] = sigmoidf_(v[j]);
                        }
                        *(v4u*)(zrow + bj * 128) = pack8(v);
                    }
                }
                if (KIND == 6) {
                    rs += __shfl_xor(rs, 16); rs += __shfl_xor(rs, 32); rq += __shfl_xor(rq, 16); rq += __shfl_xor(rq, 32);
                    if (fq == 0) { float* d = AST + ((size_t)row * 16 + (u.pn & 3) * 4 + wc) * 2; d[0] = rs; d[1] = rq; }
                }
                asm volatile("" ::: "memory");
            }
    }
    __device__ __forceinline__ void operator()(const f32x4 (&acc)[2][2][4][2], const pg8::Unit& u, int wr, int wc, int fr, int fq) const {
        const int seg = u.pn >> 2;
        if (seg >= 10) body<3>(acc, u, wr, wc, fr, fq);
        else if (seg == 0) body<1>(acc, u, wr, wc, fr, fq);
        else if (seg == 1) body<6>(acc, u, wr, wc, fr, fq);
        else if (seg == 5 || seg == 9) body<2>(acc, u, wr, wc, fr, fq);
        else if (seg == 3 || seg == 4) body<4>(acc, u, wr, wc, fr, fq);
        else if (seg == 6 || seg == 7) body<5>(acc, u, wr, wc, fr, fq);
        else body<0>(acc, u, wr, wc, fr, fq);
    }
};
struct EpiUpK {
    static constexpr bool PERM = true, AFTER_DRAIN = false, HOOK = true; static constexpr int H1 = 16, H2 = 32, NST = 16;
    const bf16* Zg  ; bf16* MG;
    __device__ __forceinline__ void hook(f32x4 (&acc)[2][2][4][2], const pg8::Unit& u, int t, int wr, int wc, int fr, int fq) const {
        int frl = fr, fql = fq; asm volatile("" : "+v"(frl), "+v"(fql));
        const int row0 = u.pm * 256 + wr * 64 + frl, colt = u.pn * 256 + wc * 32 + 8 * fql;
        const bf16* zn = Zg + (t == 16 ? 0 : 2048);
#pragma unroll
        for (int ai = 0; ai < 2; ++ai) {
            v4u nw[4][2], dw[4][2];
#pragma unroll
            for (int m = 0; m < 4; ++m)
#pragma unroll
                for (int bj = 0; bj < 2; ++bj) { const size_t ro = (size_t)(row0 + ai * 128 + m * 16) * INW + colt + bj * 128; nw[m][bj] = *(const v4u*)(zn + ro); dw[m][bj] = *(const v4u*)(zn + 2048 + ro); }
#pragma unroll
            for (int m = 0; m < 4; ++m)
#pragma unroll
                for (int bj = 0; bj < 2; ++bj) {
                    float gn[8], gd[8]; unpack8(nw[m][bj], gn); unpack8(dw[m][bj], gd);
#pragma unroll
                    for (int j = 0; j < 4; ++j) { acc[ai][bj][m][0][j] *= gn[j] * __builtin_amdgcn_rcpf(gd[j]); acc[ai][bj][m][1][j] *= gn[4 + j] * __builtin_amdgcn_rcpf(gd[4 + j]); }
                }
            asm volatile("" ::: "memory");
        }
    }
    __device__ __forceinline__ void operator()(const f32x4 (&acc)[2][2][4][2], const pg8::Unit& u, int wr, int wc, int fr, int fq) const {
        const int row0 = u.pm * 256 + wr * 64 + fr, colt = u.pn * 256 + wc * 32 + 8 * fq;
#pragma unroll
        for (int ai = 0; ai < 2; ++ai)
#pragma unroll
            for (int m = 0; m < 4; ++m) {
                const int row = row0 + ai * 128 + m * 16;
#pragma unroll
                for (int bj = 0; bj < 2; ++bj) {
                    const int col = colt + bj * 128;
                    float g[8]; unpack8(*(const v4u*)(Zg + 4096 + (size_t)row * INW + col), g);
                    float v[8];
#pragma unroll
                    for (int j = 0; j < 4; ++j) { v[j] = acc[ai][bj][m][0][j] * g[j]; v[4 + j] = acc[ai][bj][m][1][j] * g[4 + j]; }
                    *(v4u*)(MG + (size_t)row * DM + col) = pack8(v);
                }
                asm volatile("" ::: "memory");
            }
    }
};
struct EpiBf16P {
    static constexpr bool PERM = true, AFTER_DRAIN = false, HOOK = false; static constexpr int H1 = -1, H2 = -1, NST = 16;
    bf16* C; int ldc; size_t kq_stride;
    __device__ __forceinline__ void operator()(const f32x4 (&acc)[2][2][4][2], const pg8::Unit& u, int wr, int wc, int fr, int fq) const {
        const int row0 = u.pm * 256 + wr * 64 + fr, colt = u.pn * 256 + wc * 32 + 8 * fq;
#pragma unroll
        for (int ai = 0; ai < 2; ++ai)
#pragma unroll
            for (int m = 0; m < 4; ++m) {
                bf16* rp = C + (size_t)u.kq * kq_stride + (size_t)(row0 + ai * 128 + m * 16) * ldc + colt;
#pragma unroll
                for (int bj = 0; bj < 2; ++bj) { float v[8];
#pragma unroll
                    for (int j = 0; j < 4; ++j) { v[j] = acc[ai][bj][m][0][j]; v[4 + j] = acc[ai][bj][m][1][j]; }
                    *(v4u*)(rp + bj * 128) = pack8(v); }
            }
    }
};
struct EpiSwi {
    static constexpr bool PERM = true, AFTER_DRAIN = false, HOOK = false; static constexpr int H1 = -1, H2 = -1, NST = 16;
    bf16* ACT;
    __device__ __forceinline__ void operator()(const f32x4 (&acc)[2][2][4][2], const pg8::Unit& u, int wr, int wc, int fr, int fq) const {
        const int row0 = u.pm * 256 + wr * 64 + fr, colt = u.pn * 128 + wc * 32 + 8 * fq;
#pragma unroll
        for (int ai = 0; ai < 2; ++ai)
#pragma unroll
            for (int m = 0; m < 4; ++m) {
                float v[8];
#pragma unroll
                for (int j = 0; j < 4; ++j) { v[j] = siluf_(acc[ai][1][m][0][j]) * acc[ai][0][m][0][j]; v[4 + j] = siluf_(acc[ai][1][m][1][j]) * acc[ai][0][m][1][j]; }
                *(v4u*)(ACT + (size_t)(row0 + ai * 128 + m * 16) * DFF + colt) = pack8(v);
            }
    }
};

struct Ctx {
    LAS unsigned char* lds; int tid, lane, wave, vcu, G;
};

struct CvtDesc { const float* src; int N; bf16* dst; int dld; };
__device__ __forceinline__ void cvt_load(const CvtDesc& d, f32x4 (&v)[16]) {
#pragma unroll
    for (int i = 0; i < 16; ++i) v[i] = *(const f32x4*)(d.src + (size_t)(4 * i) * d.N);
}
__device__ __forceinline__ void cvt_finish(const CvtDesc& d, const f32x4 (&v)[16], LAS float* scr, int lane) {
#pragma unroll
    for (int i = 0; i < 16; ++i) { LAS float* s = scr + (4 * i + (lane >> 4)) * 65 + 4 * (lane & 15); s[0] = v[i].x; s[1] = v[i].y; s[2] = v[i].z; s[3] = v[i].w; }
    asm volatile("s_waitcnt lgkmcnt(0)" ::: "memory");
    const int c = lane & 7;
#pragma unroll
    for (int j = 0; j < 8; ++j) { const int n = (lane >> 3) + 8 * j; const LAS float* s = scr + (8 * c) * 65 + n;
        v4u o; o.x = pk2(s[0 * 65], s[1 * 65]); o.y = pk2(s[2 * 65], s[3 * 65]); o.z = pk2(s[4 * 65], s[5 * 65]); o.w = pk2(s[6 * 65], s[7 * 65]);
        *(v4u*)(d.dst + (size_t)n * d.dld + 8 * c) = o; }
    asm volatile("s_waitcnt lgkmcnt(0)" ::: "memory");
}
constexpr int IT_IN = 32 * 256, IT_UP = 16 * 32, IT_OUT = 32 * 32, IT_FI = 32 * 176, IT_FO = 88 * 32, IT_LAYER = IT_IN + 3 * IT_UP + IT_OUT + IT_FI + IT_FO;
__device__ __forceinline__ CvtDesc cvt_desc(const Args& a, int l, int r, int lane) {
    bf16* wl = (bf16*)(a.ws + WS_WT) + (size_t)l * WL_ELEMS;
    const float* W; int N, k0, n0, dld, drow0, dcol0; bf16* dst;
    if (r < IT_IN) { const int kb = r / 256, nb = r % 256; W = a.w_in + (size_t)l * DM * INW; N = INW; k0 = 64 * kb; n0 = 64 * nb; dst = wl + OFF_IN; dld = DM; drow0 = n0; dcol0 = k0; }
    else { r -= IT_IN;
    if (r < 3 * IT_UP) { const int br = r / IT_UP, q = r % IT_UP, kb = q / 32, nb = q % 32;
        W = (br == 0 ? a.w_up_a : (br == 1 ? a.w_up_b : a.w_up_c)) + (size_t)l * 1024 * DM; N = DM; k0 = 64 * kb; n0 = 64 * nb; dst = wl + OFF_UP; dld = YW; drow0 = n0; dcol0 = 1024 * br + k0; }
    else { r -= 3 * IT_UP;
    if (r < IT_OUT) { const int kb = r / 32, nb = r % 32; W = a.w_out + (size_t)l * DM * DM; N = DM; k0 = 64 * kb; n0 = 64 * nb; dst = wl + OFF_OUT; dld = DM; drow0 = n0; dcol0 = k0; }
    else { r -= IT_OUT;
    if (r < IT_FI) { const int kb = r / 176, nb = r % 176; n0 = 64 * nb; k0 = 64 * kb; W = a.w_fi + (size_t)l * DM * NFI; N = NFI; dst = wl + OFF_FI; dld = DM;
        drow0 = (n0 < DFF) ? (256 * (n0 / 128) + (n0 % 128)) : (256 * ((n0 - DFF) / 128) + 128 + ((n0 - DFF) % 128)); dcol0 = k0; }
    else { r -= IT_FI; const int kb = r / 32, nb = r % 32; W = a.w_fo + (size_t)l * DFF * DM; N = DM; k0 = 64 * kb; n0 = 64 * nb; dst = wl + OFF_FO; dld = DFF; drow0 = n0; dcol0 = k0; } } } }
    CvtDesc d; d.src = W + (size_t)(k0 + (lane >> 4)) * N + n0 + 4 * (lane & 15); d.N = N; d.dst = dst + (size_t)drow0 * dld + dcol0; d.dld = dld; return d;
}
__device__ __forceinline__ void cvt_three(const Args& a, int l, int r0, int rstep, LAS float* scr, int lane) {
    const CvtDesc d0 = cvt_desc(a, l, r0, lane), d1 = cvt_desc(a, l, r0 + rstep, lane), d2 = cvt_desc(a, l, r0 + 2 * rstep, lane);
    f32x4 v0[16], v1[16], v2[16];
    cvt_load(d0, v0); cvt_load(d1, v1); cvt_load(d2, v2);
    cvt_finish(d0, v0, scr, lane); cvt_finish(d1, v1, scr, lane); cvt_finish(d2, v2, scr, lane);
}
__device__ __forceinline__ void phase_prologue(const Args& a, const Ctx& F) {
    unsigned char* ws = a.ws;
    {
        LAS float* scr = (LAS float*)(F.lds + F.wave * 16640);
        const int gw = F.vcu * NWAVES + F.wave, NGW = F.G * NWAVES;
        for (int it = gw; it < IT_LAYER / 3; it += NGW) cvt_three(a, 0, it, IT_LAYER / 3, scr, F.lane);
    }
    __syncthreads();
    {
        LAS float* sc = (LAS float*)F.lds;
        LAS float* red = (LAS float*)(F.lds + 24576);
        float* MOD = (float*)(ws + WS_MOD);
        for (int i = F.tid; i < 3 * DM; i += NTHR) { const int ci = i / DM, k = i % DM; const float x = (ci == 0) ? a.c_ctx[k] : a.c[(ci - 1) * DM + k]; sc[i] = x / (1.0f + expf(-x)); }
        __syncthreads();
        const int cx = F.tid & 31, kg = F.tid >> 5;
        for (int u = F.vcu; u < 4 * 96; u += F.G) {
            const int l = u / 96, cb = u % 96;
            const float* wp = a.w_ada + ((size_t)l * DM + 128 * kg) * 12288 + 128 * cb + 4 * cx;
            f32x4 a0 = {0.f, 0.f, 0.f, 0.f}, a1 = a0, a2 = a0;
#pragma unroll 8
            for (int k = 0; k < 128; ++k) { const f32x4 w = *(const f32x4*)(wp + (size_t)k * 12288);
                const float s0 = sc[128 * kg + k], s1 = sc[DM + 128 * kg + k], s2 = sc[2 * DM + 128 * kg + k];
                a0 += w * s0; a1 += w * s1; a2 += w * s2; }
#pragma unroll
            for (int j = 0; j < 4; ++j) { red[(kg * 3 + 0) * 128 + 4 * cx + j] = a0[j]; red[(kg * 3 + 1) * 128 + 4 * cx + j] = a1[j]; red[(kg * 3 + 2) * 128 + 4 * cx + j] = a2[j]; }
            __syncthreads();
            if (F.tid < 384) { const int ci = F.tid / 128, col = F.tid % 128; float s = 0.f;
#pragma unroll
                for (int g = 0; g < 16; ++g) s += red[(g * 3 + ci) * 128 + col];
                MOD[(size_t)(l * 3 + ci) * 12288 + 128 * cb + col] = s + a.b_ada[l * 12288 + 128 * cb + col]; }
            __syncthreads();
        }
    }
    {
        float* LB = (float*)(ws + WS_LB); float* ROPE = (float*)(ws + WS_ROPE);
        for (int i = F.vcu * NTHR + F.tid; i < 2048; i += F.G * NTHR) {
            const int dir = i / 1024, f = i % 1024;
            float x[4], mx = -3.0e38f;
#pragma unroll
            for (int l = 0; l < 4; ++l) { x[l] = a.lb_logits[(dir * 4 + l) * 1024 + f]; mx = fmaxf(mx, x[l]); }
            float e[4], s = 0.f;
#pragma unroll
            for (int l = 0; l < 4; ++l) { e[l] = expf(x[l] - mx); s += e[l]; }
            float cs = 0.f;
#pragma unroll
            for (int l = 0; l < 4; ++l) { if (l > 0) cs += e[l] / s; LB[(dir * 4 + l) * 1024 + f] = cs; }
            const int p = i / 32, fi = i % 32;
            const float inv = powf(10000.0f, -(float)(2 * fi) / 64.0f), ang = (float)p * inv;
            ROPE[2 * i] = cosf(ang); ROPE[2 * i + 1] = sinf(ang);
        }
    }
}

__device__ __forceinline__ void rownorm_phase(const Args& a, const Ctx& F, bool first, const bf16* T, const float* gate  , const float* gpost,
                                              bool write_h, const float* gn, const float* scv, const float* shv  ) {
    float* X = a.out + OUT_Y; bf16* XB = (bf16*)(a.ws + WS_XB); bf16* H = (bf16*)(a.ws + WS_H); const bf16* TP = (const bf16*)(a.ws + WS_TP);
    LAS float* V1 = (LAS float*)F.lds; LAS float* V2 = V1 + 3 * DM; LAS float* V3 = V2 + 3 * DM;
    __syncthreads();
    for (int i = F.tid; i < 3 * DM; i += NTHR) { const int ci = i / DM, c = i % DM;
        if (T) V1[i] = gate[(size_t)ci * 12288 + c] * gpost[c];
        if (write_h) { V2[i] = gn[c] * (1.0f + scv[(size_t)ci * 12288 + c]); V3[i] = shv[(size_t)ci * 12288 + c]; } }
    __syncthreads();
    const int gw = F.vcu * NWAVES + F.wave, NGW = F.G * NWAVES;
    for (int m = gw; m < MTOK; m += NGW) {
        const int ci = (m < NCTX) ? 0 : 1 + ((m - NCTX) >> 10);
        f32x4 x[8];
        if (first) { const float* xr = (m < NCTX) ? a.x_prompt + (size_t)m * DM : a.x_sample + (size_t)(m - NCTX) * DM;
#pragma unroll
            for (int j = 0; j < 8; ++j) x[j] = *((const f32x4*)xr + F.lane + 64 * j);
        } else {
#pragma unroll
            for (int j = 0; j < 8; ++j) { const v2u w = *((const v2u*)(XB + (size_t)m * DM) + F.lane + 64 * j); x[j] = (f32x4){bf2f_lo(w.x), bf2f_hi(w.x), bf2f_lo(w.y), bf2f_hi(w.y)}; }
        }
        if (T) {
            f32x4 t[8]; float ss = 0.f;
#pragma unroll
            for (int j = 0; j < 8; ++j) {
                if (m < NCTX) { const v2u w = *((const v2u*)(T + (size_t)m * DM) + F.lane + 64 * j); t[j] = (f32x4){bf2f_lo(w.x), bf2f_hi(w.x), bf2f_lo(w.y), bf2f_hi(w.y)}; }
                else { const v2u* tp = (const v2u*)(TP + (size_t)(m - NCTX) * DM) + F.lane + 64 * j; const v2u w0 = tp[0], w1 = tp[TPQ / 4], w2 = tp[2 * (TPQ / 4)], w3 = tp[3 * (TPQ / 4)];
                    t[j] = (f32x4){(bf2f_lo(w0.x) + bf2f_lo(w1.x)) + (bf2f_lo(w2.x) + bf2f_lo(w3.x)), (bf2f_hi(w0.x) + bf2f_hi(w1.x)) + (bf2f_hi(w2.x) + bf2f_hi(w3.x)),
                                   (bf2f_lo(w0.y) + bf2f_lo(w1.y)) + (bf2f_lo(w2.y) + bf2f_lo(w3.y)), (bf2f_hi(w0.y) + bf2f_hi(w1.y)) + (bf2f_hi(w2.y) + bf2f_hi(w3.y))}; }
                ss += (t[j].x * t[j].x + t[j].y * t[j].y) + (t[j].z * t[j].z + t[j].w * t[j].w); }
            const float r = 1.0f / sqrtf(wave_sum(ss) * (1.0f / DM) + EPS);
#pragma unroll
            for (int j = 0; j < 8; ++j) { const f32x4 v1 = *((const LAS f32x4*)(V1 + ci * DM) + F.lane + 64 * j); x[j] += v1 * (t[j] * r); }
        }
        if (!write_h) {
#pragma unroll
            for (int j = 0; j < 8; ++j) *((f32x4*)(X + (size_t)m * DM) + F.lane + 64 * j) = x[j];
        } else {
#pragma unroll
            for (int j = 0; j < 8; ++j) { v2u w; w.x = pk2(x[j].x, x[j].y); w.y = pk2(x[j].z, x[j].w); *((v2u*)(XB + (size_t)m * DM) + F.lane + 64 * j) = w; }
        }
        if (write_h) {
            float ss = 0.f;
#pragma unroll
            for (int j = 0; j < 8; ++j) ss += (x[j].x * x[j].x + x[j].y * x[j].y) + (x[j].z * x[j].z + x[j].w * x[j].w);
            const float r = 1.0f / sqrtf(wave_sum(ss) * (1.0f / DM) + EPS);
#pragma unroll
            for (int j = 0; j < 8; ++j) { const f32x4 v2 = *((const LAS f32x4*)(V2 + ci * DM) + F.lane + 64 * j), v3 = *((const LAS f32x4*)(V3 + ci * DM) + F.lane + 64 * j);
                const f32x4 h = x[j] * r * v2 + v3;
                v2u w; w.x = pk2(h.x, h.y); w.y = pk2(h.z, h.w);
                *((v2u*)(H + (size_t)m * DM) + F.lane + 64 * j) = w; }
        }
    }
    __syncthreads();
}

__device__ __forceinline__ void phase_ycnorm(const Args& a, const Ctx& F) {
    const float* OFp = (const float*)(a.ws + WS_OF); const float* OBp = (const float*)(a.ws + WS_OB);
    const bf16* Z = (const bf16*)(a.ws + WS_Z); bf16* Y = (bf16*)(a.ws + WS_Y);
    const int gw = F.vcu * NWAVES + F.wave, NGW = F.G * NWAVES;
    for (int m = gw; m < MTOK; m += NGW) {
        float o[16]; float ss = 0.f;
#pragma unroll
        for (int j = 0; j < 4; ++j) { const f32x4 p = *((const f32x4*)(OFp + (size_t)m * 1024 + 16 * F.lane) + j), q = *((const f32x4*)(OBp + (size_t)m * 1024 + 16 * F.lane) + j);
            const f32x4 s = p + q; o[4 * j] = s.x; o[4 * j + 1] = s.y; o[4 * j + 2] = s.z; o[4 * j + 3] = s.w; ss += (s.x * s.x + s.y * s.y) + (s.z * s.z + s.w * s.w); }
        ss += __shfl_xor(ss, 1); ss += __shfl_xor(ss, 2); ss += __shfl_xor(ss, 4);
        const float r = 1.0f / sqrtf(ss * (1.0f / 128.0f) + EPS);
        float g0[8], g1[8];
        unpack8(*(const v4u*)(Z + (size_t)m * INW + 9216 + 16 * F.lane), g0); unpack8(*(const v4u*)(Z + (size_t)m * INW + 9216 + 16 * F.lane + 8), g1);
        float y0[8], y1[8];
#pragma unroll
        for (int j = 0; j < 8; ++j) { y0[j] = o[j] * r * g0[j]; y1[j] = o[8 + j] * r * g1[j]; }
        *(v4u*)(Y + (size_t)m * YW + 2048 + 16 * F.lane) = pack8(y0); *(v4u*)(Y + (size_t)m * YW + 2048 + 16 * F.lane + 8) = pack8(y1);
    }
}

typedef short bf16x8 __attribute__((ext_vector_type(8)));
typedef short s16x4 __attribute__((ext_vector_type(4)));
typedef float f32x16 __attribute__((ext_vector_type(16)));
typedef __bf16 bf16x4_t __attribute__((ext_vector_type(4)));
#define MFMA32(a, b, c) __builtin_amdgcn_mfma_f32_32x32x16_bf16((a), (b), (c), 0, 0, 0)
__device__ __forceinline__ bf16x8 pack_regs(const f32x16& x, int s) {
    v4u p; p.x = cvtpk(x[8 * s], x[8 * s + 1]); p.y = cvtpk(x[8 * s + 2], x[8 * s + 3]); p.z = cvtpk(x[8 * s + 4], x[8 * s + 5]); p.w = cvtpk(x[8 * s + 6], x[8 * s + 7]);
    return __builtin_bit_cast(bf16x8, p);
}
__device__ __forceinline__ s16x4 tr_read(const LAS unsigned char* p) { return __builtin_bit_cast(s16x4, __builtin_amdgcn_ds_read_tr16_b64_v4bf16((LAS bf16x4_t*)p)); }
__device__ __forceinline__ bf16x8 tr_pair(const LAS unsigned char* lo, const LAS unsigned char* hi) { const s16x4 a = tr_read(lo), b = tr_read(hi); return __builtin_shufflevector(a, b, 0, 1, 2, 3, 4, 5, 6, 7); }
constexpr float ATT_SCALE = 0.08838834764831845f;
constexpr int KP = 272, VP = 320;
constexpr int ATT_K_OFF = 0, ATT_V_OFF = 256 * KP, ATT_RPB_OFF = ATT_V_OFF + 256 * VP;
struct AttnW { f32x16 O[4]; float m, l; };
template <int MODE, bool QLDS>
__device__ __forceinline__ void attn_tile(AttnW& W, const bf16x8 (&qf)[8], const LAS unsigned char* Ql, const LAS unsigned char* Kl, const LAS unsigned char* Vl, int kt0, int lane, const LAS float* rpb_row, int kc0, int qc) {
    const int r = lane & 31, h = lane >> 5;
    f32x16 sacc;
#pragma unroll
    for (int i = 0; i < 16; ++i) sacc[i] = 0.f;
    const LAS unsigned char* kp = Kl + (kt0 + r) * KP + 16 * h;
#pragma unroll
    for (int ks = 0; ks < 8; ++ks) { const bf16x8 a = *(const LAS bf16x8*)(kp + 32 * ks); const bf16x8 q = QLDS ? *(const LAS bf16x8*)(Ql + 32 * ks) : qf[ks]; sacc = MFMA32(a, q, sacc); }
    float mt = -1.0e30f;
    if (MODE == 1) {
        const int c_start = min(max(qc - 8, 0), 48);
        const int kb = kc0 + 4 * h - c_start;
        const LAS float* bp = rpb_row + (kc0 + 4 * h - qc + 15);
#pragma unroll
        for (int i = 0; i < 16; ++i) { const int off = (i & 3) + 8 * (i >> 2); const bool ok = (unsigned)(kb + off) < 16u;
            const float bias = bp[ok ? off : (qc - kc0 - 4 * h)];
            const float v = ok ? (sacc[i] * ATT_SCALE + bias) : -1.0e30f; sacc[i] = v; mt = fmaxf(mt, v); }
    } else {
#pragma unroll
        for (int i = 0; i < 16; ++i) { sacc[i] *= ATT_SCALE; mt = fmaxf(mt, sacc[i]); }
    }
    mt = fmaxf(mt, __shfl_xor(mt, 32));
    const float mn = fmaxf(W.m, mt), alpha = __expf(W.m - mn);
    float ls = 0.f;
#pragma unroll
    for (int i = 0; i < 16; ++i) { const float e = (MODE == 1 && sacc[i] < -1.0e29f) ? 0.f : __expf(sacc[i] - mn); sacc[i] = e; ls += e; }
    ls += __shfl_xor(ls, 32);
    W.l = W.l * alpha + ls; W.m = mn;
    if (__any(alpha != 1.0f)) {
#pragma unroll
        for (int dt = 0; dt < 4; ++dt)
#pragma unroll
            for (int i = 0; i < 16; ++i) W.O[dt][i] *= alpha;
    }
    const bf16x8 pb0 = pack_regs(sacc, 0), pb1 = pack_regs(sacc, 1);
    const int g = (lane >> 4) & 1, q4 = (lane & 15) >> 2, p4 = lane & 3;
    const LAS unsigned char* vp = Vl + (kt0 + 4 * h + q4) * VP + 32 * g + 8 * p4;
#pragma unroll
    for (int dt = 0; dt < 4; ++dt) {
        const bf16x8 v0 = tr_pair(vp + 64 * dt, vp + 64 * dt + 8 * VP);
        const bf16x8 v1 = tr_pair(vp + 64 * dt + 16 * VP, vp + 64 * dt + 24 * VP);
        W.O[dt] = MFMA32(v0, pb0, W.O[dt]); W.O[dt] = MFMA32(v1, pb1, W.O[dt]);
    }
}
__device__ __forceinline__ void attn_init(AttnW& W) {
    W.m = -1.0e30f; W.l = 0.f;
#pragma unroll
    for (int dt = 0; dt < 4; ++dt)
#pragma unroll
        for (int i = 0; i < 16; ++i) W.O[dt][i] = 0.f;
}
__device__ __forceinline__ void attn_store_dt(const f32x16& O, float inv, bf16* yrow, int dt, int h) {
#pragma unroll
    for (int g4 = 0; g4 < 4; ++g4) { v2u w; w.x = cvtpk(O[4 * g4] * inv, O[4 * g4 + 1] * inv); w.y = cvtpk(O[4 * g4 + 2] * inv, O[4 * g4 + 3] * inv);
        *(v2u*)(yrow + 32 * dt + 8 * g4 + 4 * h) = w; }
}

__device__ __forceinline__ void unitAttnCtx(const Args& a, const Ctx& F, int unit) {
    const int hd = unit & 7, b = unit >> 3;
    const bf16* Z = (const bf16*)(a.ws + WS_Z); bf16* Y = (bf16*)(a.ws + WS_Y);
    const LAS unsigned char* Kl = F.lds + ATT_K_OFF; const LAS unsigned char* Vl = F.lds + ATT_V_OFF;
    for (int p = F.tid; p < 4096; p += NTHR) { const int key = p >> 4, c16 = p & 15; const bf16* src = Z + (size_t)(b * 256 + key) * INW + hd * 128 + 8 * c16;
        *(LAS v4u*)(F.lds + ATT_K_OFF + key * KP + 16 * c16) = *(const v4u*)(src + 3072); *(LAS v4u*)(F.lds + ATT_V_OFF + key * VP + 16 * c16) = *(const v4u*)(src + 4096); }
    AttnW W; attn_init(W); bf16x8 qf[8];
    const int r = F.lane & 31, h = F.lane >> 5;
    const int mq = b * 256 + 32 * F.wave + r;
    { const bf16* qp = Z + (size_t)mq * INW + 2048 + hd * 128 + 8 * h;
#pragma unroll
      for (int ks = 0; ks < 8; ++ks) qf[ks] = __builtin_bit_cast(bf16x8, *(const v4u*)(qp + 16 * ks)); }
    __syncthreads();
#pragma unroll 1
    for (int kt = 0; kt < 8; ++kt) attn_tile<0, false>(W, qf, nullptr, Kl, Vl, 32 * kt, F.lane, nullptr, 0, 0);
    const float inv = 1.0f / W.l;
    bf16* yrow = Y + (size_t)mq * YW + 1024 + hd * 128;
#pragma unroll
    for (int dt = 0; dt < 4; ++dt) attn_store_dt(W.O[dt], inv, yrow, dt, h);
    __syncthreads();
}
constexpr int LQ_OFF = 0, LK_OFF = 64 * KP, LV_OFF = LK_OFF + 128 * KP, LRPB_OFF = LV_OFF + 128 * VP;
__device__ __forceinline__ void unitAttnLat(const Args& a, const Ctx& F, int l, int unit) {
    const int gr = unit & 15, hd = (unit >> 4) & 7, b = unit >> 7;
    const bf16* Z = (const bf16*)(a.ws + WS_Z); bf16* Y = (bf16*)(a.ws + WS_Y);
    const float* ROPE = (const float*)(a.ws + WS_ROPE);
    const LAS unsigned char* Kl = F.lds + LK_OFF; const LAS unsigned char* Vl = F.lds + LV_OFF; LAS float* rp = (LAS float*)(F.lds + LRPB_OFF);
    const int r = F.lane & 31, h = F.lane >> 5, qh = F.wave & 1, kt = F.wave >> 1;
    const int qc = 32 * qh + r;
    const int r_start = min(max(gr - 4, 0), 8);
    const int mq = NCTX + b * 1024 + gr * 64 + qc;
    __syncthreads();
    for (int i = F.tid; i < 15 * 31; i += NTHR) rp[i] = a.rpb[(size_t)(l * 8 + hd) * 465 + i];
    {
        const int qq = F.tid >> 3, half = (F.tid >> 2) & 1, sp = F.tid & 3, pos = half ? qq : gr;
        const bf16* src = Z + (size_t)(NCTX + b * 1024 + gr * 64 + qq) * INW + 2048 + hd * 128 + 64 * half + 8 * sp;
        const float* rt = ROPE + 2 * (pos * 32 + 8 * sp);
        float x[8], y[8], lo[8], hi[8]; unpack8(*(const v4u*)src, x); unpack8(*(const v4u*)(src + 32), y);
#pragma unroll
        for (int j4 = 0; j4 < 4; ++j4) { const f32x4 cssn = *(const f32x4*)(rt + 4 * j4);
            lo[2 * j4] = x[2 * j4] * cssn.x - y[2 * j4] * cssn.y; hi[2 * j4] = y[2 * j4] * cssn.x + x[2 * j4] * cssn.y;
            lo[2 * j4 + 1] = x[2 * j4 + 1] * cssn.z - y[2 * j4 + 1] * cssn.w; hi[2 * j4 + 1] = y[2 * j4 + 1] * cssn.z + x[2 * j4 + 1] * cssn.w; }
        LAS unsigned char* d = F.lds + LQ_OFF + qq * KP + 2 * (64 * half + 8 * sp);
        *(LAS v4u*)d = pack8(lo); *(LAS v4u*)(d + 64) = pack8(hi);
    }
    AttnW W; attn_init(W);
    const LAS unsigned char* Ql = F.lds + LQ_OFF + qc * KP + 16 * h;
    const bf16x8 qdummy[8] = {};
    f32x4 R[16];
    const int jk0 = F.tid, jk1 = F.tid + NTHR;
#define LAT_PREFETCH(cn) do { \
        if ((cn) < 4) { \
            _Pragma("unroll") for (int q = 0; q < 2; ++q) { const int job = q ? jk1 : jk0; const int key = job >> 3, half = (job >> 2) & 1, sp = job & 3; \
                const int kr = r_start + 2 * (cn) + (key >> 6), kc = key & 63, pos = half ? kc : kr; \
                const bf16* src = Z + (size_t)(NCTX + b * 1024 + kr * 64 + kc) * INW + 3072 + hd * 128 + 64 * half + 8 * sp; \
                const float* rt = ROPE + 2 * (pos * 32 + 8 * sp); \
                R[2 * q] = __builtin_bit_cast(f32x4, *(const v4u*)src); R[2 * q + 1] = __builtin_bit_cast(f32x4, *(const v4u*)(src + 32)); \
                _Pragma("unroll") for (int j4 = 0; j4 < 4; ++j4) R[8 + 4 * q + j4] = *(const f32x4*)(rt + 4 * j4); } \
            _Pragma("unroll") for (int q = 0; q < 4; ++q) { const int pc = F.tid + q * NTHR; const int key = pc >> 4, c16 = pc & 15; const int kr = r_start + 2 * (cn) + (key >> 6), kc = key & 63; \
                R[4 + q] = __builtin_bit_cast(f32x4, *(const v4u*)(Z + (size_t)(NCTX + b * 1024 + kr * 64 + kc) * INW + 4096 + hd * 128 + 8 * c16)); } \
        } else { \
            _Pragma("unroll") for (int q = 0; q < 4; ++q) { const int pc = F.tid + q * NTHR; const int key = pc >> 4, c16 = pc & 15; \
                const size_t off = ((size_t)(b * 4 + l) * 512 + 128 * ((cn) - 4) + key) * 1024 + hd * 128 + 8 * c16; \
                R[4 * q] = *(const f32x4*)(a.cache_k + off); R[4 * q + 1] = *(const f32x4*)(a.cache_k + off + 4); R[4 * q + 2] = *(const f32x4*)(a.cache_v + off); R[4 * q + 3] = *(const f32x4*)(a.cache_v + off + 4); } \
        } } while (0)
#pragma unroll 1
    for (int chn = 0; chn < 8; ++chn) {
        LAT_PREFETCH(chn);
        __syncthreads();
        if (chn < 4) {
#pragma unroll
            for (int q = 0; q < 2; ++q) { const int job = q ? jk1 : jk0; const int key = job >> 3, half = (job >> 2) & 1, sp = job & 3;
                float x[8], y[8], lo[8], hi[8]; unpack8(__builtin_bit_cast(v4u, R[2 * q]), x); unpack8(__builtin_bit_cast(v4u, R[2 * q + 1]), y);
#pragma unroll
                for (int j4 = 0; j4 < 4; ++j4) { const f32x4 cssn = R[8 + 4 * q + j4];
                    lo[2 * j4] = x[2 * j4] * cssn.x - y[2 * j4] * cssn.y; hi[2 * j4] = y[2 * j4] * cssn.x + x[2 * j4] * cssn.y;
                    lo[2 * j4 + 1] = x[2 * j4 + 1] * cssn.z - y[2 * j4 + 1] * cssn.w; hi[2 * j4 + 1] = y[2 * j4 + 1] * cssn.z + x[2 * j4 + 1] * cssn.w; }
                LAS unsigned char* d = F.lds + LK_OFF + key * KP + 2 * (64 * half + 8 * sp);
                *(LAS v4u*)d = pack8(lo); *(LAS v4u*)(d + 64) = pack8(hi); }
#pragma unroll
            for (int q = 0; q < 4; ++q) { const int pc = F.tid + q * NTHR; const int key = pc >> 4, c16 = pc & 15;
                *(LAS v4u*)(F.lds + LV_OFF + key * VP + 16 * c16) = __builtin_bit_cast(v4u, R[4 + q]); }
        } else {
#pragma unroll
            for (int q = 0; q < 4; ++q) { const int pc = F.tid + q * NTHR; const int key = pc >> 4, c16 = pc & 15;
                const f32x4 k0 = R[4 * q], k1 = R[4 * q + 1], v0 = R[4 * q + 2], v1 = R[4 * q + 3];
                v4u kw, vw; kw.x = cvtpk(k0.x, k0.y); kw.y = cvtpk(k0.z, k0.w); kw.z = cvtpk(k1.x, k1.y); kw.w = cvtpk(k1.z, k1.w);
                vw.x = cvtpk(v0.x, v0.y); vw.y = cvtpk(v0.z, v0.w); vw.z = cvtpk(v1.x, v1.y); vw.w = cvtpk(v1.z, v1.w);
                *(LAS v4u*)(F.lds + LK_OFF + key * KP + 16 * c16) = kw; *(LAS v4u*)(F.lds + LV_OFF + key * VP + 16 * c16) = vw; }
        }
        __syncthreads();
        if (chn < 4) {
            const int kr = r_start + 2 * chn + (kt >> 1), dr = kr - gr + 7;
            attn_tile<1, true>(W, qdummy, Ql, Kl, Vl, 32 * kt, F.lane, rp + dr * 31, 32 * (kt & 1), qc);
        } else {
            attn_tile<0, true>(W, qdummy, Ql, Kl, Vl, 32 * kt, F.lane, nullptr, 0, 0);
        }
    }
#undef LAT_PREFETCH
    __syncthreads();
    LAS float* ML = (LAS float*)F.lds; LAS float* OB = (LAS float*)(F.lds + 4096);
    ML[(F.wave * 2 + 0) * 64 + F.lane] = W.m; ML[(F.wave * 2 + 1) * 64 + F.lane] = W.l;
#pragma unroll
    for (int dt = 0; dt < 4; ++dt)
#pragma unroll
        for (int i = 0; i < 16; ++i) OB[(F.wave * 64 + dt * 16 + i) * 64 + F.lane] = W.O[dt][i];
    __syncthreads();
    {
        float mi[4], li[4], mt = -1.0e30f;
#pragma unroll
        for (int k = 0; k < 4; ++k) { const int w2 = 2 * k + qh; mi[k] = ML[(w2 * 2 + 0) * 64 + F.lane]; li[k] = ML[(w2 * 2 + 1) * 64 + F.lane]; mt = fmaxf(mt, mi[k]); }
        float wk[4], lt = 0.f;
#pragma unroll
        for (int k = 0; k < 4; ++k) { wk[k] = __expf(mi[k] - mt); lt += wk[k] * li[k]; }
        const float inv = 1.0f / lt;
#pragma unroll
        for (int k = 0; k < 4; ++k) wk[k] *= inv;
        bf16* yrow = Y + (size_t)mq * YW + 1024 + hd * 128 + 32 * kt + 4 * h;
#pragma unroll
        for (int g4 = 0; g4 < 4; ++g4) {
            float o[4];
#pragma unroll
            for (int i = 0; i < 4; ++i) { float sacc = 0.f;
#pragma unroll
                for (int k = 0; k < 4; ++k) sacc += wk[k] * OB[((2 * k + qh) * 64 + kt * 16 + 4 * g4 + i) * 64 + F.lane];
                o[i] = sacc; }
            v2u w; w.x = cvtpk(o[0], o[1]); w.y = cvtpk(o[2], o[3]);
            *(v2u*)(yrow + 8 * g4) = w;
            asm volatile("" ::: "memory");
        }
    }
    __syncthreads();
}

constexpr int AW_OFF = 0, AV_OFF = 128 * KP, AST_OFF = AV_OFF + 128 * VP;
__device__ __forceinline__ void unitA(const Args& a, const Ctx& F, int l, int unit) {
    const int ch = unit >> 3, g = unit & 7, m0 = ch * 128;
    const bf16* Z = (const bf16*)(a.ws + WS_Z); bf16* Y = (bf16*)(a.ws + WS_Y);
    LAS float* st = (LAS float*)(F.lds + AST_OFF);
    __syncthreads();
    if (F.tid < 128) {
        const float* ap = (const float*)(a.ws + WS_AST) + (size_t)(m0 + F.tid) * 32;
        float sm = 0.f, sq = 0.f;
#pragma unroll
        for (int q = 0; q < 8; ++q) { const f32x4 v = *(const f32x4*)(ap + 4 * q); sm += v.x + v.z; sq += v.y + v.w; }
        const float mean = sm * (1.0f / 1024.0f), var = fmaxf(sq * (1.0f / 1024.0f) - mean * mean, 0.f);
        st[F.tid] = mean; st[128 + F.tid] = 1.0f / sqrtf(var + EPS);
    }
    {
        const int t = F.tid >> 2, s0 = 32 * (F.tid & 3);
        const float* wp = a.a_w + ((size_t)(l * 8 + g) * 128 + t) * 128 + s0;
#pragma unroll
        for (int q = 0; q < 4; ++q) { const f32x4 w0 = *(const f32x4*)(wp + 8 * q), w1 = *(const f32x4*)(wp + 8 * q + 4);
            v4u o; o.x = cvtpk(w0.x, w0.y); o.y = cvtpk(w0.z, w0.w); o.z = cvtpk(w1.x, w1.y); o.w = cvtpk(w1.z, w1.w);
            *(LAS v4u*)(F.lds + AW_OFF + t * KP + 2 * (s0 + 8 * q)) = o; }
    }
    __syncthreads();
    {
        const int s = F.tid >> 2, c0 = 32 * (F.tid & 3);
        const float mean = st[s], rstd = st[128 + s];
        const bf16* rp = Z + (size_t)(m0 + s) * INW + 1024 + 128 * g + c0;
#pragma unroll
        for (int q = 0; q < 4; ++q) { float x[8]; unpack8(*(const v4u*)(rp + 8 * q), x);
#pragma unroll
            for (int j = 0; j < 8; ++j) x[j] = (x[j] - mean) * rstd;
            *(LAS v4u*)(F.lds + AV_OFF + s * VP + 2 * (c0 + 8 * q)) = pack8(x); }
    }
    __syncthreads();
    const int lane = F.lane, r = lane & 31, h = lane >> 5, gq = (lane >> 4) & 1, q4 = (lane & 15) >> 2, p4 = lane & 3;
    const int ttile = F.wave & 3, ct0 = 2 * (F.wave >> 2);
    f32x16 acc[2];
#pragma unroll
    for (int c2 = 0; c2 < 2; ++c2)
#pragma unroll
        for (int i = 0; i < 16; ++i) acc[c2][i] = 0.f;
    {
        const LAS unsigned char* wp = F.lds + AW_OFF + (32 * ttile + r) * KP + 16 * h;
        const LAS unsigned char* vp = F.lds + AV_OFF + (8 * h + q4) * VP + 2 * (32 * ct0 + 16 * gq) + 8 * p4;
#pragma unroll
        for (int ks = 0; ks < 8; ++ks) {
            const bf16x8 wb = *(const LAS bf16x8*)(wp + 32 * ks);
#pragma unroll
            for (int c2 = 0; c2 < 2; ++c2) {
                const LAS unsigned char* v0 = vp + 16 * ks * VP + 64 * c2;
                acc[c2] = MFMA32(tr_pair(v0, v0 + 4 * VP), wb, acc[c2]);
            }
        }
    }
    {
        const int t = 32 * ttile + r; const float bsv = a.a_b[(l * 8 + g) * 128 + t];
        const bf16* up = Z + (size_t)(m0 + t) * INW + 128 * g + 4 * h; bf16* yp = Y + (size_t)(m0 + t) * YW + 128 * g + 4 * h;
#pragma unroll
        for (int c2 = 0; c2 < 2; ++c2)
#pragma unroll
            for (int g4 = 0; g4 < 4; ++g4) {
                const int c = 32 * (ct0 + c2) + 8 * g4;
                const v2u uw = *(const v2u*)(up + c);
                v2u o; o.x = cvtpk(bf2f_lo(uw.x) * (acc[c2][4 * g4] + bsv), bf2f_hi(uw.x) * (acc[c2][4 * g4 + 1] + bsv));
                o.y = cvtpk(bf2f_lo(uw.y) * (acc[c2][4 * g4 + 2] + bsv), bf2f_hi(uw.y) * (acc[c2][4 * g4 + 3] + bsv));
                *(v2u*)(yp + c) = o;
            }
    }
    __syncthreads();
}

constexpr int HP = 272;
constexpr int HG_QD = 0, HG_KD = 32 * HP, HG_KL = 2 * 32 * HP, HG_V = 3 * 32 * HP, HG_G = 4 * 32 * HP, HG_BUF = HG_G + 512, HG_DIR = 2 * HG_BUF;
struct HgPre { v4u q[2], v[2]; f32x4 f[4]; };
__device__ __forceinline__ void hg_load(HgPre& P, const bf16* Z, const float* LOGF, size_t m, int dir, int hd, int d0) {
    const bf16* zr = Z + m * INW + hd * 128 + d0; const float* fr = LOGF + m * 2048 + dir * 1024 + hd * 128 + d0;
    P.q[0] = *(const v4u*)(zr + 5120); P.q[1] = *(const v4u*)(zr + 5128); P.v[0] = *(const v4u*)(zr + 8192); P.v[1] = *(const v4u*)(zr + 8200);
#pragma unroll
    for (int j = 0; j < 4; ++j) P.f[j] = *(const f32x4*)(fr + 4 * j);
}
template <int CTRL, int ROWMASK> __device__ __forceinline__ float dpp_add(float x) {
    return x + __int_as_float(__builtin_amdgcn_update_dpp(0, __float_as_int(x), CTRL, ROWMASK, 0xF, true)); }
__device__ __forceinline__ float scan32(float x) {
    x = dpp_add<0x111, 0xF>(x); x = dpp_add<0x112, 0xF>(x); x = dpp_add<0x114, 0xF>(x); x = dpp_add<0x118, 0xF>(x); x = dpp_add<0x142, 0xA>(x); return x; }
__device__ __forceinline__ void hg_estep(const HgPre& P, LAS unsigned char* buf, int lane_, int w4) {
    int lane = lane_; asm volatile("" : "+v"(lane));
    const int tt = lane & 31, hf = lane >> 5, d0 = 32 * w4 + 16 * hf;
    float bl[16];
#pragma unroll
    for (int j = 0; j < 16; ++j) bl[j] = scan32(P.f[j >> 2][j & 3]);
    LAS unsigned char* row = buf + tt * HP + 2 * d0;
#pragma unroll
    for (int hh = 0; hh < 2; ++hh) {
        float qd[8], kd[8], kl[8];
        float q[8]; unpack8(P.q[hh], q);
#pragma unroll
        for (int j = 0; j < 8; ++j) { const int jj = 8 * hh + j; const float bC0 = __int_as_float(__builtin_amdgcn_readlane(__float_as_int(bl[jj]), 31)), bC1 = __int_as_float(__builtin_amdgcn_readlane(__float_as_int(bl[jj]), 63)); const float bC = hf ? bC1 : bC0; const float k = 1.0f - __builtin_amdgcn_exp2f(P.f[jj >> 2][jj & 3]);
            qd[j] = q[j] * __builtin_amdgcn_exp2f(bl[jj]); kd[j] = k * __builtin_amdgcn_exp2f(fminf(-bl[jj], 115.0f)); kl[j] = k * __builtin_amdgcn_exp2f(bC - bl[jj]); }
        *(LAS v4u*)(row + HG_QD + 16 * hh) = pack8(qd); *(LAS v4u*)(row + HG_KD + 16 * hh) = pack8(kd); *(LAS v4u*)(row + HG_KL + 16 * hh) = pack8(kl);
        asm volatile("" ::: "memory");
    }
    *(LAS v4u*)(row + HG_V) = P.v[0]; *(LAS v4u*)(row + HG_V + 16) = P.v[1];
    if (tt == 31) {
#pragma unroll
        for (int j4 = 0; j4 < 4; ++j4) *(LAS f32x4*)(buf + HG_G + 4 * (d0 + 4 * j4)) = (f32x4){__builtin_amdgcn_exp2f(bl[4 * j4]), __builtin_amdgcn_exp2f(bl[4 * j4 + 1]), __builtin_amdgcn_exp2f(bl[4 * j4 + 2]), __builtin_amdgcn_exp2f(bl[4 * j4 + 3])};
    }
}
__device__ __forceinline__ void hg_mstep(f32x16 (&S)[4], const LAS unsigned char* buf, int lane_, int w4, bf16* Og, int c, int n, int dir, int mbase, int hd) {
    int lane = lane_; asm volatile("" : "+v"(lane));
    const int r = lane & 31, h = lane >> 5, g = (lane >> 4) & 1, q4 = (lane & 15) >> 2, p4 = lane & 3;
    f32x16 X0;
#pragma unroll
    for (int i = 0; i < 16; ++i) X0[i] = 0.f;
    {   const LAS unsigned char* kp = buf + HG_KD + r * HP + 16 * h; const LAS unsigned char* qp = buf + HG_QD + r * HP + 16 * h;
#pragma unroll
        for (int ks = 0; ks < 8; ++ks) X0 = MFMA32(*(const LAS bf16x8*)(kp + 32 * ks), *(const LAS bf16x8*)(qp + 32 * ks), X0); }
    f32x16 O0;
#pragma unroll
    for (int i = 0; i < 16; ++i) O0[i] = 0.f;
    {
        const LAS unsigned char* qp = buf + HG_QD + r * HP + 8 * h;
#pragma unroll
        for (int dt = 0; dt < 4; ++dt)
#pragma unroll
            for (int st = 0; st < 2; ++st) {
                const s16x4 lo = *(const LAS s16x4*)(qp + 2 * (32 * dt + 16 * st)), hi = *(const LAS s16x4*)(qp + 2 * (32 * dt + 16 * st + 8));
                O0 = MFMA32(__builtin_shufflevector(lo, hi, 0, 1, 2, 3, 4, 5, 6, 7), pack_regs(S[dt], st), O0);
            }
    }
#pragma unroll
    for (int i = 0; i < 16; ++i) { const int srow = (i & 3) + 8 * (i >> 2) + 4 * h; X0[i] = (srow <= r) ? X0[i] : 0.f; }
    {
        const LAS unsigned char* vp = buf + HG_V + (4 * h + q4) * HP + 2 * (32 * w4 + 16 * g) + 8 * p4;
        O0 = MFMA32(pack_regs(X0, 0), tr_pair(vp, vp + 8 * HP), O0);
        O0 = MFMA32(pack_regs(X0, 1), tr_pair(vp + 16 * HP, vp + 24 * HP), O0);
    }
    asm volatile("" ::: "memory");
    {
        const LAS float* G = (const LAS float*)(buf + HG_G);
        const LAS unsigned char* vp = buf + HG_V + (8 * h + q4) * HP + 2 * (32 * w4 + 16 * g) + 8 * p4;
        const bf16x8 vb0 = tr_pair(vp, vp + 4 * HP), vb1 = tr_pair(vp + 16 * HP, vp + 20 * HP);
#pragma unroll
        for (int dt = 0; dt < 4; ++dt) {
#pragma unroll
            for (int g4 = 0; g4 < 4; ++g4) { const f32x4 gv = *(const LAS f32x4*)(G + 32 * dt + 8 * g4 + 4 * h);
#pragma unroll
                for (int jj = 0; jj < 4; ++jj) S[dt][4 * g4 + jj] *= gv[jj]; }
            const LAS unsigned char* kp = buf + HG_KL + (8 * h + q4) * HP + 2 * (32 * dt + 16 * g) + 8 * p4;
            S[dt] = MFMA32(tr_pair(kp, kp + 4 * HP), vb0, S[dt]);
            S[dt] = MFMA32(tr_pair(kp + 16 * HP, kp + 20 * HP), vb1, S[dt]);
                }
    }
    {
        const int tb = 32 * c + 4 * h; const int p0 = dir ? (n - 1 - tb) : tb, stp = dir ? -1024 : 1024;
        bf16* ob = Og + (size_t)mbase * 1024 + hd * 128 + 32 * w4;
        const int o0 = p0 * 1024 + r;
#pragma unroll
        for (int i = 0; i < 16; ++i) ob[o0 + ((i & 3) + 8 * (i >> 2)) * stp] = (bf16)(cvtpk(O0[i], 0.f) & 0xffffu);
    }
}
__device__ __forceinline__ void unitHgrn(const Args& a, const Ctx& F, int l, bool lat, int b, int hd) {
    const bf16* Z = (const bf16*)(a.ws + WS_Z); const float* LOGF = (const float*)(a.ws + WS_LOGF); bf16* Y = (bf16*)(a.ws + WS_Y);
    const int w4 = F.wave >> 1, lane = F.lane;
    LAS unsigned char* base = F.lds;
    const int n = lat ? 1024 : 256, mbase = lat ? NCTX + b * 1024 : b * 256, nch = n >> 5, ng = 2 * nch;
    __syncthreads();
    if ((F.wave & 1) == 0) {
        const int tt = lane & 31, d0 = 32 * w4 + 16 * (lane >> 5);
        HgPre P;
        hg_load(P, Z, LOGF, (size_t)(mbase + tt), 0, hd, d0);
        hg_estep(P, base, lane, w4);
        {   const int g1 = 1, dir1 = (g1 >= nch), c1 = g1 - dir1 * nch, p1 = 32 * c1 + tt; hg_load(P, Z, LOGF, (size_t)(mbase + (dir1 ? (n - 1 - p1) : p1)), dir1, hd, d0); }
        asm volatile("s_waitcnt lgkmcnt(0)" ::: "memory"); __builtin_amdgcn_s_barrier(); asm volatile("" ::: "memory");
#pragma unroll 1
        for (int g = 0; g < ng; ++g) {
            if (g + 1 < ng) {
                hg_estep(P, base + ((g + 1) & 1) * HG_BUF, lane, w4);
                if (g + 2 < ng) { const int g2 = g + 2, dir2 = (g2 >= nch), c2 = g2 - dir2 * nch, p2 = 32 * c2 + tt; hg_load(P, Z, LOGF, (size_t)(mbase + (dir2 ? (n - 1 - p2) : p2)), dir2, hd, d0); }
            }
            asm volatile("s_waitcnt lgkmcnt(0)" ::: "memory"); __builtin_amdgcn_s_barrier(); asm volatile("" ::: "memory");
        }
    } else {
        const int r = lane & 31, h = lane >> 5, h512 = 512 * h;
        f32x16 S[4];
        if (lat) {
            const float* sp = a.state + ((((size_t)b * 4 + l) * 2 + 0) * 8 + hd) * 16384 + 32 * w4 + r;
#pragma unroll
            for (int dt = 0; dt < 4; ++dt)
#pragma unroll
                for (int i = 0; i < 16; ++i) S[dt][i] = sp[(32 * dt + (i & 3) + 8 * (i >> 2)) * 128 + h512];
        } else {
#pragma unroll
            for (int dt = 0; dt < 4; ++dt)
#pragma unroll
                for (int i = 0; i < 16; ++i) S[dt][i] = 0.f;
        }
        asm volatile("s_waitcnt lgkmcnt(0)" ::: "memory"); __builtin_amdgcn_s_barrier(); asm volatile("" ::: "memory");
#pragma unroll 1
        for (int g = 0; g < ng; ++g) {
            const int dir = (g >= nch), c = g - dir * nch;
            if (g == nch) {
                if (!lat) {
                    float* so = a.out + OUT_S + ((((size_t)b * 4 + l) * 2 + 0) * 8 + hd) * 16384 + 32 * w4 + r;
#pragma unroll
                    for (int dt = 0; dt < 4; ++dt)
#pragma unroll
                        for (int i = 0; i < 16; ++i) { so[(32 * dt + (i & 3) + 8 * (i >> 2)) * 128 + h512] = S[dt][i]; S[dt][i] = 0.f; }
                } else {
                    const float* sp = a.state + ((((size_t)b * 4 + l) * 2 + 1) * 8 + hd) * 16384 + 32 * w4 + r;
#pragma unroll
                    for (int dt = 0; dt < 4; ++dt)
#pragma unroll
                        for (int i = 0; i < 16; ++i) S[dt][i] = sp[(32 * dt + (i & 3) + 8 * (i >> 2)) * 128 + h512];
                }
            }
            hg_mstep(S, base + (g & 1) * HG_BUF, lane, w4, (bf16*)(a.ws + (dir ? WS_OB : WS_OF)), c, n, dir, mbase, hd);
            asm volatile("s_waitcnt lgkmcnt(0)" ::: "memory"); __builtin_amdgcn_s_barrier(); asm volatile("" ::: "memory");
        }
        if (!lat) {
            float* so = a.out + OUT_S + ((((size_t)b * 4 + l) * 2 + 1) * 8 + hd) * 16384 + 32 * w4 + r;
#pragma unroll
            for (int dt = 0; dt < 4; ++dt)
#pragma unroll
                for (int i = 0; i < 16; ++i) so[(32 * dt + (i & 3) + 8 * (i >> 2)) * 128 + h512] = S[dt][i];
        }
    }
    __syncthreads();
    {
        const bf16* OFp = (const bf16*)(a.ws + WS_OF); const bf16* OBp = (const bf16*)(a.ws + WS_OB);
        const int e16 = 16 * (F.tid & 7);
        for (int t0 = 0; t0 < n; t0 += 64) {
            const size_t m = (size_t)(mbase + t0 + (F.tid >> 3));
            float o[16]; float ss = 0.f;
#pragma unroll
            for (int j = 0; j < 2; ++j) { float pf[8], pb[8]; unpack8(*((const v4u*)(OFp + m * 1024 + hd * 128 + e16) + j), pf); unpack8(*((const v4u*)(OBp + m * 1024 + hd * 128 + e16) + j), pb);
#pragma unroll
                for (int q = 0; q < 8; ++q) { const float sv = pf[q] + pb[q]; o[8 * j + q] = sv; ss += sv * sv; } }
            ss += __shfl_xor(ss, 1); ss += __shfl_xor(ss, 2); ss += __shfl_xor(ss, 4);
            const float rn = 1.0f / sqrtf(ss * (1.0f / 128.0f) + EPS);
            float g0[8], g1[8];
            unpack8(*(const v4u*)(Z + m * INW + 9216 + hd * 128 + e16), g0); unpack8(*(const v4u*)(Z + m * INW + 9216 + hd * 128 + e16 + 8), g1);
            float y0[8], y1[8];
#pragma unroll
            for (int j = 0; j < 8; ++j) { y0[j] = o[j] * rn * g0[j]; y1[j] = o[8 + j] * rn * g1[j]; }
            *(v4u*)(Y + m * YW + 2048 + hd * 128 + e16) = pack8(y0); *(v4u*)(Y + m * YW + 2048 + hd * 128 + e16 + 8) = pack8(y1);
        }
    }
    __syncthreads();
}

__device__ __forceinline__ const Args* args_ptr() { unsigned long long p = (unsigned long long)__builtin_amdgcn_kernarg_segment_ptr(); asm volatile("" : "+s"(p)); return (const Args*)(const void __attribute__((address_space(4)))*)p; }
__device__ __forceinline__ Ctx make_ctx() {
    Ctx F; int t = threadIdx.x; asm volatile("" : "+v"(t));
    unsigned z = 0; asm volatile("" : "+s"(z));
    F.lds = (LAS unsigned char*)(uintptr_t)z;
    F.tid = t; F.lane = t & 63; F.wave = __builtin_amdgcn_readfirstlane(t >> 6);
    F.G = gridDim.x; { const int bx = blockIdx.x; F.vcu = (F.G % 8 == 0) ? (bx % 8) * (F.G / 8) + bx / 8 : bx; }
    return F;
}
constexpr int NU_CV = 800, NU_HL = 16, NU_AL = 256, NU_HC = 256, NU_AC = 256, NU_A = 640, NU_M1 = NU_HL + NU_AL + NU_HC + NU_AC + NU_A;
#ifndef PROBE_UT
#define PROBE_UT (-1)
#endif
__device__ __forceinline__ void phase_mixers(int l, int qslot) {
    for (;;) {
        int u;
        {   const Args& a = *args_ptr(); const Ctx F = make_ctx();
            unsigned* head = (unsigned*)(a.ws + WS_CTL) + CW_Q + 64 * qslot;
            volatile LAS unsigned* bc = (volatile LAS unsigned*)(F.lds + LDSCTL_OFF) + 4;
            __syncthreads();
            if (F.tid == 0) bc[0] = __hip_atomic_fetch_add(head, 1u, __ATOMIC_RELAXED, __HIP_MEMORY_SCOPE_AGENT);
            __syncthreads();
            u = (int)bc[0]; }
        u = __builtin_amdgcn_readfirstlane(u);
        if (u < NU_HL) { for (int rr = 0; rr < (PROBE_UT == 0 ? 2 : 1); ++rr) { const Args& a = *args_ptr(); const Ctx F = make_ctx(); unitHgrn(a, F, l, true, u >> 3, u & 7); } continue; }
        u -= NU_HL;
        if (l < DEPTH - 1) {
            if (u >= 3 * NU_CV) break;
            const int trip = u / 3, pos = u - 3 * trip;
            if (pos == 2) {
                const Args& a = *args_ptr(); const Ctx F = make_ctx();
                LAS float* scr = (LAS float*)(F.lds + F.wave * 16640);
                cvt_three(a, l + 1, trip * 24 + F.wave, 8, scr, F.lane);
                continue;
            }
            u = 2 * trip + pos;
            if (u >= NU_M1 - NU_HL) continue;
        } else if (u >= NU_M1 - NU_HL) break;
        if (u < NU_HC) { for (int rr = 0; rr < (PROBE_UT == 2 ? 2 : 1); ++rr) { const Args& a = *args_ptr(); const Ctx F = make_ctx(); unitHgrn(a, F, l, false, u >> 3, u & 7); } continue; }
        u -= NU_HC;
        if (u < NU_AL) { for (int rr = 0; rr < (PROBE_UT == 1 ? 2 : 1); ++rr) { const Args& a = *args_ptr(); const Ctx F = make_ctx(); unitAttnLat(a, F, l, u); } continue; }
        u -= NU_AL;
        if (u < NU_AC) { for (int rr = 0; rr < (PROBE_UT == 3 ? 2 : 1); ++rr) { const Args& a = *args_ptr(); const Ctx F = make_ctx(); unitAttnCtx(a, F, u); } continue; }
        u -= NU_AC;
        for (int rr = 0; rr < (PROBE_UT == 4 ? 2 : 1); ++rr) { const Args& a = *args_ptr(); const Ctx F = make_ctx(); unitA(a, F, l, u); }
    }
}

__global__ void __launch_bounds__(NTHR, 2) fwd(Args a_in) {
    extern __shared__ __attribute__((aligned(16))) unsigned char lds_raw[];
    volatile LAS unsigned* MISC = (volatile LAS unsigned*)((LAS unsigned char*)lds_raw + LDSCTL_OFF);
    for (int u = threadIdx.x; u < 256; u += NTHR) MISC[u] = 0u;
    __syncthreads();
    const int lo = a_in.ph_lo, hi = a_in.ph_hi;
    const bool multi = (hi - lo) > 1;
    XcdBarrier bar; bar.bar = (unsigned*)(a_in.ws + WS_CTL) + CW_BAR; bar.x = 0; bar.st = MISC;
    if (multi) bar = xcd_barrier_post((unsigned*)(a_in.ws + WS_CTL) + CW_BAR, MISC);
#ifndef PMASK
#define PMASK 0xFFFFFFFFu
#endif
#define PM(b) ((PMASK >> (b)) & 1u)
#define IN(k) (lo <= (k) && (k) < hi)
#define SEAM(k) do { if (IN(k) && IN((k) + 1)) xcd_barrier(bar); } while (0)
#ifndef PROBE_P
#define PROBE_P (-1)
#define PROBE_N 0
#define PROBE_L 1
#endif
#define REP_BEGIN(k) for (int rep = 0; rep < ((PROBE_P == (k) && l == PROBE_L) ? 1 + PROBE_N : 1); ++rep) {
#define REP_END(k) if (PROBE_P == (k) && l == PROBE_L && rep < PROBE_N) xcd_barrier(bar); }

    if (PM(0) && IN(PH_PRO)) { const int l = PROBE_L; REP_BEGIN(0) const Args& a = *args_ptr(); const Ctx F = make_ctx(); phase_prologue(a, F); REP_END(0) SEAM(PH_PRO); }
    if (PM(1) && IN(PH_T1)) { const int l = PROBE_L; REP_BEGIN(1) const Args& a = *args_ptr(); const Ctx F = make_ctx(); const float* MOD = (const float*)(a.ws + WS_MOD);
        rownorm_phase(a, F, true, nullptr, nullptr, nullptr, true, a.norm_g + 0, MOD + 1 * 2048, MOD + 0 * 2048); REP_END(1) SEAM(PH_T1); }

    for (int l = 0; l < DEPTH; ++l) {
        const int pb = PH_L0 + l * PH_PER_LAYER;
        if (PM(2) && IN(pb + 0)) { REP_BEGIN(2)
            const Args& a = *args_ptr(); const Ctx F = make_ctx(); unsigned char* ws = a.ws; const bf16* wl = (const bf16*)(ws + WS_WT) + (size_t)l * WL_ELEMS;
            pg8::Gemm g{(const bf16*)(ws + WS_H), wl + OFF_IN, MTOK, INW, DM, DM, DM, 0}; pg8::StaticOrder S; S.init(MTOK, INW, F.G, (int)blockIdx.x);
            EpiIn E{(bf16*)(ws + WS_Z), (float*)(ws + WS_LOGF), (const float*)(ws + WS_LB) + l * 1024, a.out + OUT_K + (size_t)l * 262144, a.out + OUT_V + (size_t)l * 262144, (float*)(ws + WS_AST)};
            pg8::gemm_phase<EpiIn, pg8::StaticOrder, true, true>(F.lds, g, S, E);
            REP_END(2) SEAM(pb + 0);
        }
        if (PM(3) && IN(pb + 1)) { REP_BEGIN(3) phase_mixers(l, l + 4 * rep); REP_END(3) SEAM(pb + 1); }
        if (PM(5) && IN(pb + 3)) { REP_BEGIN(5)
            const Args& a = *args_ptr(); const Ctx F = make_ctx(); unsigned char* ws = a.ws; const bf16* wl = (const bf16*)(ws + WS_WT) + (size_t)l * WL_ELEMS;
            pg8::StaticOrder S; S.init(MTOK, DM, F.G, (int)blockIdx.x);
            pg8::Gemm g{(const bf16*)(ws + WS_Y), wl + OFF_UP, MTOK, DM, YW, YW, YW, 0}; EpiUpK E{(const bf16*)(ws + WS_Z) + 10240, (bf16*)(ws + WS_MG)};
            pg8::gemm_phase<EpiUpK, pg8::StaticOrder, true, true>(F.lds, g, S, E);
            REP_END(5) SEAM(pb + 3);
        }
        if (PM(6) && IN(pb + 4)) { REP_BEGIN(6)
            {   const Args& a = *args_ptr(); const Ctx F = make_ctx(); unsigned char* ws = a.ws; const bf16* wl = (const bf16*)(ws + WS_WT) + (size_t)l * WL_ELEMS;
                pg8::Gemm g{(const bf16*)(ws + WS_MG), wl + OFF_OUT, NCTX, DM, DM, DM, DM, 0}; pg8::StaticOrder S; S.init(NCTX, DM, F.G, (int)blockIdx.x);
                EpiBf16P E{(bf16*)(ws + WS_T), DM, 0}; pg8::gemm_phase<EpiBf16P, pg8::StaticOrder, true, true>(F.lds, g, S, E); }
            {   const Args& a = *args_ptr(); const Ctx F = make_ctx(); unsigned char* ws = a.ws; const bf16* wl = (const bf16*)(ws + WS_WT) + (size_t)l * WL_ELEMS;
                pg8::Gemm g{(const bf16*)(ws + WS_MG) + (size_t)NCTX * DM, wl + OFF_OUT, NLAT, DM, DM / 4, DM, DM, (DM / 4) * 2}; pg8::SplitOrder S; S.init(F.G, (int)blockIdx.x);
                EpiBf16P E{(bf16*)(ws + WS_TP), DM, TPQ}; pg8::gemm_phase<EpiBf16P, pg8::SplitOrder, true, true>(F.lds, g, S, E); }
            REP_END(6) SEAM(pb + 4);
        }
        if (PM(7) && IN(pb + 5)) { REP_BEGIN(7) const Args& a = *args_ptr(); const Ctx F = make_ctx(); const float* modl = (const float*)(a.ws + WS_MOD) + (size_t)l * 3 * 12288; const float* gl = a.norm_g + (size_t)l * 4 * DM;
            rownorm_phase(a, F, false, (const bf16*)(a.ws + WS_T), modl + 2 * 2048, gl + 1 * DM, true, gl + 2 * DM, modl + 4 * 2048, modl + 3 * 2048); REP_END(7) SEAM(pb + 5); }
        if (PM(8) && IN(pb + 6)) { REP_BEGIN(8)
            const Args& a = *args_ptr(); const Ctx F = make_ctx(); unsigned char* ws = a.ws; const bf16* wl = (const bf16*)(ws + WS_WT) + (size_t)l * WL_ELEMS;
            pg8::Gemm g{(const bf16*)(ws + WS_H), wl + OFF_FI, MTOK, NFI, DM, DM, DM, 0}; pg8::StaticOrder S; S.init(MTOK, NFI, F.G, (int)blockIdx.x);
            EpiSwi E{(bf16*)(ws + WS_ACT)}; pg8::gemm_phase<EpiSwi, pg8::StaticOrder, true, true>(F.lds, g, S, E);
            REP_END(8) SEAM(pb + 6);
        }
        if (PM(9) && IN(pb + 7)) { REP_BEGIN(9)
            {   const Args& a = *args_ptr(); const Ctx F = make_ctx(); unsigned char* ws = a.ws; const bf16* wl = (const bf16*)(ws + WS_WT) + (size_t)l * WL_ELEMS;
                pg8::Gemm g{(const bf16*)(ws + WS_ACT), wl + OFF_FO, NCTX, DM, DFF, DFF, DFF, 0}; pg8::StaticOrder S; S.init(NCTX, DM, F.G, (int)blockIdx.x);
                EpiBf16P E{(bf16*)(ws + WS_T), DM, 0}; pg8::gemm_phase<EpiBf16P, pg8::StaticOrder, true, true>(F.lds, g, S, E); }
            {   const Args& a = *args_ptr(); const Ctx F = make_ctx(); unsigned char* ws = a.ws; const bf16* wl = (const bf16*)(ws + WS_WT) + (size_t)l * WL_ELEMS;
                pg8::Gemm g{(const bf16*)(ws + WS_ACT) + (size_t)NCTX * DFF, wl + OFF_FO, NLAT, DM, DFF / 4, DFF, DFF, (DFF / 4) * 2}; pg8::SplitOrder S; S.init(F.G, (int)blockIdx.x);
                EpiBf16P E{(bf16*)(ws + WS_TP), DM, TPQ}; pg8::gemm_phase<EpiBf16P, pg8::SplitOrder, true, true>(F.lds, g, S, E); }
            REP_END(9) SEAM(pb + 7);
        }
        if (PM(10) && IN(pb + 8)) { REP_BEGIN(10)
            const Args& a = *args_ptr(); const Ctx F = make_ctx(); const float* MOD = (const float*)(a.ws + WS_MOD);
            const bool last = (l == DEPTH - 1); const int ln = last ? l : l + 1;
            const float* modl = MOD + (size_t)l * 3 * 12288; const float* gl = a.norm_g + (size_t)l * 4 * DM;
            const float* modn = MOD + (size_t)ln * 3 * 12288; const float* gnn = a.norm_g + (size_t)ln * 4 * DM;
            rownorm_phase(a, F, false, (const bf16*)(a.ws + WS_T), modl + 5 * 2048, gl + 3 * DM, !last, gnn + 0, modn + 1 * 2048, modn + 0 * 2048);
            REP_END(10) SEAM(pb + 8);
        }
    }
#undef IN
#undef SEAM
#undef REP_BEGIN
#undef REP_END
}

#ifndef MK_ONE_LAUNCH
#define MK_ONE_LAUNCH 1
#endif
extern "C" void kernel_launch(void* const* d_in, const int* in_sizes, int n_in, void* d_out, int out_size, void* d_ws, size_t ws_size, hipStream_t stream) {
    static int grid = 0;
    if (grid == 0) {
        if (n_in != 21 || (size_t)out_size != OUT_END || ws_size < WS_END) { fprintf(stderr, "kernel_launch: unexpected shapes: n_in %d out %d ws %zu\n", n_in, out_size, ws_size); grid = -1; return; }
        int dev = 0, cus = 0, per_cu = 0;
        if (hipGetDevice(&dev) != hipSuccess || hipDeviceGetAttribute(&cus, hipDeviceAttributeMultiprocessorCount, dev) != hipSuccess) { grid = -1; return; }
        if (hipFuncSetAttribute((const void*)fwd, hipFuncAttributeMaxDynamicSharedMemorySize, LDS_BYTES) != hipSuccess) { fprintf(stderr, "kernel_launch: hipFuncSetAttribute failed\n"); grid = -1; return; }
        if (hipOccupancyMaxActiveBlocksPerMultiprocessor(&per_cu, (const void*)fwd, NTHR, LDS_BYTES) != hipSuccess || per_cu < 1) fprintf(stderr, "kernel_launch: occupancy query says %d\n", per_cu);
        (void)hipGetLastError();
        grid = cus;
    }
    if (grid < 0) return;
    (void)hipMemsetAsync((char*)d_ws + WS_CTL, 0, CTL_ZERO_BYTES, stream);
    Args a{};
    const float** ap = (const float**)&a;
    for (int i = 0; i < 21; ++i) ap[i] = (const float*)d_in[i];
    a.out = (float*)d_out; a.ws = (unsigned char*)d_ws;
#if MK_ONE_LAUNCH
    a.ph_lo = 0; a.ph_hi = PH_END;
    hipLaunchKernelGGL(fwd, dim3(grid), dim3(NTHR), LDS_BYTES, stream, a);
#else
    for (int p = 0; p < PH_END; ++p) { a.ph_lo = p; a.ph_hi = p + 1; hipLaunchKernelGGL(fwd, dim3(grid), dim3(NTHR), LDS_BYTES, stream, a); }
#endif
}
```

```cpp
#include <hip/hip_runtime.h>
#include <cstdio>
#include <cstdint>
namespace pg8 {
#define PG8_LAS __attribute__((address_space(3)))
typedef unsigned short bf16_t;
typedef short bf16x8 __attribute__((ext_vector_type(8)));
typedef float f32x4 __attribute__((ext_vector_type(4)));
typedef unsigned u32x4 __attribute__((ext_vector_type(4)));
constexpr int BM = 256, BK = 64, HALF = 128, HTB = HALF * BK * 2  , STAGE_BYTES = 8 * HTB, NXCD = 8, WGM = 8;

__host__ __device__ __forceinline__ int lds_byte(int r, int c) { const int st = (r >> 4) * 2 + (c >> 5), rr = r & 15, cc = c & 31, ob = rr * 64 + cc * 2; return st * 1024 + (ob ^ (((ob >> 9) & 1) << 5)); }
__host__ __device__ __forceinline__ void stage_rc(int b, int& R, int& C) { const int st = b / 1024, sb = b % 1024, swz = sb ^ (((sb >> 9) & 1) << 5); R = (st >> 1) * 16 + swz / 64; C = (st & 1) * 32 + (swz % 64) / 2; }
__host__ __device__ __forceinline__ int perm32(int rho) { const int n = rho >> 4, i = rho & 15; return 8 * (i >> 2) + 4 * n + (i & 3); }

struct Unit { int pm, pn, kq; };
struct SplitOrder {
    int G, c;
    __host__ __device__ void init(int G_, int c_) { G = G_; c = c_; }
    __host__ __device__ bool next(int i, Unit& u) const { const long L = (long)i * G + c; if (L >= 256) return false; const int t = (int)L >> 2; u.kq = (int)L & 3; u.pm = t & 7; u.pn = t >> 3; return true; }
    __device__ __forceinline__ void a_ready(const Unit&) const {}
    __device__ __forceinline__ void done(const Unit&) const {}
};
struct Gemm { const bf16_t* A; const bf16_t* Bt; int M, N, K, lda, ldb, koff; };

struct StaticOrder {
    int nM, nN, nwg, G, c;
    __host__ __device__ void init(int M, int N, int G_, int c_) { nM = M / BM; nN = N / BM; nwg = nM * nN; G = G_; c = c_; }
    __host__ __device__ bool next(int i, Unit& u) const {
        const long L = (long)i * G + c; if (L >= nwg) return false;
        int wgid = (int)L; { const int q = nwg / NXCD, r = nwg % NXCD, xcd = wgid % NXCD, off = wgid / NXCD; wgid = (xcd < r ? xcd * (q + 1) : r * (q + 1) + (xcd - r) * q) + off; }
        const int nig = WGM * nN, gid = wgid / nig, fm = gid * WGM, gsz = (nM - fm) < WGM ? (nM - fm) : WGM;
        u.pm = fm + ((wgid % nig) % gsz); u.pn = (wgid % nig) / gsz; u.kq = 0; return true;
    }
    __device__ __forceinline__ void a_ready(const Unit&) const {}
    __device__ __forceinline__ void done(const Unit&) const {}
};
struct ReverseNOrder : StaticOrder {
    __host__ __device__ bool next(int i, Unit& u) const { if (!StaticOrder::next(i, u)) return false; u.pn = nN - 1 - u.pn; return true; }
};
template <class Epi, class Sched, bool ALIGN_EPI = false, bool SP2 = false>
__device__ __forceinline__ void gemm_phase(PG8_LAS unsigned char* lds, const Gemm g, const Sched& S, const Epi& E) {
    int tid_ = threadIdx.x; asm volatile("" : "+v"(tid_));
    const int tid = tid_, wid = __builtin_amdgcn_readfirstlane(tid >> 6), lane = tid & 63, wr = wid >> 2, wc = wid & 3, fr = lane & 15, fq = lane >> 4;
    const int K = g.K, nt = K / BK;
    unsigned voffA[2], voffB[2];
#pragma unroll
    for (int i = 0; i < 2; ++i) { int R, C; stage_rc(tid * 16 + i * 8192, R, C); const int Rb = Epi::PERM ? ((R & ~31) + perm32(R & 31)) : R;
        voffA[i] = (unsigned)(R * g.lda + C) * 2u; voffB[i] = (unsigned)(Rb * g.ldb + C) * 2u; }
    const size_t kstep = (size_t)(BK * 2);
    const size_t hstepA = (size_t)HALF * g.lda * 2, hstepB = (size_t)HALF * g.ldb * 2;
    const size_t tstepA = 2 * hstepA, tstepB = 2 * hstepB;
    const unsigned ldsw = (unsigned)wid * 1024u;
    const int aoff = lds_byte(wr * 64 + fr, fq * 8), boff = lds_byte(wc * 32 + fr, fq * 8);
#define PG8_SA(b, h) (((b) * 2 + (h)) * HTB)
#define PG8_SB(b, h) ((4 + (b) * 2 + (h)) * HTB)
#define PG8_STAGE(bufoff, gbase, voff) do { _Pragma("unroll") for (int _i = 0; _i < 2; ++_i) \
        __builtin_amdgcn_global_load_lds((const unsigned*)((const char*)(gbase) + (voff)[_i]), (PG8_LAS unsigned*)(lds + (bufoff) + ldsw + _i * 8192), 16, 0, 0); } while (0)
#define PG8_LDA(dst, b, h) do { _Pragma("unroll") for (int m = 0; m < 4; ++m) _Pragma("unroll") for (int k = 0; k < 2; ++k) dst[m][k] = *(const PG8_LAS bf16x8*)(lds + PG8_SA(b, h) + aoff + m * 2048 + k * 1024); } while (0)
#define PG8_LDB(dst, b, h) do { _Pragma("unroll") for (int n = 0; n < 2; ++n) _Pragma("unroll") for (int k = 0; k < 2; ++k) dst[n][k] = *(const PG8_LAS bf16x8*)(lds + PG8_SB(b, h) + boff + n * 2048 + k * 1024); } while (0)
#define PG8_MMA(ai, bj, At, Bt) do { __builtin_amdgcn_s_setprio(1); _Pragma("unroll") for (int m = 0; m < 4; ++m) _Pragma("unroll") for (int n = 0; n < 2; ++n) _Pragma("unroll") for (int k = 0; k < 2; ++k) \
        acc[ai][bj][m][n] = __builtin_amdgcn_mfma_f32_16x16x32_bf16(Bt[n][k], At[m][k], acc[ai][bj][m][n], 0, 0, 0); __builtin_amdgcn_s_setprio(0); } while (0)
#define PG8_WAIT_V(n) asm volatile("s_waitcnt vmcnt(" #n ")" ::: "memory")
#define PG8_WAIT_L(n) asm volatile("s_waitcnt lgkmcnt(" #n ")" ::: "memory")
#define PG8_BAR __builtin_amdgcn_s_barrier()
#define PG8_SCHED __builtin_amdgcn_sched_barrier(0)
    Unit cur, nxt; int ui = 0;
    if (!S.next(0, cur)) return;
    f32x4 acc[2][2][4][2];
#pragma unroll
    for (int a = 0; a < 2; ++a)
#pragma unroll
        for (int b = 0; b < 2; ++b)
#pragma unroll
            for (int m = 0; m < 4; ++m)
#pragma unroll
                for (int n = 0; n < 2; ++n) acc[a][b][m][n] = (f32x4){0.f, 0.f, 0.f, 0.f};
    bf16x8 At[4][2], B0[2][2], B1[2][2];
    const char* cA = (const char*)g.A + (size_t)cur.pm * tstepA + (size_t)cur.kq * g.koff; const char* cB = (const char*)g.Bt + (size_t)cur.pn * tstepB + (size_t)cur.kq * g.koff;
    S.a_ready(cur);
    if constexpr (SP2) {
        PG8_STAGE(PG8_SB(0, 0), cB, voffB); PG8_STAGE(PG8_SB(0, 1), cB + hstepB, voffB); PG8_STAGE(PG8_SA(0, 0), cA, voffA); PG8_STAGE(PG8_SA(0, 1), cA + hstepA, voffA);
        if (wr == 1) PG8_BAR;
        PG8_WAIT_V(2); PG8_BAR;
        PG8_STAGE(PG8_SB(1, 0), cB + kstep, voffB); PG8_STAGE(PG8_SA(1, 0), cA + kstep, voffA); PG8_STAGE(PG8_SB(1, 1), cB + hstepB + kstep, voffB);
        PG8_WAIT_V(6); PG8_BAR;
    } else {
        PG8_STAGE(PG8_SB(0, 0), cB, voffB); PG8_STAGE(PG8_SA(0, 0), cA, voffA); PG8_STAGE(PG8_SB(0, 1), cB + hstepB, voffB); PG8_STAGE(PG8_SA(0, 1), cA + hstepA, voffA);
        if (wr == 1) PG8_BAR;
        PG8_WAIT_V(4); PG8_BAR;
        PG8_STAGE(PG8_SB(1, 0), cB + kstep, voffB); PG8_STAGE(PG8_SA(1, 0), cA + kstep, voffA); PG8_STAGE(PG8_SB(1, 1), cB + hstepB + kstep, voffB);
        PG8_WAIT_V(6); PG8_BAR;
    }
    for (;;) {
        const bool has_next = S.next(ui + 1, nxt);
        const char* nA = has_next ? (const char*)g.A + (size_t)nxt.pm * tstepA + (size_t)nxt.kq * g.koff : cA; const char* nB = has_next ? (const char*)g.Bt + (size_t)nxt.pn * tstepB + (size_t)nxt.kq * g.koff : cB;
        for (int t = 0; t < nt; t += 2) {
            const bool last = (t == nt - 2);
            const char* a1 = cA + (size_t)(t + 1) * kstep;
            const char* a2 = last ? nA : cA + (size_t)(t + 2) * kstep; const char* b2 = last ? nB : cB + (size_t)(t + 2) * kstep;
            const char* a3 = a2 + kstep; const char* b3 = b2 + kstep;
            if (last && has_next) S.a_ready(nxt);
            if constexpr (Epi::HOOK) { if (t == Epi::H1 || t == Epi::H2) E.hook(acc, cur, t, wr, wc, fr, fq); }
            if constexpr (SP2) {
            PG8_LDB(B0, 0, 0); PG8_LDB(B1, 0, 1); PG8_SCHED; PG8_LDA(At, 0, 0); PG8_STAGE(PG8_SA(1, 1), a1 + hstepA, voffA);
            PG8_WAIT_V(8); PG8_WAIT_L(0); PG8_BAR; PG8_MMA(0, 0, At, B0); PG8_MMA(0, 1, At, B1); PG8_BAR; PG8_SCHED;
            PG8_LDA(At, 0, 1); PG8_STAGE(PG8_SB(0, 0), b2, voffB); PG8_STAGE(PG8_SB(0, 1), b2 + hstepB, voffB); PG8_STAGE(PG8_SA(0, 0), a2, voffA);
            PG8_WAIT_V(8); PG8_WAIT_L(0); PG8_BAR; PG8_MMA(1, 0, At, B0); PG8_MMA(1, 1, At, B1); PG8_BAR; PG8_SCHED;
            PG8_LDB(B0, 1, 0); PG8_LDB(B1, 1, 1); PG8_SCHED; PG8_LDA(At, 1, 0); PG8_STAGE(PG8_SA(0, 1), a2 + hstepA, voffA);
            PG8_WAIT_V(8); PG8_WAIT_L(0); PG8_BAR; PG8_MMA(0, 0, At, B0); PG8_MMA(0, 1, At, B1); PG8_BAR; PG8_SCHED;
            PG8_LDA(At, 1, 1); PG8_STAGE(PG8_SB(1, 0), b3, voffB); PG8_STAGE(PG8_SB(1, 1), b3 + hstepB, voffB); PG8_STAGE(PG8_SA(1, 0), a3, voffA);
            PG8_WAIT_V(8); PG8_WAIT_L(0); PG8_BAR; PG8_MMA(1, 0, At, B0); PG8_MMA(1, 1, At, B1); PG8_BAR; PG8_SCHED;
            } else {
            PG8_LDB(B0, 0, 0); PG8_SCHED; PG8_LDA(At, 0, 0); PG8_STAGE(PG8_SA(1, 1), a1 + hstepA, voffA);
            PG8_WAIT_L(8); PG8_BAR; PG8_WAIT_L(0); PG8_MMA(0, 0, At, B0); PG8_BAR; PG8_SCHED;
            PG8_LDB(B1, 0, 1); PG8_STAGE(PG8_SB(0, 0), b2, voffB);
            PG8_BAR; PG8_WAIT_L(0); PG8_MMA(0, 1, At, B1); PG8_BAR;
            PG8_LDA(At, 0, 1); PG8_STAGE(PG8_SA(0, 0), a2, voffA);
            PG8_BAR; PG8_WAIT_L(0); PG8_MMA(1, 0, At, B0); PG8_BAR; PG8_SCHED;
            PG8_STAGE(PG8_SB(0, 1), b2 + hstepB, voffB);
            PG8_WAIT_V(6); PG8_BAR; PG8_MMA(1, 1, At, B1); PG8_BAR;
            PG8_LDB(B0, 1, 0); PG8_SCHED; PG8_LDA(At, 1, 0); PG8_STAGE(PG8_SA(0, 1), a2 + hstepA, voffA);
            PG8_WAIT_L(8); PG8_BAR; PG8_WAIT_L(0); PG8_MMA(0, 0, At, B0); PG8_BAR; PG8_SCHED;
            PG8_LDB(B1, 1, 1); PG8_STAGE(PG8_SB(1, 0), b3, voffB);
            PG8_BAR; PG8_WAIT_L(0); PG8_MMA(0, 1, At, B1); PG8_BAR;
            PG8_LDA(At, 1, 1); PG8_STAGE(PG8_SA(1, 0), a3, voffA);
            PG8_BAR; PG8_WAIT_L(0); PG8_MMA(1, 0, At, B0); PG8_BAR; PG8_SCHED;
            PG8_STAGE(PG8_SB(1, 1), b3 + hstepB, voffB);
            PG8_WAIT_V(6); PG8_BAR; PG8_MMA(1, 1, At, B1); PG8_BAR;
            }
        }
        if constexpr (ALIGN_EPI) { if (wr == 0) PG8_BAR; }
        if constexpr (!Epi::AFTER_DRAIN) { E(acc, cur, wr, wc, fr, fq); S.done(cur); }
        if (!has_next) break;
#pragma unroll
        for (int a = 0; a < 2; ++a)
#pragma unroll
            for (int b = 0; b < 2; ++b)
#pragma unroll
                for (int m = 0; m < 4; ++m)
#pragma unroll
                    for (int n = 0; n < 2; ++n) acc[a][b][m][n] = (f32x4){0.f, 0.f, 0.f, 0.f};
        cur = nxt; cA = nA; cB = nB; ++ui;
        if constexpr (ALIGN_EPI) { if (wr == 1) PG8_BAR; }
    }
    PG8_WAIT_V(0);
    if constexpr (!ALIGN_EPI) { if (wr == 0) PG8_BAR; }
    PG8_BAR;
    if constexpr (Epi::AFTER_DRAIN) { E.fused(acc, cur, wr, wc, fr, fq, lds, wid, lane); S.done(cur); }
#undef PG8_SA
#undef PG8_SB
#undef PG8_STAGE
#undef PG8_LDA
#undef PG8_LDB
#undef PG8_MMA
#undef PG8_WAIT_V
#undef PG8_WAIT_L
#undef PG8_BAR
#undef PG8_SCHED
}
}

#define GAS __attribute__((address_space(1)))
#define LAS __attribute__((address_space(3)))
typedef unsigned short bf16;
typedef unsigned v4u __attribute__((ext_vector_type(4)));
typedef unsigned v2u __attribute__((ext_vector_type(2)));
typedef float f32x4 __attribute__((ext_vector_type(4)));

constexpr int DM = 2048, NCTX = 8192, NLAT = 2048, MTOK = 10240, DEPTH = 4;
constexpr int INW = 16384, DFF = 5632, NFI = 11264, YW = 3072;
constexpr float EPS = 1e-6f;
constexpr int NWAVES = 8, NTHR = 512;

constexpr size_t MiB = 1u << 20;
constexpr size_t WS_CTL = 0, CTL_ZERO_BYTES = 1 * MiB;
constexpr size_t WS_MOD = 1 * MiB;
constexpr size_t WS_LB = 2 * MiB;
constexpr size_t WS_ROPE = 2 * MiB + 65536;
constexpr size_t WS_AST = 2 * MiB + 131072;
constexpr size_t WS_WT = 4 * MiB;
constexpr size_t WL_ELEMS = 78643200;
constexpr size_t OFF_IN = 0, OFF_UP = 33554432, OFF_OUT = 39845888, OFF_FI = 44040192, OFF_FO = 67108864;
constexpr size_t WS_Z = 604 * MiB;
constexpr size_t WS_LOGF = 924 * MiB;
constexpr size_t WS_H = 1004 * MiB;
constexpr size_t WS_Y = 1044 * MiB;
constexpr size_t WS_OF = 1104 * MiB;
constexpr size_t WS_OB = 1144 * MiB;
constexpr size_t WS_TP = 1184 * MiB;
constexpr size_t TPQ = 2048 * 2048;
constexpr size_t WS_MG = 1264 * MiB;
constexpr size_t WS_T = 1304 * MiB;
constexpr size_t WS_XB = 1344 * MiB;
constexpr size_t WS_ACT = 1384 * MiB;
constexpr size_t WS_END = 1494 * MiB;
constexpr int CW_BAR = 4096;
constexpr int CW_Q = 16384;
constexpr int CW_LC = 20480;
constexpr size_t OUT_Y = 0, OUT_K = 20971520, OUT_V = OUT_K + 33554432, OUT_S = OUT_V + 33554432, OUT_END = OUT_S + 33554432;

constexpr int LDS_BYTES = 155648;
constexpr int LDSCTL_OFF = 154624;

constexpr int PH_PRO = 0, PH_T1 = 1, PH_L0 = 2, PH_PER_LAYER = 9, PH_END = PH_L0 + DEPTH * PH_PER_LAYER;

struct Args {
    const float *x_prompt, *x_sample, *cache_k, *cache_v, *state, *c, *c_ctx, *w_ada, *b_ada, *norm_g, *w_in, *a_w, *a_b, *rpb, *lb_logits, *w_up_a, *w_up_b, *w_up_c, *w_out, *w_fi, *w_fo;
    float* out; unsigned char* ws; int ph_lo, ph_hi;
};

__device__ __forceinline__ float bf2f_lo(unsigned w) { return __uint_as_float(w << 16); }
__device__ __forceinline__ float bf2f_hi(unsigned w) { return __uint_as_float(w & 0xffff0000u); }
__device__ __forceinline__ unsigned f2bf(float f) { unsigned u = __float_as_uint(f); return (u + 0x7fffu + ((u >> 16) & 1u)) >> 16; }
typedef __bf16 bf16x2_t __attribute__((ext_vector_type(2)));
typedef float f32x2_t __attribute__((ext_vector_type(2)));
__device__ __forceinline__ unsigned cvtpk(float lo, float hi) { const f32x2_t v = {lo, hi}; return __builtin_bit_cast(unsigned, __builtin_convertvector(v, bf16x2_t)); }
__device__ __forceinline__ unsigned pk2(float lo, float hi) { return cvtpk(lo, hi); }
__device__ __forceinline__ void unpack8(const v4u w, float (&f)[8]) {
    f[0] = bf2f_lo(w.x); f[1] = bf2f_hi(w.x); f[2] = bf2f_lo(w.y); f[3] = bf2f_hi(w.y); f[4] = bf2f_lo(w.z); f[5] = bf2f_hi(w.z); f[6] = bf2f_lo(w.w); f[7] = bf2f_hi(w.w); }
__device__ __forceinline__ v4u pack8(const float (&f)[8]) { v4u w; w.x = pk2(f[0], f[1]); w.y = pk2(f[2], f[3]); w.z = pk2(f[4], f[5]); w.w = pk2(f[6], f[7]); return w; }
__device__ __forceinline__ float wave_sum(float v) {
#pragma unroll
    for (int o = 1; o < 64; o <<= 1) v += __shfl_xor(v, o);
    return v;
}
__device__ __forceinline__ float sigmoidf_(float x) { return __builtin_amdgcn_rcpf(1.0f + __builtin_amdgcn_exp2f(-1.4426950408889634f * x)); }
__device__ __forceinline__ float siluf_(float x) { return x * __builtin_amdgcn_rcpf(1.0f + __builtin_amdgcn_exp2f(-1.4426950408889634f * x)); }
__device__ __forceinline__ float gelu_tanh_(float x) { const float y = (-1.4426950408889634f * 1.5957691216057308f) * (x + 0.044715f * x * x * x); return x * __builtin_amdgcn_rcpf(1.0f + __builtin_amdgcn_exp2f(y)); }

#define XB_TMO      128
#define XB_XCNT(j)  (256  + 64 * (j))
#define XB_XSUB(j)  (1280 + 64 * (j))
#define XB_XGEN(j)  (2304 + 64 * (j))
#define XB_TOP      3328
#define XB_TOPGEN   3392
#define XCD_BAR_WORDS 3456
#define XB_SPIN_CAP (1u << 18)
__device__ __forceinline__ unsigned xb_ld(unsigned* p)              { return __hip_atomic_load(p, __ATOMIC_RELAXED, __HIP_MEMORY_SCOPE_AGENT); }
__device__ __forceinline__ unsigned xb_add(unsigned* p, unsigned v) { return __hip_atomic_fetch_add(p, v, __ATOMIC_RELAXED, __HIP_MEMORY_SCOPE_AGENT); }
__device__ __forceinline__ unsigned xb_xcc_id() { return (unsigned)__builtin_amdgcn_s_getreg((3 << 11) | 20) & 0xFu; }
#define XB_SPIN(cond, bar) do { unsigned _sp = 0; while (cond) { __builtin_amdgcn_s_sleep(1); \
    if ((++_sp & 255u) == 0u) { if (xb_ld(&(bar)[XB_TMO])) break; if (_sp > XB_SPIN_CAP) { atomicAdd(&(bar)[XB_TMO], 1u); break; } } } } while (0)
struct XcdBarrier { unsigned* bar; unsigned x; volatile LAS unsigned* st; };
__device__ __forceinline__ XcdBarrier xcd_barrier_post(unsigned* bar, volatile LAS unsigned* st) {
    XcdBarrier b; b.bar = bar; b.x = xb_xcc_id(); b.st = st;
    if (threadIdx.x == 0) (void)xb_add(&bar[XB_XCNT(b.x)], 1u);
    return b;
}
__device__ __forceinline__ void xcd_barrier_complete(unsigned* bar, unsigned x, unsigned& nloc, unsigned& nx) {
    const unsigned G = gridDim.x * gridDim.y * gridDim.z;
    unsigned sum, cnt, mine, sp = 0u;
    for (;;) {
        sum = 0u; cnt = 0u; mine = 0u;
#pragma unroll
        for (unsigned j = 0; j < 16; ++j) { const unsigned c = xb_ld(&bar[XB_XCNT(j)]); sum += c; cnt += (c > 0u) ? 1u : 0u; mine = (j == x) ? c : mine; }
        if (sum == G) break;
        __builtin_amdgcn_s_sleep(1);
        if ((++sp & 255u) == 0u) { if (xb_ld(&bar[XB_TMO])) break; if (sp > XB_SPIN_CAP) { atomicAdd(&bar[XB_TMO], 1u); break; } }
    }
    nloc = mine > 0u ? mine : 1u; nx = cnt > 0u ? cnt : 1u;
}
__device__ __forceinline__ void xcd_barrier(const XcdBarrier& b) {
    asm volatile("s_waitcnt vmcnt(0)" ::: "memory");
    __syncthreads();
    if (threadIdx.x == 0) {
        unsigned* bar = b.bar;
        __builtin_amdgcn_s_waitcnt(0);
        unsigned nloc = b.st[0], nx = b.st[1];
        if (nloc == 0u) { xcd_barrier_complete(bar, b.x, nloc, nx); b.st[0] = nloc; b.st[1] = nx; }
        const unsigned old = xb_add(&bar[XB_XSUB(b.x)], 1u);
        const unsigned gen = old / nloc;
        if (old + 1u == (gen + 1u) * nloc) {
            __builtin_amdgcn_fence(__ATOMIC_RELEASE, "agent");
            asm volatile("s_waitcnt vmcnt(0)" ::: "memory");
            const unsigned og = xb_add(&bar[XB_TOP], 1u);
            const unsigned tg = og / nx;
            if (og + 1u == (tg + 1u) * nx) xb_add(&bar[XB_TOPGEN], 1u);
            else XB_SPIN(xb_ld(&bar[XB_TOPGEN]) == tg, bar);
            __builtin_amdgcn_fence(__ATOMIC_ACQUIRE, "agent");
            xb_add(&bar[XB_XGEN(b.x)], 1u);
            asm volatile("s_waitcnt vmcnt(0)" ::: "memory");
        } else {
            XB_SPIN(xb_ld(&bar[XB_XGEN(b.x)]) == gen, bar);
            __builtin_amdgcn_fence(__ATOMIC_ACQUIRE, "agent");
            asm volatile("s_waitcnt vmcnt(0)" ::: "memory");
        }
    }
    __syncthreads();
}

struct EpiIn {
    static constexpr bool PERM = true, AFTER_DRAIN = false, HOOK = false; static constexpr int H1 = -1, H2 = -1, NST = 16;
    bf16* Z; float* LOGF; const float* lbp  ; float* outK; float* outV; float* AST;
    template <int KIND>
    __device__ __forceinline__ void body(const f32x4 (&acc)[2][2][4][2], const pg8::Unit& u, int wr, int wc, int fr, int fq) const {
        const int row0 = u.pm * 256 + wr * 64 + fr, colt = u.pn * 256 + wc * 32 + 8 * fq;
        const int seg = u.pn >> 2;
#pragma unroll
        for (int ai = 0; ai < 2; ++ai)
#pragma unroll
            for (int m = 0; m < 4; ++m) {
                const int row = row0 + ai * 128 + m * 16;
                bf16* zrow = Z + (size_t)row * INW + colt;
                float rs = 0.f, rq = 0.f;
#pragma unroll
                for (int bj = 0; bj < 2; ++bj) {
                    float v[8];
#pragma unroll
                    for (int j = 0; j < 4; ++j) { v[j] = acc[ai][bj][m][0][j]; v[4 + j] = acc[ai][bj][m][1][j]; }
                    if (KIND == 5) {
                        const int c2 = colt + bj * 128 - 6144;
                        const float* lb = lbp + (seg - 6) * 4096 + (c2 & 1023);
                        float o[8];
#pragma unroll
                        for (int j = 0; j < 8; ++j) { const float b = lb[j]; o[j] = __builtin_amdgcn_logf(b + (1.0f - b) * sigmoidf_(v[j])); }
                        float* dst = LOGF + (size_t)row * 2048 + c2;
                        *(f32x4*)dst = (f32x4){o[0], o[1], o[2], o[3]}; *(f32x4*)(dst + 4) = (f32x4){o[4], o[5], o[6], o[7]};
                    } else {
                        if (KIND == 4) {
                            if (row < NCTX) { float* dst = (seg == 3 ? outK : outV) + ((size_t)(row >> 8) * 1024 + (row & 255)) * 1024 + (colt + bj * 128 - (seg == 3 ? 3072 : 4096));
                                *(f32x4*)dst = (f32x4){v[0], v[1], v[2], v[3]}; *(f32x4*)(dst + 4) = (f32x4){v[4], v[5], v[6], v[7]}; }
                        }
                        if (KIND == 1 || KIND == 6) {
#pragma unroll
                            for (int j = 0; j < 8; ++j) v[j] = gelu_tanh_(v[j]);
                        }
                        if (KIND == 6) {
#pragma unroll
                            for (int j = 0; j < 8; ++j) { rs += v[j]; rq += v[j] * v[j]; }
                        }
                        if (KIND == 2) {
#pragma unroll
                            for (int j = 0; j < 8; ++j) v[j] = siluf_(v[j]);
                        }
                        if (KIND == 3) {
#pragma unroll
                            for (int j = 0; j < 8; ++j) v[j] = sigmoidf_(v[j]);
                        }
                        *(v4u*)(zrow + bj * 128) = pack8(v);
                    }
                }
                if (KIND == 6) {
                    rs += __shfl_xor(rs, 16); rs += __shfl_xor(rs, 32); rq += __shfl_xor(rq, 16); rq += __shfl_xor(rq, 32);
                    if (fq == 0) { float* d = AST + ((size_t)row * 16 + (u.pn & 3) * 4 + wc) * 2; d[0] = rs; d[1] = rq; }
                }
                asm volatile("" ::: "memory");
            }
    }
    __device__ __forceinline__ void operator()(const f32x4 (&acc)[2][2][4][2], const pg8::Unit& u, int wr, int wc, int fr, int fq) const {
        const int seg = u.pn >> 2;
        if (seg >= 10) body<3>(acc, u, wr, wc, fr, fq);
        else if (seg == 0) body<1>(acc, u, wr, wc, fr, fq);
        else if (seg == 1) body<6>(acc, u, wr, wc, fr, fq);
        else if (seg == 5 || seg == 9) body<2>(acc, u, wr, wc, fr, fq);
        else if (seg == 3 || seg == 4) body<4>(acc, u, wr, wc, fr, fq);
        else if (seg == 6 || seg == 7) body<5>(acc, u, wr, wc, fr, fq);
        else body<0>(acc, u, wr, wc, fr, fq);
    }
};
struct EpiUpK {
    static constexpr bool PERM = true, AFTER_DRAIN = false, HOOK = true; static constexpr int H1 = 16, H2 = 32, NST = 16;
    const bf16* Zg  ; bf16* MG;
    __device__ __forceinline__ void hook(f32x4 (&acc)[2][2][4][2], const pg8::Unit& u, int t, int wr, int wc, int fr, int fq) const {
        int frl = fr, fql = fq; asm volatile("" : "+v"(frl), "+v"(fql));
        const int row0 = u.pm * 256 + wr * 64 + frl, colt = u.pn * 256 + wc * 32 + 8 * fql;
        const bf16* zn = Zg + (t == 16 ? 0 : 2048);
#pragma unroll
        for (int ai = 0; ai < 2; ++ai) {
            v4u nw[4][2], dw[4][2];
#pragma unroll
            for (int m = 0; m < 4; ++m)
#pragma unroll
                for (int bj = 0; bj < 2; ++bj) { const size_t ro = (size_t)(row0 + ai * 128 + m * 16) * INW + colt + bj * 128; nw[m][bj] = *(const v4u*)(zn + ro); dw[m][bj] = *(const v4u*)(zn + 2048 + ro); }
#pragma unroll
            for (int m = 0; m < 4; ++m)
#pragma unroll
                for (int bj = 0; bj < 2; ++bj) {
                    float gn[8], gd[8]; unpack8(nw[m][bj], gn); unpack8(dw[m][bj], gd);
#pragma unroll
                    for (int j = 0; j < 4; ++j) { acc[ai][bj][m][0][j] *= gn[j] * __builtin_amdgcn_rcpf(gd[j]); acc[ai][bj][m][1][j] *= gn[4 + j] * __builtin_amdgcn_rcpf(gd[4 + j]); }
                }
            asm volatile("" ::: "memory");
        }
    }
    __device__ __forceinline__ void operator()(const f32x4 (&acc)[2][2][4][2], const pg8::Unit& u, int wr, int wc, int fr, int fq) const {
        const int row0 = u.pm * 256 + wr * 64 + fr, colt = u.pn * 256 + wc * 32 + 8 * fq;
#pragma unroll
        for (int ai = 0; ai < 2; ++ai)
#pragma unroll
            for (int m = 0; m < 4; ++m) {
                const int row = row0 + ai * 128 + m * 16;
#pragma unroll
                for (int bj = 0; bj < 2; ++bj) {
                    const int col = colt + bj * 128;
                    float g[8]; unpack8(*(const v4u*)(Zg + 4096 + (size_t)row * INW + col), g);
                    float v[8];
#pragma unroll
                    for (int j = 0; j < 4; ++j) { v[j] = acc[ai][bj][m][0][j] * g[j]; v[4 + j] = acc[ai][bj][m][1][j] * g[4 + j]; }
                    *(v4u*)(MG + (size_t)row * DM + col) = pack8(v);
                }
                asm volatile("" ::: "memory");
            }
    }
};
struct EpiBf16P {
    static constexpr bool PERM = true, AFTER_DRAIN = false, HOOK = false; static constexpr int H1 = -1, H2 = -1, NST = 16;
    bf16* C; int ldc; size_t kq_stride;
    __device__ __forceinline__ void operator()(const f32x4 (&acc)[2][2][4][2], const pg8::Unit& u, int wr, int wc, int fr, int fq) const {
        const int row0 = u.pm * 256 + wr * 64 + fr, colt = u.pn * 256 + wc * 32 + 8 * fq;
#pragma unroll
        for (int ai = 0; ai < 2; ++ai)
#pragma unroll
            for (int m = 0; m < 4; ++m) {
                bf16* rp = C + (size_t)u.kq * kq_stride + (size_t)(row0 + ai * 128 + m * 16) * ldc + colt;
#pragma unroll
                for (int bj = 0; bj < 2; ++bj) { float v[8];
#pragma unroll
                    for (int j = 0; j < 4; ++j) { v[j] = acc[ai][bj][m][0][j]; v[4 + j] = acc[ai][bj][m][1][j]; }
                    *(v4u*)(rp + bj * 128) = pack8(v); }
            }
    }
};
struct EpiSwi {
    static constexpr bool PERM = true, AFTER_DRAIN = false, HOOK = false; static constexpr int H1 = -1, H2 = -1, NST = 16;
    bf16* ACT;
    __device__ __forceinline__ void operator()(const f32x4 (&acc)[2][2][4][2], const pg8::Unit& u, int wr, int wc, int fr, int fq) const {
        const int row0 = u.pm * 256 + wr * 64 + fr, colt = u.pn * 128 + wc * 32 + 8 * fq;
#pragma unroll
        for (int ai = 0; ai < 2; ++ai)
#pragma unroll
            for (int m = 0; m < 4; ++m) {
                float v[8];
#pragma unroll
                for (int j = 0; j < 4; ++j) { v[j] = siluf_(acc[ai][1][m][0][j]) * acc[ai][0][m][0][j]; v[4 + j] = siluf_(acc[ai][1][m][1][j]) * acc[ai][0][m][1][j]; }
                *(v4u*)(ACT + (size_t)(row0 + ai * 128 + m * 16) * DFF + colt) = pack8(v);
            }
    }
};

struct Ctx {
    LAS unsigned char* lds; int tid, lane, wave, vcu, G;
};

struct CvtDesc { const float* src; int N; bf16* dst; int dld; };
__device__ __forceinline__ void cvt_load(const CvtDesc& d, f32x4 (&v)[16]) {
#pragma unroll
    for (int i = 0; i < 16; ++i) v[i] = *(const f32x4*)(d.src + (size_t)(4 * i) * d.N);
}
__device__ __forceinline__ void cvt_finish(const CvtDesc& d, const f32x4 (&v)[16], LAS float* scr, int lane) {
#pragma unroll
    for (int i = 0; i < 16; ++i) { LAS float* s = scr + (4 * i + (lane >> 4)) * 65 + 4 * (lane & 15); s[0] = v[i].x; s[1] = v[i].y; s[2] = v[i].z; s[3] = v[i].w; }
    asm volatile("s_waitcnt lgkmcnt(0)" ::: "memory");
    const int c = lane & 7;
#pragma unroll
    for (int j = 0; j < 8; ++j) { const int n = (lane >> 3) + 8 * j; const LAS float* s = scr + (8 * c) * 65 + n;
        v4u o; o.x = pk2(s[0 * 65], s[1 * 65]); o.y = pk2(s[2 * 65], s[3 * 65]); o.z = pk2(s[4 * 65], s[5 * 65]); o.w = pk2(s[6 * 65], s[7 * 65]);
        *(v4u*)(d.dst + (size_t)n * d.dld + 8 * c) = o; }
    asm volatile("s_waitcnt lgkmcnt(0)" ::: "memory");
}
constexpr int IT_IN = 32 * 256, IT_UP = 16 * 32, IT_OUT = 32 * 32, IT_FI = 32 * 176, IT_FO = 88 * 32, IT_LAYER = IT_IN + 3 * IT_UP + IT_OUT + IT_FI + IT_FO;
__device__ __forceinline__ CvtDesc cvt_desc(const Args& a, int l, int r, int lane) {
    bf16* wl = (bf16*)(a.ws + WS_WT) + (size_t)l * WL_ELEMS;
    const float* W; int N, k0, n0, dld, drow0, dcol0; bf16* dst;
    if (r < IT_IN) { const int kb = r / 256, nb = r % 256; W = a.w_in + (size_t)l * DM * INW; N = INW; k0 = 64 * kb; n0 = 64 * nb; dst = wl + OFF_IN; dld = DM; drow0 = n0; dcol0 = k0; }
    else { r -= IT_IN;
    if (r < 3 * IT_UP) { const int br = r / IT_UP, q = r % IT_UP, kb = q / 32, nb = q % 32;
        W = (br == 0 ? a.w_up_a : (br == 1 ? a.w_up_b : a.w_up_c)) + (size_t)l * 1024 * DM; N = DM; k0 = 64 * kb; n0 = 64 * nb; dst = wl + OFF_UP; dld = YW; drow0 = n0; dcol0 = 1024 * br + k0; }
    else { r -= 3 * IT_UP;
    if (r < IT_OUT) { const int kb = r / 32, nb = r % 32; W = a.w_out + (size_t)l * DM * DM; N = DM; k0 = 64 * kb; n0 = 64 * nb; dst = wl + OFF_OUT; dld = DM; drow0 = n0; dcol0 = k0; }
    else { r -= IT_OUT;
    if (r < IT_FI) { const int kb = r / 176, nb = r % 176; n0 = 64 * nb; k0 = 64 * kb; W = a.w_fi + (size_t)l * DM * NFI; N = NFI; dst = wl + OFF_FI; dld = DM;
        drow0 = (n0 < DFF) ? (256 * (n0 / 128) + (n0 % 128)) : (256 * ((n0 - DFF) / 128) + 128 + ((n0 - DFF) % 128)); dcol0 = k0; }
    else { r -= IT_FI; const int kb = r / 32, nb = r % 32; W = a.w_fo + (size_t)l * DFF * DM; N = DM; k0 = 64 * kb; n0 = 64 * nb; dst = wl + OFF_FO; dld = DFF; drow0 = n0; dcol0 = k0; } } } }
    CvtDesc d; d.src = W + (size_t)(k0 + (lane >> 4)) * N + n0 + 4 * (lane & 15); d.N = N; d.dst = dst + (size_t)drow0 * dld + dcol0; d.dld = dld; return d;
}
__device__ __forceinline__ void cvt_three(const Args& a, int l, int r0, int rstep, LAS float* scr, int lane) {
    const CvtDesc d0 = cvt_desc(a, l, r0, lane), d1 = cvt_desc(a, l, r0 + rstep, lane), d2 = cvt_desc(a, l, r0 + 2 * rstep, lane);
    f32x4 v0[16], v1[16], v2[16];
    cvt_load(d0, v0); cvt_load(d1, v1); cvt_load(d2, v2);
    cvt_finish(d0, v0, scr, lane); cvt_finish(d1, v1, scr, lane); cvt_finish(d2, v2, scr, lane);
}
__device__ __forceinline__ void adaln_unit(const Args& a, const Ctx& F, int l, int cb) {
    LAS float* sc = (LAS float*)F.lds;
    LAS float* red = (LAS float*)(F.lds + 24576);
    float* MOD = (float*)(a.ws + WS_MOD);
    __syncthreads();
    for (int i = F.tid; i < 3 * DM; i += NTHR) { const int ci = i / DM, k = i % DM; const float x = (ci == 0) ? a.c_ctx[k] : a.c[(ci - 1) * DM + k]; sc[i] = x / (1.0f + expf(-x)); }
    __syncthreads();
    const int cx = F.tid & 31, kg = F.tid >> 5;
    const float* wp = a.w_ada + ((size_t)l * DM + 128 * kg) * 12288 + 128 * cb + 4 * cx;
    f32x4 a0 = {0.f, 0.f, 0.f, 0.f}, a1 = a0, a2 = a0;
#pragma unroll 8
    for (int k = 0; k < 128; ++k) { const f32x4 w = *(const f32x4*)(wp + (size_t)k * 12288);
        const float s0 = sc[128 * kg + k], s1 = sc[DM + 128 * kg + k], s2 = sc[2 * DM + 128 * kg + k];
        a0 += w * s0; a1 += w * s1; a2 += w * s2; }
#pragma unroll
    for (int j = 0; j < 4; ++j) { red[(kg * 3 + 0) * 128 + 4 * cx + j] = a0[j]; red[(kg * 3 + 1) * 128 + 4 * cx + j] = a1[j]; red[(kg * 3 + 2) * 128 + 4 * cx + j] = a2[j]; }
    __syncthreads();
    if (F.tid < 384) { const int ci = F.tid / 128, col = F.tid % 128; float sm = 0.f;
#pragma unroll
        for (int g = 0; g < 16; ++g) sm += red[(g * 3 + ci) * 128 + col];
        MOD[(size_t)(l * 3 + ci) * 12288 + 128 * cb + col] = sm + a.b_ada[l * 12288 + 128 * cb + col]; }
    __syncthreads();
}
__device__ __forceinline__ void phase_prologue(const Args& a, const Ctx& F) {
    unsigned char* ws = a.ws;
    {
        LAS float* scr = (LAS float*)(F.lds + F.wave * 16640);
        const int gw = F.vcu * NWAVES + F.wave, NGW = F.G * NWAVES;
        for (int it = gw; it < IT_LAYER / 3; it += NGW) cvt_three(a, 0, it, IT_LAYER / 3, scr, F.lane);
    }
    __syncthreads();
    for (int u = F.vcu; u < 4 * 96; u += F.G) adaln_unit(a, F, u / 96, u % 96);
    {
        float* LB = (float*)(ws + WS_LB); float* ROPE = (float*)(ws + WS_ROPE);
        for (int i = F.vcu * NTHR + F.tid; i < 2048; i += F.G * NTHR) {
            const int dir = i / 1024, f = i % 1024;
            float x[4], mx = -3.0e38f;
#pragma unroll
            for (int l = 0; l < 4; ++l) { x[l] = a.lb_logits[(dir * 4 + l) * 1024 + f]; mx = fmaxf(mx, x[l]); }
            float e[4], s = 0.f;
#pragma unroll
            for (int l = 0; l < 4; ++l) { e[l] = expf(x[l] - mx); s += e[l]; }
            float cs = 0.f;
#pragma unroll
            for (int l = 0; l < 4; ++l) { if (l > 0) cs += e[l] / s; LB[(dir * 4 + l) * 1024 + f] = cs; }
            const int p = i / 32, fi = i % 32;
            const float inv = powf(10000.0f, -(float)(2 * fi) / 64.0f), ang = (float)p * inv;
            ROPE[2 * i] = cosf(ang); ROPE[2 * i + 1] = sinf(ang);
        }
    }
}

__device__ __forceinline__ void rownorm_phase(const Args& a, const Ctx& F, bool first, const bf16* T, const float* gate  , const float* gpost,
                                              bool write_h, const float* gn, const float* scv, const float* shv  ) {
    float* X = a.out + OUT_Y; bf16* XB = (bf16*)(a.ws + WS_XB); bf16* H = (bf16*)(a.ws + WS_H); const bf16* TP = (const bf16*)(a.ws + WS_TP);
    LAS float* V1 = (LAS float*)F.lds; LAS float* V2 = V1 + 3 * DM; LAS float* V3 = V2 + 3 * DM;
    const int gw = F.vcu * NWAVES + F.wave, NGW = F.G * NWAVES;
    struct RowRaw { f32x4 xf[8]; v2u tw[4][8]; };
#define RN_LOAD(R, m_) do { const int mr_ = (m_); \
        if (first) { const float* xr = (mr_ < NCTX) ? a.x_prompt + (size_t)mr_ * DM : a.x_sample + (size_t)(mr_ - NCTX) * DM; \
            _Pragma("unroll") for (int j = 0; j < 8; ++j) R.xf[j] = *((const f32x4*)xr + F.lane + 64 * j); } \
        else { _Pragma("unroll") for (int j = 0; j < 8; ++j) { const v2u w = *((const v2u*)(XB + (size_t)mr_ * DM) + F.lane + 64 * j); R.xf[j].x = __uint_as_float(w.x); R.xf[j].y = __uint_as_float(w.y); } } \
        if (T) { if (mr_ < NCTX) { _Pragma("unroll") for (int j = 0; j < 8; ++j) R.tw[0][j] = *((const v2u*)(T + (size_t)mr_ * DM) + F.lane + 64 * j); } \
                 else { _Pragma("unroll") for (int q = 0; q < 4; ++q) _Pragma("unroll") for (int j = 0; j < 8; ++j) R.tw[q][j] = *((const v2u*)(TP + (size_t)q * TPQ + (size_t)(mr_ - NCTX) * DM) + F.lane + 64 * j); } } \
    } while (0)
    RowRaw R;
    if (gw < MTOK) RN_LOAD(R, gw);
    __syncthreads();
    for (int i = F.tid; i < 3 * DM; i += NTHR) { const int ci = i / DM, c = i % DM;
        if (T) V1[i] = gate[(size_t)ci * 12288 + c] * gpost[c];
        if (write_h) { V2[i] = gn[c] * (1.0f + scv[(size_t)ci * 12288 + c]); V3[i] = shv[(size_t)ci * 12288 + c]; } }
    __syncthreads();
    for (int m = gw; m < MTOK; m += NGW) {
        const int ci = (m < NCTX) ? 0 : 1 + ((m - NCTX) >> 10);
        f32x4 x[8], t[8];
        if (first) {
#pragma unroll
            for (int j = 0; j < 8; ++j) x[j] = R.xf[j];
        } else {
#pragma unroll
            for (int j = 0; j < 8; ++j) { const unsigned wx = __float_as_uint(R.xf[j].x), wy = __float_as_uint(R.xf[j].y); x[j] = (f32x4){bf2f_lo(wx), bf2f_hi(wx), bf2f_lo(wy), bf2f_hi(wy)}; }
        }
        if (T) {
#pragma unroll
            for (int j = 0; j < 8; ++j) {
                if (m < NCTX) { const v2u w = R.tw[0][j]; t[j] = (f32x4){bf2f_lo(w.x), bf2f_hi(w.x), bf2f_lo(w.y), bf2f_hi(w.y)}; }
                else { const v2u w0 = R.tw[0][j], w1 = R.tw[1][j], w2 = R.tw[2][j], w3 = R.tw[3][j];
                    t[j] = (f32x4){(bf2f_lo(w0.x) + bf2f_lo(w1.x)) + (bf2f_lo(w2.x) + bf2f_lo(w3.x)), (bf2f_hi(w0.x) + bf2f_hi(w1.x)) + (bf2f_hi(w2.x) + bf2f_hi(w3.x)),
                                   (bf2f_lo(w0.y) + bf2f_lo(w1.y)) + (bf2f_lo(w2.y) + bf2f_lo(w3.y)), (bf2f_hi(w0.y) + bf2f_hi(w1.y)) + (bf2f_hi(w2.y) + bf2f_hi(w3.y))}; } }
        }
        asm volatile("" ::: "memory");
        if (m + NGW < MTOK) RN_LOAD(R, m + NGW);
        if (T) {
            float ss = 0.f;
#pragma unroll
            for (int j = 0; j < 8; ++j) ss += (t[j].x * t[j].x + t[j].y * t[j].y) + (t[j].z * t[j].z + t[j].w * t[j].w);
            const float r = 1.0f / sqrtf(wave_sum(ss) * (1.0f / DM) + EPS);
#pragma unroll
            for (int j = 0; j < 8; ++j) { const f32x4 v1 = *((const LAS f32x4*)(V1 + ci * DM) + F.lane + 64 * j); x[j] += v1 * (t[j] * r); }
        }
        if (!write_h) {
#pragma unroll
            for (int j = 0; j < 8; ++j) *((f32x4*)(X + (size_t)m * DM) + F.lane + 64 * j) = x[j];
        } else {
#pragma unroll
            for (int j = 0; j < 8; ++j) { v2u w; w.x = pk2(x[j].x, x[j].y); w.y = pk2(x[j].z, x[j].w); *((v2u*)(XB + (size_t)m * DM) + F.lane + 64 * j) = w; }
        }
        if (write_h) {
            float ss = 0.f;
#pragma unroll
            for (int j = 0; j < 8; ++j) ss += (x[j].x * x[j].x + x[j].y * x[j].y) + (x[j].z * x[j].z + x[j].w * x[j].w);
            const float r = 1.0f / sqrtf(wave_sum(ss) * (1.0f / DM) + EPS);
#pragma unroll
            for (int j = 0; j < 8; ++j) { const f32x4 v2 = *((const LAS f32x4*)(V2 + ci * DM) + F.lane + 64 * j), v3 = *((const LAS f32x4*)(V3 + ci * DM) + F.lane + 64 * j);
                const f32x4 h = x[j] * r * v2 + v3;
                v2u w; w.x = pk2(h.x, h.y); w.y = pk2(h.z, h.w);
                *((v2u*)(H + (size_t)m * DM) + F.lane + 64 * j) = w; }
        }
    }
#undef RN_LOAD
    __syncthreads();
}

__device__ __forceinline__ void phase_ycnorm(const Args& a, const Ctx& F) {
    const float* OFp = (const float*)(a.ws + WS_OF); const float* OBp = (const float*)(a.ws + WS_OB);
    const bf16* Z = (const bf16*)(a.ws + WS_Z); bf16* Y = (bf16*)(a.ws + WS_Y);
    const int gw = F.vcu * NWAVES + F.wave, NGW = F.G * NWAVES;
    for (int m = gw; m < MTOK; m += NGW) {
        float o[16]; float ss = 0.f;
#pragma unroll
        for (int j = 0; j < 4; ++j) { const f32x4 p = *((const f32x4*)(OFp + (size_t)m * 1024 + 16 * F.lane) + j), q = *((const f32x4*)(OBp + (size_t)m * 1024 + 16 * F.lane) + j);
            const f32x4 s = p + q; o[4 * j] = s.x; o[4 * j + 1] = s.y; o[4 * j + 2] = s.z; o[4 * j + 3] = s.w; ss += (s.x * s.x + s.y * s.y) + (s.z * s.z + s.w * s.w); }
        ss += __shfl_xor(ss, 1); ss += __shfl_xor(ss, 2); ss += __shfl_xor(ss, 4);
        const float r = 1.0f / sqrtf(ss * (1.0f / 128.0f) + EPS);
        float g0[8], g1[8];
        unpack8(*(const v4u*)(Z + (size_t)m * INW + 9216 + 16 * F.lane), g0); unpack8(*(const v4u*)(Z + (size_t)m * INW + 9216 + 16 * F.lane + 8), g1);
        float y0[8], y1[8];
#pragma unroll
        for (int j = 0; j < 8; ++j) { y0[j] = o[j] * r * g0[j]; y1[j] = o[8 + j] * r * g1[j]; }
        *(v4u*)(Y + (size_t)m * YW + 2048 + 16 * F.lane) = pack8(y0); *(v4u*)(Y + (size_t)m * YW + 2048 + 16 * F.lane + 8) = pack8(y1);
    }
}

typedef short bf16x8 __attribute__((ext_vector_type(8)));
typedef short s16x4 __attribute__((ext_vector_type(4)));
typedef float f32x16 __attribute__((ext_vector_type(16)));
typedef __bf16 bf16x4_t __attribute__((ext_vector_type(4)));
#define MFMA32(a, b, c) __builtin_amdgcn_mfma_f32_32x32x16_bf16((a), (b), (c), 0, 0, 0)
__device__ __forceinline__ bf16x8 pack_regs(const f32x16& x, int s) {
    v4u p; p.x = cvtpk(x[8 * s], x[8 * s + 1]); p.y = cvtpk(x[8 * s + 2], x[8 * s + 3]); p.z = cvtpk(x[8 * s + 4], x[8 * s + 5]); p.w = cvtpk(x[8 * s + 6], x[8 * s + 7]);
    return __builtin_bit_cast(bf16x8, p);
}
__device__ __forceinline__ s16x4 tr_read(const LAS unsigned char* p) { return __builtin_bit_cast(s16x4, __builtin_amdgcn_ds_read_tr16_b64_v4bf16((LAS bf16x4_t*)p)); }
__device__ __forceinline__ bf16x8 tr_pair(const LAS unsigned char* lo, const LAS unsigned char* hi) { const s16x4 a = tr_read(lo), b = tr_read(hi); return __builtin_shufflevector(a, b, 0, 1, 2, 3, 4, 5, 6, 7); }
constexpr float ATT_SCALE = 0.08838834764831845f;
constexpr int KP = 272, VP = 320;
constexpr int ATT_K_OFF = 0, ATT_V_OFF = 256 * KP, ATT_RPB_OFF = ATT_V_OFF + 256 * VP;
struct AttnW { f32x16 O[4]; float m, l; };
template <int MODE, bool QLDS>
__device__ __forceinline__ void attn_tile(AttnW& W, const bf16x8 (&qf)[8], const LAS unsigned char* Ql, const LAS unsigned char* Kl, const LAS unsigned char* Vl, int kt0, int lane, const LAS float* rpb_row, int kc0, int qc) {
    const int r = lane & 31, h = lane >> 5;
    f32x16 sacc;
#pragma unroll
    for (int i = 0; i < 16; ++i) sacc[i] = 0.f;
    const LAS unsigned char* kp = Kl + (kt0 + r) * KP + 16 * h;
#pragma unroll
    for (int ks = 0; ks < 8; ++ks) { const bf16x8 a = *(const LAS bf16x8*)(kp + 32 * ks); const bf16x8 q = QLDS ? *(const LAS bf16x8*)(Ql + 32 * ks) : qf[ks]; sacc = MFMA32(a, q, sacc); }
    float mt = -1.0e30f;
    if (MODE == 1) {
        const int c_start = min(max(qc - 8, 0), 48);
        const int kb = kc0 + 4 * h - c_start;
        const LAS float* bp = rpb_row + (kc0 + 4 * h - qc + 15);
#pragma unroll
        for (int i = 0; i < 16; ++i) { const int off = (i & 3) + 8 * (i >> 2); const bool ok = (unsigned)(kb + off) < 16u;
            const float bias = bp[ok ? off : (qc - kc0 - 4 * h)];
            const float v = ok ? (sacc[i] * ATT_SCALE + bias) : -1.0e30f; sacc[i] = v; mt = fmaxf(mt, v); }
    } else {
#pragma unroll
        for (int i = 0; i < 16; ++i) { sacc[i] *= ATT_SCALE; mt = fmaxf(mt, sacc[i]); }
    }
    mt = fmaxf(mt, __shfl_xor(mt, 32));
    const float mn = fmaxf(W.m, mt), alpha = __expf(W.m - mn);
    float ls = 0.f;
#pragma unroll
    for (int i = 0; i < 16; ++i) { const float e = (MODE == 1 && sacc[i] < -1.0e29f) ? 0.f : __expf(sacc[i] - mn); sacc[i] = e; ls += e; }
    ls += __shfl_xor(ls, 32);
    W.l = W.l * alpha + ls; W.m = mn;
    if (__any(alpha != 1.0f)) {
#pragma unroll
        for (int dt = 0; dt < 4; ++dt)
#pragma unroll
            for (int i = 0; i < 16; ++i) W.O[dt][i] *= alpha;
    }
    const bf16x8 pb0 = pack_regs(sacc, 0), pb1 = pack_regs(sacc, 1);
    const int g = (lane >> 4) & 1, q4 = (lane & 15) >> 2, p4 = lane & 3;
    const LAS unsigned char* vp = Vl + (kt0 + 4 * h + q4) * VP + 32 * g + 8 * p4;
#pragma unroll
    for (int dt = 0; dt < 4; ++dt) {
        const bf16x8 v0 = tr_pair(vp + 64 * dt, vp + 64 * dt + 8 * VP);
        const bf16x8 v1 = tr_pair(vp + 64 * dt + 16 * VP, vp + 64 * dt + 24 * VP);
        W.O[dt] = MFMA32(v0, pb0, W.O[dt]); W.O[dt] = MFMA32(v1, pb1, W.O[dt]);
    }
}
__device__ __forceinline__ void attn_init(AttnW& W) {
    W.m = -1.0e30f; W.l = 0.f;
#pragma unroll
    for (int dt = 0; dt < 4; ++dt)
#pragma unroll
        for (int i = 0; i < 16; ++i) W.O[dt][i] = 0.f;
}
__device__ __forceinline__ void attn_store_dt(const f32x16& O, float inv, bf16* yrow, int dt, int h) {
#pragma unroll
    for (int g4 = 0; g4 < 4; ++g4) { v2u w; w.x = cvtpk(O[4 * g4] * inv, O[4 * g4 + 1] * inv); w.y = cvtpk(O[4 * g4 + 2] * inv, O[4 * g4 + 3] * inv);
        *(v2u*)(yrow + 32 * dt + 8 * g4 + 4 * h) = w; }
}

__device__ __forceinline__ void unitAttnCtx(const Args& a, const Ctx& F, int unit) {
    const int hd = unit & 7, b = unit >> 3;
    const bf16* Z = (const bf16*)(a.ws + WS_Z); bf16* Y = (bf16*)(a.ws + WS_Y);
    const LAS unsigned char* Kl = F.lds + ATT_K_OFF; const LAS unsigned char* Vl = F.lds + ATT_V_OFF;
    for (int p = F.tid; p < 4096; p += NTHR) { const int key = p >> 4, c16 = p & 15; const bf16* src = Z + (size_t)(b * 256 + key) * INW + hd * 128 + 8 * c16;
        *(LAS v4u*)(F.lds + ATT_K_OFF + key * KP + 16 * c16) = *(const v4u*)(src + 3072); *(LAS v4u*)(F.lds + ATT_V_OFF + key * VP + 16 * c16) = *(const v4u*)(src + 4096); }
    AttnW W; attn_init(W); bf16x8 qf[8];
    const int r = F.lane & 31, h = F.lane >> 5;
    const int mq = b * 256 + 32 * F.wave + r;
    { const bf16* qp = Z + (size_t)mq * INW + 2048 + hd * 128 + 8 * h;
#pragma unroll
      for (int ks = 0; ks < 8; ++ks) qf[ks] = __builtin_bit_cast(bf16x8, *(const v4u*)(qp + 16 * ks)); }
    __syncthreads();
#pragma unroll 1
    for (int kt = 0; kt < 8; ++kt) attn_tile<0, false>(W, qf, nullptr, Kl, Vl, 32 * kt, F.lane, nullptr, 0, 0);
    const float inv = 1.0f / W.l;
    bf16* yrow = Y + (size_t)mq * YW + 1024 + hd * 128;
#pragma unroll
    for (int dt = 0; dt < 4; ++dt) attn_store_dt(W.O[dt], inv, yrow, dt, h);
    __syncthreads();
}
constexpr int LQ_OFF = 0, LK_OFF = 64 * KP, LV_OFF = LK_OFF + 128 * KP, LRPB_OFF = LV_OFF + 128 * VP;
__device__ __forceinline__ void unitAttnLat(const Args& a, const Ctx& F, int l, int unit) {
    const int gr = unit & 15, hd = (unit >> 4) & 7, b = unit >> 7;
    const bf16* Z = (const bf16*)(a.ws + WS_Z); bf16* Y = (bf16*)(a.ws + WS_Y);
    const float* ROPE = (const float*)(a.ws + WS_ROPE);
    const LAS unsigned char* Kl = F.lds + LK_OFF; const LAS unsigned char* Vl = F.lds + LV_OFF; LAS float* rp = (LAS float*)(F.lds + LRPB_OFF);
    const int r = F.lane & 31, h = F.lane >> 5, qh = F.wave & 1, kt = F.wave >> 1;
    const int qc = 32 * qh + r;
    const int r_start = min(max(gr - 4, 0), 8);
    const int mq = NCTX + b * 1024 + gr * 64 + qc;
    __syncthreads();
    for (int i = F.tid; i < 15 * 31; i += NTHR) rp[i] = a.rpb[(size_t)(l * 8 + hd) * 465 + i];
    {
        const int qq = F.tid >> 3, half = (F.tid >> 2) & 1, sp = F.tid & 3, pos = half ? qq : gr;
        const bf16* src = Z + (size_t)(NCTX + b * 1024 + gr * 64 + qq) * INW + 2048 + hd * 128 + 64 * half + 8 * sp;
        const float* rt = ROPE + 2 * (pos * 32 + 8 * sp);
        float x[8], y[8], lo[8], hi[8]; unpack8(*(const v4u*)src, x); unpack8(*(const v4u*)(src + 32), y);
#pragma unroll
        for (int j4 = 0; j4 < 4; ++j4) { const f32x4 cssn = *(const f32x4*)(rt + 4 * j4);
            lo[2 * j4] = x[2 * j4] * cssn.x - y[2 * j4] * cssn.y; hi[2 * j4] = y[2 * j4] * cssn.x + x[2 * j4] * cssn.y;
            lo[2 * j4 + 1] = x[2 * j4 + 1] * cssn.z - y[2 * j4 + 1] * cssn.w; hi[2 * j4 + 1] = y[2 * j4 + 1] * cssn.z + x[2 * j4 + 1] * cssn.w; }
        LAS unsigned char* d = F.lds + LQ_OFF + qq * KP + 2 * (64 * half + 8 * sp);
        *(LAS v4u*)d = pack8(lo); *(LAS v4u*)(d + 64) = pack8(hi);
    }
    AttnW W; attn_init(W);
    const LAS unsigned char* Ql = F.lds + LQ_OFF + qc * KP + 16 * h;
    const bf16x8 qdummy[8] = {};
    f32x4 R[16];
    const int jk0 = F.tid, jk1 = F.tid + NTHR;
#define LAT_PREFETCH(cn) do { \
        if ((cn) < 4) { \
            _Pragma("unroll") for (int q = 0; q < 2; ++q) { const int job = q ? jk1 : jk0; const int key = job >> 3, half = (job >> 2) & 1, sp = job & 3; \
                const int kr = r_start + 2 * (cn) + (key >> 6), kc = key & 63, pos = half ? kc : kr; \
                const bf16* src = Z + (size_t)(NCTX + b * 1024 + kr * 64 + kc) * INW + 3072 + hd * 128 + 64 * half + 8 * sp; \
                const float* rt = ROPE + 2 * (pos * 32 + 8 * sp); \
                R[2 * q] = __builtin_bit_cast(f32x4, *(const v4u*)src); R[2 * q + 1] = __builtin_bit_cast(f32x4, *(const v4u*)(src + 32)); \
                _Pragma("unroll") for (int j4 = 0; j4 < 4; ++j4) R[8 + 4 * q + j4] = *(const f32x4*)(rt + 4 * j4); } \
            _Pragma("unroll") for (int q = 0; q < 4; ++q) { const int pc = F.tid + q * NTHR; const int key = pc >> 4, c16 = pc & 15; const int kr = r_start + 2 * (cn) + (key >> 6), kc = key & 63; \
                R[4 + q] = __builtin_bit_cast(f32x4, *(const v4u*)(Z + (size_t)(NCTX + b * 1024 + kr * 64 + kc) * INW + 4096 + hd * 128 + 8 * c16)); } \
        } else { \
            _Pragma("unroll") for (int q = 0; q < 4; ++q) { const int pc = F.tid + q * NTHR; const int key = pc >> 4, c16 = pc & 15; \
                const size_t off = ((size_t)(b * 4 + l) * 512 + 128 * ((cn) - 4) + key) * 1024 + hd * 128 + 8 * c16; \
                R[4 * q] = *(const f32x4*)(a.cache_k + off); R[4 * q + 1] = *(const f32x4*)(a.cache_k + off + 4); R[4 * q + 2] = *(const f32x4*)(a.cache_v + off); R[4 * q + 3] = *(const f32x4*)(a.cache_v + off + 4); } \
        } } while (0)
#pragma unroll 1
    for (int chn = 0; chn < 8; ++chn) {
        LAT_PREFETCH(chn);
        __syncthreads();
        if (chn < 4) {
#pragma unroll
            for (int q = 0; q < 2; ++q) { const int job = q ? jk1 : jk0; const int key = job >> 3, half = (job >> 2) & 1, sp = job & 3;
                float x[8], y[8], lo[8], hi[8]; unpack8(__builtin_bit_cast(v4u, R[2 * q]), x); unpack8(__builtin_bit_cast(v4u, R[2 * q + 1]), y);
#pragma unroll
                for (int j4 = 0; j4 < 4; ++j4) { const f32x4 cssn = R[8 + 4 * q + j4];
                    lo[2 * j4] = x[2 * j4] * cssn.x - y[2 * j4] * cssn.y; hi[2 * j4] = y[2 * j4] * cssn.x + x[2 * j4] * cssn.y;
                    lo[2 * j4 + 1] = x[2 * j4 + 1] * cssn.z - y[2 * j4 + 1] * cssn.w; hi[2 * j4 + 1] = y[2 * j4 + 1] * cssn.z + x[2 * j4 + 1] * cssn.w; }
                LAS unsigned char* d = F.lds + LK_OFF + key * KP + 2 * (64 * half + 8 * sp);
                *(LAS v4u*)d = pack8(lo); *(LAS v4u*)(d + 64) = pack8(hi); }
#pragma unroll
            for (int q = 0; q < 4; ++q) { const int pc = F.tid + q * NTHR; const int key = pc >> 4, c16 = pc & 15;
                *(LAS v4u*)(F.lds + LV_OFF + key * VP + 16 * c16) = __builtin_bit_cast(v4u, R[4 + q]); }
        } else {
#pragma unroll
            for (int q = 0; q < 4; ++q) { const int pc = F.tid + q * NTHR; const int key = pc >> 4, c16 = pc & 15;
                const f32x4 k0 = R[4 * q], k1 = R[4 * q + 1], v0 = R[4 * q + 2], v1 = R[4 * q + 3];
                v4u kw, vw; kw.x = cvtpk(k0.x, k0.y); kw.y = cvtpk(k0.z, k0.w); kw.z = cvtpk(k1.x, k1.y); kw.w = cvtpk(k1.z, k1.w);
                vw.x = cvtpk(v0.x, v0.y); vw.y = cvtpk(v0.z, v0.w); vw.z = cvtpk(v1.x, v1.y); vw.w = cvtpk(v1.z, v1.w);
                *(LAS v4u*)(F.lds + LK_OFF + key * KP + 16 * c16) = kw; *(LAS v4u*)(F.lds + LV_OFF + key * VP + 16 * c16) = vw; }
        }
        __syncthreads();
        if (chn < 4) {
            const int kr = r_start + 2 * chn + (kt >> 1), dr = kr - gr + 7;
            attn_tile<1, true>(W, qdummy, Ql, Kl, Vl, 32 * kt, F.lane, rp + dr * 31, 32 * (kt & 1), qc);
        } else {
            attn_tile<0, true>(W, qdummy, Ql, Kl, Vl, 32 * kt, F.lane, nullptr, 0, 0);
        }
    }
#undef LAT_PREFETCH
    __syncthreads();
    LAS float* ML = (LAS float*)F.lds; LAS float* OB = (LAS float*)(F.lds + 4096);
    ML[(F.wave * 2 + 0) * 64 + F.lane] = W.m; ML[(F.wave * 2 + 1) * 64 + F.lane] = W.l;
#pragma unroll
    for (int dt = 0; dt < 4; ++dt)
#pragma unroll
        for (int i = 0; i < 16; ++i) OB[(F.wave * 64 + dt * 16 + i) * 64 + F.lane] = W.O[dt][i];
    __syncthreads();
    {
        float mi[4], li[4], mt = -1.0e30f;
#pragma unroll
        for (int k = 0; k < 4; ++k) { const int w2 = 2 * k + qh; mi[k] = ML[(w2 * 2 + 0) * 64 + F.lane]; li[k] = ML[(w2 * 2 + 1) * 64 + F.lane]; mt = fmaxf(mt, mi[k]); }
        float wk[4], lt = 0.f;
#pragma unroll
        for (int k = 0; k < 4; ++k) { wk[k] = __expf(mi[k] - mt); lt += wk[k] * li[k]; }
        const float inv = 1.0f / lt;
#pragma unroll
        for (int k = 0; k < 4; ++k) wk[k] *= inv;
        bf16* yrow = Y + (size_t)mq * YW + 1024 + hd * 128 + 32 * kt + 4 * h;
#pragma unroll
        for (int g4 = 0; g4 < 4; ++g4) {
            float o[4];
#pragma unroll
            for (int i = 0; i < 4; ++i) { float sacc = 0.f;
#pragma unroll
                for (int k = 0; k < 4; ++k) sacc += wk[k] * OB[((2 * k + qh) * 64 + kt * 16 + 4 * g4 + i) * 64 + F.lane];
                o[i] = sacc; }
            v2u w; w.x = cvtpk(o[0], o[1]); w.y = cvtpk(o[2], o[3]);
            *(v2u*)(yrow + 8 * g4) = w;
            asm volatile("" ::: "memory");
        }
    }
    __syncthreads();
}

constexpr int AW_OFF = 0, AV_OFF = 128 * KP, AST_OFF = AV_OFF + 128 * VP;
__device__ __forceinline__ void unitA(const Args& a, const Ctx& F, int l, int unit) {
    const int ch = unit >> 3, g = unit & 7, m0 = ch * 128;
    const bf16* Z = (const bf16*)(a.ws + WS_Z); bf16* Y = (bf16*)(a.ws + WS_Y);
    LAS float* st = (LAS float*)(F.lds + AST_OFF);
    __syncthreads();
    if (F.tid < 128) {
        const float* ap = (const float*)(a.ws + WS_AST) + (size_t)(m0 + F.tid) * 32;
        float sm = 0.f, sq = 0.f;
#pragma unroll
        for (int q = 0; q < 8; ++q) { const f32x4 v = *(const f32x4*)(ap + 4 * q); sm += v.x + v.z; sq += v.y + v.w; }
        const float mean = sm * (1.0f / 1024.0f), var = fmaxf(sq * (1.0f / 1024.0f) - mean * mean, 0.f);
        st[F.tid] = mean; st[128 + F.tid] = 1.0f / sqrtf(var + EPS);
    }
    {
        const int t = F.tid >> 2, s0 = 32 * (F.tid & 3);
        const float* wp = a.a_w + ((size_t)(l * 8 + g) * 128 + t) * 128 + s0;
#pragma unroll
        for (int q = 0; q < 4; ++q) { const f32x4 w0 = *(const f32x4*)(wp + 8 * q), w1 = *(const f32x4*)(wp + 8 * q + 4);
            v4u o; o.x = cvtpk(w0.x, w0.y); o.y = cvtpk(w0.z, w0.w); o.z = cvtpk(w1.x, w1.y); o.w = cvtpk(w1.z, w1.w);
            *(LAS v4u*)(F.lds + AW_OFF + t * KP + 2 * (s0 + 8 * q)) = o; }
    }
    __syncthreads();
    {
        const int s = F.tid >> 2, c0 = 32 * (F.tid & 3);
        const float mean = st[s], rstd = st[128 + s];
        const bf16* rp = Z + (size_t)(m0 + s) * INW + 1024 + 128 * g + c0;
#pragma unroll
        for (int q = 0; q < 4; ++q) { float x[8]; unpack8(*(const v4u*)(rp + 8 * q), x);
#pragma unroll
            for (int j = 0; j < 8; ++j) x[j] = (x[j] - mean) * rstd;
            *(LAS v4u*)(F.lds + AV_OFF + s * VP + 2 * (c0 + 8 * q)) = pack8(x); }
    }
    __syncthreads();
    const int lane = F.lane, r = lane & 31, h = lane >> 5, gq = (lane >> 4) & 1, q4 = (lane & 15) >> 2, p4 = lane & 3;
    const int ttile = F.wave & 3, ct0 = 2 * (F.wave >> 2);
    f32x16 acc[2];
#pragma unroll
    for (int c2 = 0; c2 < 2; ++c2)
#pragma unroll
        for (int i = 0; i < 16; ++i) acc[c2][i] = 0.f;
    {
        const LAS unsigned char* wp = F.lds + AW_OFF + (32 * ttile + r) * KP + 16 * h;
        const LAS unsigned char* vp = F.lds + AV_OFF + (8 * h + q4) * VP + 2 * (32 * ct0 + 16 * gq) + 8 * p4;
#pragma unroll
        for (int ks = 0; ks < 8; ++ks) {
            const bf16x8 wb = *(const LAS bf16x8*)(wp + 32 * ks);
#pragma unroll
            for (int c2 = 0; c2 < 2; ++c2) {
                const LAS unsigned char* v0 = vp + 16 * ks * VP + 64 * c2;
                acc[c2] = MFMA32(tr_pair(v0, v0 + 4 * VP), wb, acc[c2]);
            }
        }
    }
    {
        const int t = 32 * ttile + r; const float bsv = a.a_b[(l * 8 + g) * 128 + t];
        const bf16* up = Z + (size_t)(m0 + t) * INW + 128 * g + 4 * h; bf16* yp = Y + (size_t)(m0 + t) * YW + 128 * g + 4 * h;
#pragma unroll
        for (int c2 = 0; c2 < 2; ++c2)
#pragma unroll
            for (int g4 = 0; g4 < 4; ++g4) {
                const int c = 32 * (ct0 + c2) + 8 * g4;
                const v2u uw = *(const v2u*)(up + c);
                v2u o; o.x = cvtpk(bf2f_lo(uw.x) * (acc[c2][4 * g4] + bsv), bf2f_hi(uw.x) * (acc[c2][4 * g4 + 1] + bsv));
                o.y = cvtpk(bf2f_lo(uw.y) * (acc[c2][4 * g4 + 2] + bsv), bf2f_hi(uw.y) * (acc[c2][4 * g4 + 3] + bsv));
                *(v2u*)(yp + c) = o;
            }
    }
    __syncthreads();
}

constexpr int HP = 272;
constexpr int HG_QD = 0, HG_KD = 32 * HP, HG_KL = 2 * 32 * HP, HG_V = 3 * 32 * HP, HG_G = 4 * 32 * HP, HG_BUF = HG_G + 512, HG_DIR = 2 * HG_BUF;
struct HgPre { v4u q[2], v[2]; f32x4 f[4]; };
__device__ __forceinline__ void hg_load(HgPre& P, const bf16* Z, const float* LOGF, size_t m, int dir, int hd, int d0) {
    const bf16* zr = Z + m * INW + hd * 128 + d0; const float* fr = LOGF + m * 2048 + dir * 1024 + hd * 128 + d0;
    P.q[0] = *(const v4u*)(zr + 5120); P.q[1] = *(const v4u*)(zr + 5128); P.v[0] = *(const v4u*)(zr + 8192); P.v[1] = *(const v4u*)(zr + 8200);
#pragma unroll
    for (int j = 0; j < 4; ++j) P.f[j] = *(const f32x4*)(fr + 4 * j);
}
template <int CTRL, int ROWMASK> __device__ __forceinline__ float dpp_add(float x) {
    return x + __int_as_float(__builtin_amdgcn_update_dpp(0, __float_as_int(x), CTRL, ROWMASK, 0xF, true)); }
__device__ __forceinline__ float scan32(float x) {
    x = dpp_add<0x111, 0xF>(x); x = dpp_add<0x112, 0xF>(x); x = dpp_add<0x114, 0xF>(x); x = dpp_add<0x118, 0xF>(x); x = dpp_add<0x142, 0xA>(x); return x; }
__device__ __forceinline__ void hg_estep(const HgPre& P, LAS unsigned char* buf, int lane_, int w4) {
    int lane = lane_; asm volatile("" : "+v"(lane));
    const int tt = lane & 31, hf = lane >> 5, d0 = 32 * w4 + 16 * hf;
    float bl[16];
#pragma unroll
    for (int j = 0; j < 16; ++j) bl[j] = scan32(P.f[j >> 2][j & 3]);
    LAS unsigned char* row = buf + tt * HP + 2 * d0;
#pragma unroll
    for (int hh = 0; hh < 2; ++hh) {
        float qd[8], kd[8], kl[8];
        float q[8]; unpack8(P.q[hh], q);
#pragma unroll
        for (int j = 0; j < 8; ++j) { const int jj = 8 * hh + j; const float bC0 = __int_as_float(__builtin_amdgcn_readlane(__float_as_int(bl[jj]), 31)), bC1 = __int_as_float(__builtin_amdgcn_readlane(__float_as_int(bl[jj]), 63)); const float bC = hf ? bC1 : bC0; const float k = 1.0f - __builtin_amdgcn_exp2f(P.f[jj >> 2][jj & 3]);
            qd[j] = q[j] * __builtin_amdgcn_exp2f(bl[jj]); kd[j] = k * __builtin_amdgcn_exp2f(fminf(-bl[jj], 115.0f)); kl[j] = k * __builtin_amdgcn_exp2f(bC - bl[jj]); }
        *(LAS v4u*)(row + HG_QD + 16 * hh) = pack8(qd); *(LAS v4u*)(row + HG_KD + 16 * hh) = pack8(kd); *(LAS v4u*)(row + HG_KL + 16 * hh) = pack8(kl);
        asm volatile("" ::: "memory");
    }
    *(LAS v4u*)(row + HG_V) = P.v[0]; *(LAS v4u*)(row + HG_V + 16) = P.v[1];
    if (tt == 31) {
#pragma unroll
        for (int j4 = 0; j4 < 4; ++j4) *(LAS f32x4*)(buf + HG_G + 4 * (d0 + 4 * j4)) = (f32x4){__builtin_amdgcn_exp2f(bl[4 * j4]), __builtin_amdgcn_exp2f(bl[4 * j4 + 1]), __builtin_amdgcn_exp2f(bl[4 * j4 + 2]), __builtin_amdgcn_exp2f(bl[4 * j4 + 3])};
    }
}
__device__ __forceinline__ void hg_mstep(f32x16 (&S)[4], const LAS unsigned char* buf, int lane_, int w4, bf16* Og, int c, int n, int dir, int mbase, int hd) {
    int lane = lane_; asm volatile("" : "+v"(lane));
    const int r = lane & 31, h = lane >> 5, g = (lane >> 4) & 1, q4 = (lane & 15) >> 2, p4 = lane & 3;
    f32x16 X0;
#pragma unroll
    for (int i = 0; i < 16; ++i) X0[i] = 0.f;
    {   const LAS unsigned char* kp = buf + HG_KD + r * HP + 16 * h; const LAS unsigned char* qp = buf + HG_QD + r * HP + 16 * h;
#pragma unroll
        for (int ks = 0; ks < 8; ++ks) X0 = MFMA32(*(const LAS bf16x8*)(kp + 32 * ks), *(const LAS bf16x8*)(qp + 32 * ks), X0); }
    f32x16 O0;
#pragma unroll
    for (int i = 0; i < 16; ++i) O0[i] = 0.f;
    {
        const LAS unsigned char* qp = buf + HG_QD + r * HP + 8 * h;
#pragma unroll
        for (int dt = 0; dt < 4; ++dt)
#pragma unroll
            for (int st = 0; st < 2; ++st) {
                const s16x4 lo = *(const LAS s16x4*)(qp + 2 * (32 * dt + 16 * st)), hi = *(const LAS s16x4*)(qp + 2 * (32 * dt + 16 * st + 8));
                O0 = MFMA32(__builtin_shufflevector(lo, hi, 0, 1, 2, 3, 4, 5, 6, 7), pack_regs(S[dt], st), O0);
            }
    }
#pragma unroll
    for (int i = 0; i < 16; ++i) { const int srow = (i & 3) + 8 * (i >> 2) + 4 * h; X0[i] = (srow <= r) ? X0[i] : 0.f; }
    {
        const LAS unsigned char* vp = buf + HG_V + (4 * h + q4) * HP + 2 * (32 * w4 + 16 * g) + 8 * p4;
        O0 = MFMA32(pack_regs(X0, 0), tr_pair(vp, vp + 8 * HP), O0);
        O0 = MFMA32(pack_regs(X0, 1), tr_pair(vp + 16 * HP, vp + 24 * HP), O0);
    }
    asm volatile("" ::: "memory");
    {
        const LAS float* G = (const LAS float*)(buf + HG_G);
        const LAS unsigned char* vp = buf + HG_V + (8 * h + q4) * HP + 2 * (32 * w4 + 16 * g) + 8 * p4;
        const bf16x8 vb0 = tr_pair(vp, vp + 4 * HP), vb1 = tr_pair(vp + 16 * HP, vp + 20 * HP);
#pragma unroll
        for (int dt = 0; dt < 4; ++dt) {
#pragma unroll
            for (int g4 = 0; g4 < 4; ++g4) { const f32x4 gv = *(const LAS f32x4*)(G + 32 * dt + 8 * g4 + 4 * h);
#pragma unroll
                for (int jj = 0; jj < 4; ++jj) S[dt][4 * g4 + jj] *= gv[jj]; }
            const LAS unsigned char* kp = buf + HG_KL + (8 * h + q4) * HP + 2 * (32 * dt + 16 * g) + 8 * p4;
            S[dt] = MFMA32(tr_pair(kp, kp + 4 * HP), vb0, S[dt]);
            S[dt] = MFMA32(tr_pair(kp + 16 * HP, kp + 20 * HP), vb1, S[dt]);
                }
    }
    {
        const int tb = 32 * c + 4 * h; const int p0 = dir ? (n - 1 - tb) : tb, stp = dir ? -1024 : 1024;
        bf16* ob = Og + (size_t)mbase * 1024 + hd * 128 + 32 * w4;
        const int o0 = p0 * 1024 + r;
#pragma unroll
        for (int i = 0; i < 16; ++i) ob[o0 + ((i & 3) + 8 * (i >> 2)) * stp] = (bf16)(cvtpk(O0[i], 0.f) & 0xffffu);
    }
}
__device__ __forceinline__ void unitHgrn(const Args& a, const Ctx& F, int l, bool lat, int b, int hd, int dir0, int ndir) {
    const bf16* Z = (const bf16*)(a.ws + WS_Z); const float* LOGF = (const float*)(a.ws + WS_LOGF); bf16* Y = (bf16*)(a.ws + WS_Y);
    const int w4 = F.wave >> 1, lane = F.lane;
    LAS unsigned char* base = F.lds;
    const int n = lat ? 1024 : 256, mbase = lat ? NCTX + b * 1024 : b * 256, nch = n >> 5, ng = ndir * nch;
    __syncthreads();
    if ((F.wave & 1) == 0) {
        const int tt = lane & 31, d0 = 32 * w4 + 16 * (lane >> 5);
        HgPre P;
        hg_load(P, Z, LOGF, (size_t)(mbase + (dir0 ? (n - 1 - tt) : tt)), dir0, hd, d0);
        hg_estep(P, base, lane, w4);
        {   const int g1 = 1, sw1 = (g1 >= nch), dir1 = dir0 + sw1, c1 = g1 - sw1 * nch, p1 = 32 * c1 + tt; hg_load(P, Z, LOGF, (size_t)(mbase + (dir1 ? (n - 1 - p1) : p1)), dir1, hd, d0); }
        asm volatile("s_waitcnt lgkmcnt(0)" ::: "memory"); __builtin_amdgcn_s_barrier(); asm volatile("" ::: "memory");
#pragma unroll 1
        for (int g = 0; g < ng; ++g) {
            if (g + 1 < ng) {
                hg_estep(P, base + ((g + 1) & 1) * HG_BUF, lane, w4);
                if (g + 2 < ng) { const int g2 = g + 2, sw2 = (g2 >= nch), dir2 = dir0 + sw2, c2 = g2 - sw2 * nch, p2 = 32 * c2 + tt; hg_load(P, Z, LOGF, (size_t)(mbase + (dir2 ? (n - 1 - p2) : p2)), dir2, hd, d0); }
            }
            asm volatile("s_waitcnt lgkmcnt(0)" ::: "memory"); __builtin_amdgcn_s_barrier(); asm volatile("" ::: "memory");
        }
    } else {
        const int r = lane & 31, h = lane >> 5, h512 = 512 * h;
        f32x16 S[4];
        if (lat) {
            const float* sp = a.state + ((((size_t)b * 4 + l) * 2 + dir0) * 8 + hd) * 16384 + 32 * w4 + r;
#pragma unroll
            for (int dt = 0; dt < 4; ++dt)
#pragma unroll
                for (int i = 0; i < 16; ++i) S[dt][i] = sp[(32 * dt + (i & 3) + 8 * (i >> 2)) * 128 + h512];
        } else {
#pragma unroll
            for (int dt = 0; dt < 4; ++dt)
#pragma unroll
                for (int i = 0; i < 16; ++i) S[dt][i] = 0.f;
        }
        asm volatile("s_waitcnt lgkmcnt(0)" ::: "memory"); __builtin_amdgcn_s_barrier(); asm volatile("" ::: "memory");
#pragma unroll 1
        for (int g = 0; g < ng; ++g) {
            const int sw = (g >= nch), dir = dir0 + sw, c = g - sw * nch;
            if (g == nch) {
                if (!lat) {
                    float* so = a.out + OUT_S + ((((size_t)b * 4 + l) * 2 + 0) * 8 + hd) * 16384 + 32 * w4 + r;
#pragma unroll
                    for (int dt = 0; dt < 4; ++dt)
#pragma unroll
                        for (int i = 0; i < 16; ++i) { so[(32 * dt + (i & 3) + 8 * (i >> 2)) * 128 + h512] = S[dt][i]; S[dt][i] = 0.f; }
                } else {
                    const float* sp = a.state + ((((size_t)b * 4 + l) * 2 + 1) * 8 + hd) * 16384 + 32 * w4 + r;
#pragma unroll
                    for (int dt = 0; dt < 4; ++dt)
#pragma unroll
                        for (int i = 0; i < 16; ++i) S[dt][i] = sp[(32 * dt + (i & 3) + 8 * (i >> 2)) * 128 + h512];
                }
            }
            hg_mstep(S, base + (g & 1) * HG_BUF, lane, w4, (bf16*)(a.ws + (dir ? WS_OB : WS_OF)), c, n, dir, mbase, hd);
            asm volatile("s_waitcnt lgkmcnt(0)" ::: "memory"); __builtin_amdgcn_s_barrier(); asm volatile("" ::: "memory");
        }
        if (!lat) {
            float* so = a.out + OUT_S + ((((size_t)b * 4 + l) * 2 + 1) * 8 + hd) * 16384 + 32 * w4 + r;
#pragma unroll
            for (int dt = 0; dt < 4; ++dt)
#pragma unroll
                for (int i = 0; i < 16; ++i) so[(32 * dt + (i & 3) + 8 * (i >> 2)) * 128 + h512] = S[dt][i];
        }
    }
    if (lat) {
        __syncthreads();
        volatile LAS unsigned* bc = (volatile LAS unsigned*)(F.lds + LDSCTL_OFF) + 5;
        if (F.tid == 0) {
            __builtin_amdgcn_fence(__ATOMIC_RELEASE, "agent"); asm volatile("s_waitcnt vmcnt(0)" ::: "memory");
            const unsigned old = __hip_atomic_fetch_add((unsigned*)(a.ws + WS_CTL) + CW_LC + 64 * (l * 16 + b * 8 + hd), 1u, __ATOMIC_RELAXED, __HIP_MEMORY_SCOPE_AGENT);
            if (old == 1u) { __builtin_amdgcn_fence(__ATOMIC_ACQUIRE, "agent"); asm volatile("s_waitcnt vmcnt(0)" ::: "memory"); }
            bc[0] = old;
        }
        __syncthreads();
        if (bc[0] != 1u) { __syncthreads(); return; }
    }
    __syncthreads();
    {
        const bf16* OFp = (const bf16*)(a.ws + WS_OF); const bf16* OBp = (const bf16*)(a.ws + WS_OB);
        const int e16 = 16 * (F.tid & 7);
#pragma unroll 1
        for (int t0 = 0; t0 < n; t0 += 128) {
            v4u rf[2][2], rb[2][2], rg[2][2];
#pragma unroll
            for (int q = 0; q < 2; ++q) { const size_t m = (size_t)(mbase + t0 + 64 * q + (F.tid >> 3));
#pragma unroll
                for (int j2 = 0; j2 < 2; ++j2) { rf[q][j2] = *((const v4u*)(OFp + m * 1024 + hd * 128 + e16) + j2); rb[q][j2] = *((const v4u*)(OBp + m * 1024 + hd * 128 + e16) + j2);
                    rg[q][j2] = *(const v4u*)(Z + m * INW + 9216 + hd * 128 + e16 + 8 * j2); } }
#pragma unroll
            for (int q = 0; q < 2; ++q) { const size_t m = (size_t)(mbase + t0 + 64 * q + (F.tid >> 3));
                float o[16]; float ss = 0.f;
#pragma unroll
                for (int j2 = 0; j2 < 2; ++j2) { float pf[8], pb[8]; unpack8(rf[q][j2], pf); unpack8(rb[q][j2], pb);
#pragma unroll
                    for (int k = 0; k < 8; ++k) { const float sv = pf[k] + pb[k]; o[8 * j2 + k] = sv; ss += sv * sv; } }
                ss += __shfl_xor(ss, 1); ss += __shfl_xor(ss, 2); ss += __shfl_xor(ss, 4);
                const float rn = 1.0f / sqrtf(ss * (1.0f / 128.0f) + EPS);
                float g0[8], g1[8]; unpack8(rg[q][0], g0); unpack8(rg[q][1], g1);
                float y0[8], y1[8];
#pragma unroll
                for (int k = 0; k < 8; ++k) { y0[k] = o[k] * rn * g0[k]; y1[k] = o[8 + k] * rn * g1[k]; }
                *(v4u*)(Y + m * YW + 2048 + hd * 128 + e16) = pack8(y0); *(v4u*)(Y + m * YW + 2048 + hd * 128 + e16 + 8) = pack8(y1); }
        }
    }
    __syncthreads();
}

__device__ __forceinline__ const Args* args_ptr() { unsigned long long p = (unsigned long long)__builtin_amdgcn_kernarg_segment_ptr(); asm volatile("" : "+s"(p)); return (const Args*)(const void __attribute__((address_space(4)))*)p; }
__device__ __forceinline__ Ctx make_ctx() {
    Ctx F; int t = threadIdx.x; asm volatile("" : "+v"(t));
    unsigned z = 0; asm volatile("" : "+s"(z));
    F.lds = (LAS unsigned char*)(uintptr_t)z;
    F.tid = t; F.lane = t & 63; F.wave = __builtin_amdgcn_readfirstlane(t >> 6);
    F.G = gridDim.x; { const int bx = blockIdx.x; F.vcu = (F.G % 8 == 0) ? (bx % 8) * (F.G / 8) + bx / 8 : bx; }
    return F;
}
constexpr int NU_CV = 800, NU_HL = 32, NU_AL = 256, NU_HC = 256, NU_AC = 256, NU_A = 640, NU_M1 = NU_HL + NU_AL + NU_HC + NU_AC + NU_A;
#ifndef PROBE_UT
#define PROBE_UT (-1)
#endif
__device__ __forceinline__ void phase_mixers(int l, int qslot) {
    for (;;) {
        int u;
        {   const Args& a = *args_ptr(); const Ctx F = make_ctx();
            unsigned* head = (unsigned*)(a.ws + WS_CTL) + CW_Q + 64 * qslot;
            volatile LAS unsigned* bc = (volatile LAS unsigned*)(F.lds + LDSCTL_OFF) + 4;
            __syncthreads();
            if (F.tid == 0) bc[0] = __hip_atomic_fetch_add(head, 1u, __ATOMIC_RELAXED, __HIP_MEMORY_SCOPE_AGENT);
            __syncthreads();
            u = (int)bc[0]; }
        u = __builtin_amdgcn_readfirstlane(u);
        if (u < NU_HL) { for (int rr = 0; rr < (PROBE_UT == 0 ? 2 : 1); ++rr) { const Args& a = *args_ptr(); const Ctx F = make_ctx(); unitHgrn(a, F, l, true, u >> 4, (u >> 1) & 7, u & 1, 1); } continue; }
        u -= NU_HL;
        if (l < DEPTH - 1) {
            if (u >= 3 * NU_CV) break;
            const int trip = u / 3, pos = u - 3 * trip;
            if (pos == 2) {
                const Args& a = *args_ptr(); const Ctx F = make_ctx();
                LAS float* scr = (LAS float*)(F.lds + F.wave * 16640);
                cvt_three(a, l + 1, trip * 24 + F.wave, 8, scr, F.lane);
                continue;
            }
            u = 2 * trip + pos;
            if (u >= NU_M1 - NU_HL) continue;
        } else if (u >= NU_M1 - NU_HL) break;
        if (u < NU_HC) { for (int rr = 0; rr < (PROBE_UT == 2 ? 2 : 1); ++rr) { const Args& a = *args_ptr(); const Ctx F = make_ctx(); unitHgrn(a, F, l, false, u >> 3, u & 7, 0, 2); } continue; }
        u -= NU_HC;
        if (u < NU_AL) { for (int rr = 0; rr < (PROBE_UT == 1 ? 2 : 1); ++rr) { const Args& a = *args_ptr(); const Ctx F = make_ctx(); unitAttnLat(a, F, l, u); } continue; }
        u -= NU_AL;
        if (u < NU_AC) { for (int rr = 0; rr < (PROBE_UT == 3 ? 2 : 1); ++rr) { const Args& a = *args_ptr(); const Ctx F = make_ctx(); unitAttnCtx(a, F, u); } continue; }
        u -= NU_AC;
        for (int rr = 0; rr < (PROBE_UT == 4 ? 2 : 1); ++rr) { const Args& a = *args_ptr(); const Ctx F = make_ctx(); unitA(a, F, l, u); }
    }
}

__global__ void __launch_bounds__(NTHR, 2) fwd(Args a_in) {
    extern __shared__ __attribute__((aligned(16))) unsigned char lds_raw[];
    volatile LAS unsigned* MISC = (volatile LAS unsigned*)((LAS unsigned char*)lds_raw + LDSCTL_OFF);
    for (int u = threadIdx.x; u < 256; u += NTHR) MISC[u] = 0u;
    __syncthreads();
    const int lo = a_in.ph_lo, hi = a_in.ph_hi;
    const bool multi = (hi - lo) > 1;
    XcdBarrier bar; bar.bar = (unsigned*)(a_in.ws + WS_CTL) + CW_BAR; bar.x = 0; bar.st = MISC;
    if (multi) bar = xcd_barrier_post((unsigned*)(a_in.ws + WS_CTL) + CW_BAR, MISC);
#ifndef PMASK
#define PMASK 0xFFFFFFFFu
#endif
#define PM(b) ((PMASK >> (b)) & 1u)
#define IN(k) (lo <= (k) && (k) < hi)
#ifndef TS_PHASE
#define TS_PHASE (-1)
#define TS_MULT 0
#endif
    unsigned long long ts0 = 0ull, tsd = 0ull;
#define TS_START(gp) do { if (TS_PHASE >= 0 && (gp) == TS_PHASE) ts0 = __builtin_amdgcn_s_memrealtime(); } while (0)
#define SEAM(k) do { if (IN(k) && IN((k) + 1)) xcd_barrier(bar); if (TS_PHASE >= 0 && (k) == TS_PHASE) tsd = __builtin_amdgcn_s_memrealtime() - ts0; } while (0)
#ifndef PROBE_P
#define PROBE_P (-1)
#define PROBE_N 0
#define PROBE_L 1
#endif
#define REP_BEGIN(k) for (int rep = 0; rep < ((PROBE_P == (k) && l == PROBE_L) ? 1 + PROBE_N : 1); ++rep) {
#define REP_END(k) if (PROBE_P == (k) && l == PROBE_L && rep < PROBE_N) xcd_barrier(bar); }

    if (PM(0) && IN(PH_PRO)) { const int l = PROBE_L; TS_START(PH_PRO); REP_BEGIN(0) const Args& a = *args_ptr(); const Ctx F = make_ctx(); phase_prologue(a, F); REP_END(0) SEAM(PH_PRO); }
    if (PM(1) && IN(PH_T1)) { const int l = PROBE_L; TS_START(PH_T1); REP_BEGIN(1) const Args& a = *args_ptr(); const Ctx F = make_ctx(); const float* MOD = (const float*)(a.ws + WS_MOD);
        rownorm_phase(a, F, true, nullptr, nullptr, nullptr, true, a.norm_g + 0, MOD + 1 * 2048, MOD + 0 * 2048); REP_END(1) SEAM(PH_T1); }

    for (int l = 0; l < DEPTH; ++l) {
        const int pb = PH_L0 + l * PH_PER_LAYER;
        if (PM(2) && IN(pb + 0)) { TS_START(pb + 0); REP_BEGIN(2)
            const Args& a = *args_ptr(); const Ctx F = make_ctx(); unsigned char* ws = a.ws; const bf16* wl = (const bf16*)(ws + WS_WT) + (size_t)l * WL_ELEMS;
            pg8::Gemm g{(const bf16*)(ws + WS_H), wl + OFF_IN, MTOK, INW, DM, DM, DM, 0}; pg8::ReverseNOrder S; S.init(MTOK, INW, F.G, (int)blockIdx.x);
            EpiIn E{(bf16*)(ws + WS_Z), (float*)(ws + WS_LOGF), (const float*)(ws + WS_LB) + l * 1024, a.out + OUT_K + (size_t)l * 262144, a.out + OUT_V + (size_t)l * 262144, (float*)(ws + WS_AST)};
            pg8::gemm_phase<EpiIn, pg8::ReverseNOrder, true, true>(F.lds, g, S, E);
            REP_END(2) SEAM(pb + 0);
        }
        if (PM(3) && IN(pb + 1)) { TS_START(pb + 1); REP_BEGIN(3) phase_mixers(l, l + 4 * rep); REP_END(3) SEAM(pb + 1); }
        if (PM(5) && IN(pb + 3)) { TS_START(pb + 3); REP_BEGIN(5)
            const Args& a = *args_ptr(); const Ctx F = make_ctx(); unsigned char* ws = a.ws; const bf16* wl = (const bf16*)(ws + WS_WT) + (size_t)l * WL_ELEMS;
            pg8::StaticOrder S; S.init(MTOK, DM, F.G, (int)blockIdx.x);
            pg8::Gemm g{(const bf16*)(ws + WS_Y), wl + OFF_UP, MTOK, DM, YW, YW, YW, 0}; EpiUpK E{(const bf16*)(ws + WS_Z) + 10240, (bf16*)(ws + WS_MG)};
            pg8::gemm_phase<EpiUpK, pg8::StaticOrder, true, true>(F.lds, g, S, E);
            REP_END(5) SEAM(pb + 3);
        }
        if (PM(6) && IN(pb + 4)) { TS_START(pb + 4); REP_BEGIN(6)
            {   const Args& a = *args_ptr(); const Ctx F = make_ctx(); unsigned char* ws = a.ws; const bf16* wl = (const bf16*)(ws + WS_WT) + (size_t)l * WL_ELEMS;
                pg8::Gemm g{(const bf16*)(ws + WS_MG), wl + OFF_OUT, NCTX, DM, DM, DM, DM, 0}; pg8::StaticOrder S; S.init(NCTX, DM, F.G, (int)blockIdx.x);
                EpiBf16P E{(bf16*)(ws + WS_T), DM, 0}; pg8::gemm_phase<EpiBf16P, pg8::StaticOrder, true, true>(F.lds, g, S, E); }
            {   const Args& a = *args_ptr(); const Ctx F = make_ctx(); unsigned char* ws = a.ws; const bf16* wl = (const bf16*)(ws + WS_WT) + (size_t)l * WL_ELEMS;
                pg8::Gemm g{(const bf16*)(ws + WS_MG) + (size_t)NCTX * DM, wl + OFF_OUT, NLAT, DM, DM / 4, DM, DM, (DM / 4) * 2}; pg8::SplitOrder S; S.init(F.G, (int)blockIdx.x);
                EpiBf16P E{(bf16*)(ws + WS_TP), DM, TPQ}; pg8::gemm_phase<EpiBf16P, pg8::SplitOrder, true, true>(F.lds, g, S, E); }
            REP_END(6) SEAM(pb + 4);
        }
        if (PM(7) && IN(pb + 5)) { TS_START(pb + 5); REP_BEGIN(7) const Args& a = *args_ptr(); const Ctx F = make_ctx(); const float* modl = (const float*)(a.ws + WS_MOD) + (size_t)l * 3 * 12288; const float* gl = a.norm_g + (size_t)l * 4 * DM;
            rownorm_phase(a, F, false, (const bf16*)(a.ws + WS_T), modl + 2 * 2048, gl + 1 * DM, true, gl + 2 * DM, modl + 4 * 2048, modl + 3 * 2048); REP_END(7) SEAM(pb + 5); }
        if (PM(8) && IN(pb + 6)) { TS_START(pb + 6); REP_BEGIN(8)
            const Args& a = *args_ptr(); const Ctx F = make_ctx(); unsigned char* ws = a.ws; const bf16* wl = (const bf16*)(ws + WS_WT) + (size_t)l * WL_ELEMS;
            pg8::Gemm g{(const bf16*)(ws + WS_H), wl + OFF_FI, MTOK, NFI, DM, DM, DM, 0}; pg8::StaticOrder S; S.init(MTOK, NFI, F.G, (int)blockIdx.x);
            EpiSwi E{(bf16*)(ws + WS_ACT)}; pg8::gemm_phase<EpiSwi, pg8::StaticOrder, true, true>(F.lds, g, S, E);
            REP_END(8) SEAM(pb + 6);
        }
        if (PM(9) && IN(pb + 7)) { TS_START(pb + 7); REP_BEGIN(9)
            {   const Args& a = *args_ptr(); const Ctx F = make_ctx(); unsigned char* ws = a.ws; const bf16* wl = (const bf16*)(ws + WS_WT) + (size_t)l * WL_ELEMS;
                pg8::Gemm g{(const bf16*)(ws + WS_ACT), wl + OFF_FO, NCTX, DM, DFF, DFF, DFF, 0}; pg8::StaticOrder S; S.init(NCTX, DM, F.G, (int)blockIdx.x);
                EpiBf16P E{(bf16*)(ws + WS_T), DM, 0}; pg8::gemm_phase<EpiBf16P, pg8::StaticOrder, true, true>(F.lds, g, S, E); }
            {   const Args& a = *args_ptr(); const Ctx F = make_ctx(); unsigned char* ws = a.ws; const bf16* wl = (const bf16*)(ws + WS_WT) + (size_t)l * WL_ELEMS;
                pg8::Gemm g{(const bf16*)(ws + WS_ACT) + (size_t)NCTX * DFF, wl + OFF_FO, NLAT, DM, DFF / 4, DFF, DFF, (DFF / 4) * 2}; pg8::SplitOrder S; S.init(F.G, (int)blockIdx.x);
                EpiBf16P E{(bf16*)(ws + WS_TP), DM, TPQ}; pg8::gemm_phase<EpiBf16P, pg8::SplitOrder, true, true>(F.lds, g, S, E); }
            REP_END(9) SEAM(pb + 7);
        }
        if (PM(10) && IN(pb + 8)) { TS_START(pb + 8); REP_BEGIN(10)
            const Args& a = *args_ptr(); const Ctx F = make_ctx(); const float* MOD = (const float*)(a.ws + WS_MOD);
            const bool last = (l == DEPTH - 1); const int ln = last ? l : l + 1;
            const float* modl = MOD + (size_t)l * 3 * 12288; const float* gl = a.norm_g + (size_t)l * 4 * DM;
            const float* modn = MOD + (size_t)ln * 3 * 12288; const float* gnn = a.norm_g + (size_t)ln * 4 * DM;
            rownorm_phase(a, F, false, (const bf16*)(a.ws + WS_T), modl + 5 * 2048, gl + 3 * DM, !last, gnn + 0, modn + 1 * 2048, modn + 0 * 2048);
            REP_END(10) SEAM(pb + 8);
        }
    }
    if (TS_PHASE >= 0 && blockIdx.x == 0 && threadIdx.x == 0) { const unsigned long long t0 = __builtin_amdgcn_s_memrealtime(); while (__builtin_amdgcn_s_memrealtime() - t0 < (unsigned long long)TS_MULT * tsd) __builtin_amdgcn_s_sleep(8); }
#undef IN
#undef SEAM
#undef REP_BEGIN
#undef REP_END
}

#ifndef MK_ONE_LAUNCH
#define MK_ONE_LAUNCH 1
#endif
extern "C" void kernel_launch(void* const* d_in, const int* in_sizes, int n_in, void* d_out, int out_size, void* d_ws, size_t ws_size, hipStream_t stream) {
    static int grid = 0;
    if (grid == 0) {
        if (n_in != 21 || (size_t)out_size != OUT_END || ws_size < WS_END) { fprintf(stderr, "kernel_launch: unexpected shapes: n_in %d out %d ws %zu\n", n_in, out_size, ws_size); grid = -1; return; }
        int dev = 0, cus = 0, per_cu = 0;
        if (hipGetDevice(&dev) != hipSuccess || hipDeviceGetAttribute(&cus, hipDeviceAttributeMultiprocessorCount, dev) != hipSuccess) { grid = -1; return; }
        if (hipFuncSetAttribute((const void*)fwd, hipFuncAttributeMaxDynamicSharedMemorySize, LDS_BYTES) != hipSuccess) { fprintf(stderr, "kernel_launch: hipFuncSetAttribute failed\n"); grid = -1; return; }
        if (hipOccupancyMaxActiveBlocksPerMultiprocessor(&per_cu, (const void*)fwd, NTHR, LDS_BYTES) != hipSuccess || per_cu < 1) fprintf(stderr, "kernel_launch: occupancy query says %d\n", per_cu);
        (void)hipGetLastError();
        grid = cus;
    }
    if (grid < 0) return;
    (void)hipMemsetAsync((char*)d_ws + WS_CTL, 0, CTL_ZERO_BYTES, stream);
    Args a{};
    const float** ap = (const float**)&a;
    for (int i = 0; i < 21; ++i) ap[i] = (const float*)d_in[i];
    a.out = (float*)d_out; a.ws = (unsigned char*)d_ws;
#if MK_ONE_LAUNCH
    a.ph_lo = 0; a.ph_hi = PH_END;
    hipLaunchKernelGGL(fwd, dim3(grid), dim3(NTHR), LDS_BYTES, stream, a);
#else
    for (int p = 0; p < PH_END; ++p) { a.ph_lo = p; a.ph_hi = p + 1; hipLaunchKernelGGL(fwd, dim3(grid), dim3(NTHR), LDS_BYTES, stream, a); }
#endif
}
```

```cpp
#include <hip/hip_runtime.h>
#include <cstdio>
#include <cstdint>
namespace pg8 {
#define PG8_LAS __attribute__((address_space(3)))
typedef unsigned short bf16_t;
typedef short bf16x8 __attribute__((ext_vector_type(8)));
typedef float f32x4 __attribute__((ext_vector_type(4)));
typedef unsigned u32x4 __attribute__((ext_vector_type(4)));
constexpr int BM = 256, BK = 64, HALF = 128, HTB = HALF * BK * 2  , STAGE_BYTES = 8 * HTB, NXCD = 8, WGM = 8;

__host__ __device__ __forceinline__ int lds_byte(int r, int c) { const int st = (r >> 4) * 2 + (c >> 5), rr = r & 15, cc = c & 31, ob = rr * 64 + cc * 2; return st * 1024 + (ob ^ (((ob >> 9) & 1) << 5)); }
__host__ __device__ __forceinline__ void stage_rc(int b, int& R, int& C) { const int st = b / 1024, sb = b % 1024, swz = sb ^ (((sb >> 9) & 1) << 5); R = (st >> 1) * 16 + swz / 64; C = (st & 1) * 32 + (swz % 64) / 2; }
__host__ __device__ __forceinline__ int perm32(int rho) { const int n = rho >> 4, i = rho & 15; return 8 * (i >> 2) + 4 * n + (i & 3); }

struct Unit { int pm, pn, kq; };
struct SplitOrder {
    int G, c;
    __host__ __device__ void init(int G_, int c_) { G = G_; c = c_; }
    __host__ __device__ bool next(int i, Unit& u) const { const long L = (long)i * G + c; if (L >= 256) return false; const int t = (int)L >> 2; u.kq = (int)L & 3; u.pm = t & 7; u.pn = t >> 3; return true; }
    __device__ __forceinline__ void a_ready(const Unit&) const {}
    __device__ __forceinline__ void done(const Unit&) const {}
};
struct TailOrder {
    int G, c, pm0;
    __host__ __device__ void init(int G_, int c_, int pm0_) { G = G_; c = c_; pm0 = pm0_; }
    __host__ __device__ bool next(int i, Unit& u) const { const long L = (long)i * G + c; if (L >= 64) return false; u.pm = pm0 + ((int)L & 7); u.pn = (int)L >> 3; u.kq = 0; return true; }
    __device__ __forceinline__ void a_ready(const Unit&) const {}
    __device__ __forceinline__ void done(const Unit&) const {}
};
struct Gemm { const bf16_t* A; const bf16_t* Bt; int M, N, K, lda, ldb, koff; };

struct StaticOrder {
    int nM, nN, nwg, G, c;
    __host__ __device__ void init(int M, int N, int G_, int c_) { nM = M / BM; nN = N / BM; nwg = nM * nN; G = G_; c = c_; }
    __host__ __device__ bool next(int i, Unit& u) const {
        const long L = (long)i * G + c; if (L >= nwg) return false;
        int wgid = (int)L; { const int q = nwg / NXCD, r = nwg % NXCD, xcd = wgid % NXCD, off = wgid / NXCD; wgid = (xcd < r ? xcd * (q + 1) : r * (q + 1) + (xcd - r) * q) + off; }
        const int nig = WGM * nN, gid = wgid / nig, fm = gid * WGM, gsz = (nM - fm) < WGM ? (nM - fm) : WGM;
        u.pm = fm + ((wgid % nig) % gsz); u.pn = (wgid % nig) / gsz; u.kq = 0; return true;
    }
    __device__ __forceinline__ void a_ready(const Unit&) const {}
    __device__ __forceinline__ void done(const Unit&) const {}
};
struct SubOrder : StaticOrder {
    __host__ __device__ void init(int M, int N, int G_, int c_, int c0) { StaticOrder::init(M, N, G_ - c0, c_ - c0); }
    __host__ __device__ bool next(int i, Unit& u) const { if (c < 0) return false; return StaticOrder::next(i, u); }
};
struct ReverseNOrder : StaticOrder {
    __host__ __device__ bool next(int i, Unit& u) const { if (!StaticOrder::next(i, u)) return false; u.pn = nN - 1 - u.pn; return true; }
};
template <class Epi, class Sched, bool ALIGN_EPI = false, bool SP2 = false>
__device__ __forceinline__ void gemm_phase(PG8_LAS unsigned char* lds, const Gemm g, const Sched& S, const Epi& E) {
    int tid_ = threadIdx.x; asm volatile("" : "+v"(tid_));
    const int tid = tid_, wid = __builtin_amdgcn_readfirstlane(tid >> 6), lane = tid & 63, wr = wid >> 2, wc = wid & 3, fr = lane & 15, fq = lane >> 4;
    const int K = g.K, nt = K / BK;
    unsigned voffA[2], voffB[2];
#pragma unroll
    for (int i = 0; i < 2; ++i) { int R, C; stage_rc(tid * 16 + i * 8192, R, C); const int Rb = Epi::PERM ? ((R & ~31) + perm32(R & 31)) : R;
        voffA[i] = (unsigned)(R * g.lda + C) * 2u; voffB[i] = (unsigned)(Rb * g.ldb + C) * 2u; }
    const size_t kstep = (size_t)(BK * 2);
    const size_t hstepA = (size_t)HALF * g.lda * 2, hstepB = (size_t)HALF * g.ldb * 2;
    const size_t tstepA = 2 * hstepA, tstepB = 2 * hstepB;
    const unsigned ldsw = (unsigned)wid * 1024u;
    const int aoff = lds_byte(wr * 64 + fr, fq * 8), boff = lds_byte(wc * 32 + fr, fq * 8);
#define PG8_SA(b, h) (((b) * 2 + (h)) * HTB)
#define PG8_SB(b, h) ((4 + (b) * 2 + (h)) * HTB)
#define PG8_STAGE(bufoff, gbase, voff) do { _Pragma("unroll") for (int _i = 0; _i < 2; ++_i) \
        __builtin_amdgcn_global_load_lds((const unsigned*)((const char*)(gbase) + (voff)[_i]), (PG8_LAS unsigned*)(lds + (bufoff) + ldsw + _i * 8192), 16, 0, 0); } while (0)
#define PG8_LDA(dst, b, h) do { _Pragma("unroll") for (int m = 0; m < 4; ++m) _Pragma("unroll") for (int k = 0; k < 2; ++k) dst[m][k] = *(const PG8_LAS bf16x8*)(lds + PG8_SA(b, h) + aoff + m * 2048 + k * 1024); } while (0)
#define PG8_LDB(dst, b, h) do { _Pragma("unroll") for (int n = 0; n < 2; ++n) _Pragma("unroll") for (int k = 0; k < 2; ++k) dst[n][k] = *(const PG8_LAS bf16x8*)(lds + PG8_SB(b, h) + boff + n * 2048 + k * 1024); } while (0)
#define PG8_MMA(ai, bj, At, Bt) do { __builtin_amdgcn_s_setprio(1); _Pragma("unroll") for (int m = 0; m < 4; ++m) _Pragma("unroll") for (int n = 0; n < 2; ++n) _Pragma("unroll") for (int k = 0; k < 2; ++k) \
        acc[ai][bj][m][n] = __builtin_amdgcn_mfma_f32_16x16x32_bf16(Bt[n][k], At[m][k], acc[ai][bj][m][n], 0, 0, 0); __builtin_amdgcn_s_setprio(0); } while (0)
#define PG8_WAIT_V(n) asm volatile("s_waitcnt vmcnt(" #n ")" ::: "memory")
#define PG8_WAIT_L(n) asm volatile("s_waitcnt lgkmcnt(" #n ")" ::: "memory")
#define PG8_BAR __builtin_amdgcn_s_barrier()
#define PG8_SCHED __builtin_amdgcn_sched_barrier(0)
    Unit cur, nxt; int ui = 0;
    if (!S.next(0, cur)) return;
    f32x4 acc[2][2][4][2];
#pragma unroll
    for (int a = 0; a < 2; ++a)
#pragma unroll
        for (int b = 0; b < 2; ++b)
#pragma unroll
            for (int m = 0; m < 4; ++m)
#pragma unroll
                for (int n = 0; n < 2; ++n) acc[a][b][m][n] = (f32x4){0.f, 0.f, 0.f, 0.f};
    bf16x8 At[4][2], B0[2][2], B1[2][2];
    const char* cA = (const char*)g.A + (size_t)cur.pm * tstepA + (size_t)cur.kq * g.koff; const char* cB = (const char*)g.Bt + (size_t)cur.pn * tstepB + (size_t)cur.kq * g.koff;
    S.a_ready(cur);
    if constexpr (SP2) {
        PG8_STAGE(PG8_SB(0, 0), cB, voffB); PG8_STAGE(PG8_SB(0, 1), cB + hstepB, voffB); PG8_STAGE(PG8_SA(0, 0), cA, voffA); PG8_STAGE(PG8_SA(0, 1), cA + hstepA, voffA);
        if (wr == 1) PG8_BAR;
        PG8_WAIT_V(2); PG8_BAR;
        PG8_STAGE(PG8_SB(1, 0), cB + kstep, voffB); PG8_STAGE(PG8_SA(1, 0), cA + kstep, voffA); PG8_STAGE(PG8_SB(1, 1), cB + hstepB + kstep, voffB);
        PG8_WAIT_V(6); PG8_BAR;
    } else {
        PG8_STAGE(PG8_SB(0, 0), cB, voffB); PG8_STAGE(PG8_SA(0, 0), cA, voffA); PG8_STAGE(PG8_SB(0, 1), cB + hstepB, voffB); PG8_STAGE(PG8_SA(0, 1), cA + hstepA, voffA);
        if (wr == 1) PG8_BAR;
        PG8_WAIT_V(4); PG8_BAR;
        PG8_STAGE(PG8_SB(1, 0), cB + kstep, voffB); PG8_STAGE(PG8_SA(1, 0), cA + kstep, voffA); PG8_STAGE(PG8_SB(1, 1), cB + hstepB + kstep, voffB);
        PG8_WAIT_V(6); PG8_BAR;
    }
    for (;;) {
        const bool has_next = S.next(ui + 1, nxt);
        const char* nA = has_next ? (const char*)g.A + (size_t)nxt.pm * tstepA + (size_t)nxt.kq * g.koff : cA; const char* nB = has_next ? (const char*)g.Bt + (size_t)nxt.pn * tstepB + (size_t)nxt.kq * g.koff : cB;
        for (int t = 0; t < nt; t += 2) {
            const bool last = (t == nt - 2);
            const char* a1 = cA + (size_t)(t + 1) * kstep;
            const char* a2 = last ? nA : cA + (size_t)(t + 2) * kstep; const char* b2 = last ? nB : cB + (size_t)(t + 2) * kstep;
            const char* a3 = a2 + kstep; const char* b3 = b2 + kstep;
            if (last && has_next) S.a_ready(nxt);
            if constexpr (Epi::HOOK) { if (t == Epi::H1 || t == Epi::H2) E.hook(acc, cur, t, wr, wc, fr, fq); }
            if constexpr (SP2) {
            PG8_LDB(B0, 0, 0); PG8_LDB(B1, 0, 1); PG8_SCHED; PG8_LDA(At, 0, 0); PG8_STAGE(PG8_SA(1, 1), a1 + hstepA, voffA);
            PG8_WAIT_V(8); PG8_WAIT_L(0); PG8_BAR; PG8_MMA(0, 0, At, B0); PG8_MMA(0, 1, At, B1); PG8_BAR; PG8_SCHED;
            PG8_LDA(At, 0, 1); PG8_STAGE(PG8_SB(0, 0), b2, voffB); PG8_STAGE(PG8_SB(0, 1), b2 + hstepB, voffB); PG8_STAGE(PG8_SA(0, 0), a2, voffA);
            PG8_WAIT_V(8); PG8_WAIT_L(0); PG8_BAR; PG8_MMA(1, 0, At, B0); PG8_MMA(1, 1, At, B1); PG8_BAR; PG8_SCHED;
            PG8_LDB(B0, 1, 0); PG8_LDB(B1, 1, 1); PG8_SCHED; PG8_LDA(At, 1, 0); PG8_STAGE(PG8_SA(0, 1), a2 + hstepA, voffA);
            PG8_WAIT_V(8); PG8_WAIT_L(0); PG8_BAR; PG8_MMA(0, 0, At, B0); PG8_MMA(0, 1, At, B1); PG8_BAR; PG8_SCHED;
            PG8_LDA(At, 1, 1); PG8_STAGE(PG8_SB(1, 0), b3, voffB); PG8_STAGE(PG8_SB(1, 1), b3 + hstepB, voffB); PG8_STAGE(PG8_SA(1, 0), a3, voffA);
            PG8_WAIT_V(8); PG8_WAIT_L(0); PG8_BAR; PG8_MMA(1, 0, At, B0); PG8_MMA(1, 1, At, B1); PG8_BAR; PG8_SCHED;
            } else {
            PG8_LDB(B0, 0, 0); PG8_SCHED; PG8_LDA(At, 0, 0); PG8_STAGE(PG8_SA(1, 1), a1 + hstepA, voffA);
            PG8_WAIT_L(8); PG8_BAR; PG8_WAIT_L(0); PG8_MMA(0, 0, At, B0); PG8_BAR; PG8_SCHED;
            PG8_LDB(B1, 0, 1); PG8_STAGE(PG8_SB(0, 0), b2, voffB);
            PG8_BAR; PG8_WAIT_L(0); PG8_MMA(0, 1, At, B1); PG8_BAR;
            PG8_LDA(At, 0, 1); PG8_STAGE(PG8_SA(0, 0), a2, voffA);
            PG8_BAR; PG8_WAIT_L(0); PG8_MMA(1, 0, At, B0); PG8_BAR; PG8_SCHED;
            PG8_STAGE(PG8_SB(0, 1), b2 + hstepB, voffB);
            PG8_WAIT_V(6); PG8_BAR; PG8_MMA(1, 1, At, B1); PG8_BAR;
            PG8_LDB(B0, 1, 0); PG8_SCHED; PG8_LDA(At, 1, 0); PG8_STAGE(PG8_SA(0, 1), a2 + hstepA, voffA);
            PG8_WAIT_L(8); PG8_BAR; PG8_WAIT_L(0); PG8_MMA(0, 0, At, B0); PG8_BAR; PG8_SCHED;
            PG8_LDB(B1, 1, 1); PG8_STAGE(PG8_SB(1, 0), b3, voffB);
            PG8_BAR; PG8_WAIT_L(0); PG8_MMA(0, 1, At, B1); PG8_BAR;
            PG8_LDA(At, 1, 1); PG8_STAGE(PG8_SA(1, 0), a3, voffA);
            PG8_BAR; PG8_WAIT_L(0); PG8_MMA(1, 0, At, B0); PG8_BAR; PG8_SCHED;
            PG8_STAGE(PG8_SB(1, 1), b3 + hstepB, voffB);
            PG8_WAIT_V(6); PG8_BAR; PG8_MMA(1, 1, At, B1); PG8_BAR;
            }
        }
        if constexpr (ALIGN_EPI) { if (wr == 0) PG8_BAR; }
        if constexpr (!Epi::AFTER_DRAIN) { E(acc, cur, wr, wc, fr, fq); S.done(cur); }
        if (!has_next) break;
#pragma unroll
        for (int a = 0; a < 2; ++a)
#pragma unroll
            for (int b = 0; b < 2; ++b)
#pragma unroll
                for (int m = 0; m < 4; ++m)
#pragma unroll
                    for (int n = 0; n < 2; ++n) acc[a][b][m][n] = (f32x4){0.f, 0.f, 0.f, 0.f};
        cur = nxt; cA = nA; cB = nB; ++ui;
        if constexpr (ALIGN_EPI) { if (wr == 1) PG8_BAR; }
    }
    PG8_WAIT_V(0);
    if constexpr (!ALIGN_EPI) { if (wr == 0) PG8_BAR; }
    PG8_BAR;
    if constexpr (Epi::AFTER_DRAIN) { E.fused(acc, cur, wr, wc, fr, fq, lds, wid, lane); S.done(cur); }
#undef PG8_SA
#undef PG8_SB
#undef PG8_STAGE
#undef PG8_LDA
#undef PG8_LDB
#undef PG8_MMA
#undef PG8_WAIT_V
#undef PG8_WAIT_L
#undef PG8_BAR
#undef PG8_SCHED
}
}

#define GAS __attribute__((address_space(1)))
#define LAS __attribute__((address_space(3)))
typedef unsigned short bf16;
typedef unsigned v4u __attribute__((ext_vector_type(4)));
typedef unsigned v2u __attribute__((ext_vector_type(2)));
typedef float f32x4 __attribute__((ext_vector_type(4)));

constexpr int DM = 2048, NCTX = 8192, NLAT = 2048, MTOK = 10240, DEPTH = 4;
constexpr int INW = 16384, DFF = 5632, NFI = 11264, YW = 3072;
constexpr float EPS = 1e-6f;
constexpr int NWAVES = 8, NTHR = 512;

constexpr size_t MiB = 1u << 20;
constexpr size_t WS_CTL = 0, CTL_ZERO_BYTES = 1 * MiB;
constexpr size_t WS_MOD = 1 * MiB;
constexpr size_t WS_LB = 2 * MiB;
constexpr size_t WS_ROPE = 2 * MiB + 65536;
constexpr size_t WS_AST = 2 * MiB + 131072;
constexpr size_t WS_WT = 4 * MiB;
constexpr size_t WL_ELEMS = 78643200;
constexpr size_t OFF_IN = 0, OFF_UP = 33554432, OFF_OUT = 39845888, OFF_FI = 44040192, OFF_FO = 67108864;
constexpr size_t WS_Z = 604 * MiB;
constexpr size_t WS_LOGF = 924 * MiB;
constexpr size_t WS_H = 1004 * MiB;
constexpr size_t WS_Y = 1044 * MiB;
constexpr size_t WS_OF = 1104 * MiB;
constexpr size_t WS_OB = 1144 * MiB;
constexpr size_t WS_TP = 1184 * MiB;
constexpr size_t TPQ = 2048 * 2048;
constexpr size_t WS_MG = 1264 * MiB;
constexpr size_t WS_T = 1304 * MiB;
constexpr size_t WS_XB = 1344 * MiB;
constexpr size_t WS_ACT = 1384 * MiB;
constexpr size_t WS_END = 1494 * MiB;
constexpr int CW_BAR = 4096;
constexpr int CW_Q = 16384;
constexpr int CW_LC = 20480;
constexpr size_t OUT_Y = 0, OUT_K = 20971520, OUT_V = OUT_K + 33554432, OUT_S = OUT_V + 33554432, OUT_END = OUT_S + 33554432;

constexpr int LDS_BYTES = 155648;
constexpr int LDSCTL_OFF = 154624;

constexpr int PH_PRO = 0, PH_T1 = 1, PH_L0 = 2, PH_PER_LAYER = 9, PH_END = PH_L0 + DEPTH * PH_PER_LAYER;

struct Args {
    const float *x_prompt, *x_sample, *cache_k, *cache_v, *state, *c, *c_ctx, *w_ada, *b_ada, *norm_g, *w_in, *a_w, *a_b, *rpb, *lb_logits, *w_up_a, *w_up_b, *w_up_c, *w_out, *w_fi, *w_fo;
    float* out; unsigned char* ws; int ph_lo, ph_hi;
};

__device__ __forceinline__ float bf2f_lo(unsigned w) { return __uint_as_float(w << 16); }
__device__ __forceinline__ float bf2f_hi(unsigned w) { return __uint_as_float(w & 0xffff0000u); }
__device__ __forceinline__ unsigned f2bf(float f) { unsigned u = __float_as_uint(f); return (u + 0x7fffu + ((u >> 16) & 1u)) >> 16; }
typedef __bf16 bf16x2_t __attribute__((ext_vector_type(2)));
typedef float f32x2_t __attribute__((ext_vector_type(2)));
__device__ __forceinline__ unsigned cvtpk(float lo, float hi) { const f32x2_t v = {lo, hi}; return __builtin_bit_cast(unsigned, __builtin_convertvector(v, bf16x2_t)); }
__device__ __forceinline__ unsigned pk2(float lo, float hi) { return cvtpk(lo, hi); }
__device__ __forceinline__ void unpack8(const v4u w, float (&f)[8]) {
    f[0] = bf2f_lo(w.x); f[1] = bf2f_hi(w.x); f[2] = bf2f_lo(w.y); f[3] = bf2f_hi(w.y); f[4] = bf2f_lo(w.z); f[5] = bf2f_hi(w.z); f[6] = bf2f_lo(w.w); f[7] = bf2f_hi(w.w); }
__device__ __forceinline__ v4u pack8(const float (&f)[8]) { v4u w; w.x = pk2(f[0], f[1]); w.y = pk2(f[2], f[3]); w.z = pk2(f[4], f[5]); w.w = pk2(f[6], f[7]); return w; }
__device__ __forceinline__ float wave_sum(float v) {
#pragma unroll
    for (int o = 1; o < 64; o <<= 1) v += __shfl_xor(v, o);
    return v;
}
__device__ __forceinline__ float sigmoidf_(float x) { return __builtin_amdgcn_rcpf(1.0f + __builtin_amdgcn_exp2f(-1.4426950408889634f * x)); }
__device__ __forceinline__ float siluf_(float x) { return x * __builtin_amdgcn_rcpf(1.0f + __builtin_amdgcn_exp2f(-1.4426950408889634f * x)); }
__device__ __forceinline__ float gelu_tanh_(float x) { const float y = (-1.4426950408889634f * 1.5957691216057308f) * (x + 0.044715f * x * x * x); return x * __builtin_amdgcn_rcpf(1.0f + __builtin_amdgcn_exp2f(y)); }

#define XB_TMO      128
#define XB_XCNT(j)  (256  + 64 * (j))
#define XB_XSUB(j)  (1280 + 64 * (j))
#define XB_XGEN(j)  (2304 + 64 * (j))
#define XB_TOP      3328
#define XB_TOPGEN   3392
#define XCD_BAR_WORDS 3456
#define XB_SPIN_CAP (1u << 18)
__device__ __forceinline__ unsigned xb_ld(unsigned* p)              { return __hip_atomic_load(p, __ATOMIC_RELAXED, __HIP_MEMORY_SCOPE_AGENT); }
__device__ __forceinline__ unsigned xb_add(unsigned* p, unsigned v) { return __hip_atomic_fetch_add(p, v, __ATOMIC_RELAXED, __HIP_MEMORY_SCOPE_AGENT); }
__device__ __forceinline__ unsigned xb_xcc_id() { return (unsigned)__builtin_amdgcn_s_getreg((3 << 11) | 20) & 0xFu; }
#define XB_SPIN(cond, bar) do { unsigned _sp = 0; while (cond) { __builtin_amdgcn_s_sleep(1); \
    if ((++_sp & 255u) == 0u) { if (xb_ld(&(bar)[XB_TMO])) break; if (_sp > XB_SPIN_CAP) { atomicAdd(&(bar)[XB_TMO], 1u); break; } } } } while (0)
struct XcdBarrier { unsigned* bar; unsigned x; volatile LAS unsigned* st; };
__device__ __forceinline__ XcdBarrier xcd_barrier_post(unsigned* bar, volatile LAS unsigned* st) {
    XcdBarrier b; b.bar = bar; b.x = xb_xcc_id(); b.st = st;
    if (threadIdx.x == 0) (void)xb_add(&bar[XB_XCNT(b.x)], 1u);
    return b;
}
__device__ __forceinline__ void xcd_barrier_complete(unsigned* bar, unsigned x, unsigned& nloc, unsigned& nx) {
    const unsigned G = gridDim.x * gridDim.y * gridDim.z;
    unsigned sum, cnt, mine, sp = 0u;
    for (;;) {
        sum = 0u; cnt = 0u; mine = 0u;
#pragma unroll
        for (unsigned j = 0; j < 16; ++j) { const unsigned c = xb_ld(&bar[XB_XCNT(j)]); sum += c; cnt += (c > 0u) ? 1u : 0u; mine = (j == x) ? c : mine; }
        if (sum == G) break;
        __builtin_amdgcn_s_sleep(1);
        if ((++sp & 255u) == 0u) { if (xb_ld(&bar[XB_TMO])) break; if (sp > XB_SPIN_CAP) { atomicAdd(&bar[XB_TMO], 1u); break; } }
    }
    nloc = mine > 0u ? mine : 1u; nx = cnt > 0u ? cnt : 1u;
}
__device__ __forceinline__ void xcd_barrier(const XcdBarrier& b) {
    asm volatile("s_waitcnt vmcnt(0)" ::: "memory");
    __syncthreads();
    if (threadIdx.x == 0) {
        unsigned* bar = b.bar;
        __builtin_amdgcn_s_waitcnt(0);
        unsigned nloc = b.st[0], nx = b.st[1];
        if (nloc == 0u) { xcd_barrier_complete(bar, b.x, nloc, nx); b.st[0] = nloc; b.st[1] = nx; }
        const unsigned old = xb_add(&bar[XB_XSUB(b.x)], 1u);
        const unsigned gen = old / nloc;
        if (old + 1u == (gen + 1u) * nloc) {
            __builtin_amdgcn_fence(__ATOMIC_RELEASE, "agent");
            asm volatile("s_waitcnt vmcnt(0)" ::: "memory");
            const unsigned og = xb_add(&bar[XB_TOP], 1u);
            const unsigned tg = og / nx;
            if (og + 1u == (tg + 1u) * nx) xb_add(&bar[XB_TOPGEN], 1u);
            else XB_SPIN(xb_ld(&bar[XB_TOPGEN]) == tg, bar);
            __builtin_amdgcn_fence(__ATOMIC_ACQUIRE, "agent");
            xb_add(&bar[XB_XGEN(b.x)], 1u);
            asm volatile("s_waitcnt vmcnt(0)" ::: "memory");
        } else {
            XB_SPIN(xb_ld(&bar[XB_XGEN(b.x)]) == gen, bar);
            __builtin_amdgcn_fence(__ATOMIC_ACQUIRE, "agent");
            asm volatile("s_waitcnt vmcnt(0)" ::: "memory");
        }
    }
    __syncthreads();
}

struct EpiIn {
    static constexpr bool PERM = true, AFTER_DRAIN = false, HOOK = false; static constexpr int H1 = -1, H2 = -1, NST = 16;
    bf16* Z; float* LOGF; const float* lbp  ; float* outK; float* outV; float* AST;
    template <int KIND>
    __device__ __forceinline__ void body(const f32x4 (&acc)[2][2][4][2], const pg8::Unit& u, int wr, int wc, int fr, int fq) const {
        const int row0 = u.pm * 256 + wr * 64 + fr, colt = u.pn * 256 + wc * 32 + 8 * fq;
        const int seg = u.pn >> 2;
#pragma unroll
        for (int ai = 0; ai < 2; ++ai)
#pragma unroll
            for (int m = 0; m < 4; ++m) {
                const int row = row0 + ai * 128 + m * 16;
                bf16* zrow = Z + (size_t)row * INW + colt;
                float rs = 0.f, rq = 0.f;
#pragma unroll
                for (int bj = 0; bj < 2; ++bj) {
                    float v[8];
#pragma unroll
                    for (int j = 0; j < 4; ++j) { v[j] = acc[ai][bj][m][0][j]; v[4 + j] = acc[ai][bj][m][1][j]; }
                    if (KIND == 5) {
                        const int c2 = colt + bj * 128 - 6144;
                        const float* lb = lbp + (seg - 6) * 4096 + (c2 & 1023);
                        float o[8];
#pragma unroll
                        for (int j = 0; j < 8; ++j) { const float b = lb[j]; o[j] = __builtin_amdgcn_logf(b + (1.0f - b) * sigmoidf_(v[j])); }
                        float* dst = LOGF + (size_t)row * 2048 + c2;
                        *(f32x4*)dst = (f32x4){o[0], o[1], o[2], o[3]}; *(f32x4*)(dst + 4) = (f32x4){o[4], o[5], o[6], o[7]};
                    } else {
                        if (KIND == 4) {
                            if (row < NCTX) { float* dst = (seg == 3 ? outK : outV) + ((size_t)(row >> 8) * 1024 + (row & 255)) * 1024 + (colt + bj * 128 - (seg == 3 ? 3072 : 4096));
                                *(f32x4*)dst = (f32x4){v[0], v[1], v[2], v[3]}; *(f32x4*)(dst + 4) = (f32x4){v[4], v[5], v[6], v[7]}; }
                        }
                        if (KIND == 1 || KIND == 6) {
#pragma unroll
                            for (int j = 0; j < 8; ++j) v[j] = gelu_tanh_(v[j]);
                        }
                        if (KIND == 6) {
#pragma unroll
                            for (int j = 0; j < 8; ++j) { rs += v[j]; rq += v[j] * v[j]; }
                        }
                        if (KIND == 2) {
#pragma unroll
                            for (int j = 0; j < 8; ++j) v[j] = siluf_(v[j]);
                        }
                        if (KIND == 3) {
#pragma unroll
                            for (int j = 0; j < 8; ++j) v[j] = sigmoidf_(v[j]);
                        }
                        *(v4u*)(zrow + bj * 128) = pack8(v);
                    }
                }
                if (KIND == 6) {
                    rs += __shfl_xor(rs, 16); rs += __shfl_xor(rs, 32); rq += __shfl_xor(rq, 16); rq += __shfl_xor(rq, 32);
                    if (fq == 0) { float* d = AST + ((size_t)row * 16 + (u.pn & 3) * 4 + wc) * 2; d[0] = rs; d[1] = rq; }
                }
                asm volatile("" ::: "memory");
            }
    }
    __device__ __forceinline__ void operator()(const f32x4 (&acc)[2][2][4][2], const pg8::Unit& u, int wr, int wc, int fr, int fq) const {
        const int seg = u.pn >> 2;
        if (seg >= 10) body<3>(acc, u, wr, wc, fr, fq);
        else if (seg == 0) body<1>(acc, u, wr, wc, fr, fq);
        else if (seg == 1) body<6>(acc, u, wr, wc, fr, fq);
        else if (seg == 5 || seg == 9) body<2>(acc, u, wr, wc, fr, fq);
        else if (seg == 3 || seg == 4) body<4>(acc, u, wr, wc, fr, fq);
        else if (seg == 6 || seg == 7) body<5>(acc, u, wr, wc, fr, fq);
        else body<0>(acc, u, wr, wc, fr, fq);
    }
};
struct EpiUpK {
    static constexpr bool PERM = true, AFTER_DRAIN = false, HOOK = true; static constexpr int H1 = 16, H2 = 32, NST = 16;
    const bf16* Zg  ; bf16* MG;
    __device__ __forceinline__ void hook(f32x4 (&acc)[2][2][4][2], const pg8::Unit& u, int t, int wr, int wc, int fr, int fq) const {
        int frl = fr, fql = fq; asm volatile("" : "+v"(frl), "+v"(fql));
        const int row0 = u.pm * 256 + wr * 64 + frl, colt = u.pn * 256 + wc * 32 + 8 * fql;
        const bf16* zn = Zg + (t == 16 ? 0 : 2048);
#pragma unroll
        for (int ai = 0; ai < 2; ++ai) {
            v4u nw[4][2], dw[4][2];
#pragma unroll
            for (int m = 0; m < 4; ++m)
#pragma unroll
                for (int bj = 0; bj < 2; ++bj) { const size_t ro = (size_t)(row0 + ai * 128 + m * 16) * INW + colt + bj * 128; nw[m][bj] = *(const v4u*)(zn + ro); dw[m][bj] = *(const v4u*)(zn + 2048 + ro); }
#pragma unroll
            for (int m = 0; m < 4; ++m)
#pragma unroll
                for (int bj = 0; bj < 2; ++bj) {
                    float gn[8], gd[8]; unpack8(nw[m][bj], gn); unpack8(dw[m][bj], gd);
#pragma unroll
                    for (int j = 0; j < 4; ++j) { acc[ai][bj][m][0][j] *= gn[j] * __builtin_amdgcn_rcpf(gd[j]); acc[ai][bj][m][1][j] *= gn[4 + j] * __builtin_amdgcn_rcpf(gd[4 + j]); }
                }
            asm volatile("" ::: "memory");
        }
    }
    __device__ __forceinline__ void operator()(const f32x4 (&acc)[2][2][4][2], const pg8::Unit& u, int wr, int wc, int fr, int fq) const {
        const int row0 = u.pm * 256 + wr * 64 + fr, colt = u.pn * 256 + wc * 32 + 8 * fq;
#pragma unroll
        for (int ai = 0; ai < 2; ++ai)
#pragma unroll
            for (int m = 0; m < 4; ++m) {
                const int row = row0 + ai * 128 + m * 16;
#pragma unroll
                for (int bj = 0; bj < 2; ++bj) {
                    const int col = colt + bj * 128;
                    float g[8]; unpack8(*(const v4u*)(Zg + 4096 + (size_t)row * INW + col), g);
                    float v[8];
#pragma unroll
                    for (int j = 0; j < 4; ++j) { v[j] = acc[ai][bj][m][0][j] * g[j]; v[4 + j] = acc[ai][bj][m][1][j] * g[4 + j]; }
                    *(v4u*)(MG + (size_t)row * DM + col) = pack8(v);
                }
                asm volatile("" ::: "memory");
            }
    }
};
struct EpiBf16P {
    static constexpr bool PERM = true, AFTER_DRAIN = false, HOOK = false; static constexpr int H1 = -1, H2 = -1, NST = 16;
    bf16* C; int ldc; size_t kq_stride;
    __device__ __forceinline__ void operator()(const f32x4 (&acc)[2][2][4][2], const pg8::Unit& u, int wr, int wc, int fr, int fq) const {
        const int row0 = u.pm * 256 + wr * 64 + fr, colt = u.pn * 256 + wc * 32 + 8 * fq;
#pragma unroll
        for (int ai = 0; ai < 2; ++ai)
#pragma unroll
            for (int m = 0; m < 4; ++m) {
                bf16* rp = C + (size_t)u.kq * kq_stride + (size_t)(row0 + ai * 128 + m * 16) * ldc + colt;
#pragma unroll
                for (int bj = 0; bj < 2; ++bj) { float v[8];
#pragma unroll
                    for (int j = 0; j < 4; ++j) { v[j] = acc[ai][bj][m][0][j]; v[4 + j] = acc[ai][bj][m][1][j]; }
                    *(v4u*)(rp + bj * 128) = pack8(v); }
            }
    }
};
struct EpiSwi {
    static constexpr bool PERM = true, AFTER_DRAIN = false, HOOK = false; static constexpr int H1 = -1, H2 = -1, NST = 16;
    bf16* ACT;
    __device__ __forceinline__ void operator()(const f32x4 (&acc)[2][2][4][2], const pg8::Unit& u, int wr, int wc, int fr, int fq) const {
        const int row0 = u.pm * 256 + wr * 64 + fr, colt = u.pn * 128 + wc * 32 + 8 * fq;
#pragma unroll
        for (int ai = 0; ai < 2; ++ai)
#pragma unroll
            for (int m = 0; m < 4; ++m) {
                float v[8];
#pragma unroll
                for (int j = 0; j < 4; ++j) { v[j] = siluf_(acc[ai][1][m][0][j]) * acc[ai][0][m][0][j]; v[4 + j] = siluf_(acc[ai][1][m][1][j]) * acc[ai][0][m][1][j]; }
                *(v4u*)(ACT + (size_t)(row0 + ai * 128 + m * 16) * DFF + colt) = pack8(v);
            }
    }
};

struct Ctx {
    LAS unsigned char* lds; int tid, lane, wave, vcu, G;
};

struct CvtDesc { const float* src; int N; bf16* dst; int dld; };
__device__ __forceinline__ void cvt_load(const CvtDesc& d, f32x4 (&v)[16]) {
#pragma unroll
    for (int i = 0; i < 16; ++i) v[i] = *(const f32x4*)(d.src + (size_t)(4 * i) * d.N);
}
__device__ __forceinline__ void cvt_finish(const CvtDesc& d, const f32x4 (&v)[16], LAS float* scr, int lane) {
#pragma unroll
    for (int i = 0; i < 16; ++i) { LAS float* s = scr + (4 * i + (lane >> 4)) * 65 + 4 * (lane & 15); s[0] = v[i].x; s[1] = v[i].y; s[2] = v[i].z; s[3] = v[i].w; }
    asm volatile("s_waitcnt lgkmcnt(0)" ::: "memory");
    const int c = lane & 7;
#pragma unroll
    for (int j = 0; j < 8; ++j) { const int n = (lane >> 3) + 8 * j; const LAS float* s = scr + (8 * c) * 65 + n;
        v4u o; o.x = pk2(s[0 * 65], s[1 * 65]); o.y = pk2(s[2 * 65], s[3 * 65]); o.z = pk2(s[4 * 65], s[5 * 65]); o.w = pk2(s[6 * 65], s[7 * 65]);
        *(v4u*)(d.dst + (size_t)n * d.dld + 8 * c) = o; }
    asm volatile("s_waitcnt lgkmcnt(0)" ::: "memory");
}
constexpr int IT_IN = 32 * 256, IT_UP = 16 * 32, IT_OUT = 32 * 32, IT_FI = 32 * 176, IT_FO = 88 * 32, IT_LAYER = IT_IN + 3 * IT_UP + IT_OUT + IT_FI + IT_FO;
__device__ __forceinline__ CvtDesc cvt_desc(const Args& a, int l, int r, int lane) {
    bf16* wl = (bf16*)(a.ws + WS_WT) + (size_t)l * WL_ELEMS;
    const float* W; int N, k0, n0, dld, drow0, dcol0; bf16* dst;
    if (r < IT_IN) { const int kb = r / 256, nb = r % 256; W = a.w_in + (size_t)l * DM * INW; N = INW; k0 = 64 * kb; n0 = 64 * nb; dst = wl + OFF_IN; dld = DM; drow0 = n0; dcol0 = k0; }
    else { r -= IT_IN;
    if (r < 3 * IT_UP) { const int br = r / IT_UP, q = r % IT_UP, kb = q / 32, nb = q % 32;
        W = (br == 0 ? a.w_up_a : (br == 1 ? a.w_up_b : a.w_up_c)) + (size_t)l * 1024 * DM; N = DM; k0 = 64 * kb; n0 = 64 * nb; dst = wl + OFF_UP; dld = YW; drow0 = n0; dcol0 = 1024 * br + k0; }
    else { r -= 3 * IT_UP;
    if (r < IT_OUT) { const int kb = r / 32, nb = r % 32; W = a.w_out + (size_t)l * DM * DM; N = DM; k0 = 64 * kb; n0 = 64 * nb; dst = wl + OFF_OUT; dld = DM; drow0 = n0; dcol0 = k0; }
    else { r -= IT_OUT;
    if (r < IT_FI) { const int kb = r / 176, nb = r % 176; n0 = 64 * nb; k0 = 64 * kb; W = a.w_fi + (size_t)l * DM * NFI; N = NFI; dst = wl + OFF_FI; dld = DM;
        drow0 = (n0 < DFF) ? (256 * (n0 / 128) + (n0 % 128)) : (256 * ((n0 - DFF) / 128) + 128 + ((n0 - DFF) % 128)); dcol0 = k0; }
    else { r -= IT_FI; const int kb = r / 32, nb = r % 32; W = a.w_fo + (size_t)l * DFF * DM; N = DM; k0 = 64 * kb; n0 = 64 * nb; dst = wl + OFF_FO; dld = DFF; drow0 = n0; dcol0 = k0; } } } }
    CvtDesc d; d.src = W + (size_t)(k0 + (lane >> 4)) * N + n0 + 4 * (lane & 15); d.N = N; d.dst = dst + (size_t)drow0 * dld + dcol0; d.dld = dld; return d;
}
__device__ __forceinline__ void cvt_three(const Args& a, int l, int r0, int rstep, LAS float* scr, int lane) {
    const CvtDesc d0 = cvt_desc(a, l, r0, lane), d1 = cvt_desc(a, l, r0 + rstep, lane), d2 = cvt_desc(a, l, r0 + 2 * rstep, lane);
    f32x4 v0[16], v1[16], v2[16];
    cvt_load(d0, v0); cvt_load(d1, v1); cvt_load(d2, v2);
    cvt_finish(d0, v0, scr, lane); cvt_finish(d1, v1, scr, lane); cvt_finish(d2, v2, scr, lane);
}
__device__ __forceinline__ void cvt_two(const Args& a, int l, int r0, int rstep, LAS float* scr, int lane) {
    const CvtDesc d0 = cvt_desc(a, l, r0, lane), d1 = cvt_desc(a, l, r0 + rstep, lane);
    f32x4 v0[16], v1[16];
    cvt_load(d0, v0); cvt_load(d1, v1);
    cvt_finish(d0, v0, scr, lane); cvt_finish(d1, v1, scr, lane);
}
__device__ __forceinline__ void adaln_unit(const Args& a, const Ctx& F, int l, int cb) {
    LAS float* sc = (LAS float*)F.lds;
    LAS float* red = (LAS float*)(F.lds + 24576);
    float* MOD = (float*)(a.ws + WS_MOD);
    __syncthreads();
    for (int i = F.tid; i < 3 * DM; i += NTHR) { const int ci = i / DM, k = i % DM; const float x = (ci == 0) ? a.c_ctx[k] : a.c[(ci - 1) * DM + k]; sc[i] = x / (1.0f + expf(-x)); }
    __syncthreads();
    const int cx = F.tid & 31, kg = F.tid >> 5;
    const float* wp = a.w_ada + ((size_t)l * DM + 128 * kg) * 12288 + 128 * cb + 4 * cx;
    f32x4 a0 = {0.f, 0.f, 0.f, 0.f}, a1 = a0, a2 = a0;
#pragma unroll 8
    for (int k = 0; k < 128; ++k) { const f32x4 w = *(const f32x4*)(wp + (size_t)k * 12288);
        const float s0 = sc[128 * kg + k], s1 = sc[DM + 128 * kg + k], s2 = sc[2 * DM + 128 * kg + k];
        a0 += w * s0; a1 += w * s1; a2 += w * s2; }
#pragma unroll
    for (int j = 0; j < 4; ++j) { red[(kg * 3 + 0) * 128 + 4 * cx + j] = a0[j]; red[(kg * 3 + 1) * 128 + 4 * cx + j] = a1[j]; red[(kg * 3 + 2) * 128 + 4 * cx + j] = a2[j]; }
    __syncthreads();
    if (F.tid < 384) { const int ci = F.tid / 128, col = F.tid % 128; float sm = 0.f;
#pragma unroll
        for (int g = 0; g < 16; ++g) sm += red[(g * 3 + ci) * 128 + col];
        MOD[(size_t)(l * 3 + ci) * 12288 + 128 * cb + col] = sm + a.b_ada[l * 12288 + 128 * cb + col]; }
    __syncthreads();
}
__device__ __forceinline__ void adaln_all(const Args& a, const Ctx& F) {
    LAS float* sc = (LAS float*)F.lds;
    LAS float* red = (LAS float*)(F.lds + 24576);
    float* MOD = (float*)(a.ws + WS_MOD);
    __syncthreads();
    for (int i = F.tid; i < 3 * DM; i += NTHR) { const int ci = i / DM, k = i % DM; const float x = (ci == 0) ? a.c_ctx[k] : a.c[(ci - 1) * DM + k]; sc[i] = x / (1.0f + expf(-x)); }
    __syncthreads();
    const int cx = F.tid & 15, kg = F.tid >> 4;
    for (int u = F.vcu; u < 4 * 192; u += F.G) {
        const int l = u / 192, cb = u % 192;
        const float* wp = a.w_ada + ((size_t)l * DM + 64 * kg) * 12288 + 64 * cb + 4 * cx;
        f32x4 a0 = {0.f, 0.f, 0.f, 0.f}, a1 = a0, a2 = a0;
#pragma unroll 1
        for (int k0 = 0; k0 < 64; k0 += 16) {
            f32x4 w[16];
#pragma unroll
            for (int i = 0; i < 16; ++i) w[i] = *(const f32x4*)(wp + (size_t)(k0 + i) * 12288);
#pragma unroll
            for (int i = 0; i < 16; ++i) { const float s0 = sc[64 * kg + k0 + i], s1 = sc[DM + 64 * kg + k0 + i], s2 = sc[2 * DM + 64 * kg + k0 + i];
                a0 += w[i] * s0; a1 += w[i] * s1; a2 += w[i] * s2; }
        }
        *(LAS f32x4*)(red + (kg * 3 + 0) * 64 + 4 * cx) = a0; *(LAS f32x4*)(red + (kg * 3 + 1) * 64 + 4 * cx) = a1; *(LAS f32x4*)(red + (kg * 3 + 2) * 64 + 4 * cx) = a2;
        __syncthreads();
        if (F.tid < 192) { const int ci = F.tid / 64, col = F.tid % 64; float sm = 0.f;
#pragma unroll
            for (int g = 0; g < 32; ++g) sm += red[(g * 3 + ci) * 64 + col];
            MOD[(size_t)(l * 3 + ci) * 12288 + 64 * cb + col] = sm + a.b_ada[l * 12288 + 64 * cb + col]; }
        __syncthreads();
    }
}
__device__ __forceinline__ void phase_prologue(const Args& a, const Ctx& F) {
    unsigned char* ws = a.ws;
    {
        LAS float* scr = (LAS float*)(F.lds + F.wave * 16640);
        const int gw = F.vcu * NWAVES + F.wave, NGW = F.G * NWAVES;
        for (int it = gw; it < IT_IN / 2; it += NGW) cvt_two(a, 0, it, IT_IN / 2, scr, F.lane);
    }
    __syncthreads();
    adaln_all(a, F);
    {
        float* LB = (float*)(ws + WS_LB); float* ROPE = (float*)(ws + WS_ROPE);
        for (int i = F.vcu * NTHR + F.tid; i < 2048; i += F.G * NTHR) {
            const int dir = i / 1024, f = i % 1024;
            float x[4], mx = -3.0e38f;
#pragma unroll
            for (int l = 0; l < 4; ++l) { x[l] = a.lb_logits[(dir * 4 + l) * 1024 + f]; mx = fmaxf(mx, x[l]); }
            float e[4], s = 0.f;
#pragma unroll
            for (int l = 0; l < 4; ++l) { e[l] = expf(x[l] - mx); s += e[l]; }
            float cs = 0.f;
#pragma unroll
            for (int l = 0; l < 4; ++l) { if (l > 0) cs += e[l] / s; LB[(dir * 4 + l) * 1024 + f] = cs; }
            const int p = i / 32, fi = i % 32;
            const float inv = powf(10000.0f, -(float)(2 * fi) / 64.0f), ang = (float)p * inv;
            ROPE[2 * i] = cosf(ang); ROPE[2 * i + 1] = sinf(ang);
        }
    }
}

__device__ __forceinline__ void rownorm_phase(const Args& a, const Ctx& F, bool first, const bf16* T, const float* gate  , const float* gpost,
                                              bool write_h, const float* gn, const float* scv, const float* shv  ) {
    float* X = a.out + OUT_Y; bf16* XB = (bf16*)(a.ws + WS_XB); bf16* H = (bf16*)(a.ws + WS_H); const bf16* TP = (const bf16*)(a.ws + WS_TP);
    LAS float* V1 = (LAS float*)F.lds; LAS float* V2 = V1 + 3 * DM; LAS float* V3 = V2 + 3 * DM;
    const int gw = F.vcu * NWAVES + F.wave, NGW = F.G * NWAVES;
    struct RowRaw { f32x4 xf[8]; v2u tw[4][8]; };
#define RN_LOAD(R, m_) do { const int mr_ = (m_); \
        if (first) { const float* xr = (mr_ < NCTX) ? a.x_prompt + (size_t)mr_ * DM : a.x_sample + (size_t)(mr_ - NCTX) * DM; \
            _Pragma("unroll") for (int j = 0; j < 8; ++j) R.xf[j] = *((const f32x4*)xr + F.lane + 64 * j); } \
        else { _Pragma("unroll") for (int j = 0; j < 8; ++j) { const v2u w = *((const v2u*)(XB + (size_t)mr_ * DM) + F.lane + 64 * j); R.xf[j].x = __uint_as_float(w.x); R.xf[j].y = __uint_as_float(w.y); } } \
        if (T) { if (mr_ < NCTX) { _Pragma("unroll") for (int j = 0; j < 8; ++j) R.tw[0][j] = *((const v2u*)(T + (size_t)mr_ * DM) + F.lane + 64 * j); } \
                 else { _Pragma("unroll") for (int q = 0; q < 4; ++q) _Pragma("unroll") for (int j = 0; j < 8; ++j) R.tw[q][j] = *((const v2u*)(TP + (size_t)q * TPQ + (size_t)(mr_ - NCTX) * DM) + F.lane + 64 * j); } } \
    } while (0)
    RowRaw R;
    if (gw < MTOK) RN_LOAD(R, gw);
    __syncthreads();
    for (int i = F.tid; i < 3 * DM; i += NTHR) { const int ci = i / DM, c = i % DM;
        if (T) V1[i] = gate[(size_t)ci * 12288 + c] * gpost[c];
        if (write_h) { V2[i] = gn[c] * (1.0f + scv[(size_t)ci * 12288 + c]); V3[i] = shv[(size_t)ci * 12288 + c]; } }
    __syncthreads();
    for (int m = gw; m < MTOK; m += NGW) {
        const int ci = (m < NCTX) ? 0 : 1 + ((m - NCTX) >> 10);
        f32x4 x[8], t[8];
        if (first) {
#pragma unroll
            for (int j = 0; j < 8; ++j) x[j] = R.xf[j];
        } else {
#pragma unroll
            for (int j = 0; j < 8; ++j) { const unsigned wx = __float_as_uint(R.xf[j].x), wy = __float_as_uint(R.xf[j].y); x[j] = (f32x4){bf2f_lo(wx), bf2f_hi(wx), bf2f_lo(wy), bf2f_hi(wy)}; }
        }
        if (T) {
#pragma unroll
            for (int j = 0; j < 8; ++j) {
                if (m < NCTX) { const v2u w = R.tw[0][j]; t[j] = (f32x4){bf2f_lo(w.x), bf2f_hi(w.x), bf2f_lo(w.y), bf2f_hi(w.y)}; }
                else { const v2u w0 = R.tw[0][j], w1 = R.tw[1][j], w2 = R.tw[2][j], w3 = R.tw[3][j];
                    t[j] = (f32x4){(bf2f_lo(w0.x) + bf2f_lo(w1.x)) + (bf2f_lo(w2.x) + bf2f_lo(w3.x)), (bf2f_hi(w0.x) + bf2f_hi(w1.x)) + (bf2f_hi(w2.x) + bf2f_hi(w3.x)),
                                   (bf2f_lo(w0.y) + bf2f_lo(w1.y)) + (bf2f_lo(w2.y) + bf2f_lo(w3.y)), (bf2f_hi(w0.y) + bf2f_hi(w1.y)) + (bf2f_hi(w2.y) + bf2f_hi(w3.y))}; } }
        }
        asm volatile("" ::: "memory");
        if (m + NGW < MTOK) RN_LOAD(R, m + NGW);
        if (T) {
            float ss = 0.f;
#pragma unroll
            for (int j = 0; j < 8; ++j) ss += (t[j].x * t[j].x + t[j].y * t[j].y) + (t[j].z * t[j].z + t[j].w * t[j].w);
            const float r = 1.0f / sqrtf(wave_sum(ss) * (1.0f / DM) + EPS);
#pragma unroll
            for (int j = 0; j < 8; ++j) { const f32x4 v1 = *((const LAS f32x4*)(V1 + ci * DM) + F.lane + 64 * j); x[j] += v1 * (t[j] * r); }
        }
        if (!write_h) {
#pragma unroll
            for (int j = 0; j < 8; ++j) *((f32x4*)(X + (size_t)m * DM) + F.lane + 64 * j) = x[j];
        } else {
#pragma unroll
            for (int j = 0; j < 8; ++j) { v2u w; w.x = pk2(x[j].x, x[j].y); w.y = pk2(x[j].z, x[j].w); *((v2u*)(XB + (size_t)m * DM) + F.lane + 64 * j) = w; }
        }
        if (write_h) {
            float ss = 0.f;
#pragma unroll
            for (int j = 0; j < 8; ++j) ss += (x[j].x * x[j].x + x[j].y * x[j].y) + (x[j].z * x[j].z + x[j].w * x[j].w);
            const float r = 1.0f / sqrtf(wave_sum(ss) * (1.0f / DM) + EPS);
#pragma unroll
            for (int j = 0; j < 8; ++j) { const f32x4 v2 = *((const LAS f32x4*)(V2 + ci * DM) + F.lane + 64 * j), v3 = *((const LAS f32x4*)(V3 + ci * DM) + F.lane + 64 * j);
                const f32x4 h = x[j] * r * v2 + v3;
                v2u w; w.x = pk2(h.x, h.y); w.y = pk2(h.z, h.w);
                *((v2u*)(H + (size_t)m * DM) + F.lane + 64 * j) = w; }
        }
    }
#undef RN_LOAD
    __syncthreads();
}

__device__ __forceinline__ void phase_ycnorm(const Args& a, const Ctx& F) {
    const float* OFp = (const float*)(a.ws + WS_OF); const float* OBp = (const float*)(a.ws + WS_OB);
    const bf16* Z = (const bf16*)(a.ws + WS_Z); bf16* Y = (bf16*)(a.ws + WS_Y);
    const int gw = F.vcu * NWAVES + F.wave, NGW = F.G * NWAVES;
    for (int m = gw; m < MTOK; m += NGW) {
        float o[16]; float ss = 0.f;
#pragma unroll
        for (int j = 0; j < 4; ++j) { const f32x4 p = *((const f32x4*)(OFp + (size_t)m * 1024 + 16 * F.lane) + j), q = *((const f32x4*)(OBp + (size_t)m * 1024 + 16 * F.lane) + j);
            const f32x4 s = p + q; o[4 * j] = s.x; o[4 * j + 1] = s.y; o[4 * j + 2] = s.z; o[4 * j + 3] = s.w; ss += (s.x * s.x + s.y * s.y) + (s.z * s.z + s.w * s.w); }
        ss += __shfl_xor(ss, 1); ss += __shfl_xor(ss, 2); ss += __shfl_xor(ss, 4);
        const float r = 1.0f / sqrtf(ss * (1.0f / 128.0f) + EPS);
        float g0[8], g1[8];
        unpack8(*(const v4u*)(Z + (size_t)m * INW + 9216 + 16 * F.lane), g0); unpack8(*(const v4u*)(Z + (size_t)m * INW + 9216 + 16 * F.lane + 8), g1);
        float y0[8], y1[8];
#pragma unroll
        for (int j = 0; j < 8; ++j) { y0[j] = o[j] * r * g0[j]; y1[j] = o[8 + j] * r * g1[j]; }
        *(v4u*)(Y + (size_t)m * YW + 2048 + 16 * F.lane) = pack8(y0); *(v4u*)(Y + (size_t)m * YW + 2048 + 16 * F.lane + 8) = pack8(y1);
    }
}

typedef short bf16x8 __attribute__((ext_vector_type(8)));
typedef short s16x4 __attribute__((ext_vector_type(4)));
typedef float f32x16 __attribute__((ext_vector_type(16)));
typedef __bf16 bf16x4_t __attribute__((ext_vector_type(4)));
#define MFMA32(a, b, c) __builtin_amdgcn_mfma_f32_32x32x16_bf16((a), (b), (c), 0, 0, 0)
__device__ __forceinline__ bf16x8 pack_regs(const f32x16& x, int s) {
    v4u p; p.x = cvtpk(x[8 * s], x[8 * s + 1]); p.y = cvtpk(x[8 * s + 2], x[8 * s + 3]); p.z = cvtpk(x[8 * s + 4], x[8 * s + 5]); p.w = cvtpk(x[8 * s + 6], x[8 * s + 7]);
    return __builtin_bit_cast(bf16x8, p);
}
__device__ __forceinline__ s16x4 tr_read(const LAS unsigned char* p) { return __builtin_bit_cast(s16x4, __builtin_amdgcn_ds_read_tr16_b64_v4bf16((LAS bf16x4_t*)p)); }
__device__ __forceinline__ bf16x8 tr_pair(const LAS unsigned char* lo, const LAS unsigned char* hi) { const s16x4 a = tr_read(lo), b = tr_read(hi); return __builtin_shufflevector(a, b, 0, 1, 2, 3, 4, 5, 6, 7); }
constexpr float ATT_SCALE = 0.08838834764831845f;
constexpr int KP = 272, VP = 320;
constexpr int ATT_K_OFF = 0, ATT_V_OFF = 256 * KP, ATT_RPB_OFF = ATT_V_OFF + 256 * VP;
struct AttnW { f32x16 O[4]; float m, l; };
template <int MODE, bool QLDS>
__device__ __forceinline__ void attn_tile(AttnW& W, const bf16x8 (&qf)[8], const LAS unsigned char* Ql, const LAS unsigned char* Kl, const LAS unsigned char* Vl, int kt0, int lane, const LAS float* rpb_row, int kc0, int qc) {
    const int r = lane & 31, h = lane >> 5;
    f32x16 sacc;
#pragma unroll
    for (int i = 0; i < 16; ++i) sacc[i] = 0.f;
    const LAS unsigned char* kp = Kl + (kt0 + r) * KP + 16 * h;
#pragma unroll
    for (int ks = 0; ks < 8; ++ks) { const bf16x8 a = *(const LAS bf16x8*)(kp + 32 * ks); const bf16x8 q = QLDS ? *(const LAS bf16x8*)(Ql + 32 * ks) : qf[ks]; sacc = MFMA32(a, q, sacc); }
    float mt = -1.0e30f;
    if (MODE == 1) {
        const int c_start = min(max(qc - 8, 0), 48);
        const int kb = kc0 + 4 * h - c_start;
        const LAS float* bp = rpb_row + (kc0 + 4 * h - qc + 15);
#pragma unroll
        for (int i = 0; i < 16; ++i) { const int off = (i & 3) + 8 * (i >> 2); const bool ok = (unsigned)(kb + off) < 16u;
            const float bias = bp[ok ? off : (qc - kc0 - 4 * h)];
            const float v = ok ? (sacc[i] * ATT_SCALE + bias) : -1.0e30f; sacc[i] = v; mt = fmaxf(mt, v); }
    } else {
#pragma unroll
        for (int i = 0; i < 16; ++i) { sacc[i] *= ATT_SCALE; mt = fmaxf(mt, sacc[i]); }
    }
    mt = fmaxf(mt, __shfl_xor(mt, 32));
    const float mn = fmaxf(W.m, mt), alpha = __expf(W.m - mn);
    float ls = 0.f;
#pragma unroll
    for (int i = 0; i < 16; ++i) { const float e = (MODE == 1 && sacc[i] < -1.0e29f) ? 0.f : __expf(sacc[i] - mn); sacc[i] = e; ls += e; }
    ls += __shfl_xor(ls, 32);
    W.l = W.l * alpha + ls; W.m = mn;
    if (__any(alpha != 1.0f)) {
#pragma unroll
        for (int dt = 0; dt < 4; ++dt)
#pragma unroll
            for (int i = 0; i < 16; ++i) W.O[dt][i] *= alpha;
    }
    const bf16x8 pb0 = pack_regs(sacc, 0), pb1 = pack_regs(sacc, 1);
    const int g = (lane >> 4) & 1, q4 = (lane & 15) >> 2, p4 = lane & 3;
    const LAS unsigned char* vp = Vl + (kt0 + 4 * h + q4) * VP + 32 * g + 8 * p4;
#pragma unroll
    for (int dt = 0; dt < 4; ++dt) {
        const bf16x8 v0 = tr_pair(vp + 64 * dt, vp + 64 * dt + 8 * VP);
        const bf16x8 v1 = tr_pair(vp + 64 * dt + 16 * VP, vp + 64 * dt + 24 * VP);
        W.O[dt] = MFMA32(v0, pb0, W.O[dt]); W.O[dt] = MFMA32(v1, pb1, W.O[dt]);
    }
}
__device__ __forceinline__ void attn_init(AttnW& W) {
    W.m = -1.0e30f; W.l = 0.f;
#pragma unroll
    for (int dt = 0; dt < 4; ++dt)
#pragma unroll
        for (int i = 0; i < 16; ++i) W.O[dt][i] = 0.f;
}
__device__ __forceinline__ void attn_store_dt(const f32x16& O, float inv, bf16* yrow, int dt, int h) {
#pragma unroll
    for (int g4 = 0; g4 < 4; ++g4) { v2u w; w.x = cvtpk(O[4 * g4] * inv, O[4 * g4 + 1] * inv); w.y = cvtpk(O[4 * g4 + 2] * inv, O[4 * g4 + 3] * inv);
        *(v2u*)(yrow + 32 * dt + 8 * g4 + 4 * h) = w; }
}

__device__ __forceinline__ void unitAttnCtx(const Args& a, const Ctx& F, int unit) {
    const int hd = unit & 7, b = unit >> 3;
    const bf16* Z = (const bf16*)(a.ws + WS_Z); bf16* Y = (bf16*)(a.ws + WS_Y);
    const LAS unsigned char* Kl = F.lds + ATT_K_OFF; const LAS unsigned char* Vl = F.lds + ATT_V_OFF;
    for (int p = F.tid; p < 4096; p += NTHR) { const int key = p >> 4, c16 = p & 15; const bf16* src = Z + (size_t)(b * 256 + key) * INW + hd * 128 + 8 * c16;
        *(LAS v4u*)(F.lds + ATT_K_OFF + key * KP + 16 * c16) = *(const v4u*)(src + 3072); *(LAS v4u*)(F.lds + ATT_V_OFF + key * VP + 16 * c16) = *(const v4u*)(src + 4096); }
    AttnW W; attn_init(W); bf16x8 qf[8];
    const int r = F.lane & 31, h = F.lane >> 5;
    const int mq = b * 256 + 32 * F.wave + r;
    { const bf16* qp = Z + (size_t)mq * INW + 2048 + hd * 128 + 8 * h;
#pragma unroll
      for (int ks = 0; ks < 8; ++ks) qf[ks] = __builtin_bit_cast(bf16x8, *(const v4u*)(qp + 16 * ks)); }
    __syncthreads();
#pragma unroll 1
    for (int kt = 0; kt < 8; ++kt) attn_tile<0, false>(W, qf, nullptr, Kl, Vl, 32 * kt, F.lane, nullptr, 0, 0);
    const float inv = 1.0f / W.l;
    bf16* yrow = Y + (size_t)mq * YW + 1024 + hd * 128;
#pragma unroll
    for (int dt = 0; dt < 4; ++dt) attn_store_dt(W.O[dt], inv, yrow, dt, h);
    __syncthreads();
}
constexpr int LQ_OFF = 0, LK_OFF = 64 * KP, LV_OFF = LK_OFF + 128 * KP, LRPB_OFF = LV_OFF + 128 * VP;
__device__ __forceinline__ void unitAttnLat(const Args& a, const Ctx& F, int l, int unit) {
    const int gr = unit & 15, hd = (unit >> 4) & 7, b = unit >> 7;
    const bf16* Z = (const bf16*)(a.ws + WS_Z); bf16* Y = (bf16*)(a.ws + WS_Y);
    const float* ROPE = (const float*)(a.ws + WS_ROPE);
    const LAS unsigned char* Kl = F.lds + LK_OFF; const LAS unsigned char* Vl = F.lds + LV_OFF; LAS float* rp = (LAS float*)(F.lds + LRPB_OFF);
    const int r = F.lane & 31, h = F.lane >> 5, qh = F.wave & 1, kt = F.wave >> 1;
    const int qc = 32 * qh + r;
    const int r_start = min(max(gr - 4, 0), 8);
    const int mq = NCTX + b * 1024 + gr * 64 + qc;
    __syncthreads();
    for (int i = F.tid; i < 15 * 31; i += NTHR) rp[i] = a.rpb[(size_t)(l * 8 + hd) * 465 + i];
    {
        const int qq = F.tid >> 3, half = (F.tid >> 2) & 1, sp = F.tid & 3, pos = half ? qq : gr;
        const bf16* src = Z + (size_t)(NCTX + b * 1024 + gr * 64 + qq) * INW + 2048 + hd * 128 + 64 * half + 8 * sp;
        const float* rt = ROPE + 2 * (pos * 32 + 8 * sp);
        float x[8], y[8], lo[8], hi[8]; unpack8(*(const v4u*)src, x); unpack8(*(const v4u*)(src + 32), y);
#pragma unroll
        for (int j4 = 0; j4 < 4; ++j4) { const f32x4 cssn = *(const f32x4*)(rt + 4 * j4);
            lo[2 * j4] = x[2 * j4] * cssn.x - y[2 * j4] * cssn.y; hi[2 * j4] = y[2 * j4] * cssn.x + x[2 * j4] * cssn.y;
            lo[2 * j4 + 1] = x[2 * j4 + 1] * cssn.z - y[2 * j4 + 1] * cssn.w; hi[2 * j4 + 1] = y[2 * j4 + 1] * cssn.z + x[2 * j4 + 1] * cssn.w; }
        LAS unsigned char* d = F.lds + LQ_OFF + qq * KP + 2 * (64 * half + 8 * sp);
        *(LAS v4u*)d = pack8(lo); *(LAS v4u*)(d + 64) = pack8(hi);
    }
    AttnW W; attn_init(W);
    const LAS unsigned char* Ql = F.lds + LQ_OFF + qc * KP + 16 * h;
    const bf16x8 qdummy[8] = {};
    f32x4 R[16];
    const int jk0 = F.tid, jk1 = F.tid + NTHR;
#define LAT_PREFETCH(cn) do { \
        if ((cn) < 4) { \
            _Pragma("unroll") for (int q = 0; q < 2; ++q) { const int job = q ? jk1 : jk0; const int key = job >> 3, half = (job >> 2) & 1, sp = job & 3; \
                const int kr = r_start + 2 * (cn) + (key >> 6), kc = key & 63, pos = half ? kc : kr; \
                const bf16* src = Z + (size_t)(NCTX + b * 1024 + kr * 64 + kc) * INW + 3072 + hd * 128 + 64 * half + 8 * sp; \
                const float* rt = ROPE + 2 * (pos * 32 + 8 * sp); \
                R[2 * q] = __builtin_bit_cast(f32x4, *(const v4u*)src); R[2 * q + 1] = __builtin_bit_cast(f32x4, *(const v4u*)(src + 32)); \
                _Pragma("unroll") for (int j4 = 0; j4 < 4; ++j4) R[8 + 4 * q + j4] = *(const f32x4*)(rt + 4 * j4); } \
            _Pragma("unroll") for (int q = 0; q < 4; ++q) { const int pc = F.tid + q * NTHR; const int key = pc >> 4, c16 = pc & 15; const int kr = r_start + 2 * (cn) + (key >> 6), kc = key & 63; \
                R[4 + q] = __builtin_bit_cast(f32x4, *(const v4u*)(Z + (size_t)(NCTX + b * 1024 + kr * 64 + kc) * INW + 4096 + hd * 128 + 8 * c16)); } \
        } else { \
            _Pragma("unroll") for (int q = 0; q < 4; ++q) { const int pc = F.tid + q * NTHR; const int key = pc >> 4, c16 = pc & 15; \
                const size_t off = ((size_t)(b * 4 + l) * 512 + 128 * ((cn) - 4) + key) * 1024 + hd * 128 + 8 * c16; \
                R[4 * q] = *(const f32x4*)(a.cache_k + off); R[4 * q + 1] = *(const f32x4*)(a.cache_k + off + 4); R[4 * q + 2] = *(const f32x4*)(a.cache_v + off); R[4 * q + 3] = *(const f32x4*)(a.cache_v + off + 4); } \
        } } while (0)
#pragma unroll 1
    for (int chn = 0; chn < 8; ++chn) {
        LAT_PREFETCH(chn);
        __syncthreads();
        if (chn < 4) {
#pragma unroll
            for (int q = 0; q < 2; ++q) { const int job = q ? jk1 : jk0; const int key = job >> 3, half = (job >> 2) & 1, sp = job & 3;
                float x[8], y[8], lo[8], hi[8]; unpack8(__builtin_bit_cast(v4u, R[2 * q]), x); unpack8(__builtin_bit_cast(v4u, R[2 * q + 1]), y);
#pragma unroll
                for (int j4 = 0; j4 < 4; ++j4) { const f32x4 cssn = R[8 + 4 * q + j4];
                    lo[2 * j4] = x[2 * j4] * cssn.x - y[2 * j4] * cssn.y; hi[2 * j4] = y[2 * j4] * cssn.x + x[2 * j4] * cssn.y;
                    lo[2 * j4 + 1] = x[2 * j4 + 1] * cssn.z - y[2 * j4 + 1] * cssn.w; hi[2 * j4 + 1] = y[2 * j4 + 1] * cssn.z + x[2 * j4 + 1] * cssn.w; }
                LAS unsigned char* d = F.lds + LK_OFF + key * KP + 2 * (64 * half + 8 * sp);
                *(LAS v4u*)d = pack8(lo); *(LAS v4u*)(d + 64) = pack8(hi); }
#pragma unroll
            for (int q = 0; q < 4; ++q) { const int pc = F.tid + q * NTHR; const int key = pc >> 4, c16 = pc & 15;
                *(LAS v4u*)(F.lds + LV_OFF + key * VP + 16 * c16) = __builtin_bit_cast(v4u, R[4 + q]); }
        } else {
#pragma unroll
            for (int q = 0; q < 4; ++q) { const int pc = F.tid + q * NTHR; const int key = pc >> 4, c16 = pc & 15;
                const f32x4 k0 = R[4 * q], k1 = R[4 * q + 1], v0 = R[4 * q + 2], v1 = R[4 * q + 3];
                v4u kw, vw; kw.x = cvtpk(k0.x, k0.y); kw.y = cvtpk(k0.z, k0.w); kw.z = cvtpk(k1.x, k1.y); kw.w = cvtpk(k1.z, k1.w);
                vw.x = cvtpk(v0.x, v0.y); vw.y = cvtpk(v0.z, v0.w); vw.z = cvtpk(v1.x, v1.y); vw.w = cvtpk(v1.z, v1.w);
                *(LAS v4u*)(F.lds + LK_OFF + key * KP + 16 * c16) = kw; *(LAS v4u*)(F.lds + LV_OFF + key * VP + 16 * c16) = vw; }
        }
        __syncthreads();
        if (chn < 4) {
            const int kr = r_start + 2 * chn + (kt >> 1), dr = kr - gr + 7;
            attn_tile<1, true>(W, qdummy, Ql, Kl, Vl, 32 * kt, F.lane, rp + dr * 31, 32 * (kt & 1), qc);
        } else {
            attn_tile<0, true>(W, qdummy, Ql, Kl, Vl, 32 * kt, F.lane, nullptr, 0, 0);
        }
    }
#undef LAT_PREFETCH
    __syncthreads();
    LAS float* ML = (LAS float*)F.lds; LAS float* OB = (LAS float*)(F.lds + 4096);
    ML[(F.wave * 2 + 0) * 64 + F.lane] = W.m; ML[(F.wave * 2 + 1) * 64 + F.lane] = W.l;
#pragma unroll
    for (int dt = 0; dt < 4; ++dt)
#pragma unroll
        for (int i = 0; i < 16; ++i) OB[(F.wave * 64 + dt * 16 + i) * 64 + F.lane] = W.O[dt][i];
    __syncthreads();
    {
        float mi[4], li[4], mt = -1.0e30f;
#pragma unroll
        for (int k = 0; k < 4; ++k) { const int w2 = 2 * k + qh; mi[k] = ML[(w2 * 2 + 0) * 64 + F.lane]; li[k] = ML[(w2 * 2 + 1) * 64 + F.lane]; mt = fmaxf(mt, mi[k]); }
        float wk[4], lt = 0.f;
#pragma unroll
        for (int k = 0; k < 4; ++k) { wk[k] = __expf(mi[k] - mt); lt += wk[k] * li[k]; }
        const float inv = 1.0f / lt;
#pragma unroll
        for (int k = 0; k < 4; ++k) wk[k] *= inv;
        bf16* yrow = Y + (size_t)mq * YW + 1024 + hd * 128 + 32 * kt + 4 * h;
#pragma unroll
        for (int g4 = 0; g4 < 4; ++g4) {
            float o[4];
#pragma unroll
            for (int i = 0; i < 4; ++i) { float sacc = 0.f;
#pragma unroll
                for (int k = 0; k < 4; ++k) sacc += wk[k] * OB[((2 * k + qh) * 64 + kt * 16 + 4 * g4 + i) * 64 + F.lane];
                o[i] = sacc; }
            v2u w; w.x = cvtpk(o[0], o[1]); w.y = cvtpk(o[2], o[3]);
            *(v2u*)(yrow + 8 * g4) = w;
            asm volatile("" ::: "memory");
        }
    }
    __syncthreads();
}

constexpr int AW_OFF = 0, AV_OFF = 128 * KP, AST_OFF = AV_OFF + 128 * VP;
__device__ __forceinline__ void unitA(const Args& a, const Ctx& F, int l, int unit) {
    const int ch = unit >> 3, g = unit & 7, m0 = ch * 128;
    const bf16* Z = (const bf16*)(a.ws + WS_Z); bf16* Y = (bf16*)(a.ws + WS_Y);
    LAS float* st = (LAS float*)(F.lds + AST_OFF);
    __syncthreads();
    if (F.tid < 128) {
        const float* ap = (const float*)(a.ws + WS_AST) + (size_t)(m0 + F.tid) * 32;
        float sm = 0.f, sq = 0.f;
#pragma unroll
        for (int q = 0; q < 8; ++q) { const f32x4 v = *(const f32x4*)(ap + 4 * q); sm += v.x + v.z; sq += v.y + v.w; }
        const float mean = sm * (1.0f / 1024.0f), var = fmaxf(sq * (1.0f / 1024.0f) - mean * mean, 0.f);
        st[F.tid] = mean; st[128 + F.tid] = 1.0f / sqrtf(var + EPS);
    }
    {
        const int t = F.tid >> 2, s0 = 32 * (F.tid & 3);
        const float* wp = a.a_w + ((size_t)(l * 8 + g) * 128 + t) * 128 + s0;
#pragma unroll
        for (int q = 0; q < 4; ++q) { const f32x4 w0 = *(const f32x4*)(wp + 8 * q), w1 = *(const f32x4*)(wp + 8 * q + 4);
            v4u o; o.x = cvtpk(w0.x, w0.y); o.y = cvtpk(w0.z, w0.w); o.z = cvtpk(w1.x, w1.y); o.w = cvtpk(w1.z, w1.w);
            *(LAS v4u*)(F.lds + AW_OFF + t * KP + 2 * (s0 + 8 * q)) = o; }
    }
    __syncthreads();
    {
        const int s = F.tid >> 2, c0 = 32 * (F.tid & 3);
        const float mean = st[s], rstd = st[128 + s];
        const bf16* rp = Z + (size_t)(m0 + s) * INW + 1024 + 128 * g + c0;
#pragma unroll
        for (int q = 0; q < 4; ++q) { float x[8]; unpack8(*(const v4u*)(rp + 8 * q), x);
#pragma unroll
            for (int j = 0; j < 8; ++j) x[j] = (x[j] - mean) * rstd;
            *(LAS v4u*)(F.lds + AV_OFF + s * VP + 2 * (c0 + 8 * q)) = pack8(x); }
    }
    __syncthreads();
    const int lane = F.lane, r = lane & 31, h = lane >> 5, gq = (lane >> 4) & 1, q4 = (lane & 15) >> 2, p4 = lane & 3;
    const int ttile = F.wave & 3, ct0 = 2 * (F.wave >> 2);
    f32x16 acc[2];
#pragma unroll
    for (int c2 = 0; c2 < 2; ++c2)
#pragma unroll
        for (int i = 0; i < 16; ++i) acc[c2][i] = 0.f;
    {
        const LAS unsigned char* wp = F.lds + AW_OFF + (32 * ttile + r) * KP + 16 * h;
        const LAS unsigned char* vp = F.lds + AV_OFF + (8 * h + q4) * VP + 2 * (32 * ct0 + 16 * gq) + 8 * p4;
#pragma unroll
        for (int ks = 0; ks < 8; ++ks) {
            const bf16x8 wb = *(const LAS bf16x8*)(wp + 32 * ks);
#pragma unroll
            for (int c2 = 0; c2 < 2; ++c2) {
                const LAS unsigned char* v0 = vp + 16 * ks * VP + 64 * c2;
                acc[c2] = MFMA32(tr_pair(v0, v0 + 4 * VP), wb, acc[c2]);
            }
        }
    }
    {
        const int t = 32 * ttile + r; const float bsv = a.a_b[(l * 8 + g) * 128 + t];
        const bf16* up = Z + (size_t)(m0 + t) * INW + 128 * g + 4 * h; bf16* yp = Y + (size_t)(m0 + t) * YW + 128 * g + 4 * h;
#pragma unroll
        for (int c2 = 0; c2 < 2; ++c2)
#pragma unroll
            for (int g4 = 0; g4 < 4; ++g4) {
                const int c = 32 * (ct0 + c2) + 8 * g4;
                const v2u uw = *(const v2u*)(up + c);
                v2u o; o.x = cvtpk(bf2f_lo(uw.x) * (acc[c2][4 * g4] + bsv), bf2f_hi(uw.x) * (acc[c2][4 * g4 + 1] + bsv));
                o.y = cvtpk(bf2f_lo(uw.y) * (acc[c2][4 * g4 + 2] + bsv), bf2f_hi(uw.y) * (acc[c2][4 * g4 + 3] + bsv));
                *(v2u*)(yp + c) = o;
            }
    }
    __syncthreads();
}

constexpr int HP = 272;
constexpr int HG_QD = 0, HG_KD = 32 * HP, HG_KL = 2 * 32 * HP, HG_V = 3 * 32 * HP, HG_G = 4 * 32 * HP, HG_BUF = HG_G + 512, HG_DIR = 2 * HG_BUF;
struct HgPre { v4u q[2], v[2]; f32x4 f[4]; };
__device__ __forceinline__ void hg_load(HgPre& P, const bf16* Z, const float* LOGF, size_t m, int dir, int hd, int d0) {
    const bf16* zr = Z + m * INW + hd * 128 + d0; const float* fr = LOGF + m * 2048 + dir * 1024 + hd * 128 + d0;
    P.q[0] = *(const v4u*)(zr + 5120); P.q[1] = *(const v4u*)(zr + 5128); P.v[0] = *(const v4u*)(zr + 8192); P.v[1] = *(const v4u*)(zr + 8200);
#pragma unroll
    for (int j = 0; j < 4; ++j) P.f[j] = *(const f32x4*)(fr + 4 * j);
}
template <int CTRL, int ROWMASK> __device__ __forceinline__ float dpp_add(float x) {
    return x + __int_as_float(__builtin_amdgcn_update_dpp(0, __float_as_int(x), CTRL, ROWMASK, 0xF, true)); }
__device__ __forceinline__ float scan32(float x) {
    x = dpp_add<0x111, 0xF>(x); x = dpp_add<0x112, 0xF>(x); x = dpp_add<0x114, 0xF>(x); x = dpp_add<0x118, 0xF>(x); x = dpp_add<0x142, 0xA>(x); return x; }
__device__ __forceinline__ void hg_estep(const HgPre& P, LAS unsigned char* buf, int lane_, int w4) {
    int lane = lane_; asm volatile("" : "+v"(lane));
    const int tt = lane & 31, hf = lane >> 5, d0 = 32 * w4 + 16 * hf;
    float bl[16];
#pragma unroll
    for (int j = 0; j < 16; ++j) bl[j] = scan32(P.f[j >> 2][j & 3]);
    LAS unsigned char* row = buf + tt * HP + 2 * d0;
#pragma unroll
    for (int hh = 0; hh < 2; ++hh) {
        float qd[8], kd[8], kl[8];
        float q[8]; unpack8(P.q[hh], q);
#pragma unroll
        for (int j = 0; j < 8; ++j) { const int jj = 8 * hh + j; const float bC0 = __int_as_float(__builtin_amdgcn_readlane(__float_as_int(bl[jj]), 31)), bC1 = __int_as_float(__builtin_amdgcn_readlane(__float_as_int(bl[jj]), 63)); const float bC = hf ? bC1 : bC0; const float k = 1.0f - __builtin_amdgcn_exp2f(P.f[jj >> 2][jj & 3]);
            qd[j] = q[j] * __builtin_amdgcn_exp2f(bl[jj]); kd[j] = k * __builtin_amdgcn_exp2f(fminf(-bl[jj], 115.0f)); kl[j] = k * __builtin_amdgcn_exp2f(bC - bl[jj]); }
        *(LAS v4u*)(row + HG_QD + 16 * hh) = pack8(qd); *(LAS v4u*)(row + HG_KD + 16 * hh) = pack8(kd); *(LAS v4u*)(row + HG_KL + 16 * hh) = pack8(kl);
        asm volatile("" ::: "memory");
    }
    *(LAS v4u*)(row + HG_V) = P.v[0]; *(LAS v4u*)(row + HG_V + 16) = P.v[1];
    if (tt == 31) {
#pragma unroll
        for (int j4 = 0; j4 < 4; ++j4) *(LAS f32x4*)(buf + HG_G + 4 * (d0 + 4 * j4)) = (f32x4){__builtin_amdgcn_exp2f(bl[4 * j4]), __builtin_amdgcn_exp2f(bl[4 * j4 + 1]), __builtin_amdgcn_exp2f(bl[4 * j4 + 2]), __builtin_amdgcn_exp2f(bl[4 * j4 + 3])};
    }
}
__device__ __forceinline__ void hg_mstep(f32x16 (&S)[4], const LAS unsigned char* buf, int lane_, int w4, bf16* Og, int c, int n, int dir, int mbase, int hd) {
    int lane = lane_; asm volatile("" : "+v"(lane));
    const int r = lane & 31, h = lane >> 5, g = (lane >> 4) & 1, q4 = (lane & 15) >> 2, p4 = lane & 3;
    f32x16 X0;
#pragma unroll
    for (int i = 0; i < 16; ++i) X0[i] = 0.f;
    {   const LAS unsigned char* kp = buf + HG_KD + r * HP + 16 * h; const LAS unsigned char* qp = buf + HG_QD + r * HP + 16 * h;
#pragma unroll
        for (int ks = 0; ks < 8; ++ks) X0 = MFMA32(*(const LAS bf16x8*)(kp + 32 * ks), *(const LAS bf16x8*)(qp + 32 * ks), X0); }
    f32x16 O0;
#pragma unroll
    for (int i = 0; i < 16; ++i) O0[i] = 0.f;
    {
        const LAS unsigned char* qp = buf + HG_QD + r * HP + 8 * h;
#pragma unroll
        for (int dt = 0; dt < 4; ++dt)
#pragma unroll
            for (int st = 0; st < 2; ++st) {
                const s16x4 lo = *(const LAS s16x4*)(qp + 2 * (32 * dt + 16 * st)), hi = *(const LAS s16x4*)(qp + 2 * (32 * dt + 16 * st + 8));
                O0 = MFMA32(__builtin_shufflevector(lo, hi, 0, 1, 2, 3, 4, 5, 6, 7), pack_regs(S[dt], st), O0);
            }
    }
#pragma unroll
    for (int i = 0; i < 16; ++i) { const int srow = (i & 3) + 8 * (i >> 2) + 4 * h; X0[i] = (srow <= r) ? X0[i] : 0.f; }
    {
        const LAS unsigned char* vp = buf + HG_V + (4 * h + q4) * HP + 2 * (32 * w4 + 16 * g) + 8 * p4;
        O0 = MFMA32(pack_regs(X0, 0), tr_pair(vp, vp + 8 * HP), O0);
        O0 = MFMA32(pack_regs(X0, 1), tr_pair(vp + 16 * HP, vp + 24 * HP), O0);
    }
    asm volatile("" ::: "memory");
    {
        const LAS float* G = (const LAS float*)(buf + HG_G);
        const LAS unsigned char* vp = buf + HG_V + (8 * h + q4) * HP + 2 * (32 * w4 + 16 * g) + 8 * p4;
        const bf16x8 vb0 = tr_pair(vp, vp + 4 * HP), vb1 = tr_pair(vp + 16 * HP, vp + 20 * HP);
#pragma unroll
        for (int dt = 0; dt < 4; ++dt) {
#pragma unroll
            for (int g4 = 0; g4 < 4; ++g4) { const f32x4 gv = *(const LAS f32x4*)(G + 32 * dt + 8 * g4 + 4 * h);
#pragma unroll
                for (int jj = 0; jj < 4; ++jj) S[dt][4 * g4 + jj] *= gv[jj]; }
            const LAS unsigned char* kp = buf + HG_KL + (8 * h + q4) * HP + 2 * (32 * dt + 16 * g) + 8 * p4;
            S[dt] = MFMA32(tr_pair(kp, kp + 4 * HP), vb0, S[dt]);
            S[dt] = MFMA32(tr_pair(kp + 16 * HP, kp + 20 * HP), vb1, S[dt]);
                }
    }
    {
        const int tb = 32 * c + 4 * h; const int p0 = dir ? (n - 1 - tb) : tb, stp = dir ? -1024 : 1024;
        bf16* ob = Og + (size_t)mbase * 1024 + hd * 128 + 32 * w4;
        const int o0 = p0 * 1024 + r;
#pragma unroll
        for (int i = 0; i < 16; ++i) ob[o0 + ((i & 3) + 8 * (i >> 2)) * stp] = (bf16)(cvtpk(O0[i], 0.f) & 0xffffu);
    }
}
__device__ __forceinline__ void unitHgrn(const Args& a, const Ctx& F, int l, bool lat, int b, int hd, int dir0, int ndir) {
    const bf16* Z = (const bf16*)(a.ws + WS_Z); const float* LOGF = (const float*)(a.ws + WS_LOGF); bf16* Y = (bf16*)(a.ws + WS_Y);
    const int w4 = F.wave >> 1, lane = F.lane;
    LAS unsigned char* base = F.lds;
    const int n = lat ? 1024 : 256, mbase = lat ? NCTX + b * 1024 : b * 256, nch = n >> 5, ng = ndir * nch;
    __syncthreads();
    if ((F.wave & 1) == 0) {
        const int tt = lane & 31, d0 = 32 * w4 + 16 * (lane >> 5);
        HgPre P;
        hg_load(P, Z, LOGF, (size_t)(mbase + (dir0 ? (n - 1 - tt) : tt)), dir0, hd, d0);
        hg_estep(P, base, lane, w4);
        {   const int g1 = 1, sw1 = (g1 >= nch), dir1 = dir0 + sw1, c1 = g1 - sw1 * nch, p1 = 32 * c1 + tt; hg_load(P, Z, LOGF, (size_t)(mbase + (dir1 ? (n - 1 - p1) : p1)), dir1, hd, d0); }
        asm volatile("s_waitcnt lgkmcnt(0)" ::: "memory"); __builtin_amdgcn_s_barrier(); asm volatile("" ::: "memory");
#pragma unroll 1
        for (int g = 0; g < ng; ++g) {
            if (g + 1 < ng) {
                hg_estep(P, base + ((g + 1) & 1) * HG_BUF, lane, w4);
                if (g + 2 < ng) { const int g2 = g + 2, sw2 = (g2 >= nch), dir2 = dir0 + sw2, c2 = g2 - sw2 * nch, p2 = 32 * c2 + tt; hg_load(P, Z, LOGF, (size_t)(mbase + (dir2 ? (n - 1 - p2) : p2)), dir2, hd, d0); }
            }
            asm volatile("s_waitcnt lgkmcnt(0)" ::: "memory"); __builtin_amdgcn_s_barrier(); asm volatile("" ::: "memory");
        }
    } else {
        const int r = lane & 31, h = lane >> 5, h512 = 512 * h;
        f32x16 S[4];
        if (lat) {
            const float* sp = a.state + ((((size_t)b * 4 + l) * 2 + dir0) * 8 + hd) * 16384 + 32 * w4 + r;
#pragma unroll
            for (int dt = 0; dt < 4; ++dt)
#pragma unroll
                for (int i = 0; i < 16; ++i) S[dt][i] = sp[(32 * dt + (i & 3) + 8 * (i >> 2)) * 128 + h512];
        } else {
#pragma unroll
            for (int dt = 0; dt < 4; ++dt)
#pragma unroll
                for (int i = 0; i < 16; ++i) S[dt][i] = 0.f;
        }
        asm volatile("s_waitcnt lgkmcnt(0)" ::: "memory"); __builtin_amdgcn_s_barrier(); asm volatile("" ::: "memory");
#pragma unroll 1
        for (int g = 0; g < ng; ++g) {
            const int sw = (g >= nch), dir = dir0 + sw, c = g - sw * nch;
            if (g == nch) {
                if (!lat) {
                    float* so = a.out + OUT_S + ((((size_t)b * 4 + l) * 2 + 0) * 8 + hd) * 16384 + 32 * w4 + r;
#pragma unroll
                    for (int dt = 0; dt < 4; ++dt)
#pragma unroll
                        for (int i = 0; i < 16; ++i) { so[(32 * dt + (i & 3) + 8 * (i >> 2)) * 128 + h512] = S[dt][i]; S[dt][i] = 0.f; }
                } else {
                    const float* sp = a.state + ((((size_t)b * 4 + l) * 2 + 1) * 8 + hd) * 16384 + 32 * w4 + r;
#pragma unroll
                    for (int dt = 0; dt < 4; ++dt)
#pragma unroll
                        for (int i = 0; i < 16; ++i) S[dt][i] = sp[(32 * dt + (i & 3) + 8 * (i >> 2)) * 128 + h512];
                }
            }
            hg_mstep(S, base + (g & 1) * HG_BUF, lane, w4, (bf16*)(a.ws + (dir ? WS_OB : WS_OF)), c, n, dir, mbase, hd);
            asm volatile("s_waitcnt lgkmcnt(0)" ::: "memory"); __builtin_amdgcn_s_barrier(); asm volatile("" ::: "memory");
        }
        if (!lat) {
            float* so = a.out + OUT_S + ((((size_t)b * 4 + l) * 2 + 1) * 8 + hd) * 16384 + 32 * w4 + r;
#pragma unroll
            for (int dt = 0; dt < 4; ++dt)
#pragma unroll
                for (int i = 0; i < 16; ++i) so[(32 * dt + (i & 3) + 8 * (i >> 2)) * 128 + h512] = S[dt][i];
        }
    }
    if (lat) {
        __syncthreads();
        volatile LAS unsigned* bc = (volatile LAS unsigned*)(F.lds + LDSCTL_OFF) + 5;
        if (F.tid == 0) {
            __builtin_amdgcn_fence(__ATOMIC_RELEASE, "agent"); asm volatile("s_waitcnt vmcnt(0)" ::: "memory");
            const unsigned old = __hip_atomic_fetch_add((unsigned*)(a.ws + WS_CTL) + CW_LC + 64 * (l * 16 + b * 8 + hd), 1u, __ATOMIC_RELAXED, __HIP_MEMORY_SCOPE_AGENT);
            if (old == 1u) { __builtin_amdgcn_fence(__ATOMIC_ACQUIRE, "agent"); asm volatile("s_waitcnt vmcnt(0)" ::: "memory"); }
            bc[0] = old;
        }
        __syncthreads();
        if (bc[0] != 1u) { __syncthreads(); return; }
    }
    __syncthreads();
    {
        const bf16* OFp = (const bf16*)(a.ws + WS_OF); const bf16* OBp = (const bf16*)(a.ws + WS_OB);
        const int e16 = 16 * (F.tid & 7);
#pragma unroll 1
        for (int t0 = 0; t0 < n; t0 += 128) {
            v4u rf[2][2], rb[2][2], rg[2][2];
#pragma unroll
            for (int q = 0; q < 2; ++q) { const size_t m = (size_t)(mbase + t0 + 64 * q + (F.tid >> 3));
#pragma unroll
                for (int j2 = 0; j2 < 2; ++j2) { rf[q][j2] = *((const v4u*)(OFp + m * 1024 + hd * 128 + e16) + j2); rb[q][j2] = *((const v4u*)(OBp + m * 1024 + hd * 128 + e16) + j2);
                    rg[q][j2] = *(const v4u*)(Z + m * INW + 9216 + hd * 128 + e16 + 8 * j2); } }
#pragma unroll
            for (int q = 0; q < 2; ++q) { const size_t m = (size_t)(mbase + t0 + 64 * q + (F.tid >> 3));
                float o[16]; float ss = 0.f;
#pragma unroll
                for (int j2 = 0; j2 < 2; ++j2) { float pf[8], pb[8]; unpack8(rf[q][j2], pf); unpack8(rb[q][j2], pb);
#pragma unroll
                    for (int k = 0; k < 8; ++k) { const float sv = pf[k] + pb[k]; o[8 * j2 + k] = sv; ss += sv * sv; } }
                ss += __shfl_xor(ss, 1); ss += __shfl_xor(ss, 2); ss += __shfl_xor(ss, 4);
                const float rn = 1.0f / sqrtf(ss * (1.0f / 128.0f) + EPS);
                float g0[8], g1[8]; unpack8(rg[q][0], g0); unpack8(rg[q][1], g1);
                float y0[8], y1[8];
#pragma unroll
                for (int k = 0; k < 8; ++k) { y0[k] = o[k] * rn * g0[k]; y1[k] = o[8 + k] * rn * g1[k]; }
                *(v4u*)(Y + m * YW + 2048 + hd * 128 + e16) = pack8(y0); *(v4u*)(Y + m * YW + 2048 + hd * 128 + e16 + 8) = pack8(y1); }
        }
    }
    __syncthreads();
}

__device__ __forceinline__ const Args* args_ptr() { unsigned long long p = (unsigned long long)__builtin_amdgcn_kernarg_segment_ptr(); asm volatile("" : "+s"(p)); return (const Args*)(const void __attribute__((address_space(4)))*)p; }
__device__ __forceinline__ Ctx make_ctx() {
    Ctx F; int t = threadIdx.x; asm volatile("" : "+v"(t));
    unsigned z = 0; asm volatile("" : "+s"(z));
    F.lds = (LAS unsigned char*)(uintptr_t)z;
    F.tid = t; F.lane = t & 63; F.wave = __builtin_amdgcn_readfirstlane(t >> 6);
    F.G = gridDim.x; { const int bx = blockIdx.x; F.vcu = (F.G % 8 == 0) ? (bx % 8) * (F.G / 8) + bx / 8 : bx; }
    return F;
}
constexpr int NU_CV0 = (IT_LAYER - IT_IN + 8) / 24; static_assert(NU_CV0 * 24 == IT_LAYER - IT_IN + 8, "layer-0 deferred conversion tickets");
constexpr int NU_CV = 800, NU_HL = 32, NU_AL = 256, NU_HC = 256, NU_AC = 256, NU_A = 640, NU_M1 = NU_HL + NU_AL + NU_HC + NU_AC + NU_A;
#ifndef PROBE_UT
#define PROBE_UT (-1)
#endif
__device__ __forceinline__ void phase_mixers(int l, int qslot) {
    for (;;) {
        int u;
        {   const Args& a = *args_ptr(); const Ctx F = make_ctx();
            unsigned* head = (unsigned*)(a.ws + WS_CTL) + CW_Q + 64 * qslot;
            volatile LAS unsigned* bc = (volatile LAS unsigned*)(F.lds + LDSCTL_OFF) + 4;
            __syncthreads();
            if (F.tid == 0) bc[0] = __hip_atomic_fetch_add(head, 1u, __ATOMIC_RELAXED, __HIP_MEMORY_SCOPE_AGENT);
            __syncthreads();
            u = (int)bc[0]; }
        u = __builtin_amdgcn_readfirstlane(u);
        if (u < NU_HL) { for (int rr = 0; rr < (PROBE_UT == 0 ? 2 : 1); ++rr) { const Args& a = *args_ptr(); const Ctx F = make_ctx(); unitHgrn(a, F, l, true, u >> 4, (u >> 1) & 7, u & 1, 1); } continue; }
        u -= NU_HL;
        if (l < DEPTH - 1) {
            int cl = -1, r0 = 0;
            {
                if (u >= 2 * (NU_M1 - NU_HL)) break;
                const int trip = u >> 1, ncv = NU_CV + (l == 0 ? NU_CV0 : 0);
                if (u & 1) { if (trip >= ncv) continue; cl = (trip < NU_CV) ? l + 1 : 0; r0 = (trip < NU_CV) ? trip * 24 : (IT_IN - 8) + (trip - NU_CV) * 24; }
                else u = trip;
            }
            if (cl >= 0) {
                const Args& a = *args_ptr(); const Ctx F = make_ctx();
                LAS float* scr = (LAS float*)(F.lds + F.wave * 16640);
                cvt_three(a, cl, r0 + F.wave, 8, scr, F.lane);
                continue;
            }
        } else if (u >= NU_M1 - NU_HL) break;
        if (u < NU_HC) { for (int rr = 0; rr < (PROBE_UT == 2 ? 2 : 1); ++rr) { const Args& a = *args_ptr(); const Ctx F = make_ctx(); unitHgrn(a, F, l, false, u >> 3, u & 7, 0, 2); } continue; }
        u -= NU_HC;
        if (u < NU_AL) { for (int rr = 0; rr < (PROBE_UT == 1 ? 2 : 1); ++rr) { const Args& a = *args_ptr(); const Ctx F = make_ctx(); unitAttnLat(a, F, l, u); } continue; }
        u -= NU_AL;
        if (u < NU_AC) { for (int rr = 0; rr < (PROBE_UT == 3 ? 2 : 1); ++rr) { const Args& a = *args_ptr(); const Ctx F = make_ctx(); unitAttnCtx(a, F, u); } continue; }
        u -= NU_AC;
        for (int rr = 0; rr < (PROBE_UT == 4 ? 2 : 1); ++rr) { const Args& a = *args_ptr(); const Ctx F = make_ctx(); unitA(a, F, l, u); }
    }
}

__global__ void __launch_bounds__(NTHR, 2) fwd(Args a_in) {
    extern __shared__ __attribute__((aligned(16))) unsigned char lds_raw[];
    volatile LAS unsigned* MISC = (volatile LAS unsigned*)((LAS unsigned char*)lds_raw + LDSCTL_OFF);
    for (int u = threadIdx.x; u < 256; u += NTHR) MISC[u] = 0u;
    __syncthreads();
    const int lo = a_in.ph_lo, hi = a_in.ph_hi;
    const bool multi = (hi - lo) > 1;
    XcdBarrier bar; bar.bar = (unsigned*)(a_in.ws + WS_CTL) + CW_BAR; bar.x = 0; bar.st = MISC;
    if (multi) bar = xcd_barrier_post((unsigned*)(a_in.ws + WS_CTL) + CW_BAR, MISC);
#ifndef PMASK
#define PMASK 0xFFFFFFFFu
#endif
#define PM(b) ((PMASK >> (b)) & 1u)
#define IN(k) (lo <= (k) && (k) < hi)
#ifndef TS_PHASE
#define TS_PHASE (-1)
#define TS_MULT 0
#endif
    unsigned long long ts0 = 0ull, tsd = 0ull;
#define TS_START(gp) do { if (TS_PHASE >= 0 && (gp) == TS_PHASE) ts0 = __builtin_amdgcn_s_memrealtime(); } while (0)
#define SEAM(k) do { if (IN(k) && IN((k) + 1)) xcd_barrier(bar); if (TS_PHASE >= 0 && (k) == TS_PHASE) tsd = __builtin_amdgcn_s_memrealtime() - ts0; } while (0)
#ifndef PROBE_P
#define PROBE_P (-1)
#define PROBE_N 0
#define PROBE_L 1
#endif
#define REP_BEGIN(k) for (int rep = 0; rep < ((PROBE_P == (k) && l == PROBE_L) ? 1 + PROBE_N : 1); ++rep) {
#define REP_END(k) if (PROBE_P == (k) && l == PROBE_L && rep < PROBE_N) xcd_barrier(bar); }

    if (PM(0) && IN(PH_PRO)) { const int l = PROBE_L; TS_START(PH_PRO); REP_BEGIN(0) const Args& a = *args_ptr(); const Ctx F = make_ctx(); phase_prologue(a, F); REP_END(0) SEAM(PH_PRO); }
    if (PM(1) && IN(PH_T1)) { const int l = PROBE_L; TS_START(PH_T1); REP_BEGIN(1) const Args& a = *args_ptr(); const Ctx F = make_ctx(); const float* MOD = (const float*)(a.ws + WS_MOD);
        rownorm_phase(a, F, true, nullptr, nullptr, nullptr, true, a.norm_g + 0, MOD + 1 * 2048, MOD + 0 * 2048); REP_END(1) SEAM(PH_T1); }

    for (int l = 0; l < DEPTH; ++l) {
        const int pb = PH_L0 + l * PH_PER_LAYER;
        if (PM(2) && IN(pb + 0)) { TS_START(pb + 0); REP_BEGIN(2)
            const Args& a = *args_ptr(); const Ctx F = make_ctx(); unsigned char* ws = a.ws; const bf16* wl = (const bf16*)(ws + WS_WT) + (size_t)l * WL_ELEMS;
            pg8::Gemm g{(const bf16*)(ws + WS_H), wl + OFF_IN, MTOK, INW, DM, DM, DM, 0}; pg8::ReverseNOrder S; S.init(MTOK, INW, F.G, (int)blockIdx.x);
            EpiIn E{(bf16*)(ws + WS_Z), (float*)(ws + WS_LOGF), (const float*)(ws + WS_LB) + l * 1024, a.out + OUT_K + (size_t)l * 262144, a.out + OUT_V + (size_t)l * 262144, (float*)(ws + WS_AST)};
            pg8::gemm_phase<EpiIn, pg8::ReverseNOrder, true, true>(F.lds, g, S, E);
            REP_END(2) SEAM(pb + 0);
        }
        if (PM(3) && IN(pb + 1)) { TS_START(pb + 1); REP_BEGIN(3) phase_mixers(l, l + 4 * rep); REP_END(3) SEAM(pb + 1); }
        if (PM(5) && IN(pb + 3)) { TS_START(pb + 3); REP_BEGIN(5)
            const Args& a = *args_ptr(); const Ctx F = make_ctx(); unsigned char* ws = a.ws; const bf16* wl = (const bf16*)(ws + WS_WT) + (size_t)l * WL_ELEMS;
            pg8::StaticOrder S; S.init(NCTX, DM, F.G, (int)blockIdx.x);
            pg8::Gemm g{(const bf16*)(ws + WS_Y), wl + OFF_UP, MTOK, DM, YW, YW, YW, 0}; EpiUpK E{(const bf16*)(ws + WS_Z) + 10240, (bf16*)(ws + WS_MG)};
            pg8::gemm_phase<EpiUpK, pg8::StaticOrder, true, true>(F.lds, g, S, E);
            REP_END(5) SEAM(pb + 3);
        }
        if (PM(6) && IN(pb + 4)) { TS_START(pb + 4); REP_BEGIN(6)
            {   const Args& a = *args_ptr(); const Ctx F = make_ctx(); unsigned char* ws = a.ws; const bf16* wl = (const bf16*)(ws + WS_WT) + (size_t)l * WL_ELEMS;
                pg8::TailOrder S; S.init(F.G, (int)blockIdx.x, NCTX / 256);
                pg8::Gemm g{(const bf16*)(ws + WS_Y), wl + OFF_UP, MTOK, DM, YW, YW, YW, 0}; EpiUpK E{(const bf16*)(ws + WS_Z) + 10240, (bf16*)(ws + WS_MG)};
                pg8::gemm_phase<EpiUpK, pg8::TailOrder, true, true>(F.lds, g, S, E); }
            {   const Args& a = *args_ptr(); const Ctx F = make_ctx(); unsigned char* ws = a.ws; const bf16* wl = (const bf16*)(ws + WS_WT) + (size_t)l * WL_ELEMS;
                pg8::Gemm g{(const bf16*)(ws + WS_MG), wl + OFF_OUT, NCTX, DM, DM, DM, DM, 0}; pg8::SubOrder S; S.init(NCTX, DM, F.G, (int)blockIdx.x, F.G > 128 ? 64 : 0);
                EpiBf16P E{(bf16*)(ws + WS_T), DM, 0}; pg8::gemm_phase<EpiBf16P, pg8::SubOrder, true, true>(F.lds, g, S, E); }
            xcd_barrier(bar);
            {   const Args& a = *args_ptr(); const Ctx F = make_ctx(); unsigned char* ws = a.ws; const bf16* wl = (const bf16*)(ws + WS_WT) + (size_t)l * WL_ELEMS;
                pg8::Gemm g{(const bf16*)(ws + WS_MG) + (size_t)NCTX * DM, wl + OFF_OUT, NLAT, DM, DM / 4, DM, DM, (DM / 4) * 2}; pg8::SplitOrder S; S.init(F.G, (int)blockIdx.x);
                EpiBf16P E{(bf16*)(ws + WS_TP), DM, TPQ}; pg8::gemm_phase<EpiBf16P, pg8::SplitOrder, true, true>(F.lds, g, S, E); }
            REP_END(6) SEAM(pb + 4);
        }
        if (PM(7) && IN(pb + 5)) { TS_START(pb + 5); REP_BEGIN(7) const Args& a = *args_ptr(); const Ctx F = make_ctx(); const float* modl = (const float*)(a.ws + WS_MOD) + (size_t)l * 3 * 12288; const float* gl = a.norm_g + (size_t)l * 4 * DM;
            rownorm_phase(a, F, false, (const bf16*)(a.ws + WS_T), modl + 2 * 2048, gl + 1 * DM, true, gl + 2 * DM, modl + 4 * 2048, modl + 3 * 2048); REP_END(7) SEAM(pb + 5); }
        if (PM(8) && IN(pb + 6)) { TS_START(pb + 6); REP_BEGIN(8)
            const Args& a = *args_ptr(); const Ctx F = make_ctx(); unsigned char* ws = a.ws; const bf16* wl = (const bf16*)(ws + WS_WT) + (size_t)l * WL_ELEMS;
            pg8::Gemm g{(const bf16*)(ws + WS_H), wl + OFF_FI, MTOK, NFI, DM, DM, DM, 0}; pg8::StaticOrder S; S.init(MTOK, NFI, F.G, (int)blockIdx.x);
            EpiSwi E{(bf16*)(ws + WS_ACT)}; pg8::gemm_phase<EpiSwi, pg8::StaticOrder, true, true>(F.lds, g, S, E);
            REP_END(8) SEAM(pb + 6);
        }
        if (PM(9) && IN(pb + 7)) { TS_START(pb + 7); REP_BEGIN(9)
            {   const Args& a = *args_ptr(); const Ctx F = make_ctx(); unsigned char* ws = a.ws; const bf16* wl = (const bf16*)(ws + WS_WT) + (size_t)l * WL_ELEMS;
                pg8::Gemm g{(const bf16*)(ws + WS_ACT), wl + OFF_FO, NCTX, DM, DFF, DFF, DFF, 0}; pg8::StaticOrder S; S.init(NCTX, DM, F.G, (int)blockIdx.x);
                EpiBf16P E{(bf16*)(ws + WS_T), DM, 0}; pg8::gemm_phase<EpiBf16P, pg8::StaticOrder, true, true>(F.lds, g, S, E); }
            {   const Args& a = *args_ptr(); const Ctx F = make_ctx(); unsigned char* ws = a.ws; const bf16* wl = (const bf16*)(ws + WS_WT) + (size_t)l * WL_ELEMS;
                pg8::Gemm g{(const bf16*)(ws + WS_ACT) + (size_t)NCTX * DFF, wl + OFF_FO, NLAT, DM, DFF / 4, DFF, DFF, (DFF / 4) * 2}; pg8::SplitOrder S; S.init(F.G, (int)blockIdx.x);
                EpiBf16P E{(bf16*)(ws + WS_TP), DM, TPQ}; pg8::gemm_phase<EpiBf16P, pg8::SplitOrder, true, true>(F.lds, g, S, E); }
            REP_END(9) SEAM(pb + 7);
        }
        if (PM(10) && IN(pb + 8)) { TS_START(pb + 8); REP_BEGIN(10)
            const Args& a = *args_ptr(); const Ctx F = make_ctx(); const float* MOD = (const float*)(a.ws + WS_MOD);
            const bool last = (l == DEPTH - 1); const int ln = last ? l : l + 1;
            const float* modl = MOD + (size_t)l * 3 * 12288; const float* gl = a.norm_g + (size_t)l * 4 * DM;
            const float* modn = MOD + (size_t)ln * 3 * 12288; const float* gnn = a.norm_g + (size_t)ln * 4 * DM;
            rownorm_phase(a, F, false, (const bf16*)(a.ws + WS_T), modl + 5 * 2048, gl + 3 * DM, !last, gnn + 0, modn + 1 * 2048, modn + 0 * 2048);
            REP_END(10) SEAM(pb + 8);
        }
    }
    if (TS_PHASE >= 0 && blockIdx.x == 0 && threadIdx.x == 0) { const unsigned long long t0 = __builtin_amdgcn_s_memrealtime(); while (__builtin_amdgcn_s_memrealtime() - t0 < (unsigned long long)TS_MULT * tsd) __builtin_amdgcn_s_sleep(8); }
#undef IN
#undef SEAM
#undef REP_BEGIN
#undef REP_END
}

#ifndef MK_ONE_LAUNCH
#define MK_ONE_LAUNCH 1
#endif
extern "C" void kernel_launch(void* const* d_in, const int* in_sizes, int n_in, void* d_out, int out_size, void* d_ws, size_t ws_size, hipStream_t stream) {
    static int grid = 0;
    if (grid == 0) {
        if (n_in != 21 || (size_t)out_size != OUT_END || ws_size < WS_END) { fprintf(stderr, "kernel_launch: unexpected shapes: n_in %d out %d ws %zu\n", n_in, out_size, ws_size); grid = -1; return; }
        int dev = 0, cus = 0, per_cu = 0;
        if (hipGetDevice(&dev) != hipSuccess || hipDeviceGetAttribute(&cus, hipDeviceAttributeMultiprocessorCount, dev) != hipSuccess) { grid = -1; return; }
        if (hipFuncSetAttribute((const void*)fwd, hipFuncAttributeMaxDynamicSharedMemorySize, LDS_BYTES) != hipSuccess) { fprintf(stderr, "kernel_launch: hipFuncSetAttribute failed\n"); grid = -1; return; }
        if (hipOccupancyMaxActiveBlocksPerMultiprocessor(&per_cu, (const void*)fwd, NTHR, LDS_BYTES) != hipSuccess || per_cu < 1) fprintf(stderr, "kernel_launch: occupancy query says %d\n", per_cu);
        (void)hipGetLastError();
        grid = cus;
    }
    if (grid < 0) return;
    (void)hipMemsetAsync((char*)d_ws + WS_CTL, 0, CTL_ZERO_BYTES, stream);
    Args a{};
    const float** ap = (const float**)&a;
    for (int i = 0; i < 21; ++i) ap[i] = (const float*)d_in[i];
    a.out = (float*)d_out; a.ws = (unsigned char*)d_ws;
#if MK_ONE_LAUNCH
    a.ph_lo = 0; a.ph_hi = PH_END;
    hipLaunchKernelGGL(fwd, dim3(grid), dim3(NTHR), LDS_BYTES, stream, a);
#else
    for (int p = 0; p < PH_END; ++p) { a.ph_lo = p; a.ph_hi = p + 1; hipLaunchKernelGGL(fwd, dim3(grid), dim3(NTHR), LDS_BYTES, stream, a); }
#endif
}
```
